# Optimizing an MI355X kernel written in HIP

```python
import math
import jax
import jax.numpy as jnp
from jax import lax
import numpy as np

D_MODEL = 1024
BATCH = 8
SEQ = 4096
DEPTH = 4

N_EVEN = (DEPTH + 1) // 2
N_ODD = DEPTH // 2
EPS = 1e-6
ROPE_BASE = 10000.0

ML_HEADS = 4
ML_DK = 128
ML_DV = 128
ML_CONV = 5
ML_CHUNK = 128

MLA_HEADS = 8
MLA_Q_LORA = 256
MLA_KV_LORA = 128
MLA_NOPE = 64
MLA_ROPE = 32
MLA_V = 64
MLA_QK = MLA_NOPE + MLA_ROPE
Q_BLOCK = 128

EVEN_IN_SIZES = (ML_HEADS * ML_DK, ML_HEADS * ML_DK, ML_HEADS * ML_DV, ML_HEADS * ML_DV, 4 * ML_HEADS, MLA_Q_LORA, MLA_KV_LORA, MLA_ROPE)
EVEN_IN = sum(EVEN_IN_SIZES)
MIX_WIDTH = ML_HEADS * ML_DV + MLA_HEADS * MLA_V

RET_HEADS = 4
RET_DK = 256
RET_DV = 512
RET_CHUNK = 128
RET_IN_SIZES = (RET_HEADS * RET_DK, RET_HEADS * RET_DK, RET_HEADS * RET_DV, RET_HEADS * RET_DV)
RET_IN = sum(RET_IN_SIZES)

N_EXPERTS = 32
TOP_K = 4
EXPERT_FF = 1024
SWIGLU_LIMIT = 7.0
SWIGLU_ALPHA = 1.702
MOE_BLOCK = 256

kernel_name = 'hybrid_mlstm_mla_retention_moe_encoder'


def _split(t, sizes):
    return jnp.split(t, np.cumsum(sizes)[:-1].tolist(), axis=-1)


def _rms_norm(x, g):
    xf = x.astype(jnp.float32)
    y = xf * lax.rsqrt(jnp.mean(xf * xf, axis=-1, keepdims=True) + EPS)
    return (y * g.astype(jnp.float32)).astype(x.dtype)


def _head_group_norm(y, g):
    mu = jnp.mean(y, axis=-1, keepdims=True)
    yc = y - mu
    var = jnp.mean(yc * yc, axis=-1, keepdims=True)
    return yc * lax.rsqrt(var + EPS) * g.astype(jnp.float32)


def _rotary(x, pos):
    d = x.shape[-1]
    inv = ROPE_BASE ** (-jnp.arange(0, d, 2, dtype=jnp.float32) / d)
    ang = pos.astype(jnp.float32)[..., None] * inv
    ang = ang.reshape(ang.shape[:2] + (1,) * (x.ndim - 3) + (d // 2,))
    cos = jnp.cos(ang).astype(x.dtype)
    sin = jnp.sin(ang).astype(x.dtype)
    x1, x2 = jnp.split(x, 2, axis=-1)
    return jnp.concatenate([x1 * cos - x2 * sin, x2 * cos + x1 * sin], axis=-1)


def _to_heads(t, n):
    b, s, _ = t.shape
    return t.reshape(b, s, n, -1).transpose(0, 2, 1, 3)


def _from_heads(t):
    b, n, s, d = t.shape
    return t.transpose(0, 2, 1, 3).reshape(b, s, n * d)


def _to_chunks(t, L):
    b, h, s = t.shape[:3]
    return jnp.moveaxis(t.reshape((b, h, s // L, L) + t.shape[3:]), 2, 0)


def _from_chunks(t):
    nc, b, h, L, d = t.shape
    return jnp.moveaxis(t, 0, 2).reshape(b, h, nc * L, d)


def _centred_dwconv(x, w, bias):
    y = lax.conv_general_dilated(x, w[:, None, :].astype(x.dtype), window_strides=(1,), padding='SAME',
                                 dimension_numbers=('NWC', 'WIO', 'NWC'), feature_group_count=x.shape[-1])
    return y + bias


def _mlstm_scan(q, k, v, log_i, log_f):
    b, h, s, dk = q.shape
    dv = v.shape[-1]
    L = ML_CHUNK
    lower = jnp.tril(jnp.ones((L, L), dtype=bool))

    def step(carry, inp):
        cmat, nvec, m = carry
        qc, kc, vc, ic, fc = inp
        bcum = jnp.cumsum(fc, axis=-1)
        log_d = jnp.where(lower, bcum[..., :, None] - bcum[..., None, :] + ic[..., None, :], -jnp.inf)
        m_inter = bcum + m[..., None]
        m_t = jnp.maximum(m_inter, jnp.max(log_d, axis=-1))
        w = jnp.einsum('bhld,bhsd->bhls', qc, kc) * jnp.exp(log_d - m_t[..., None])
        a_inter = jnp.exp(m_inter - m_t)[..., None]
        num = jnp.einsum('bhls,bhsv->bhlv', w, vc) + a_inter * jnp.einsum('bhld,bhdv->bhlv', qc, cmat)
        den = jnp.sum(w, axis=-1, keepdims=True) + a_inter * jnp.einsum('bhld,bhd->bhl', qc, nvec)[..., None]
        out = num / jnp.maximum(jnp.abs(den), jnp.exp(-m_t)[..., None])
        g = bcum[..., -1:] - bcum + ic
        m_new = jnp.maximum(bcum[..., -1] + m, jnp.max(g, axis=-1))
        a_state = jnp.exp(bcum[..., -1] + m - m_new)
        kw = kc * jnp.exp(g - m_new[..., None])[..., None]
        cmat = a_state[..., None, None] * cmat + jnp.einsum('bhsd,bhsv->bhdv', kw, vc)
        nvec = a_state[..., None] * nvec + jnp.sum(kw, axis=2)
        return (cmat, nvec, m_new), out

    ch = lambda t: _to_chunks(t.astype(jnp.float32), L)
    carry0 = (jnp.zeros((b, h, dk, dv), jnp.float32), jnp.zeros((b, h, dk), jnp.float32), jnp.zeros((b, h), jnp.float32))
    _, out = lax.scan(step, carry0, (ch(q), ch(k), ch(v), ch(log_i), ch(log_f)))
    return _from_chunks(out)


def _retention_scan(q, k, v, log_gamma):
    b, h, s, dk = q.shape
    dv = v.shape[-1]
    L = RET_CHUNK
    idx = jnp.arange(L, dtype=jnp.float32)
    rel = idx[:, None] - idx[None, :]
    lg = log_gamma.astype(jnp.float32)[:, None, None]
    decay_in = jnp.where(rel >= 0, jnp.exp(jnp.maximum(rel, 0.0) * lg), 0.0)
    decay_q = jnp.exp((idx + 1.0) * lg[:, :, 0])[:, :, None]
    decay_k = jnp.exp((L - 1.0 - idx) * lg[:, :, 0])[:, :, None]
    decay_c = jnp.exp(L * lg)

    def step(state, inp):
        qc, kc, vc = inp
        scores = jnp.einsum('bhld,bhsd->bhls', qc, kc) * decay_in
        out = jnp.einsum('bhls,bhsv->bhlv', scores, vc) + decay_q * jnp.einsum('bhld,bhdv->bhlv', qc, state)
        state = decay_c * state + jnp.einsum('bhsd,bhsv->bhdv', kc * decay_k, vc)
        return state, out

    ch = lambda t: _to_chunks(t.astype(jnp.float32), L)
    _, out = lax.scan(step, jnp.zeros((b, h, dk, dv), jnp.float32), (ch(q), ch(k), ch(v)))
    return _from_chunks(out)


def _blocked_softmax_attention(q, k, v):
    b, h, s, d = q.shape
    qb = jnp.moveaxis(q.reshape(b, h, s // Q_BLOCK, Q_BLOCK, d), 2, 0)
    scale = d ** -0.5

    def block(qi):
        sc = jnp.einsum('bhqd,bhkd->bhqk', qi, k).astype(jnp.float32) * scale
        p = jax.nn.softmax(sc, axis=-1).astype(v.dtype)
        return jnp.einsum('bhqk,bhkv->bhqv', p, v)

    o = lax.map(block, qb)
    return _from_chunks(o)


def _hybrid_mixer(h, pos, w_in, conv_w, conv_b, gate_b, ml_norm_g, q_norm_g, kv_norm_g, w_qb, w_kvb, qk_q_g, qk_k_g, w_out):
    b, s, _ = h.shape
    q_m, k_m, v_m, o_m, gates, q_a, kv_a, k_r = _split(h @ w_in, EVEN_IN_SIZES)
    qk_m = jax.nn.silu(_centred_dwconv(jnp.concatenate([q_m, k_m], axis=-1), conv_w, conv_b))
    q_m, k_m = jnp.split(qk_m, 2, axis=-1)
    qh = _to_heads(q_m, ML_HEADS)
    kh = _to_heads(k_m, ML_HEADS) * (ML_DK ** -0.5)
    vh = _to_heads(v_m, ML_HEADS)
    gates = (gates + gate_b).astype(jnp.float32).reshape(b, s, 4, ML_HEADS).transpose(2, 0, 3, 1)
    i_f, f_f, i_b, f_b = gates[0], gates[1], gates[2], gates[3]
    flip = lambda t: jnp.flip(t, axis=2)
    h_fwd = _mlstm_scan(qh, kh, vh, i_f, jax.nn.log_sigmoid(f_f))
    h_bwd = flip(_mlstm_scan(flip(qh), flip(kh), flip(vh), flip(i_b), flip(jax.nn.log_sigmoid(f_b))))
    h_ml = _rms_norm(h_fwd + h_bwd, ml_norm_g.reshape(ML_HEADS, 1, ML_DV)).astype(h.dtype)
    h_ml = _from_heads(h_ml) * jax.nn.sigmoid(o_m)
    q = (_rms_norm(q_a, q_norm_g) @ w_qb).reshape(b, s, MLA_HEADS, MLA_QK)
    kv = (_rms_norm(kv_a, kv_norm_g) @ w_kvb).reshape(b, s, MLA_HEADS, MLA_NOPE + MLA_V)
    k_nope, v = jnp.split(kv, [MLA_NOPE], axis=-1)
    k = jnp.concatenate([k_nope, jnp.broadcast_to(k_r[:, :, None, :], (b, s, MLA_HEADS, MLA_ROPE))], axis=-1)
    q = _rms_norm(q, qk_q_g)
    k = _rms_norm(k, qk_k_g)
    q = jnp.concatenate([q[..., :MLA_NOPE], _rotary(q[..., MLA_NOPE:], pos)], axis=-1)
    k = jnp.concatenate([k[..., :MLA_NOPE], _rotary(k[..., MLA_NOPE:], pos)], axis=-1)
    tr = lambda t: t.transpose(0, 2, 1, 3)
    o_mla = _from_heads(_blocked_softmax_attention(tr(q), tr(k), tr(v)))
    return jnp.concatenate([h_ml, o_mla], axis=-1) @ w_out


def _retention_mixer(h, pos, w_in, decay_f, decay_b, gn_g, w_out):
    b, s, _ = h.shape
    q, k, v, g = _split(h @ w_in, RET_IN_SIZES)
    q = _rotary(q.reshape(b, s, RET_HEADS, RET_DK), pos) * (RET_DK ** -0.5)
    k = _rotary(k.reshape(b, s, RET_HEADS, RET_DK), pos)
    tr = lambda t: t.transpose(0, 2, 1, 3)
    qh, kh, vh = tr(q), tr(k), _to_heads(v, RET_HEADS)
    flip = lambda t: jnp.flip(t, axis=2)
    lg_f = jax.nn.log_sigmoid(decay_f.astype(jnp.float32))
    lg_b = jax.nn.log_sigmoid(decay_b.astype(jnp.float32))
    y = _retention_scan(qh, kh, vh, lg_f) + flip(_retention_scan(flip(qh), flip(kh), flip(vh), lg_b))
    y = _head_group_norm(y, gn_g.reshape(RET_HEADS, 1, RET_DV)).astype(h.dtype)
    return (_from_heads(y) * jax.nn.silu(g)) @ w_out


def _clamped_swiglu(gu):
    gate, up = jnp.split(gu, 2, axis=-1)
    gate = jnp.minimum(gate, SWIGLU_LIMIT)
    up = jnp.clip(up, -SWIGLU_LIMIT, SWIGLU_LIMIT)
    return (up + 1.0) * gate * jax.nn.sigmoid(SWIGLU_ALPHA * gate)


def _moe_ffn(h, router_w, router_b, w_gu, b_gu, w_down, b_down):
    b, s, d = h.shape
    xt = h.reshape(-1, d)
    n = xt.shape[0]
    logits = (xt @ router_w + router_b).astype(jnp.float32)
    top_v, top_i = lax.top_k(logits, TOP_K)
    top_w = jax.nn.softmax(top_v, axis=-1)
    a = n * TOP_K
    e_flat = top_i.reshape(-1)
    tok_flat = jnp.arange(a, dtype=jnp.int32) // TOP_K
    w_flat = top_w.reshape(-1)
    order = jnp.argsort(e_flat)
    e_sorted, tok_sorted, w_sorted = e_flat[order], tok_flat[order], w_flat[order]
    counts = jnp.zeros((N_EXPERTS,), jnp.int32).at[e_flat].add(1)
    padded = (counts + MOE_BLOCK - 1) // MOE_BLOCK * MOE_BLOCK
    start = jnp.cumsum(counts) - counts
    pend = jnp.cumsum(padded)
    pstart = pend - padded
    dest = pstart[e_sorted] + jnp.arange(a, dtype=jnp.int32) - start[e_sorted]
    nb = -(-a // MOE_BLOCK) + N_EXPERTS
    tok_buf = jnp.full((nb * MOE_BLOCK,), n, jnp.int32).at[dest].set(tok_sorted)
    w_buf = jnp.zeros((nb * MOE_BLOCK,), jnp.float32).at[dest].set(w_sorted)
    blk_expert = jnp.clip(jnp.searchsorted(pend, jnp.arange(nb, dtype=jnp.int32) * MOE_BLOCK, side='right'), 0, N_EXPERTS - 1)
    x_pad = jnp.concatenate([xt, jnp.zeros((1, d), xt.dtype)], axis=0)

    def run_block(args):
        tok, e = args
        gu = x_pad[tok] @ w_gu[e] + b_gu[e]
        return _clamped_swiglu(gu) @ w_down[e] + b_down[e]

    y = lax.map(run_block, (tok_buf.reshape(nb, MOE_BLOCK), blk_expert))
    y = y.reshape(-1, d) * w_buf[:, None].astype(y.dtype)
    out = jnp.zeros((n + 1, d), y.dtype).at[tok_buf].add(y)[:n]
    return out.reshape(b, s, d)


def setup_inputs(seed: int = 0) -> dict:
    key = jax.random.key(seed)
    ks = iter(jax.random.split(key, 40))
    nrm = lambda shape, scale: jax.random.normal(next(ks), shape, jnp.float32) * scale
    gain = lambda shape: 1.0 + nrm(shape, 0.02)
    D = D_MODEL
    x = nrm((BATCH, SEQ, D), 1.0)
    c = nrm((BATCH, D), 1.0)
    positions = jnp.arange(SEQ, dtype=jnp.int32)[None, :] + jax.random.randint(next(ks), (BATCH, 1), 0, 256, jnp.int32)
    fb = jnp.linspace(3.0, 6.0, ML_HEADS, dtype=jnp.float32)
    ml_gate_b = jnp.concatenate([nrm((N_EVEN, ML_HEADS), 0.1), fb + nrm((N_EVEN, ML_HEADS), 0.1),
                                 nrm((N_EVEN, ML_HEADS), 0.1), fb + nrm((N_EVEN, ML_HEADS), 0.1)], axis=-1)
    gamma = 1.0 - jnp.exp(jnp.linspace(math.log(1.0 / 32.0), math.log(1.0 / 512.0), RET_HEADS, dtype=jnp.float32))
    decay_logit = jnp.log(gamma) - jnp.log1p(-gamma)
    return {
        'x': x,
        'c': c,
        'positions': positions,
        'ada_w': nrm((DEPTH, D, 6 * D), 0.5 * D ** -0.5),
        'ada_b': nrm((DEPTH, 6 * D), 0.02),
        'norm_mix_g': gain((DEPTH, D)),
        'norm_ffn_g': gain((DEPTH, D)),
        'hy_w_in': nrm((N_EVEN, D, EVEN_IN), D ** -0.5),
        'ml_conv_w': nrm((N_EVEN, ML_CONV, 2 * ML_HEADS * ML_DK), ML_CONV ** -0.5),
        'ml_conv_b': nrm((N_EVEN, 2 * ML_HEADS * ML_DK), 0.02),
        'ml_gate_b': ml_gate_b,
        'ml_norm_g': gain((N_EVEN, ML_HEADS * ML_DV)),
        'mla_q_norm_g': gain((N_EVEN, MLA_Q_LORA)),
        'mla_kv_norm_g': gain((N_EVEN, MLA_KV_LORA)),
        'mla_w_qb': nrm((N_EVEN, MLA_Q_LORA, MLA_HEADS * MLA_QK), MLA_Q_LORA ** -0.5),
        'mla_w_kvb': nrm((N_EVEN, MLA_KV_LORA, MLA_HEADS * (MLA_NOPE + MLA_V)), MLA_KV_LORA ** -0.5),
        'mla_qk_q_g': gain((N_EVEN, MLA_QK)),
        'mla_qk_k_g': gain((N_EVEN, MLA_QK)),
        'hy_w_out': nrm((N_EVEN, MIX_WIDTH, D), MIX_WIDTH ** -0.5),
        'ret_w_in': nrm((N_ODD, D, RET_IN), D ** -0.5),
        'ret_decay_f': decay_logit + nrm((N_ODD, RET_HEADS), 0.05),
        'ret_decay_b': decay_logit + nrm((N_ODD, RET_HEADS), 0.05),
        'ret_gn_g': gain((N_ODD, RET_HEADS * RET_DV)),
        'ret_w_out': nrm((N_ODD, RET_HEADS * RET_DV, D), (RET_HEADS * RET_DV) ** -0.5),
        'moe_router_w': nrm((DEPTH, D, N_EXPERTS), D ** -0.5),
        'moe_router_b': nrm((DEPTH, N_EXPERTS), 0.01),
        'moe_w_gu': nrm((DEPTH, N_EXPERTS, D, 2 * EXPERT_FF), D ** -0.5),
        'moe_b_gu': nrm((DEPTH, N_EXPERTS, 2 * EXPERT_FF), 0.01),
        'moe_w_down': nrm((DEPTH, N_EXPERTS, EXPERT_FF, D), EXPERT_FF ** -0.5),
        'moe_b_down': nrm((DEPTH, N_EXPERTS, D), 0.01),
    }


def reference(x, c, positions, ada_w, ada_b, norm_mix_g, norm_ffn_g, hy_w_in, ml_conv_w, ml_conv_b, ml_gate_b,
              ml_norm_g, mla_q_norm_g, mla_kv_norm_g, mla_w_qb, mla_w_kvb, mla_qk_q_g, mla_qk_k_g, hy_w_out,
              ret_w_in, ret_decay_f, ret_decay_b, ret_gn_g, ret_w_out, moe_router_w, moe_router_b, moe_w_gu,
              moe_b_gu, moe_w_down, moe_b_down):
    cs = jax.nn.silu(c)
    for layer in range(DEPTH):
        mod = (cs @ ada_w[layer] + ada_b[layer])[:, None, :]
        sh1, sc1, g1, sh2, sc2, g2 = jnp.split(mod, 6, axis=-1)
        hm = _rms_norm(x, norm_mix_g[layer]) * (1.0 + sc1) + sh1
        j = layer // 2
        if layer % 2 == 0:
            y = _hybrid_mixer(hm, positions, hy_w_in[j], ml_conv_w[j], ml_conv_b[j], ml_gate_b[j], ml_norm_g[j],
                              mla_q_norm_g[j], mla_kv_norm_g[j], mla_w_qb[j], mla_w_kvb[j], mla_qk_q_g[j],
                              mla_qk_k_g[j], hy_w_out[j])
        else:
            y = _retention_mixer(hm, positions, ret_w_in[j], ret_decay_f[j], ret_decay_b[j], ret_gn_g[j], ret_w_out[j])
        x = x + g1 * y.astype(x.dtype)
        hf = _rms_norm(x, norm_ffn_g[layer]) * (1.0 + sc2) + sh2
        x = x + g2 * _moe_ffn(hf, moe_router_w[layer], moe_router_b[layer], moe_w_gu[layer], moe_b_gu[layer],
                              moe_w_down[layer], moe_b_down[layer]).astype(x.dtype)
    return x
```

```cpp
#include <hip/hip_runtime.h>
#include <cstdio>
#include <cstdint>

#define GAS __attribute__((address_space(1)))
#define LAS __attribute__((address_space(3)))
typedef unsigned short bf16_t;
typedef short bf16x8 __attribute__((ext_vector_type(8)));
typedef short s16x4 __attribute__((ext_vector_type(4)));
typedef float f32x2 __attribute__((ext_vector_type(2)));
typedef float f32x4 __attribute__((ext_vector_type(4)));
typedef float f32x8 __attribute__((ext_vector_type(8)));
typedef float f32x16 __attribute__((ext_vector_type(16)));
typedef unsigned u32x2 __attribute__((ext_vector_type(2)));
typedef unsigned u32x4 __attribute__((ext_vector_type(4)));
typedef GAS unsigned gu32;

constexpr int NTOK = 32768, DM = 1024, SEQ = 4096, NBATCH = 8, DEPTH = 4;
constexpr int EVEN_IN = 2480, EVEN_INP = 2560;
constexpr int RET_IN = 6144;
constexpr int NEXP = 32, TOPK = 4, EFF = 1024;
constexpr int NSLOT = NTOK * TOPK;
constexpr int NSLOTP = NSLOT + NEXP * 256;
constexpr float EPS = 1e-6f;

constexpr int PC_QM = 0, PC_KM = 512, PC_VM = 1024, PC_OM = 1536, PC_QA = 2048, PC_KVA = 2304, PC_KR = 2432, PC_GT = 2464;

#define LDS_WAIT() asm volatile("s_waitcnt lgkmcnt(0)" ::: "memory")
#define VM_WAIT() asm volatile("s_waitcnt vmcnt(0)" ::: "memory")
#define SBAR() __builtin_amdgcn_sched_barrier(0)
#define FENCE() do { asm volatile("" ::: "memory"); __builtin_amdgcn_sched_barrier(0); } while (0)

__device__ __forceinline__ unsigned cvt_pk_bf16(float lo, float hi) { unsigned r; asm volatile("v_cvt_pk_bf16_f32 %0, %1, %2" : "=v"(r) : "v"(lo), "v"(hi)); return r; }
__device__ __forceinline__ float bf_lo(unsigned u) { return __builtin_bit_cast(float, u << 16); }
__device__ __forceinline__ float bf_hi(unsigned u) { return __builtin_bit_cast(float, u & 0xffff0000u); }
__device__ __forceinline__ float bf2f(bf16_t b) { return __builtin_bit_cast(float, ((unsigned)b) << 16); }
__device__ __forceinline__ bf16_t f2bf(float f) { unsigned u = __builtin_bit_cast(unsigned, f); return (bf16_t)((u + 0x7fffu + ((u >> 16) & 1u)) >> 16); }
__device__ __forceinline__ float shx(float v, int m, int lane) { return __builtin_bit_cast(float, __builtin_amdgcn_ds_bpermute((lane ^ m) << 2, __builtin_bit_cast(int, v))); }
__device__ __forceinline__ int shxi(int v, int m, int lane) { return __builtin_amdgcn_ds_bpermute((lane ^ m) << 2, v); }
__device__ __forceinline__ float sh_from(float v, int src, int lane) { (void)lane; return __builtin_bit_cast(float, __builtin_amdgcn_ds_bpermute(src << 2, __builtin_bit_cast(int, v))); }
__device__ __forceinline__ int sh_fromi(int v, int src) { return __builtin_amdgcn_ds_bpermute(src << 2, v); }
__device__ __forceinline__ float wave_sum(float v, int lane) {
#pragma unroll
    for (int o = 1; o < 64; o <<= 1) v += shx(v, o, lane);
    return v;
}
__device__ __forceinline__ float wave_max(float v, int lane) {
#pragma unroll
    for (int o = 1; o < 64; o <<= 1) v = fmaxf(v, shx(v, o, lane));
    return v;
}
__device__ __forceinline__ float sigmoidf_(float x) { return 1.f / (1.f + __expf(-x)); }
__device__ __forceinline__ float siluf_(float x) { return x / (1.f + __expf(-x)); }

#define XB_TMO      128
#define XB_XCNT(j)  (256  + 64 * (j))
#define XB_XSUB(j)  (1280 + 64 * (j))
#define XB_XGEN(j)  (2304 + 64 * (j))
#define XB_TOP      3328
#define XB_TOPGEN   3392
#define XCD_BAR_WORDS 3456
#define XB_SPIN_CAP (1u << 22)

typedef GAS unsigned* gbar_t;
__device__ __forceinline__ unsigned xb_ld(gbar_t p)              { return __hip_atomic_load(p, __ATOMIC_RELAXED, __HIP_MEMORY_SCOPE_AGENT); }
__device__ __forceinline__ unsigned xb_add(gbar_t p, unsigned v) { return __hip_atomic_fetch_add(p, v, __ATOMIC_RELAXED, __HIP_MEMORY_SCOPE_AGENT); }
__device__ __forceinline__ unsigned xb_xcc_id() { return (unsigned)__builtin_amdgcn_s_getreg((3 << 11) | 20) & 0xFu; }
#define XB_SPIN(cond, bar) do { unsigned _sp = 0; while (cond) { __builtin_amdgcn_s_sleep(1); \
    if ((++_sp & 255u) == 0u) { if (xb_ld(&(bar)[XB_TMO])) break; if (_sp > XB_SPIN_CAP) { xb_add(&(bar)[XB_TMO], 1u); break; } } } } while (0)

__device__ __forceinline__ void xcd_barrier_post(gbar_t bar) {
    if (threadIdx.x == 0) (void)xb_add(&bar[XB_XCNT(xb_xcc_id())], 1u);
}
__device__ __forceinline__ void xcd_barrier_complete(gbar_t bar, unsigned x, unsigned& nloc, unsigned& nx) {
    const unsigned G = gridDim.x * gridDim.y * gridDim.z;
    unsigned sum, cnt, mine, sp = 0u;
    for (;;) {
        sum = 0u; cnt = 0u; mine = 0u;
#pragma unroll
        for (unsigned j = 0; j < 16; ++j) { const unsigned c = xb_ld(&bar[XB_XCNT(j)]); sum += c; cnt += (c > 0u) ? 1u : 0u; mine = (j == x) ? c : mine; }
        if (sum == G) break;
        __builtin_amdgcn_s_sleep(1);
        if ((++sp & 255u) == 0u) { if (xb_ld(&bar[XB_TMO])) break; if (sp > XB_SPIN_CAP) { xb_add(&bar[XB_TMO], 1u); break; } }
    }
    nloc = mine > 0u ? mine : 1u; nx = cnt > 0u ? cnt : 1u;
}
__device__ __forceinline__ void xcd_barrier(gbar_t bar, volatile LAS unsigned* st) {
    asm volatile("s_waitcnt vmcnt(0)" ::: "memory");
    __syncthreads();
    if (threadIdx.x == 0) {
        const unsigned bx = xb_xcc_id();
        __builtin_amdgcn_s_waitcnt(0);
        unsigned nloc = st[0], nx = st[1];
        if (nloc == 0u) { xcd_barrier_complete(bar, bx, nloc, nx); st[0] = nloc; st[1] = nx; }
        const unsigned old = xb_add(&bar[XB_XSUB(bx)], 1u);
        const unsigned gen = old / nloc;
        if (old + 1u == (gen + 1u) * nloc) {
            __builtin_amdgcn_fence(__ATOMIC_RELEASE, "agent");
            asm volatile("s_waitcnt vmcnt(0)" ::: "memory");
            const unsigned og = xb_add(&bar[XB_TOP], 1u);
            const unsigned tg = og / nx;
            if (og + 1u == (tg + 1u) * nx) xb_add(&bar[XB_TOPGEN], 1u);
            else XB_SPIN(xb_ld(&bar[XB_TOPGEN]) == tg, bar);
            __builtin_amdgcn_fence(__ATOMIC_ACQUIRE, "agent");
            xb_add(&bar[XB_XGEN(bx)], 1u);
            asm volatile("s_waitcnt vmcnt(0)" ::: "memory");
        } else {
            XB_SPIN(xb_ld(&bar[XB_XGEN(bx)]) == gen, bar);
            __builtin_amdgcn_fence(__ATOMIC_ACQUIRE, "agent");
            asm volatile("s_waitcnt vmcnt(0)" ::: "memory");
        }
    }
    __syncthreads();
}
namespace pg8 {
constexpr int BM = 256, BK = 64, HALF = 128, HTB = HALF * BK * 2, STAGE_BYTES = 8 * HTB, NXCD = 8, WGM = 8;
__host__ __device__ __forceinline__ int lds_byte(int r, int c) { const int st = (r >> 4) * 2 + (c >> 5), rr = r & 15, cc = c & 31, ob = rr * 64 + cc * 2; return st * 1024 + (ob ^ (((ob >> 9) & 1) << 5)); }
__host__ __device__ __forceinline__ void stage_rc(int b, int& R, int& C) { const int st = b / 1024, sb = b % 1024, swz = sb ^ (((sb >> 9) & 1) << 5); R = (st >> 1) * 16 + swz / 64; C = (st & 1) * 32 + (swz % 64) / 2; }
__host__ __device__ __forceinline__ int perm32(int rho) { const int n = rho >> 4, i = rho & 15; return 8 * (i >> 2) + 4 * n + (i & 3); }

struct Unit { const char* A; const char* B; int pm, pn, aux; };
struct Dims { int lda, ldb, K; };

__device__ __forceinline__ void static_tile(int L, int nM, int nN, int& pm, int& pn) {
    const int nwg = nM * nN; int wgid = L;
    { const int q = nwg / NXCD, r = nwg % NXCD, xcd = wgid % NXCD, off = wgid / NXCD; wgid = (xcd < r ? xcd * (q + 1) : r * (q + 1) + (xcd - r) * q) + off; }
    const int nig = WGM * nN, gid = wgid / nig, fm = gid * WGM, gsz = (nM - fm) < WGM ? (nM - fm) : WGM;
    pm = fm + ((wgid % nig) % gsz); pn = (wgid % nig) / gsz;
}
struct StaticSched {
    const char* A; const char* Bt; int lda, ldb, nM, nN, G, c;
    __device__ __forceinline__ bool next(int i, Unit& u) const {
        const long L = (long)i * G + c; if (L >= (long)nM * nN) return false;
        int pm, pn; static_tile((int)L, nM, nN, pm, pn);
        u.pm = pm; u.pn = pn; u.aux = 0; u.A = A + (size_t)pm * BM * lda * 2; u.B = Bt + (size_t)pn * BM * ldb * 2; return true;
    }
};

template <class Epi, class Sched, bool ALIGN_EPI = true, bool SP2 = true>
__device__ __forceinline__ void gemm_phase(LAS unsigned char* lds, const Dims g, const Sched& S, const Epi& E) {
    int tid = threadIdx.x; asm volatile("" : "+v"(tid));
    const int wid = __builtin_amdgcn_readfirstlane(tid >> 6), lane = tid & 63, wr = wid >> 2, wc = wid & 3, fr = lane & 15, fq = lane >> 4;
    const int K = g.K, nt = K / BK;
    unsigned voffA[2], voffB[2];
#pragma unroll
    for (int i = 0; i < 2; ++i) { int R, C; stage_rc(tid * 16 + i * 8192, R, C); const int Rb = Epi::PERM ? ((R & ~31) + perm32(R & 31)) : R;
        voffA[i] = (unsigned)(R * g.lda + C) * 2u; voffB[i] = (unsigned)(Rb * g.ldb + C) * 2u; }
    const size_t kstep = (size_t)(BK * 2);
    const size_t hstepA = (size_t)HALF * g.lda * 2, hstepB = (size_t)HALF * g.ldb * 2;
    const unsigned ldsw = (unsigned)wid * 1024u;
    const int aoff = lds_byte(wr * 64 + fr, fq * 8), boff = lds_byte(wc * 32 + fr, fq * 8);
#define PG8_SA(b, h) (((b) * 2 + (h)) * HTB)
#define PG8_SB(b, h) ((4 + (b) * 2 + (h)) * HTB)
#define PG8_STAGE(bufoff, gbase, voff) do { _Pragma("unroll") for (int _i = 0; _i < 2; ++_i) \
        __builtin_amdgcn_global_load_lds((const unsigned*)((const char*)(gbase) + (voff)[_i]), (LAS unsigned*)(lds + (bufoff) + ldsw + _i * 8192), 16, 0, 0); } while (0)
#define PG8_LDA(dst, b, h) do { _Pragma("unroll") for (int m = 0; m < 4; ++m) _Pragma("unroll") for (int k = 0; k < 2; ++k) dst[m][k] = *(const LAS bf16x8*)(lds + PG8_SA(b, h) + aoff + m * 2048 + k * 1024); } while (0)
#define PG8_LDB(dst, b, h) do { _Pragma("unroll") for (int n = 0; n < 2; ++n) _Pragma("unroll") for (int k = 0; k < 2; ++k) dst[n][k] = *(const LAS bf16x8*)(lds + PG8_SB(b, h) + boff + n * 2048 + k * 1024); } while (0)
#define PG8_MMA(ai, bj, At, Bt) do { __builtin_amdgcn_s_setprio(1); _Pragma("unroll") for (int m = 0; m < 4; ++m) _Pragma("unroll") for (int n = 0; n < 2; ++n) _Pragma("unroll") for (int k = 0; k < 2; ++k) \
        acc[ai][bj][m][n] = __builtin_amdgcn_mfma_f32_16x16x32_bf16(Bt[n][k], At[m][k], acc[ai][bj][m][n], 0, 0, 0); __builtin_amdgcn_s_setprio(0); } while (0)
#define PG8_WAIT_V(n) asm volatile("s_waitcnt vmcnt(" #n ")" ::: "memory")
#define PG8_WAIT_L(n) asm volatile("s_waitcnt lgkmcnt(" #n ")" ::: "memory")
#define PG8_BAR __builtin_amdgcn_s_barrier()
#define PG8_SCHED __builtin_amdgcn_sched_barrier(0)
    Unit cur, nxt; int ui = 0;
    if (!S.next(0, cur)) return;
    f32x4 acc[2][2][4][2];
#pragma unroll
    for (int a = 0; a < 2; ++a)
#pragma unroll
        for (int b = 0; b < 2; ++b)
#pragma unroll
            for (int m = 0; m < 4; ++m)
#pragma unroll
                for (int n = 0; n < 2; ++n) acc[a][b][m][n] = (f32x4){0.f, 0.f, 0.f, 0.f};
    bf16x8 At[4][2], B0[2][2], B1[2][2];
    const char* cA = cur.A; const char* cB = cur.B;
    if constexpr (SP2) {
        PG8_STAGE(PG8_SB(0, 0), cB, voffB); PG8_STAGE(PG8_SB(0, 1), cB + hstepB, voffB); PG8_STAGE(PG8_SA(0, 0), cA, voffA); PG8_STAGE(PG8_SA(0, 1), cA + hstepA, voffA);
        if (wr == 1) PG8_BAR;
        PG8_WAIT_V(2); PG8_BAR;
        PG8_STAGE(PG8_SB(1, 0), cB + kstep, voffB); PG8_STAGE(PG8_SA(1, 0), cA + kstep, voffA); PG8_STAGE(PG8_SB(1, 1), cB + hstepB + kstep, voffB);
        PG8_WAIT_V(6); PG8_BAR;
    } else {
        PG8_STAGE(PG8_SB(0, 0), cB, voffB); PG8_STAGE(PG8_SA(0, 0), cA, voffA); PG8_STAGE(PG8_SB(0, 1), cB + hstepB, voffB); PG8_STAGE(PG8_SA(0, 1), cA + hstepA, voffA);
        if (wr == 1) PG8_BAR;
        PG8_WAIT_V(4); PG8_BAR;
        PG8_STAGE(PG8_SB(1, 0), cB + kstep, voffB); PG8_STAGE(PG8_SA(1, 0), cA + kstep, voffA); PG8_STAGE(PG8_SB(1, 1), cB + hstepB + kstep, voffB);
        PG8_WAIT_V(6); PG8_BAR;
    }
    for (;;) {
        const bool has_next = S.next(ui + 1, nxt);
        const char* nA = has_next ? nxt.A : cA; const char* nB = has_next ? nxt.B : cB;
        for (int t = 0; t < nt; t += 2) {
            const bool last = (t == nt - 2);
            const char* a1 = cA + (size_t)(t + 1) * kstep;
            const char* a2 = last ? nA : cA + (size_t)(t + 2) * kstep; const char* b2 = last ? nB : cB + (size_t)(t + 2) * kstep;
            const char* a3 = a2 + kstep; const char* b3 = b2 + kstep;
            if constexpr (SP2) {
            PG8_LDB(B0, 0, 0); PG8_LDB(B1, 0, 1); PG8_SCHED; PG8_LDA(At, 0, 0); PG8_STAGE(PG8_SA(1, 1), a1 + hstepA, voffA);
            PG8_WAIT_V(8); PG8_WAIT_L(0); PG8_BAR; PG8_MMA(0, 0, At, B0); PG8_MMA(0, 1, At, B1); PG8_BAR; PG8_SCHED;
            PG8_LDA(At, 0, 1); PG8_STAGE(PG8_SB(0, 0), b2, voffB); PG8_STAGE(PG8_SB(0, 1), b2 + hstepB, voffB); PG8_STAGE(PG8_SA(0, 0), a2, voffA);
            PG8_WAIT_V(8); PG8_WAIT_L(0); PG8_BAR; PG8_MMA(1, 0, At, B0); PG8_MMA(1, 1, At, B1); PG8_BAR; PG8_SCHED;
            PG8_LDB(B0, 1, 0); PG8_LDB(B1, 1, 1); PG8_SCHED; PG8_LDA(At, 1, 0); PG8_STAGE(PG8_SA(0, 1), a2 + hstepA, voffA);
            PG8_WAIT_V(8); PG8_WAIT_L(0); PG8_BAR; PG8_MMA(0, 0, At, B0); PG8_MMA(0, 1, At, B1); PG8_BAR; PG8_SCHED;
            PG8_LDA(At, 1, 1); PG8_STAGE(PG8_SB(1, 0), b3, voffB); PG8_STAGE(PG8_SB(1, 1), b3 + hstepB, voffB); PG8_STAGE(PG8_SA(1, 0), a3, voffA);
            PG8_WAIT_V(8); PG8_WAIT_L(0); PG8_BAR; PG8_MMA(1, 0, At, B0); PG8_MMA(1, 1, At, B1); PG8_BAR; PG8_SCHED;
            } else {
            PG8_LDB(B0, 0, 0); PG8_SCHED; PG8_LDA(At, 0, 0); PG8_STAGE(PG8_SA(1, 1), a1 + hstepA, voffA);
            PG8_WAIT_L(8); PG8_BAR; PG8_WAIT_L(0); PG8_MMA(0, 0, At, B0); PG8_BAR; PG8_SCHED;
            PG8_LDB(B1, 0, 1); PG8_STAGE(PG8_SB(0, 0), b2, voffB);
            PG8_BAR; PG8_WAIT_L(0); PG8_MMA(0, 1, At, B1); PG8_BAR;
            PG8_LDA(At, 0, 1); PG8_STAGE(PG8_SA(0, 0), a2, voffA);
            PG8_BAR; PG8_WAIT_L(0); PG8_MMA(1, 0, At, B0); PG8_BAR; PG8_SCHED;
            PG8_STAGE(PG8_SB(0, 1), b2 + hstepB, voffB);
            PG8_WAIT_V(6); PG8_BAR; PG8_MMA(1, 1, At, B1); PG8_BAR;
            PG8_LDB(B0, 1, 0); PG8_SCHED; PG8_LDA(At, 1, 0); PG8_STAGE(PG8_SA(0, 1), a2 + hstepA, voffA);
            PG8_WAIT_L(8); PG8_BAR; PG8_WAIT_L(0); PG8_MMA(0, 0, At, B0); PG8_BAR; PG8_SCHED;
            PG8_LDB(B1, 1, 1); PG8_STAGE(PG8_SB(1, 0), b3, voffB);
            PG8_BAR; PG8_WAIT_L(0); PG8_MMA(0, 1, At, B1); PG8_BAR;
            PG8_LDA(At, 1, 1); PG8_STAGE(PG8_SA(1, 0), a3, voffA);
            PG8_BAR; PG8_WAIT_L(0); PG8_MMA(1, 0, At, B0); PG8_BAR; PG8_SCHED;
            PG8_STAGE(PG8_SB(1, 1), b3 + hstepB, voffB);
            PG8_WAIT_V(6); PG8_BAR; PG8_MMA(1, 1, At, B1); PG8_BAR;
            }
        }
        if constexpr (ALIGN_EPI) { if (wr == 0) PG8_BAR; }
        { int tz = tid; asm volatile("" : "+v"(tz)); const int ln = tz & 63; E(acc, cur, wr, wc, ln & 15, ln >> 4); }
        if (!has_next) break;
#pragma unroll
        for (int a = 0; a < 2; ++a)
#pragma unroll
            for (int b = 0; b < 2; ++b)
#pragma unroll
                for (int m = 0; m < 4; ++m)
#pragma unroll
                    for (int n = 0; n < 2; ++n) acc[a][b][m][n] = (f32x4){0.f, 0.f, 0.f, 0.f};
        cur = nxt; cA = nA; cB = nB; ++ui;
        if constexpr (ALIGN_EPI) { if (wr == 1) PG8_BAR; }
    }
    PG8_WAIT_V(0);
    if constexpr (!ALIGN_EPI) { if (wr == 0) PG8_BAR; }
    PG8_BAR;
#undef PG8_SA
#undef PG8_SB
#undef PG8_STAGE
#undef PG8_LDA
#undef PG8_LDB
#undef PG8_MMA
#undef PG8_WAIT_V
#undef PG8_WAIT_L
#undef PG8_BAR
#undef PG8_SCHED
}

struct EpiBf16 {
    static constexpr bool PERM = true;
    bf16_t* O0; bf16_t* O1; int ldc0, ldc1; int rope_tiles; int qscale_tiles; float qscale; const GAS f32x2* rope;
    __device__ __forceinline__ void operator()(const f32x4 (&acc)[2][2][4][2], const Unit& u, int wr, int wc, int fr, int fq) const {
        const int row0 = u.pm * BM + wr * 64 + fr, col0 = u.pn * BM + wc * 32 + 8 * fq;
        bf16_t* base = u.aux ? O1 : O0; const int ld = u.aux ? ldc1 : ldc0;
        const bool do_rope = u.pn < rope_tiles; const float sc = (u.pn < qscale_tiles) ? qscale : 1.f;
#pragma unroll
        for (int ai = 0; ai < 2; ++ai)
#pragma unroll
            for (int m = 0; m < 4; ++m) {
                const int row = row0 + ai * HALF + m * 16; bf16_t* rowp = base + (size_t)row * ld + col0;
                f32x4 v00 = acc[ai][0][m][0], v01 = acc[ai][0][m][1], v10 = acc[ai][1][m][0], v11 = acc[ai][1][m][1];
                if (do_rope) {
                    const GAS f32x4* rp = (const GAS f32x4*)(rope + (size_t)row * 128 + wc * 32 + 8 * fq);
                    { const f32x4 t0 = rp[0], t1 = rp[1]; f32x4 a, b;
                      a[0] = v00[0] * t0[0] - v10[0] * t0[1]; b[0] = v10[0] * t0[0] + v00[0] * t0[1];
                      a[1] = v00[1] * t0[2] - v10[1] * t0[3]; b[1] = v10[1] * t0[2] + v00[1] * t0[3];
                      a[2] = v00[2] * t1[0] - v10[2] * t1[1]; b[2] = v10[2] * t1[0] + v00[2] * t1[1];
                      a[3] = v00[3] * t1[2] - v10[3] * t1[3]; b[3] = v10[3] * t1[2] + v00[3] * t1[3];
                      v00 = a; v10 = b; }
                    FENCE();
                    { const f32x4 t2 = rp[2], t3 = rp[3]; f32x4 a, b;
                      a[0] = v01[0] * t2[0] - v11[0] * t2[1]; b[0] = v11[0] * t2[0] + v01[0] * t2[1];
                      a[1] = v01[1] * t2[2] - v11[1] * t2[3]; b[1] = v11[1] * t2[2] + v01[1] * t2[3];
                      a[2] = v01[2] * t3[0] - v11[2] * t3[1]; b[2] = v11[2] * t3[0] + v01[2] * t3[1];
                      a[3] = v01[3] * t3[2] - v11[3] * t3[3]; b[3] = v11[3] * t3[2] + v01[3] * t3[3];
                      v01 = a; v11 = b; }
                }
                v00 = v00 * sc; v01 = v01 * sc; v10 = v10 * sc; v11 = v11 * sc;
                u32x4 w0, w1;
                w0.x = cvt_pk_bf16(v00[0], v00[1]); w0.y = cvt_pk_bf16(v00[2], v00[3]); w0.z = cvt_pk_bf16(v01[0], v01[1]); w0.w = cvt_pk_bf16(v01[2], v01[3]);
                w1.x = cvt_pk_bf16(v10[0], v10[1]); w1.y = cvt_pk_bf16(v10[2], v10[3]); w1.z = cvt_pk_bf16(v11[0], v11[1]); w1.w = cvt_pk_bf16(v11[2], v11[3]);
                *(u32x4*)(rowp) = w0; *(u32x4*)(rowp + HALF) = w1;
                FENCE();
            }
    }
};
struct EpiResid {
    static constexpr bool PERM = false;
    const float* base; float* out; const float* gate; int gstride;
    __device__ __forceinline__ void operator()(const f32x4 (&acc)[2][2][4][2], const Unit& u, int wr, int wc, int fr, int fq) const {
        const int row0 = u.pm * BM + wr * 64 + fr, col0 = u.pn * BM + wc * 32 + 4 * fq;
        const float* gp = gate + (size_t)((u.pm * BM) >> 12) * gstride + col0;
        f32x4 gv[2][2];
#pragma unroll
        for (int bj = 0; bj < 2; ++bj)
#pragma unroll
            for (int n = 0; n < 2; ++n) gv[bj][n] = *(const f32x4*)(gp + bj * HALF + n * 16);
#pragma unroll
        for (int ai = 0; ai < 2; ++ai)
#pragma unroll
            for (int m = 0; m < 4; ++m) { const size_t ro = (size_t)(row0 + ai * HALF + m * 16) * DM + col0;
#pragma unroll
                for (int bj = 0; bj < 2; ++bj)
#pragma unroll
                    for (int n = 0; n < 2; ++n) { const f32x4 bv = *(const f32x4*)(base + ro + bj * HALF + n * 16);
                        *(f32x4*)(out + ro + bj * HALF + n * 16) = bv + gv[bj][n] * acc[ai][bj][m][n]; } }
    }
};
struct EpiSwiglu {
    static constexpr bool PERM = true;
    bf16_t* act; const float* bgu;
    __device__ __forceinline__ void operator()(const f32x4 (&acc)[2][2][4][2], const Unit& u, int wr, int wc, int fr, int fq) const {
        const int row0 = u.pm * BM + wr * 64 + fr, c0 = u.pn * HALF + wc * 32 + 8 * fq;
        const float* bp = bgu + (size_t)u.aux * 2048 + c0;
        const f32x4 bg0 = *(const f32x4*)(bp), bg1 = *(const f32x4*)(bp + 4), bu0 = *(const f32x4*)(bp + 1024), bu1 = *(const f32x4*)(bp + 1028);
#pragma unroll
        for (int ai = 0; ai < 2; ++ai)
#pragma unroll
            for (int m = 0; m < 4; ++m) {
                const f32x4 g0 = acc[ai][0][m][0] + bg0, g1 = acc[ai][0][m][1] + bg1, u0 = acc[ai][1][m][0] + bu0, u1 = acc[ai][1][m][1] + bu1;
                float r[8];
#pragma unroll
                for (int j = 0; j < 4; ++j) {
                    float gg = fminf(g0[j], 7.f), uu = fminf(fmaxf(u0[j], -7.f), 7.f); r[j] = (uu + 1.f) * gg / (1.f + __expf(-1.702f * gg));
                    gg = fminf(g1[j], 7.f); uu = fminf(fmaxf(u1[j], -7.f), 7.f); r[4 + j] = (uu + 1.f) * gg / (1.f + __expf(-1.702f * gg));
                }
                u32x4 w; w.x = cvt_pk_bf16(r[0], r[1]); w.y = cvt_pk_bf16(r[2], r[3]); w.z = cvt_pk_bf16(r[4], r[5]); w.w = cvt_pk_bf16(r[6], r[7]);
                *(u32x4*)(act + (size_t)(row0 + ai * HALF + m * 16) * EFF + c0) = w;
            }
    }
};
struct EpiDown {
    static constexpr bool PERM = true;
    bf16_t* y; const float* bd; const float* wrow;
    __device__ __forceinline__ void operator()(const f32x4 (&acc)[2][2][4][2], const Unit& u, int wr, int wc, int fr, int fq) const {
        const int row0 = u.pm * BM + wr * 64 + fr, col0 = u.pn * BM + wc * 32 + 8 * fq;
        const float* bp = bd + (size_t)u.aux * DM + col0;
        const f32x4 b00 = *(const f32x4*)(bp), b01 = *(const f32x4*)(bp + 4), b10 = *(const f32x4*)(bp + HALF), b11 = *(const f32x4*)(bp + HALF + 4);
#pragma unroll
        for (int ai = 0; ai < 2; ++ai)
#pragma unroll
            for (int m = 0; m < 4; ++m) {
                const int row = row0 + ai * HALF + m * 16; const float w = wrow[row];
                const f32x4 v00 = (acc[ai][0][m][0] + b00) * w, v01 = (acc[ai][0][m][1] + b01) * w, v10 = (acc[ai][1][m][0] + b10) * w, v11 = (acc[ai][1][m][1] + b11) * w;
                u32x4 w0, w1;
                w0.x = cvt_pk_bf16(v00[0], v00[1]); w0.y = cvt_pk_bf16(v00[2], v00[3]); w0.z = cvt_pk_bf16(v01[0], v01[1]); w0.w = cvt_pk_bf16(v01[2], v01[3]);
                w1.x = cvt_pk_bf16(v10[0], v10[1]); w1.y = cvt_pk_bf16(v10[2], v10[3]); w1.z = cvt_pk_bf16(v11[0], v11[1]); w1.w = cvt_pk_bf16(v11[2], v11[3]);
                bf16_t* rowp = y + (size_t)row * DM + col0;
                *(u32x4*)(rowp) = w0; *(u32x4*)(rowp + HALF) = w1;
            }
    }
};
}
namespace la {
__device__ __forceinline__ unsigned off_a(unsigned row, unsigned ch) { return 2048u * (row >> 3) + 512u * (ch >> 2) + 64u * (row & 7) + 16u * ((ch & 3) ^ ((row >> 2) & 3)); }
__device__ __forceinline__ unsigned r_base(int lane, int e) { const unsigned h = lane >> 5; return 2048u * ((lane & 31) >> 3) + 64u * (lane & 7) + 16u * ((2u * e + h) ^ ((lane >> 2) & 3)); }
__device__ __forceinline__ unsigned t_base(int lane, int t) { const unsigned h = lane >> 5, blk = (lane >> 4) & 1, q = (lane & 15) >> 2, p = lane & 3;
    return 2048u * h + 64u * (4u * t + q) + 16u * ((2u * blk + (p >> 1)) ^ (2u * h + t)) + 8u * (p & 1); }
__device__ __forceinline__ int crow(int r, int hi) { return (r & 3) + 8 * (r >> 2) + 4 * hi; }

__device__ __forceinline__ bf16x8 lds_r128(unsigned addr) { return *(const LAS bf16x8*)(uintptr_t)addr; }
__device__ __forceinline__ bf16x8 lds_tr_frag(unsigned a0, unsigned a1) {
    s16x4 x, y; asm volatile("ds_read_b64_tr_b16 %0, %2\n\tds_read_b64_tr_b16 %1, %3\n\ts_waitcnt lgkmcnt(0)" : "=&v"(x), "=&v"(y) : "v"(a0), "v"(a1) : "memory");
    return (bf16x8){x[0], x[1], x[2], x[3], y[0], y[1], y[2], y[3]};
}
__device__ __forceinline__ bf16x8 scale_frag(bf16x8 f, float s) {
    u32x4 w = __builtin_bit_cast(u32x4, f); u32x4 o;
    o.x = cvt_pk_bf16(bf_lo(w.x) * s, bf_hi(w.x) * s); o.y = cvt_pk_bf16(bf_lo(w.y) * s, bf_hi(w.y) * s);
    o.z = cvt_pk_bf16(bf_lo(w.z) * s, bf_hi(w.z) * s); o.w = cvt_pk_bf16(bf_lo(w.w) * s, bf_hi(w.w) * s);
    return __builtin_bit_cast(bf16x8, o);
}
template <int R, int NP, bool SCALE>
__device__ __forceinline__ void stage_tile(int tid, unsigned lds_base, const bf16_t* g, int ld, const LAS float* rowscale) {
    constexpr int RPI = 32 / NP, NIT = R / RPI;
    static_assert(RPI % 8 == 0 && R % RPI == 0, "stage_tile geometry");
    const int row0 = tid / (16 * NP), cc = tid % (16 * NP), pnl = cc >> 4, ch = cc & 15;
    const unsigned la0 = lds_base + pnl * (R * 256) + off_a(row0, ch), la1 = lds_base + pnl * (R * 256) + off_a(row0 + RPI, ch);
    const bf16_t* gp = g + (size_t)row0 * ld + cc * 8;
    const size_t gstep = (size_t)RPI * ld;
#pragma unroll
    for (int it = 0; it < NIT; ++it) {
        bf16x8 v = *(const bf16x8*)(gp + it * gstep);
        if (SCALE) v = scale_frag(v, rowscale[row0 + it * RPI]);
        const unsigned la = (RPI % 16 == 0) ? la0 + it * (RPI * 256) : ((it & 1) ? la1 + (it >> 1) * (2 * RPI * 256) : la0 + (it >> 1) * (2 * RPI * 256));
        *(LAS bf16x8*)(uintptr_t)la = v;
        if ((it & 3) == 3) FENCE();
    }
}
template <int R, int CW>
__device__ __forceinline__ void stage_tile_narrow(int tid, unsigned lds_base, const bf16_t* g, int ld) {
    static_assert(CW == 64 && R % 64 == 0, "stage_tile_narrow geometry");
    const int row0 = tid >> 3, ch = tid & 7;
    const unsigned la0 = lds_base + off_a(row0, ch);
    const bf16_t* gp = g + (size_t)row0 * ld + ch * 8;
#pragma unroll
    for (int it = 0; it < R / 64; ++it) *(LAS bf16x8*)(uintptr_t)(la0 + it * 16384) = *(const bf16x8*)(gp + (size_t)it * 64 * ld);
}

struct StateArgs {
    const bf16_t* K; int ldk;
    const bf16_t* V; int ldv;
    bf16_t* Cout; int ldc; size_t cstride;
    float* Nout;
    const float* alpha; const float* beta;
    float lgam; int dir;
};
template <int DK, int DVB, bool MLSTM>
__device__ __forceinline__ void state_unit(LAS unsigned char* lds, const StateArgs a) {
    constexpr int NDKB = DK / 32, NDVB = DVB / 32, BPW = (NDKB * NDVB) / 8, NPK = DK / 128;
    static_assert(BPW >= 1 && (NDKB == 8 || NDKB == 4), "state tile geometry");
    int tid = threadIdx.x; asm volatile("" : "+v"(tid));
    const int wid = __builtin_amdgcn_readfirstlane(tid >> 6), lane = tid & 63, r32 = lane & 31, hi = lane >> 5;
    const int dkb = wid % NDKB, dvb0 = (wid / NDKB) * BPW;
    const unsigned ldsb = (unsigned)(uintptr_t)lds;
    const unsigned KP = ldsb, VP = ldsb + NPK * 32768u, WT = VP + 32768u;
    LAS float* wtab = (LAS float*)(lds + NPK * 32768 + 32768);
    const unsigned tb0 = t_base(lane, 0), tb1 = t_base(lane, 1);
    f32x16 acc[BPW];
#pragma unroll
    for (int j = 0; j < BPW; ++j) acc[j] = (f32x16){};
    float nacc = 0.f;
#pragma unroll 1
    for (int ci = 0; ci < 32; ++ci) {
        const int c = a.dir ? 31 - ci : ci; const int t0 = c * 128;
        {
            bf16_t* co = a.Cout + (size_t)c * a.cstride;
#pragma unroll
            for (int j = 0; j < BPW; ++j)
#pragma unroll
                for (int r = 0; r < 16; ++r) co[(size_t)(32 * dkb + crow(r, hi)) * a.ldc + 32 * (dvb0 + j) + r32] = f2bf(acc[j][r]);
            if (MLSTM) { if (a.Nout && tid < DK) a.Nout[(size_t)c * DK + tid] = nacc; }
        }
        float eF;
        if (MLSTM) {
            const float F = a.alpha[t0 + (a.dir ? 0 : 127)];
            if (tid < 128) wtab[tid] = __expf(F - a.alpha[t0 + tid] + a.beta[t0 + tid]);
            eF = __expf(F);
        } else {
            if (tid < 128) { const int sp = a.dir ? 127 - tid : tid; wtab[tid] = __expf((float)(127 - sp) * a.lgam); }
            eF = __expf(128.f * a.lgam);
        }
        __syncthreads();
        stage_tile<128, NPK, true>(tid, KP, a.K + (size_t)t0 * a.ldk, a.ldk, wtab);
        if constexpr (DVB == 128) stage_tile<128, 1, false>(tid, VP, a.V + (size_t)t0 * a.ldv, a.ldv, nullptr);
        else stage_tile_narrow<128, DVB>(tid, VP, a.V + (size_t)t0 * a.ldv, a.ldv);
        __syncthreads();
#pragma unroll
        for (int j = 0; j < BPW; ++j)
#pragma unroll
            for (int r = 0; r < 16; ++r) acc[j][r] *= eF;
#pragma unroll
        for (int ks = 0; ks < 8; ++ks) {
            const unsigned ka = KP + (dkb >> 2) * 32768u + 4096u * ks + 512u * (dkb & 3);
            const bf16x8 af = lds_tr_frag(ka + tb0, ka + tb1);
#pragma unroll
            for (int j = 0; j < BPW; ++j) {
                const unsigned va = VP + 4096u * ks + 512u * (dvb0 + j);
                const bf16x8 bfr = lds_tr_frag(va + tb0, va + tb1);
                acc[j] = __builtin_amdgcn_mfma_f32_32x32x16_bf16(af, bfr, acc[j], 0, 0, 0);
            }
            FENCE();
        }
        if (MLSTM) {
            if (tid < DK) { float s = 0.f; const int pnl = tid >> 7, col = tid & 127;
                for (int p = 0; p < 128; ++p) s += bf2f(*(const LAS bf16_t*)(lds + pnl * 32768 + off_a(p, col >> 3) + (col & 7) * 2));
                nacc = eF * nacc + s; }
        }
        __syncthreads();
    }
    (void)WT;
}

struct OutArgs {
    const bf16_t* Q; int ldq;
    const bf16_t* K; int ldk;
    const bf16_t* V; int ldv;
    const bf16_t* Cf; const bf16_t* Cb;
    const float* Nf; const float* Nb;
    const float* af; const float* bfw; const float* ab; const float* bbw;
    float Mf, Mb;
    float lgf, lgb;
    const float* gain;
    const bf16_t* G; int ldg;
    bf16_t* Out; int ldo;
};
template <int DK, int DV, bool MLSTM>
__device__ __forceinline__ void out_unit(LAS unsigned char* lds, LAS unsigned char* ldstab, const OutArgs a) {
    constexpr int NPK = DK / 128, NB = DV / 64, NPV = DV / 128, NKS = DK / 16, NCP = DK / 64;
    int tid = threadIdx.x; asm volatile("" : "+v"(tid));
    const int wid = __builtin_amdgcn_readfirstlane(tid >> 6), lane = tid & 63, r32 = lane & 31, hi = lane >> 5;
    const int rb = wid & 3, dh = wid >> 2;
    const unsigned ldsb = (unsigned)(uintptr_t)lds;
    const unsigned QP = ldsb, KP = ldsb + NPK * 32768u, SB = KP;
    LAS float* akf = (LAS float*)ldstab; LAS float* akb = akf + 128; LAS float* nf = akb + 128; LAS float* nbv = nf + 256; LAS float* exch = nbv + 256;
    const unsigned rb0 = r_base(lane, 0), rb1 = r_base(lane, 1), tb0 = t_base(lane, 0), tb1 = t_base(lane, 1);
    __syncthreads();
    stage_tile<128, NPK, false>(tid, QP, a.Q, a.ldq, nullptr);
    stage_tile<128, NPK, false>(tid, KP, a.K, a.ldk, nullptr);
    if (tid < 128) {
        if (MLSTM) { akf[tid] = a.af[tid] - a.bfw[tid]; akb[tid] = a.ab[tid] - a.bbw[tid]; }
        else { akf[tid] = (float)(tid + 1) * a.lgf; akb[tid] = (float)(128 - tid) * a.lgb; }
    }
    if (MLSTM) { if (tid < DK) { nf[tid] = a.Nf[tid]; nbv[tid] = a.Nb[tid]; } }
    const int l = 32 * rb + r32;
    float a_fl, a_bl;
    if (MLSTM) { a_fl = a.af[l]; a_bl = a.ab[l]; } else { a_fl = (float)(l + 1) * a.lgf; a_bl = (float)(128 - l) * a.lgb; }
    __syncthreads();
    f32x16 p[4];
#pragma unroll
    for (int kb = 0; kb < 4; ++kb) p[kb] = (f32x16){};
    float qnf = 0.f, qnb = 0.f;
#pragma unroll
    for (int ks = 0; ks < NKS; ++ks) {
        const unsigned po = (ks >> 3) * 32768u + ((ks & 1) ? rb1 : rb0) + 512u * ((ks & 7) >> 1);
        const bf16x8 qf = lds_r128(QP + po + 8192u * rb);
        bf16x8 kf[4];
#pragma unroll
        for (int kb = 0; kb < 4; ++kb) kf[kb] = lds_r128(KP + po + 8192u * kb);
#pragma unroll
        for (int kb = 0; kb < 4; ++kb) p[kb] = __builtin_amdgcn_mfma_f32_32x32x16_bf16(kf[kb], qf, p[kb], 0, 0, 0);
        FENCE();
    }
    if (MLSTM) {
#pragma unroll 1
        for (int ks = 0; ks < NKS; ++ks) {
            const bf16x8 qf = lds_r128(QP + (ks >> 3) * 32768u + ((ks & 1) ? rb1 : rb0) + 512u * ((ks & 7) >> 1) + 8192u * rb);
            const u32x4 w = __builtin_bit_cast(u32x4, qf); const int k0 = 16 * ks + 8 * hi;
            const f32x4 nf0 = *(const LAS f32x4*)(nf + k0), nf1 = *(const LAS f32x4*)(nf + k0 + 4), nb0 = *(const LAS f32x4*)(nbv + k0), nb1 = *(const LAS f32x4*)(nbv + k0 + 4);
            const float q0 = bf_lo(w.x), q1 = bf_hi(w.x), q2 = bf_lo(w.y), q3 = bf_hi(w.y), q4 = bf_lo(w.z), q5 = bf_hi(w.z), q6 = bf_lo(w.w), q7 = bf_hi(w.w);
            qnf += q0 * nf0[0] + q1 * nf0[1] + q2 * nf0[2] + q3 * nf0[3] + q4 * nf1[0] + q5 * nf1[1] + q6 * nf1[2] + q7 * nf1[3];
            qnb += q0 * nb0[0] + q1 * nb0[1] + q2 * nb0[2] + q3 * nb0[3] + q4 * nb1[0] + q5 * nb1[1] + q6 * nb1[2] + q7 * nb1[3];
        }
    }
    float rf = 1.f, rbk = 1.f;
    if (MLSTM) {
        float df = 0.f, db = 0.f;
#pragma unroll
        for (int kb = 0; kb < 4; ++kb) {
#pragma unroll
            for (int r = 0; r < 16; ++r) { const int s = 32 * kb + crow(r, hi);
                const float xf = a_fl - akf[s], xb = a_bl - akb[s];
                const float wf = __expf((s <= l) ? xf : -1.0e30f), wb = __expf((s >= l) ? xb : -1.0e30f);
                df += p[kb][r] * wf; db += p[kb][r] * wb; }
            FENCE(); }
        { auto rr = __builtin_amdgcn_permlane32_swap(__float_as_uint(df), __float_as_uint(df), false, false); df = __uint_as_float(rr[0]) + __uint_as_float(rr[1]); }
        { auto rr = __builtin_amdgcn_permlane32_swap(__float_as_uint(db), __float_as_uint(db), false, false); db = __uint_as_float(rr[0]) + __uint_as_float(rr[1]); }
        { auto rr = __builtin_amdgcn_permlane32_swap(__float_as_uint(qnf), __float_as_uint(qnf), false, false); qnf = __uint_as_float(rr[0]) + __uint_as_float(rr[1]); }
        { auto rr = __builtin_amdgcn_permlane32_swap(__float_as_uint(qnb), __float_as_uint(qnb), false, false); qnb = __uint_as_float(rr[0]) + __uint_as_float(rr[1]); }
        df += __expf(a_fl) * qnf; db += __expf(a_bl) * qnb;
        rf = 1.f / fmaxf(fabsf(df), __expf(-a.Mf)); rbk = 1.f / fmaxf(fabsf(db), __expf(-a.Mb));
        asm volatile("" : "+v"(a_fl), "+v"(a_bl));
    }
    int l2 = l; asm volatile("" : "+v"(l2));
#pragma unroll
    for (int kb = 0; kb < 4; ++kb) {
#pragma unroll
        for (int r = 0; r < 16; ++r) { const int s = 32 * kb + crow(r, hi);
            const float xf = a_fl - akf[s], xb = a_bl - akb[s];
            const float wf = __expf((s <= l2) ? xf : -1.0e30f), wb = __expf((s >= l2) ? xb : -1.0e30f);
            p[kb][r] *= (wf * rf + wb * rbk); }
        FENCE(); }
    const float qsf = __expf(a_fl) * rf, qsb = __expf(a_bl) * rbk;
    bf16x8 pa[8];
#define LA_PK4(P, BASE, OUT) do { unsigned a0 = cvt_pk_bf16(P[BASE + 0], P[BASE + 1]), a1 = cvt_pk_bf16(P[BASE + 2], P[BASE + 3]); \
    unsigned b0 = cvt_pk_bf16(P[BASE + 4], P[BASE + 5]), b1 = cvt_pk_bf16(P[BASE + 6], P[BASE + 7]); \
    auto r0 = __builtin_amdgcn_permlane32_swap(a0, b0, false, false); auto r1 = __builtin_amdgcn_permlane32_swap(a1, b1, false, false); \
    u32x4 w = {r0[0], r1[0], r0[1], r1[1]}; OUT = __builtin_bit_cast(bf16x8, w); } while (0)
#pragma unroll
    for (int kb = 0; kb < 4; ++kb) { LA_PK4(p[kb], 0, pa[2 * kb]); LA_PK4(p[kb], 8, pa[2 * kb + 1]); }
#undef LA_PK4
    f32x16 o[NB];
#pragma unroll
    for (int nb = 0; nb < NB; ++nb) o[nb] = (f32x16){};
#pragma unroll
    for (int pc = 0; pc < 2; ++pc) {
        __syncthreads();
        stage_tile<64, NPV, false>(tid, SB, a.V + (size_t)(64 * pc) * a.ldv, a.ldv, nullptr);
        __syncthreads();
#pragma unroll
        for (int ks = 0; ks < 4; ++ks) {
            const bf16x8 af = pa[4 * pc + ks];
#pragma unroll
            for (int nb = 0; nb < NB; ++nb) { const int cg = dh * NB + nb; const unsigned va = SB + (cg >> 2) * 16384u + 4096u * ks + 512u * (cg & 3);
                const bf16x8 bfr = lds_tr_frag(va + tb0, va + tb1);
                o[nb] = __builtin_amdgcn_mfma_f32_32x32x16_bf16(af, bfr, o[nb], 0, 0, 0); }
            FENCE();
        }
    }
#pragma unroll 1
    for (int pc = 0; pc < 2 * NCP; ++pc) {
        __syncthreads();
        const int dirb = pc >= NCP, cp = dirb ? pc - NCP : pc;
        const bf16_t* src = (dirb ? a.Cb : a.Cf) + (size_t)(64 * cp) * DV;
        const float qs = dirb ? qsb : qsf;
        stage_tile<64, NPV, false>(tid, SB, src, DV, nullptr);
        __syncthreads();
#pragma unroll
        for (int ks = 0; ks < 4; ++ks) {
            const int kq = 4 * cp + ks;
            const bf16x8 qf = lds_r128(QP + (kq >> 3) * 32768u + ((kq & 1) ? rb1 : rb0) + 512u * ((kq & 7) >> 1) + 8192u * rb);
            const bf16x8 af = scale_frag(qf, qs);
#pragma unroll
            for (int nb = 0; nb < NB; ++nb) { const int cg = dh * NB + nb; const unsigned va = SB + (cg >> 2) * 16384u + 4096u * ks + 512u * (cg & 3);
                const bf16x8 bfr = lds_tr_frag(va + tb0, va + tb1);
                o[nb] = __builtin_amdgcn_mfma_f32_32x32x16_bf16(af, bfr, o[nb], 0, 0, 0); }
            FENCE();
        }
    }
    float s1[16], s2[16];
#pragma unroll
    for (int r = 0; r < 16; ++r) { float x1 = 0.f, x2 = 0.f;
#pragma unroll
        for (int nb = 0; nb < NB; ++nb) { x1 += o[nb][r]; x2 += o[nb][r] * o[nb][r]; }
#pragma unroll
        for (int m = 1; m < 32; m <<= 1) { x1 += shx(x1, m, lane); x2 += shx(x2, m, lane); }
        s1[r] = x1; s2[r] = x2; }
    if (r32 == 0) {
#pragma unroll
        for (int r = 0; r < 16; ++r) { const int row = 32 * rb + crow(r, hi); exch[(dh * 128 + row) * 2] = s1[r]; exch[(dh * 128 + row) * 2 + 1] = s2[r]; }
    }
    __syncthreads();
#pragma unroll
    for (int r = 0; r < 16; ++r) {
        const int row = 32 * rb + crow(r, hi);
        const float t1 = s1[r] + exch[((1 - dh) * 128 + row) * 2], t2 = s2[r] + exch[((1 - dh) * 128 + row) * 2 + 1];
        float mean, inv;
        if (MLSTM) { mean = 0.f; inv = rsqrtf(t2 * (1.f / DV) + EPS); }
        else { mean = t1 * (1.f / DV); inv = rsqrtf(fmaxf(t2 * (1.f / DV) - mean * mean, 0.f) + EPS); }
#pragma unroll
        for (int nb = 0; nb < NB; ++nb) {
            const int col = dh * (DV / 2) + 32 * nb + r32;
            const float gpre = bf2f(a.G[(size_t)row * a.ldg + col]);
            const float gate = MLSTM ? sigmoidf_(gpre) : siluf_(gpre);
            a.Out[(size_t)row * a.ldo + col] = f2bf((o[nb][r] - mean) * inv * a.gain[col] * gate);
        }
    }
}
}
namespace att {
constexpr int DQK = 96, DVV = 64, NW = 8, QBLK = 32, KVBLK = 64, KROW = 128;
constexpr float SCALE = 0.10206207261596575f;
constexpr float THR = 8.f;
constexpr size_t SHM_V = KVBLK * DVV * 2, SHM_K = KVBLK * KROW * 2, SHM_ATTN = 2 * SHM_V + 2 * SHM_K + NW * 64 * 4;
#define KSWZ(row, colB) ((row) * 256 + ((colB) ^ (((row) & 7) << 4)))
__device__ __forceinline__ int crow(int r, int hi) { return (r & 3) + 8 * (r >> 2) + 4 * hi; }

__device__ __forceinline__ void partialSM(f32x16& p0, f32x16& p1, float& m_reg, float& mn, float& alpha) {
  constexpr float C = SCALE * 1.4426950408889634f;
  float pmax = p0[0]; for (int r = 1; r < 16; ++r) pmax = fmaxf(pmax, p0[r]); for (int r = 0; r < 16; ++r) pmax = fmaxf(pmax, p1[r]);
  { auto rr = __builtin_amdgcn_permlane32_swap(__float_as_uint(pmax), __float_as_uint(pmax), false, false);
    pmax = fmaxf(__uint_as_float(rr[0]), __uint_as_float(rr[1])); }
  if (__builtin_expect(__all(pmax - m_reg <= THR / SCALE), 1)) { mn = m_reg; alpha = 1.f; }
  else { mn = fmaxf(m_reg, pmax); alpha = __builtin_amdgcn_exp2f((m_reg - mn) * C); m_reg = mn; }
  float mnC = -mn * C;
  for (int r = 0; r < 16; ++r) p0[r] = fmaf(p0[r], C, mnC); for (int r = 0; r < 16; ++r) p1[r] = fmaf(p1[r], C, mnC);
  for (int r = 0; r < 16; ++r) p0[r] = __builtin_amdgcn_exp2f(p0[r]);
}
__device__ __forceinline__ void finishSM(f32x16& p0, f32x16& p1, float alpha, float& l_reg, bf16x8& pa0, bf16x8& pa1, bf16x8& pa2, bf16x8& pa3) {
  for (int r = 0; r < 16; ++r) p1[r] = __builtin_amdgcn_exp2f(p1[r]);
  float ps = 0; for (int r = 0; r < 16; ++r) ps += p0[r]; for (int r = 0; r < 16; ++r) ps += p1[r];
  { auto rr = __builtin_amdgcn_permlane32_swap(__float_as_uint(ps), __float_as_uint(ps), false, false);
    ps = __uint_as_float(rr[0]) + __uint_as_float(rr[1]); }
  l_reg = l_reg * alpha + ps;
#define PK4(P, BASE, OUT) do { unsigned a0 = cvt_pk_bf16(P[BASE + 0], P[BASE + 1]), a1 = cvt_pk_bf16(P[BASE + 2], P[BASE + 3]);   \
    unsigned b0 = cvt_pk_bf16(P[BASE + 4], P[BASE + 5]), b1 = cvt_pk_bf16(P[BASE + 6], P[BASE + 7]);                              \
    auto r0 = __builtin_amdgcn_permlane32_swap(a0, b0, false, false); auto r1 = __builtin_amdgcn_permlane32_swap(a1, b1, false, false); \
    u32x4 w = {r0[0], r1[0], r0[1], r1[1]}; OUT = __builtin_bit_cast(bf16x8, w); } while (0)
  PK4(p0, 0, pa0); PK4(p0, 8, pa1); PK4(p1, 0, pa2); PK4(p1, 8, pa3);
#undef PK4
}
__device__ __forceinline__ void qkt(f32x16& p0, f32x16& p1, const LAS char* Ks, const bf16x8* qr, int r32, int hi) {
  p0 = f32x16{}; p1 = f32x16{};
#pragma unroll
  for (int d0 = 0; d0 < DQK / 16; ++d0) { int cb = (d0 * 16 + hi * 8) * 2;
    bf16x8 b0 = *reinterpret_cast<const LAS bf16x8*>(Ks + KSWZ(r32, cb));
    bf16x8 b1 = *reinterpret_cast<const LAS bf16x8*>(Ks + KSWZ(32 + r32, cb));
    p0 = __builtin_amdgcn_mfma_f32_32x32x16_bf16(b0, qr[d0], p0, 0, 0, 0);
    p1 = __builtin_amdgcn_mfma_f32_32x32x16_bf16(b1, qr[d0], p1, 0, 0, 0); }
}
__device__ __forceinline__ int v_st(int k, int c) { const int kk = (k & ~0xC) | ((k & 4) << 1) | ((k & 8) >> 1); return ((kk >> 3) * 2 + (c >> 5)) * 512 + ((kk & 7) * 32 + (c & 31)) * 2; }
__device__ __forceinline__ int v_rd_base(int lane) { return ((lane & 3) << 3) | (((lane >> 2) & 3) << 6) | (((lane >> 4) & 1) << 5) | (((lane >> 5) & 1) << 8); }
constexpr int v_rd_off(int d0, int ks, int half) { return d0 * 512 + ks * 2048 + half * 1024; }
template <int OFF> __device__ __forceinline__ s16x4 tr_read(int vb) {
  s16x4 r; asm volatile("ds_read_b64_tr_b16 %0, %1 offset:%2" : "=&v"(r) : "v"(vb), "i"(OFF) : "memory"); return r;
}
template <int D0> __device__ __forceinline__ void pv_one(f32x16& od, int vb, bf16x8 pa0, bf16x8 pa1, bf16x8 pa2, bf16x8 pa3) {
  const s16x4 l0 = tr_read<v_rd_off(D0, 0, 0)>(vb), h0 = tr_read<v_rd_off(D0, 0, 1)>(vb), l1 = tr_read<v_rd_off(D0, 1, 0)>(vb), h1 = tr_read<v_rd_off(D0, 1, 1)>(vb);
  const s16x4 l2 = tr_read<v_rd_off(D0, 2, 0)>(vb), h2 = tr_read<v_rd_off(D0, 2, 1)>(vb), l3 = tr_read<v_rd_off(D0, 3, 0)>(vb), h3 = tr_read<v_rd_off(D0, 3, 1)>(vb);
  asm volatile("s_waitcnt lgkmcnt(0)" ::: "memory"); SBAR();
#define PK(L, H) (bf16x8){L[0], L[1], L[2], L[3], H[0], H[1], H[2], H[3]}
  od = __builtin_amdgcn_mfma_f32_32x32x16_bf16(pa0, PK(l0, h0), od, 0, 0, 0);
  od = __builtin_amdgcn_mfma_f32_32x32x16_bf16(pa1, PK(l1, h1), od, 0, 0, 0);
  od = __builtin_amdgcn_mfma_f32_32x32x16_bf16(pa2, PK(l2, h2), od, 0, 0, 0);
  od = __builtin_amdgcn_mfma_f32_32x32x16_bf16(pa3, PK(l3, h3), od, 0, 0, 0);
#undef PK
}
__device__ __forceinline__ void pv_d0(f32x16* o, int vb, bf16x8 pa0, bf16x8 pa1, bf16x8 pa2, bf16x8 pa3) {
  pv_one<0>(o[0], vb, pa0, pa1, pa2, pa3); pv_one<1>(o[1], vb, pa0, pa1, pa2, pa3);
}
__device__ __forceinline__ void attn_body(const bf16_t* __restrict__ Qb, const bf16_t* __restrict__ Kh, const bf16_t* __restrict__ Vh, bf16_t* __restrict__ Ob, int ldo, int seq, LAS char* lds) {
  int tid = threadIdx.x; asm volatile("" : "+v"(tid));
  const int wid = tid >> 6, lane = tid & 63, r32 = lane & 31, hi = lane >> 5;
  LAS char* V_lds = lds; LAS char* K_lds = lds + 2 * SHM_V;
  LAS float* ws = (LAS float*)(lds + 2 * SHM_V + 2 * SHM_K) + wid * 64; LAS float* li_l = ws; LAS float* al_l = ws + 32;
  float m_reg = -1e30f, l_reg = 0; f32x16 o[2] = {}; bf16x8 qr[DQK / 16];
  const bf16_t* Qw = Qb + (long)(wid * QBLK + r32) * DQK + hi * 8;
#pragma unroll
  for (int d0 = 0; d0 < DQK / 16; ++d0) qr[d0] = *reinterpret_cast<const bf16x8*>(Qw + d0 * 16);
  const int sr = tid >> 4, sc = (tid & 15) * 8;
  const int vr = tid >> 3, vc = (tid & 7) * 8, vst0 = v_st(vr, vc);
  const int vb0 = (int)(uintptr_t)V_lds + v_rd_base(lane);
  struct { bf16x8 vs0, ks0, ks1; } sr_[2];
#define SLOAD(i, k0) do { sr_[i].vs0 = *reinterpret_cast<const bf16x8*>(&Vh[(long)((k0) + vr) * DVV + vc]); \
    sr_[i].ks0 = *reinterpret_cast<const bf16x8*>(&Kh[(long)((k0) + sr) * KROW + sc]); sr_[i].ks1 = *reinterpret_cast<const bf16x8*>(&Kh[(long)((k0) + 32 + sr) * KROW + sc]); } while (0)
#define SWRITE(b, i) do { *(LAS bf16x8*)(V_lds + (b) * SHM_V + vst0) = sr_[i].vs0; int kc = sc * 2;               \
    *(LAS bf16x8*)(K_lds + (b) * SHM_K + KSWZ(sr, kc)) = sr_[i].ks0;                       \
    *(LAS bf16x8*)(K_lds + (b) * SHM_K + KSWZ(32 + sr, kc)) = sr_[i].ks1; } while (0)
#define SWAIT() asm volatile("s_waitcnt vmcnt(3)" ::: "memory")
#define RESC(a) do { if (__any((a) < 1.f)) { if (hi == 0) al_l[r32] = (a); asm volatile("s_waitcnt lgkmcnt(0)" ::: "memory"); \
    for (int d = 0; d < 2; ++d) for (int r = 0; r < 16; ++r) o[d][r] *= al_l[crow(r, hi)]; } } while (0)
  f32x16 pA0, pA1, pB0, pB1; float mnA, mnB, alA, alB; bf16x8 pa0, pa1, pa2, pa3; const int NT = seq / KVBLK;
  constexpr int SE = 0, SO = 1;
  SLOAD(SE, 0); asm volatile("s_waitcnt vmcnt(0)" ::: "memory"); SWRITE(0, SE); __syncthreads();
  qkt(pA0, pA1, K_lds, qr, r32, hi); partialSM(pA0, pA1, m_reg, mnA, alA);
  SLOAD(SO, KVBLK); if (2 < NT) SLOAD(SE, 2 * KVBLK);
  SWAIT(); SWRITE(1, SO); __syncthreads();
  for (int j = 1; j + 1 < NT; j += 2) {
    SBAR(); qkt(pB0, pB1, K_lds + SHM_K, qr, r32, hi);
    finishSM(pA0, pA1, alA, l_reg, pa0, pa1, pa2, pa3); SBAR();
    SLOAD(SO, (j + 2) * KVBLK); SBAR();
    pv_d0(o, vb0, pa0, pa1, pa2, pa3); partialSM(pB0, pB1, m_reg, mnB, alB);
    __syncthreads(); SWAIT(); SWRITE(0, SE);
    RESC(alB); __syncthreads();
    SBAR(); qkt(pA0, pA1, K_lds, qr, r32, hi);
    finishSM(pB0, pB1, alB, l_reg, pa0, pa1, pa2, pa3); SBAR();
    if (j + 3 < NT) SLOAD(SE, (j + 3) * KVBLK); SBAR();
    pv_d0(o, vb0 + (int)SHM_V, pa0, pa1, pa2, pa3); partialSM(pA0, pA1, m_reg, mnA, alA);
    __syncthreads(); SWAIT(); SWRITE(1, SO);
    RESC(alA); __syncthreads();
  }
  SBAR(); qkt(pB0, pB1, K_lds + SHM_K, qr, r32, hi);
  finishSM(pA0, pA1, alA, l_reg, pa0, pa1, pa2, pa3); SBAR();
  pv_d0(o, vb0, pa0, pa1, pa2, pa3); partialSM(pB0, pB1, m_reg, mnB, alB);
  __syncthreads(); RESC(alB);
  finishSM(pB0, pB1, alB, l_reg, pa0, pa1, pa2, pa3); SBAR();
  pv_d0(o, vb0 + (int)SHM_V, pa0, pa1, pa2, pa3);
  if (hi == 0) li_l[r32] = l_reg; asm volatile("s_waitcnt lgkmcnt(0)" ::: "memory");
  float rli[16];
#pragma unroll
  for (int r = 0; r < 16; ++r) rli[r] = __builtin_amdgcn_rcpf(li_l[crow(r, hi)]);
  bf16_t* Ow = Ob + (long)(wid * QBLK) * ldo;
#pragma unroll
  for (int r = 0; r < 16; ++r) { int orow = crow(r, hi);
#pragma unroll
    for (int d0 = 0; d0 < 2; ++d0) Ow[(long)orow * ldo + d0 * 32 + r32] = f2bf(o[d0][r] * rli[r]); }
  __syncthreads();
#undef SLOAD
#undef SWRITE
#undef SWAIT
#undef RESC
}
#undef KSWZ
}
constexpr size_t MiB = 1ull << 20;
constexpr size_t WS_CTL = 0, CTL_ZERO_BYTES = 1 * MiB;
constexpr size_t WS_MOD = 1 * MiB;
constexpr size_t WS_MISC = 2 * MiB;
constexpr size_t WS_ROPEO = 8 * MiB;
constexpr size_t WS_ROPEE = 40 * MiB;
constexpr size_t WS_WINE = 48 * MiB;
constexpr size_t WS_WQB = 58 * MiB;
constexpr size_t WS_WKVB = 59 * MiB;
constexpr size_t WS_WOUTE = 60 * MiB;
constexpr size_t WS_WINO = 64 * MiB;
constexpr size_t WS_WOUTO = 88 * MiB;
constexpr size_t WS_WGU = 96 * MiB;
constexpr size_t WS_WDN = 608 * MiB;
constexpr size_t WS_HM = 864 * MiB;
constexpr size_t WS_P = 928 * MiB;
constexpr size_t WS_X1 = 1312 * MiB;
constexpr size_t X1_QC = WS_X1, X1_KC = X1_QC + 32 * MiB, X1_QA = X1_KC + 32 * MiB, X1_KVA = X1_QA + 16 * MiB, X1_QRAW = X1_KVA + 16 * MiB, X1_KVRAW = X1_QRAW + 48 * MiB,
                 X1_QH = X1_KVRAW + 64 * MiB, X1_KH = X1_QH + 48 * MiB, X1_VH = X1_KH + 64 * MiB, X1_CM = X1_VH + 32 * MiB, X1_NM = X1_CM + 64 * MiB;
constexpr size_t WS_MIX = WS_X1 + 512 * MiB;
constexpr size_t WS_LIST = WS_MIX + 128 * MiB;
constexpr size_t WS_WLIST = WS_LIST + 16 * MiB;
constexpr size_t WS_TOKE = WS_WLIST + 16 * MiB;
constexpr size_t WS_WSORT = WS_TOKE + 1 * MiB;
constexpr size_t WS_ASORT = WS_WSORT + 1 * MiB;
constexpr size_t WS_ACT = WS_ASORT + 272 * MiB;
constexpr size_t WS_Y = WS_ACT + 272 * MiB;
constexpr size_t WS_END = WS_Y + 272 * MiB;
static_assert(X1_NM + 1 * MiB <= WS_MIX, "even-layer scratch fits");
constexpr int CW_BAR = 4096;
constexpr int CW_CNT = 8192;
constexpr int CW_QUEUE = 8192 + 1024;

constexpr int LDS_RING = 0;
constexpr int LDS_TAB = 131072;
constexpr int LT_MISC = LDS_TAB;
constexpr int LT_PSTART = LDS_TAB + 256;
constexpr int LT_CNT = LDS_TAB + 512;
constexpr int LT_BLK = LDS_TAB + 1024;
constexpr int LT_X = LDS_TAB + 1024 + 4352;
constexpr int LDS_BYTES = 147456;

#if defined(__HIP_DEVICE_COMPILE__) && __HIP_DEVICE_COMPILE__
#define ARGAS GAS
#else
#define ARGAS
#endif
typedef const ARGAS float* gcf_t; typedef const ARGAS int* gci_t;
struct Args {
    gcf_t x; gcf_t c; gci_t pos; gcf_t ada_w; gcf_t ada_b; gcf_t norm_mix_g; gcf_t norm_ffn_g;
    gcf_t hy_w_in; gcf_t ml_conv_w; gcf_t ml_conv_b; gcf_t ml_gate_b; gcf_t ml_norm_g; gcf_t mla_q_norm_g; gcf_t mla_kv_norm_g;
    gcf_t mla_w_qb; gcf_t mla_w_kvb; gcf_t mla_qk_q_g; gcf_t mla_qk_k_g; gcf_t hy_w_out;
    gcf_t ret_w_in; gcf_t ret_decay_f; gcf_t ret_decay_b; gcf_t ret_gn_g; gcf_t ret_w_out;
    gcf_t moe_router_w; gcf_t moe_router_b; gcf_t moe_w_gu; gcf_t moe_b_gu; gcf_t moe_w_down; gcf_t moe_b_down;
    ARGAS float* out; ARGAS unsigned char* ws; int ph_lo, ph_hi;
};

template <class RowMap>
__device__ __forceinline__ void transpose_item(const float* W, int N, bf16_t* WT, int ldk, LAS float* scr, int kb, int nb, int lane, const RowMap& rm) {
    const int k0 = 64 * kb, n0 = 32 * nb;
#pragma unroll 8
    for (int i = 0; i < 32; ++i) { const int kk = 2 * i + (lane >> 5); scr[kk * 33 + (lane & 31)] = W[(size_t)(k0 + kk) * N + n0 + (lane & 31)]; }
    LDS_WAIT(); asm volatile("" ::: "memory");
    const int c = lane & 7;
#pragma unroll
    for (int j = 0; j < 4; ++j) { const int n = (lane >> 3) + 8 * j; const LAS float* s = scr + (8 * c) * 33 + n;
        u32x4 o; o.x = cvt_pk_bf16(s[0 * 33], s[1 * 33]); o.y = cvt_pk_bf16(s[2 * 33], s[3 * 33]); o.z = cvt_pk_bf16(s[4 * 33], s[5 * 33]); o.w = cvt_pk_bf16(s[6 * 33], s[7 * 33]);
        *(u32x4*)(WT + (size_t)rm(n0 + n) * ldk + k0 + 8 * c) = o; }
    LDS_WAIT(); asm volatile("" ::: "memory");
}
struct RmId { __device__ __forceinline__ int operator()(int n) const { return n; } };
struct RmWinE { __device__ __forceinline__ int operator()(int n) const {
    if (n < 2048) return n; if (n < 2064) return PC_GT + (n - 2048); if (n < 2320) return PC_QA + (n - 2064); if (n < 2448) return PC_KVA + (n - 2320); return PC_KR + (n - 2448); } };
struct RmGu { __device__ __forceinline__ int operator()(int n) const { const int u = n & 1023; return 256 * (u >> 7) + (n >> 10) * 128 + (u & 127); } };

__device__ __forceinline__ void ld_row16(const float* p, int lane, f32x4 (&v)[4]) {
#pragma unroll
    for (int j = 0; j < 4; ++j) v[j] = *(const f32x4*)(p + 4 * lane + 256 * j);
}
struct Frame { LAS unsigned char* lds; int tid, lane, wave, G, bid; };
extern __shared__ __attribute__((aligned(16))) unsigned char lds_raw[];
#define MK_FRAME(F) Frame F; { int tz_ = threadIdx.x; asm volatile("" : "+v"(tz_)); \
    int g_ = gridDim.x, b_ = blockIdx.x; asm volatile("" : "+s"(g_), "+s"(b_)); \
    F.lds = (LAS unsigned char*)lds_raw; F.tid = tz_; F.lane = tz_ & 63; F.wave = __builtin_amdgcn_readfirstlane(tz_ >> 6); F.G = g_; F.bid = b_; }
typedef const __attribute__((address_space(4))) Args* CArgsP;
__device__ __forceinline__ const Args& fresh_args() { unsigned long long p = (unsigned long long)__builtin_amdgcn_kernarg_segment_ptr(); asm volatile("" : "+s"(p)); return *(const Args*)(CArgsP)p; }
__device__ __forceinline__ ARGAS unsigned char* opaque_ws(const ARGAS unsigned char* p) { unsigned long long v = (unsigned long long)p; asm volatile("" : "+s"(v)); return (ARGAS unsigned char*)v; }

__device__ __forceinline__ void p0_prologue(const Args& a) {
    MK_FRAME(F); ARGAS unsigned char* ws = opaque_ws(a.ws);
    {
        LAS float* cs = (LAS float*)(F.lds); LAS float* red = (LAS float*)(F.lds + 32768);
        for (int i = F.tid; i < NBATCH * DM; i += 512) cs[i] = siluf_(a.c[i]);
        __syncthreads();
        float* mod = (float*)(ws + WS_MOD);
        for (int it = F.bid; it < DEPTH * 48; it += F.G) {
            const int l = it / 48, n = (it % 48) * 128 + (F.tid & 127), ksl = F.tid >> 7;
            const float* w = a.ada_w + ((size_t)l * DM + ksl * 256) * 6144 + n;
            float acc[NBATCH];
#pragma unroll
            for (int b = 0; b < NBATCH; ++b) acc[b] = 0.f;
#pragma unroll 4
            for (int k = 0; k < 256; ++k) { const float wv = w[(size_t)k * 6144];
#pragma unroll
                for (int b = 0; b < NBATCH; ++b) acc[b] += cs[b * DM + ksl * 256 + k] * wv; }
#pragma unroll
            for (int b = 0; b < NBATCH; ++b) red[(ksl * NBATCH + b) * 128 + (F.tid & 127)] = acc[b];
            __syncthreads();
            for (int o = F.tid; o < NBATCH * 128; o += 512) { const int b = o >> 7, nn = o & 127;
                const float s = red[(0 * NBATCH + b) * 128 + nn] + red[(1 * NBATCH + b) * 128 + nn] + red[(2 * NBATCH + b) * 128 + nn] + red[(3 * NBATCH + b) * 128 + nn];
                const int col = (it % 48) * 128 + nn;
                mod[((size_t)l * NBATCH + b) * 6144 + col] = s + a.ada_b[(size_t)l * 6144 + col]; }
            __syncthreads();
        }
        __syncthreads();
    }
    {
        f32x2* ro = (f32x2*)(ws + WS_ROPEO); f32x2* re = (f32x2*)(ws + WS_ROPEE);
        const size_t gt = (size_t)F.bid * 512 + F.tid, GT = (size_t)F.G * 512;
        for (size_t i = gt; i < (size_t)NTOK * 128; i += GT) { const int tok = (int)(i >> 7), f = (int)(i & 127);
            const float inv = powf(10000.f, -(float)(2 * f) / 256.f); const float ang = (float)a.pos[tok] * inv; float s, c; sincosf(ang, &s, &c); ro[i] = (f32x2){c, s}; }
        for (size_t i = gt; i < (size_t)NTOK * 16; i += GT) { const int tok = (int)(i >> 4), f = (int)(i & 15);
            const float inv = powf(10000.f, -(float)(2 * f) / 32.f); const float ang = (float)a.pos[tok] * inv; float s, c; sincosf(ang, &s, &c); re[i] = (f32x2){c, s}; }
        bf16_t* wkv = (bf16_t*)(ws + WS_WKVB);
        for (size_t i = gt; i < (size_t)2 * 1024 * 16; i += GT) { const size_t row = i >> 4, ch = i & 15; *(u32x4*)(wkv + row * 256 + 128 + ch * 8) = (u32x4){0u, 0u, 0u, 0u}; }
    }
    {
        LAS float* scr = (LAS float*)(F.lds + F.wave * 16384);
        const int gw = F.bid * 8 + F.wave, NGW = F.G * 8;
        constexpr int I_WINE = 16 * 78, I_WQB = 4 * 24, I_WKVB = 2 * 32, I_WOUTE = 16 * 32, I_WINO = 16 * 192, I_WOUTO = 32 * 32, I_WGU = 16 * 64, I_WDN = 16 * 32;
        constexpr int T0 = 2 * I_WINE, T1 = T0 + 2 * I_WQB, T2 = T1 + 2 * I_WKVB, T3 = T2 + 2 * I_WOUTE, T4 = T3 + 2 * I_WINO, T5 = T4 + 2 * I_WOUTO, T6 = T5 + 128 * I_WGU, T7 = T6 + 128 * I_WDN;
        for (int it = gw; it < T7; it += NGW) {
            if (it < T0) { const int m = it / I_WINE, r = it % I_WINE, kb = r / 78, nb = r % 78;
                const float* W = a.hy_w_in + (size_t)m * DM * EVEN_IN; bf16_t* WT = (bf16_t*)(ws + WS_WINE) + (size_t)m * EVEN_INP * DM;
                const int k0 = 64 * kb, n0 = 32 * nb; const RmWinE rm;
#pragma unroll 8
                for (int i = 0; i < 32; ++i) { const int kk = 2 * i + (F.lane >> 5), n = n0 + (F.lane & 31); scr[kk * 33 + (F.lane & 31)] = (n < EVEN_IN) ? W[(size_t)(k0 + kk) * EVEN_IN + n] : 0.f; }
                LDS_WAIT(); asm volatile("" ::: "memory");
                const int c = F.lane & 7;
#pragma unroll
                for (int j = 0; j < 4; ++j) { const int n = (F.lane >> 3) + 8 * j; const LAS float* s = scr + (8 * c) * 33 + n;
                    u32x4 o; o.x = cvt_pk_bf16(s[0 * 33], s[1 * 33]); o.y = cvt_pk_bf16(s[2 * 33], s[3 * 33]); o.z = cvt_pk_bf16(s[4 * 33], s[5 * 33]); o.w = cvt_pk_bf16(s[6 * 33], s[7 * 33]);
                    if (n0 + n < EVEN_IN) *(u32x4*)(WT + (size_t)rm(n0 + n) * DM + k0 + 8 * c) = o; }
                LDS_WAIT(); asm volatile("" ::: "memory");
                continue; }
            if (it < T1) { const int q = it - T0, m = q / I_WQB, r = q % I_WQB; transpose_item(a.mla_w_qb + (size_t)m * 256 * 768, 768, (bf16_t*)(ws + WS_WQB) + (size_t)m * 768 * 256, 256, scr, r / 24, r % 24, F.lane, RmId()); continue; }
            if (it < T2) { const int q = it - T1, m = q / I_WKVB, r = q % I_WKVB; transpose_item(a.mla_w_kvb + (size_t)m * 128 * 1024, 1024, (bf16_t*)(ws + WS_WKVB) + (size_t)m * 1024 * 256, 256, scr, r / 32, r % 32, F.lane, RmId()); continue; }
            if (it < T3) { const int q = it - T2, m = q / I_WOUTE, r = q % I_WOUTE; transpose_item(a.hy_w_out + (size_t)m * DM * DM, DM, (bf16_t*)(ws + WS_WOUTE) + (size_t)m * DM * DM, DM, scr, r / 32, r % 32, F.lane, RmId()); continue; }
            if (it < T4) { const int q = it - T3, m = q / I_WINO, r = q % I_WINO; transpose_item(a.ret_w_in + (size_t)m * DM * RET_IN, RET_IN, (bf16_t*)(ws + WS_WINO) + (size_t)m * RET_IN * DM, DM, scr, r / 192, r % 192, F.lane, RmId()); continue; }
            if (it < T5) { const int q = it - T4, m = q / I_WOUTO, r = q % I_WOUTO; transpose_item(a.ret_w_out + (size_t)m * 2048 * DM, DM, (bf16_t*)(ws + WS_WOUTO) + (size_t)m * DM * 2048, 2048, scr, r / 32, r % 32, F.lane, RmId()); continue; }
            if (it < T6) { const int q = it - T5, m = q / I_WGU, r = q % I_WGU; transpose_item(a.moe_w_gu + (size_t)m * DM * 2048, 2048, (bf16_t*)(ws + WS_WGU) + (size_t)m * 2048 * DM, DM, scr, r / 64, r % 64, F.lane, RmGu()); continue; }
            { const int q = it - T6, m = q / I_WDN, r = q % I_WDN; transpose_item(a.moe_w_down + (size_t)m * EFF * DM, DM, (bf16_t*)(ws + WS_WDN) + (size_t)m * DM * EFF, EFF, scr, r / 32, r % 32, F.lane, RmId()); }
        }
    }
}

__device__ __forceinline__ void build_pstart(const Frame& F, const unsigned* cnt) {
    LAS int* ps = (LAS int*)(F.lds + LT_PSTART); LAS int* lc = (LAS int*)(F.lds + LT_CNT); LAS int* blk = (LAS int*)(F.lds + LT_BLK);
    __syncthreads();
    if (F.tid < 64) {
        const int e = F.tid & 31; const int c = (int)xb_ld((gbar_t)cnt + e); const int pad = (c + 255) & ~255;
        int incl = pad;
#pragma unroll
        for (int o = 1; o < 32; o <<= 1) { const int t = sh_fromi(incl, (e >= o) ? F.tid - o : F.tid); if (e >= o) incl += t; }
        if (F.tid < 32) { ps[e] = incl - pad; lc[e] = c; if (e == 31) ps[32] = incl; }
    }
    __syncthreads();
    const int nblk = ps[32] >> 8;
    for (int g = F.tid; g < nblk; g += 512) { int e = 0;
#pragma unroll
        for (int s = 16; s >= 1; s >>= 1) if (e + s < 32 && (ps[e + s] >> 8) <= g) e += s;
        blk[2 * g] = e; blk[2 * g + 1] = g - (ps[e] >> 8); }
    __syncthreads();
}

__device__ __forceinline__ void n1_phase(const Args& a, int layer, bool final_only) {
    MK_FRAME(F); ARGAS unsigned char* ws = opaque_ws(a.ws);
    const float* mod = (const float*)(ws + WS_MOD);
    const bool combine = layer > 0;
    const float* xsrc = (layer == 0) ? a.x : a.out;
    const int* toke = (const int*)(ws + WS_TOKE); const int* tokr = toke + NTOK * 4;
    const bf16_t* Y = (const bf16_t*)(ws + WS_Y);
    bf16_t* HM = (bf16_t*)(ws + WS_HM);
    LAS int* ps = (LAS int*)(F.lds + LT_PSTART);
    if (combine) build_pstart(F, (const unsigned*)(ws + WS_CTL) + CW_CNT + 64 * (layer - 1));
    const float* gmix = a.norm_mix_g + (size_t)(final_only ? 0 : layer) * DM;
    for (int tok = F.bid * 8 + F.wave; tok < NTOK; tok += F.G * 8) {
        const int b = tok >> 12;
        f32x4 v[4]; ld_row16(xsrc + (size_t)tok * DM, F.lane, v);
        if (combine) {
            const float* g2 = mod + ((size_t)(layer - 1) * NBATCH + b) * 6144 + 5 * DM;
            f32x4 ysum[4];
#pragma unroll
            for (int j = 0; j < 4; ++j) ysum[j] = (f32x4){0.f, 0.f, 0.f, 0.f};
#pragma unroll
            for (int k = 0; k < 4; ++k) { const int e = toke[tok * 4 + k], r = tokr[tok * 4 + k]; const size_t slot = (size_t)ps[e] + r;
                const bf16_t* yr = Y + slot * DM + 4 * F.lane;
#pragma unroll
                for (int j = 0; j < 4; ++j) { const u32x2 w = *(const u32x2*)(yr + 256 * j); ysum[j][0] += bf_lo(w.x); ysum[j][1] += bf_hi(w.x); ysum[j][2] += bf_lo(w.y); ysum[j][3] += bf_hi(w.y); } }
#pragma unroll
            for (int j = 0; j < 4; ++j) { const f32x4 g = *(const f32x4*)(g2 + 4 * F.lane + 256 * j); v[j] = v[j] + g * ysum[j]; *(f32x4*)(a.out + (size_t)tok * DM + 4 * F.lane + 256 * j) = v[j]; }
        }
        if (final_only) continue;
        float ss = 0.f;
#pragma unroll
        for (int j = 0; j < 4; ++j) ss += v[j][0] * v[j][0] + v[j][1] * v[j][1] + v[j][2] * v[j][2] + v[j][3] * v[j][3];
        const float inv = rsqrtf(wave_sum(ss, F.lane) * (1.f / DM) + EPS);
        const float* sh = mod + ((size_t)layer * NBATCH + b) * 6144; const float* sc = sh + DM;
#pragma unroll
        for (int j = 0; j < 4; ++j) { const int c0 = 4 * F.lane + 256 * j; const f32x4 g = *(const f32x4*)(gmix + c0), s1 = *(const f32x4*)(sc + c0), s0 = *(const f32x4*)(sh + c0);
            const f32x4 h = v[j] * inv * g * (s1 + 1.f) + s0;
            u32x2 o; o.x = cvt_pk_bf16(h[0], h[1]); o.y = cvt_pk_bf16(h[2], h[3]); *(u32x2*)(HM + (size_t)tok * DM + c0) = o; }
    }
}

__device__ __forceinline__ void e2_phase(const Args& a, int j) {
    MK_FRAME(F); ARGAS unsigned char* ws = opaque_ws(a.ws);
    const bf16_t* P = (const bf16_t*)(ws + WS_P);
    bf16_t* QC = (bf16_t*)(ws + X1_QC); bf16_t* KC = (bf16_t*)(ws + X1_KC); bf16_t* QA = (bf16_t*)(ws + X1_QA); bf16_t* KVA = (bf16_t*)(ws + X1_KVA);
    const float* cw = a.ml_conv_w + (size_t)j * 5 * 1024; const float* cb = a.ml_conv_b + (size_t)j * 1024;
    const float* qg = a.mla_q_norm_g + (size_t)j * 256; const float* kvg = a.mla_kv_norm_g + (size_t)j * 128;
    {
        float* ALPHA = (float*)(ws + WS_MISC); float* BETA = ALPHA + 2 * 32 * SEQ; float* MG = BETA + 2 * 32 * SEQ;
        LAS float* redm = (LAS float*)(F.lds);
        for (int u = F.bid; u < 64; u += F.G) {
            const int dir = u >> 5, bh = u & 31, b = bh >> 2, h = bh & 3;
            const float bi = a.ml_gate_b[j * 16 + (2 * dir) * 4 + h], bfg = a.ml_gate_b[j * 16 + (2 * dir + 1) * 4 + h];
            float li[8], lf[8];
#pragma unroll
            for (int i = 0; i < 8; ++i) { const size_t row = (size_t)b * SEQ + 8 * F.tid + i;
                li[i] = bf2f(P[row * EVEN_INP + PC_GT + (2 * dir) * 4 + h]) + bi;
                const float xf = bf2f(P[row * EVEN_INP + PC_GT + (2 * dir + 1) * 4 + h]) + bfg;
                lf[i] = fminf(xf, 0.f) - log1pf(__expf(-fabsf(xf))); }
            float mx = li[0];
#pragma unroll
            for (int i = 1; i < 8; ++i) mx = fmaxf(mx, li[i]);
            mx = wave_max(mx, F.lane); if (F.lane == 0) redm[F.wave] = mx;
            __syncthreads();
            float M = redm[0];
#pragma unroll
            for (int w = 1; w < 8; ++w) M = fmaxf(M, redm[w]);
            float al[8];
            if (dir == 0) { float s = 0.f;
#pragma unroll
                for (int i = 0; i < 8; ++i) { s += lf[i]; al[i] = s; }
                float tot = s, ex = 0.f;
#pragma unroll
                for (int o = 1; o < 16; o <<= 1) { const float t = sh_from(tot, ((F.lane & 15) >= o) ? F.lane - o : F.lane, F.lane); if ((F.lane & 15) >= o) tot += t; }
                ex = tot - s;
#pragma unroll
                for (int i = 0; i < 8; ++i) al[i] += ex;
            } else { float s = 0.f;
#pragma unroll
                for (int i = 7; i >= 0; --i) { s += lf[i]; al[i] = s; }
                float tot = s, ex = 0.f;
#pragma unroll
                for (int o = 1; o < 16; o <<= 1) { const float t = sh_from(tot, ((F.lane & 15) + o < 16) ? F.lane + o : F.lane, F.lane); if ((F.lane & 15) + o < 16) tot += t; }
                ex = tot - s;
#pragma unroll
                for (int i = 0; i < 8; ++i) al[i] += ex;
            }
            float* ao = ALPHA + ((size_t)dir * 32 + bh) * SEQ + 8 * F.tid; float* bo = BETA + ((size_t)dir * 32 + bh) * SEQ + 8 * F.tid;
            *(f32x4*)(ao) = (f32x4){al[0], al[1], al[2], al[3]}; *(f32x4*)(ao + 4) = (f32x4){al[4], al[5], al[6], al[7]};
            *(f32x4*)(bo) = (f32x4){li[0] - M, li[1] - M, li[2] - M, li[3] - M}; *(f32x4*)(bo + 4) = (f32x4){li[4] - M, li[5] - M, li[6] - M, li[7] - M};
            if (F.tid == 0) MG[dir * 32 + bh] = M;
            __syncthreads();
        }
    }
    for (int tok = F.bid * 8 + F.wave; tok < NTOK; tok += F.G * 8) {
        const int s = tok & (SEQ - 1);
        float aq[8], ak[8];
        { const f32x4 b0 = *(const f32x4*)(cb + 8 * F.lane), b1 = *(const f32x4*)(cb + 8 * F.lane + 4), b2 = *(const f32x4*)(cb + 512 + 8 * F.lane), b3 = *(const f32x4*)(cb + 512 + 8 * F.lane + 4);
#pragma unroll
          for (int i = 0; i < 4; ++i) { aq[i] = b0[i]; aq[4 + i] = b1[i]; ak[i] = b2[i]; ak[4 + i] = b3[i]; } }
#pragma unroll
        for (int t = 0; t < 5; ++t) { const int s2 = s + t - 2;
            if (s2 >= 0 && s2 < SEQ) { const bf16_t* pr = P + (size_t)(tok + t - 2) * EVEN_INP;
                const u32x4 q = *(const u32x4*)(pr + PC_QM + 8 * F.lane), k = *(const u32x4*)(pr + PC_KM + 8 * F.lane);
                const float* wq = cw + t * 1024 + 8 * F.lane; const float* wk = wq + 512;
                const f32x4 wq0 = *(const f32x4*)wq, wq1 = *(const f32x4*)(wq + 4), wk0 = *(const f32x4*)wk, wk1 = *(const f32x4*)(wk + 4);
                aq[0] += bf_lo(q.x) * wq0[0]; aq[1] += bf_hi(q.x) * wq0[1]; aq[2] += bf_lo(q.y) * wq0[2]; aq[3] += bf_hi(q.y) * wq0[3];
                aq[4] += bf_lo(q.z) * wq1[0]; aq[5] += bf_hi(q.z) * wq1[1]; aq[6] += bf_lo(q.w) * wq1[2]; aq[7] += bf_hi(q.w) * wq1[3];
                ak[0] += bf_lo(k.x) * wk0[0]; ak[1] += bf_hi(k.x) * wk0[1]; ak[2] += bf_lo(k.y) * wk0[2]; ak[3] += bf_hi(k.y) * wk0[3];
                ak[4] += bf_lo(k.z) * wk1[0]; ak[5] += bf_hi(k.z) * wk1[1]; ak[6] += bf_lo(k.w) * wk1[2]; ak[7] += bf_hi(k.w) * wk1[3]; } }
        constexpr float KS = 0.08838834764831845f;
#pragma unroll
        for (int i = 0; i < 8; ++i) { aq[i] = siluf_(aq[i]); ak[i] = siluf_(ak[i]) * KS; }
        u32x4 oq, ok; oq.x = cvt_pk_bf16(aq[0], aq[1]); oq.y = cvt_pk_bf16(aq[2], aq[3]); oq.z = cvt_pk_bf16(aq[4], aq[5]); oq.w = cvt_pk_bf16(aq[6], aq[7]);
        ok.x = cvt_pk_bf16(ak[0], ak[1]); ok.y = cvt_pk_bf16(ak[2], ak[3]); ok.z = cvt_pk_bf16(ak[4], ak[5]); ok.w = cvt_pk_bf16(ak[6], ak[7]);
        *(u32x4*)(QC + (size_t)tok * 512 + 8 * F.lane) = oq; *(u32x4*)(KC + (size_t)tok * 512 + 8 * F.lane) = ok;
        const bf16_t* pr = P + (size_t)tok * EVEN_INP;
        { const u32x2 w = *(const u32x2*)(pr + PC_QA + 4 * F.lane); const float x0 = bf_lo(w.x), x1 = bf_hi(w.x), x2 = bf_lo(w.y), x3 = bf_hi(w.y);
          const float inv = rsqrtf(wave_sum(x0 * x0 + x1 * x1 + x2 * x2 + x3 * x3, F.lane) * (1.f / 256.f) + EPS); const f32x4 g = *(const f32x4*)(qg + 4 * F.lane);
          u32x2 o; o.x = cvt_pk_bf16(x0 * inv * g[0], x1 * inv * g[1]); o.y = cvt_pk_bf16(x2 * inv * g[2], x3 * inv * g[3]); *(u32x2*)(QA + (size_t)tok * 256 + 4 * F.lane) = o; }
        { const unsigned w = *(const unsigned*)(pr + PC_KVA + 2 * F.lane); const float x0 = bf_lo(w), x1 = bf_hi(w);
          const float inv = rsqrtf(wave_sum(x0 * x0 + x1 * x1, F.lane) * (1.f / 128.f) + EPS); const f32x2 g = *(const f32x2*)(kvg + 2 * F.lane);
          *(unsigned*)(KVA + (size_t)tok * 256 + 2 * F.lane) = cvt_pk_bf16(x0 * inv * g[0], x1 * inv * g[1]); *(unsigned*)(KVA + (size_t)tok * 256 + 128 + 2 * F.lane) = 0u; }
    }
}

__device__ __forceinline__ void e4_phase(const Args& a, int j) {
    MK_FRAME(F); ARGAS unsigned char* ws = opaque_ws(a.ws);
    const bf16_t* P = (const bf16_t*)(ws + WS_P); const bf16_t* QRAW = (const bf16_t*)(ws + X1_QRAW); const bf16_t* KVRAW = (const bf16_t*)(ws + X1_KVRAW);
    bf16_t* QH = (bf16_t*)(ws + X1_QH); bf16_t* KH = (bf16_t*)(ws + X1_KH); bf16_t* VH = (bf16_t*)(ws + X1_VH);
    const f32x2* re = (const f32x2*)(ws + WS_ROPEE);
    const float* gq = a.mla_qk_q_g + (size_t)j * 96; const float* gk = a.mla_qk_k_g + (size_t)j * 96;
    const int h = F.lane >> 3, part = F.lane & 7;
    for (int tok = F.bid * 8 + F.wave; tok < NTOK; tok += F.G * 8) {
        const int b = tok >> 12, s = tok & (SEQ - 1);
        const f32x4 cs = *(const f32x4*)(re + (size_t)tok * 16 + 2 * part);
        const size_t hrow = ((size_t)(b * 8 + h)) * SEQ + s;
#pragma unroll
        for (int qk = 0; qk < 2; ++qk) {
            float v[12]; u32x4 w; unsigned w1, w2;
            if (qk == 0) { const bf16_t* src = QRAW + (size_t)tok * 768 + h * 96; w = *(const u32x4*)(src + 8 * part); w1 = *(const unsigned*)(src + 64 + 2 * part); w2 = *(const unsigned*)(src + 80 + 2 * part); }
            else { w = *(const u32x4*)(KVRAW + (size_t)tok * 1024 + h * 128 + 8 * part); const bf16_t* kr = P + (size_t)tok * EVEN_INP + PC_KR; w1 = *(const unsigned*)(kr + 2 * part); w2 = *(const unsigned*)(kr + 16 + 2 * part); }
            v[0] = bf_lo(w.x); v[1] = bf_hi(w.x); v[2] = bf_lo(w.y); v[3] = bf_hi(w.y); v[4] = bf_lo(w.z); v[5] = bf_hi(w.z); v[6] = bf_lo(w.w); v[7] = bf_hi(w.w);
            v[8] = bf_lo(w1); v[9] = bf_hi(w1); v[10] = bf_lo(w2); v[11] = bf_hi(w2);
            float ss = 0.f;
#pragma unroll
            for (int i = 0; i < 12; ++i) ss += v[i] * v[i];
            ss += shx(ss, 1, F.lane); ss += shx(ss, 2, F.lane); ss += shx(ss, 4, F.lane);
            const float inv = rsqrtf(ss * (1.f / 96.f) + EPS);
            const float* g = qk == 0 ? gq : gk;
            const f32x4 g0 = *(const f32x4*)(g + 8 * part), g1 = *(const f32x4*)(g + 8 * part + 4); const f32x2 ga = *(const f32x2*)(g + 64 + 2 * part), gb = *(const f32x2*)(g + 80 + 2 * part);
            v[0] *= inv * g0[0]; v[1] *= inv * g0[1]; v[2] *= inv * g0[2]; v[3] *= inv * g0[3]; v[4] *= inv * g1[0]; v[5] *= inv * g1[1]; v[6] *= inv * g1[2]; v[7] *= inv * g1[3];
            const float x10 = v[8] * inv * ga[0], x11 = v[9] * inv * ga[1], x20 = v[10] * inv * gb[0], x21 = v[11] * inv * gb[1];
            const float o10 = x10 * cs[0] - x20 * cs[1], o20 = x20 * cs[0] + x10 * cs[1], o11 = x11 * cs[2] - x21 * cs[3], o21 = x21 * cs[2] + x11 * cs[3];
            u32x4 o; o.x = cvt_pk_bf16(v[0], v[1]); o.y = cvt_pk_bf16(v[2], v[3]); o.z = cvt_pk_bf16(v[4], v[5]); o.w = cvt_pk_bf16(v[6], v[7]);
            bf16_t* dst = qk == 0 ? QH + hrow * 96 : KH + hrow * 128;
            *(u32x4*)(dst + 8 * part) = o; *(unsigned*)(dst + 64 + 2 * part) = cvt_pk_bf16(o10, o11); *(unsigned*)(dst + 80 + 2 * part) = cvt_pk_bf16(o20, o21);
            if (qk == 1) { *(u32x2*)(dst + 96 + 4 * part) = (u32x2){0u, 0u}; }
        }
        *(u32x4*)(VH + hrow * 64 + 8 * part) = *(const u32x4*)(KVRAW + (size_t)tok * 1024 + h * 128 + 64 + 8 * part);
    }
}
__device__ __forceinline__ void n2_phase(const Args& a, int layer) {
    MK_FRAME(F); ARGAS unsigned char* ws = opaque_ws(a.ws);
    const float* mod = (const float*)(ws + WS_MOD);
    bf16_t* HM = (bf16_t*)(ws + WS_HM);
    int* LIST = (int*)(ws + WS_LIST); float* WLIST = (float*)(ws + WS_WLIST); int* toke = (int*)(ws + WS_TOKE); int* tokr = toke + NTOK * 4;
    unsigned* gcnt = (unsigned*)(ws + WS_CTL) + CW_CNT + 64 * layer;
    LAS float* rwT = (LAS float*)(F.lds);
    LAS int* te = (LAS int*)(F.lds + LT_X); LAS int* tlr = te + 512; LAS float* tw = (LAS float*)(tlr + 512); LAS int* hist = (LAS int*)(tw + 512); LAS int* base = hist + 32;
    const float* rw = a.moe_router_w + (size_t)layer * DM * NEXP; const float* rbias = a.moe_router_b + (size_t)layer * NEXP;
    const float* gffn = a.norm_ffn_g + (size_t)layer * DM;
    __syncthreads();
    for (int i4 = F.tid; i4 < DM * NEXP / 4; i4 += 512) { const f32x4 v = *(const f32x4*)(rw + 4 * i4); const int k = i4 >> 3, e0 = (i4 & 7) * 4;
        rwT[(e0 + 0) * DM + k] = v[0]; rwT[(e0 + 1) * DM + k] = v[1]; rwT[(e0 + 2) * DM + k] = v[2]; rwT[(e0 + 3) * DM + k] = v[3]; }
    if (F.tid < 32) hist[F.tid] = 0;
    __syncthreads();
    const int myexp = F.lane; const float mybias = F.lane < 32 ? rbias[F.lane] : 0.f;
#pragma unroll 1
    for (int grp = F.bid; grp < NTOK / 128; grp += F.G) {
#pragma unroll 1
        for (int q = 0; q < 8; ++q) {
            const int ti0 = F.wave * 16 + q * 2;
            const int tok0 = grp * 128 + ti0; const int b = tok0 >> 12;
            const float* sh = mod + ((size_t)layer * NBATCH + b) * 6144 + 3 * DM; const float* sc = sh + DM;
            f32x4 hf[2][4];
#pragma unroll
            for (int t = 0; t < 2; ++t) {
                f32x4 v[4]; ld_row16(a.out + (size_t)(tok0 + t) * DM, F.lane, v);
                float ss = 0.f;
#pragma unroll
                for (int j = 0; j < 4; ++j) ss += v[j][0] * v[j][0] + v[j][1] * v[j][1] + v[j][2] * v[j][2] + v[j][3] * v[j][3];
                const float inv = rsqrtf(wave_sum(ss, F.lane) * (1.f / DM) + EPS);
#pragma unroll
                for (int j = 0; j < 4; ++j) { const int c0 = 4 * F.lane + 256 * j; const f32x4 g = *(const f32x4*)(gffn + c0), s1 = *(const f32x4*)(sc + c0), s0 = *(const f32x4*)(sh + c0);
                    const f32x4 h = v[j] * inv * g * (s1 + 1.f) + s0; hf[t][j] = h;
                    u32x2 o; o.x = cvt_pk_bf16(h[0], h[1]); o.y = cvt_pk_bf16(h[2], h[3]); *(u32x2*)(HM + (size_t)(tok0 + t) * DM + c0) = o; }
            }
            float lg0 = -3.0e38f, lg1 = -3.0e38f;
#pragma unroll 1
            for (int e = 0; e < 32; ++e) {
                float d0 = 0.f, d1 = 0.f;
#pragma unroll
                for (int j = 0; j < 4; ++j) { const f32x4 wv = *(const LAS f32x4*)(rwT + e * DM + 4 * F.lane + 256 * j);
                    d0 += hf[0][j][0] * wv[0] + hf[0][j][1] * wv[1] + hf[0][j][2] * wv[2] + hf[0][j][3] * wv[3];
                    d1 += hf[1][j][0] * wv[0] + hf[1][j][1] * wv[1] + hf[1][j][2] * wv[2] + hf[1][j][3] * wv[3]; }
                d0 = wave_sum(d0, F.lane); d1 = wave_sum(d1, F.lane);
                if (F.lane == e) { lg0 = d0; lg1 = d1; }
            }
#pragma unroll
            for (int t = 0; t < 2; ++t) {
                float logit = (t == 0 ? lg0 : lg1) + mybias;
                float tv[4]; int tix[4];
#pragma unroll
                for (int k = 0; k < 4; ++k) { float v = logit; int ix = myexp;
#pragma unroll
                    for (int m = 1; m < 64; m <<= 1) { const float ov = shx(v, m, F.lane); const int oi = shxi(ix, m, F.lane); if (ov > v || (ov == v && oi < ix)) { v = ov; ix = oi; } }
                    tv[k] = v; tix[k] = ix; if (myexp == ix) logit = -3.0e38f; }
                const float e1 = __expf(tv[1] - tv[0]), e2 = __expf(tv[2] - tv[0]), e3 = __expf(tv[3] - tv[0]); const float rs = 1.f / (1.f + e1 + e2 + e3);
                if (F.lane < 4) { const int ex = F.lane == 0 ? tix[0] : F.lane == 1 ? tix[1] : F.lane == 2 ? tix[2] : tix[3];
                    const float wk = (F.lane == 0 ? 1.f : F.lane == 1 ? e1 : F.lane == 2 ? e2 : e3) * rs;
                    const int lr = __hip_atomic_fetch_add(hist + ex, 1, __ATOMIC_RELAXED, __HIP_MEMORY_SCOPE_WORKGROUP);
                    const int pidx = (ti0 + t) * 4 + F.lane; te[pidx] = ex; tlr[pidx] = lr; tw[pidx] = wk; }
            }
        }
        __syncthreads();
        if (F.tid < 32) { const int h = hist[F.tid]; base[F.tid] = h > 0 ? (int)xb_add((gbar_t)gcnt + F.tid, (unsigned)h) : 0; }
        __syncthreads();
        { const int p = F.tid; const int e = te[p], rank = base[e] + tlr[p]; const int tok = grp * 128 + (p >> 2);
          LIST[(size_t)e * NSLOT + rank] = tok; WLIST[(size_t)e * NSLOT + rank] = tw[p]; toke[tok * 4 + (p & 3)] = e; tokr[tok * 4 + (p & 3)] = rank; }
        __syncthreads();
        if (F.tid < 32) hist[F.tid] = 0;
        __syncthreads();
    }
}

__device__ __forceinline__ void m1_phase(const Args& a, int layer) {
    MK_FRAME(F); ARGAS unsigned char* ws = opaque_ws(a.ws);
    build_pstart(F, (const unsigned*)(ws + WS_CTL) + CW_CNT + 64 * layer);
    LAS int* ps = (LAS int*)(F.lds + LT_PSTART); LAS int* lc = (LAS int*)(F.lds + LT_CNT); LAS int* blk = (LAS int*)(F.lds + LT_BLK);
    const bf16_t* HM = (const bf16_t*)(ws + WS_HM); bf16_t* AS = (bf16_t*)(ws + WS_ASORT); float* WS_ = (float*)(ws + WS_WSORT);
    const int* LIST = (const int*)(ws + WS_LIST); const float* WLIST = (const float*)(ws + WS_WLIST);
    const int total = ps[32];
    for (int r = F.bid * 8 + F.wave; r < total; r += F.G * 8) {
        const int g = r >> 8, e = blk[2 * g], rank = blk[2 * g + 1] * 256 + (r & 255); const bool valid = rank < lc[e];
        u32x4 v0 = (u32x4){0u, 0u, 0u, 0u}, v1 = v0; float w = 0.f;
        if (valid) { const int tok = LIST[(size_t)e * NSLOT + rank]; w = WLIST[(size_t)e * NSLOT + rank];
            v0 = *(const u32x4*)(HM + (size_t)tok * DM + 8 * F.lane); v1 = *(const u32x4*)(HM + (size_t)tok * DM + 512 + 8 * F.lane); }
        *(u32x4*)(AS + (size_t)r * DM + 8 * F.lane) = v0; *(u32x4*)(AS + (size_t)r * DM + 512 + 8 * F.lane) = v1;
        if (F.lane == 0) WS_[r] = w;
    }
}

struct MoeSched {
    const LAS int* blk; const char* A; const char* W; size_t wstride; int ntile, nunits, G, c;
    __device__ __forceinline__ bool next(int i, pg8::Unit& u) const {
        const long L = (long)i * G + c; if (L >= nunits) return false;
        const int g = (int)L / ntile, pn = (int)L % ntile, e = blk[2 * g];
        u.pm = g; u.pn = pn; u.aux = e; u.A = A + (size_t)g * 256 * 1024 * 2; u.B = W + (size_t)e * wstride + (size_t)pn * 256 * 1024 * 2; return true;
    }
};
struct MlaSched {
    const char* QA; const char* KVA; const char* Wq; const char* Wkv; int G, c;
    __device__ __forceinline__ bool next(int i, pg8::Unit& u) const {
        const long L = (long)i * G + c; if (L >= 128 * 7) return false;
        const int pm = (int)L / 7, t = (int)L % 7;
        u.pm = pm; if (t < 3) { u.pn = t; u.aux = 0; u.A = QA + (size_t)pm * 256 * 256 * 2; u.B = Wq + (size_t)t * 256 * 256 * 2; }
        else { u.pn = t - 3; u.aux = 1; u.A = KVA + (size_t)pm * 256 * 256 * 2; u.B = Wkv + (size_t)(t - 3) * 256 * 256 * 2; }
        return true;
    }
};

constexpr int NPHASE = 50;
#define IN(k) (lo <= (k) && (k) < hi)
#define GRID_BAR() do { if (fused) { xcd_barrier((gbar_t)(fresh_args().ws + WS_CTL) + CW_BAR, (volatile LAS unsigned*)((LAS unsigned char*)lds_raw + LT_MISC) + 8); } } while (0)
template <int LAYER>
__device__ __forceinline__ void layer_body(const int lo, const int hi, const bool fused) {
    constexpr int layer = LAYER;
        constexpr int pb = 1 + 12 * layer; constexpr bool odd = (layer & 1) != 0; constexpr int j = layer >> 1;
        if (IN(pb + 0)) { n1_phase(fresh_args(), layer, false); GRID_BAR(); }
        if (IN(pb + 1)) {
            const Args& a = fresh_args(); MK_FRAME(F); ARGAS unsigned char* ws = opaque_ws(a.ws);
            pg8::StaticSched S; S.A = (const char*)(ws + WS_HM); S.lda = DM; S.ldb = DM; S.nM = NTOK / 256; S.G = F.G; S.c = F.bid;
            pg8::EpiBf16 E; E.O0 = (bf16_t*)(ws + WS_P); E.O1 = E.O0; E.rope = (const GAS f32x2*)(ws + WS_ROPEO); E.qscale = 0.0625f;
            if (!odd) { S.Bt = (const char*)(ws + WS_WINE) + (size_t)j * EVEN_INP * DM * 2; S.nN = EVEN_INP / 256; E.ldc0 = E.ldc1 = EVEN_INP; E.rope_tiles = 0; E.qscale_tiles = 0; }
            else { S.Bt = (const char*)(ws + WS_WINO) + (size_t)j * RET_IN * DM * 2; S.nN = RET_IN / 256; E.ldc0 = E.ldc1 = RET_IN; E.rope_tiles = 8; E.qscale_tiles = 4; }
            pg8::gemm_phase<pg8::EpiBf16, pg8::StaticSched>(F.lds + LDS_RING, pg8::Dims{DM, DM, DM}, S, E);
            GRID_BAR();
        }
        if constexpr (!odd) {
            if (IN(pb + 2)) { e2_phase(fresh_args(), j); GRID_BAR(); }
            if (IN(pb + 3)) {
                const Args& a = fresh_args(); MK_FRAME(F); ARGAS unsigned char* ws = opaque_ws(a.ws);
                MlaSched S; S.QA = (const char*)(ws + X1_QA); S.KVA = (const char*)(ws + X1_KVA); S.Wq = (const char*)(ws + WS_WQB) + (size_t)j * 768 * 256 * 2; S.Wkv = (const char*)(ws + WS_WKVB) + (size_t)j * 1024 * 256 * 2; S.G = F.G; S.c = F.bid;
                pg8::EpiBf16 E; E.O0 = (bf16_t*)(ws + X1_QRAW); E.O1 = (bf16_t*)(ws + X1_KVRAW); E.ldc0 = 768; E.ldc1 = 1024; E.rope_tiles = 0; E.qscale_tiles = 0; E.qscale = 1.f; E.rope = nullptr;
                pg8::gemm_phase<pg8::EpiBf16, MlaSched>(F.lds + LDS_RING, pg8::Dims{256, 256, 256}, S, E);
                GRID_BAR();
            }
            if (IN(pb + 4)) { e4_phase(fresh_args(), j); GRID_BAR(); }
            if (IN(pb + 5)) {
                const Args& a = fresh_args(); MK_FRAME(F); ARGAS unsigned char* ws = opaque_ws(a.ws);
                const float* ALPHA = (const float*)(ws + WS_MISC); const float* BETA = ALPHA + 2 * 32 * SEQ;
                for (int u = F.bid; u < 128; u += F.G) {
                    const int bh = u >> 2, dir = (u >> 1) & 1, dvb = u & 1, b = bh >> 2, h = bh & 3;
                    la::StateArgs sa; sa.K = (const bf16_t*)(ws + X1_KC) + (size_t)b * SEQ * 512 + h * 128; sa.ldk = 512;
                    sa.V = (const bf16_t*)(ws + WS_P) + (size_t)b * SEQ * EVEN_INP + PC_VM + h * 128 + dvb * 64; sa.ldv = EVEN_INP;
                    sa.Cout = (bf16_t*)(ws + X1_CM) + ((size_t)(bh * 2 + dir) * 32) * 128 * 128 + dvb * 64; sa.ldc = 128; sa.cstride = 128 * 128;
                    sa.Nout = dvb == 0 ? (float*)(ws + X1_NM) + ((size_t)(bh * 2 + dir) * 32) * 128 : nullptr;
                    sa.alpha = ALPHA + ((size_t)dir * 32 + bh) * SEQ; sa.beta = BETA + ((size_t)dir * 32 + bh) * SEQ; sa.lgam = 0.f; sa.dir = dir;
                    la::state_unit<128, 64, true>(F.lds + LDS_RING, sa);
                }
                __syncthreads();
                unsigned* qh = (unsigned*)(ws + WS_CTL) + CW_QUEUE + 64 * j; LAS unsigned* qslot = (LAS unsigned*)(F.lds + LT_MISC) + 16;
                for (;;) {
                    if (F.tid == 0) *qslot = xb_add((gbar_t)qh, 1u);
                    __syncthreads();
                    const unsigned u = *qslot;
                    __syncthreads();
                    if (u >= 1024u) break;
                    const int bh = u >> 4, qb = u & 15, b = bh >> 3, h = bh & 7;
                    att::attn_body((const bf16_t*)(ws + X1_QH) + ((size_t)bh * SEQ + qb * 256) * 96, (const bf16_t*)(ws + X1_KH) + (size_t)bh * SEQ * 128, (const bf16_t*)(ws + X1_VH) + (size_t)bh * SEQ * 64,
                                   (bf16_t*)(ws + WS_MIX) + ((size_t)b * SEQ + qb * 256) * DM + 512 + h * 64, DM, SEQ, (LAS char*)(F.lds + LDS_RING));
                }
                GRID_BAR();
            }
            if (IN(pb + 6)) {
                const Args& a = fresh_args(); MK_FRAME(F); ARGAS unsigned char* ws = opaque_ws(a.ws);
                const float* ALPHA = (const float*)(ws + WS_MISC); const float* BETA = ALPHA + 2 * 32 * SEQ; const float* MG = BETA + 2 * 32 * SEQ;
                for (int u = F.bid; u < 1024; u += F.G) {
                    const int bh = u >> 5, c = u & 31, b = bh >> 2, h = bh & 3; const size_t t0 = (size_t)b * SEQ + c * 128;
                    la::OutArgs oa; oa.Q = (const bf16_t*)(ws + X1_QC) + t0 * 512 + h * 128; oa.ldq = 512; oa.K = (const bf16_t*)(ws + X1_KC) + t0 * 512 + h * 128; oa.ldk = 512;
                    oa.V = (const bf16_t*)(ws + WS_P) + t0 * EVEN_INP + PC_VM + h * 128; oa.ldv = EVEN_INP;
                    oa.Cf = (const bf16_t*)(ws + X1_CM) + ((size_t)(bh * 2 + 0) * 32 + c) * 128 * 128; oa.Cb = (const bf16_t*)(ws + X1_CM) + ((size_t)(bh * 2 + 1) * 32 + c) * 128 * 128;
                    oa.Nf = (const float*)(ws + X1_NM) + ((size_t)(bh * 2 + 0) * 32 + c) * 128; oa.Nb = (const float*)(ws + X1_NM) + ((size_t)(bh * 2 + 1) * 32 + c) * 128;
                    oa.af = ALPHA + ((size_t)0 * 32 + bh) * SEQ + c * 128; oa.bfw = BETA + ((size_t)0 * 32 + bh) * SEQ + c * 128; oa.ab = ALPHA + ((size_t)1 * 32 + bh) * SEQ + c * 128; oa.bbw = BETA + ((size_t)1 * 32 + bh) * SEQ + c * 128;
                    oa.Mf = MG[bh]; oa.Mb = MG[32 + bh]; oa.lgf = 0.f; oa.lgb = 0.f;
                    oa.gain = a.ml_norm_g + (size_t)j * 512 + h * 128; oa.G = (const bf16_t*)(ws + WS_P) + t0 * EVEN_INP + PC_OM + h * 128; oa.ldg = EVEN_INP;
                    oa.Out = (bf16_t*)(ws + WS_MIX) + t0 * DM + h * 128; oa.ldo = DM;
                    la::out_unit<128, 128, true>(F.lds + LDS_RING, F.lds + LT_X, oa);
                }
                GRID_BAR();
            }
        } else {
            if (IN(pb + 2)) {
                const Args& a = fresh_args(); MK_FRAME(F); ARGAS unsigned char* ws = opaque_ws(a.ws);
                for (int u = F.bid; u < 256; u += F.G) {
                    const int bh = u >> 3, dir = (u >> 2) & 1, dvb = u & 3, b = bh >> 2, h = bh & 3;
                    const float dl = (dir ? a.ret_decay_b : a.ret_decay_f)[j * 4 + h];
                    la::StateArgs sa; sa.K = (const bf16_t*)(ws + WS_P) + (size_t)b * SEQ * RET_IN + 1024 + h * 256; sa.ldk = RET_IN;
                    sa.V = (const bf16_t*)(ws + WS_P) + (size_t)b * SEQ * RET_IN + 2048 + h * 512 + dvb * 128; sa.ldv = RET_IN;
                    sa.Cout = (bf16_t*)(ws + WS_X1) + ((size_t)(bh * 2 + dir) * 32) * 256 * 512 + dvb * 128; sa.ldc = 512; sa.cstride = 256 * 512; sa.Nout = nullptr;
                    sa.alpha = nullptr; sa.beta = nullptr; sa.lgam = fminf(dl, 0.f) - log1pf(__expf(-fabsf(dl))); sa.dir = dir;
                    la::state_unit<256, 128, false>(F.lds + LDS_RING, sa);
                }
                GRID_BAR();
            }
            if (IN(pb + 3)) {
                const Args& a = fresh_args(); MK_FRAME(F); ARGAS unsigned char* ws = opaque_ws(a.ws);
                for (int u = F.bid; u < 1024; u += F.G) {
                    const int bh = u >> 5, c = u & 31, b = bh >> 2, h = bh & 3; const size_t t0 = (size_t)b * SEQ + c * 128;
                    const bf16_t* R = (const bf16_t*)(ws + WS_P) + t0 * RET_IN;
                    const float dlf = a.ret_decay_f[j * 4 + h], dlb = a.ret_decay_b[j * 4 + h];
                    la::OutArgs oa; oa.Q = R + h * 256; oa.ldq = RET_IN; oa.K = R + 1024 + h * 256; oa.ldk = RET_IN; oa.V = R + 2048 + h * 512; oa.ldv = RET_IN;
                    oa.Cf = (const bf16_t*)(ws + WS_X1) + ((size_t)(bh * 2 + 0) * 32 + c) * 256 * 512; oa.Cb = (const bf16_t*)(ws + WS_X1) + ((size_t)(bh * 2 + 1) * 32 + c) * 256 * 512;
                    oa.Nf = nullptr; oa.Nb = nullptr; oa.af = oa.bfw = oa.ab = oa.bbw = nullptr; oa.Mf = 0.f; oa.Mb = 0.f;
                    oa.lgf = fminf(dlf, 0.f) - log1pf(__expf(-fabsf(dlf))); oa.lgb = fminf(dlb, 0.f) - log1pf(__expf(-fabsf(dlb)));
                    oa.gain = a.ret_gn_g + (size_t)j * 2048 + h * 512; oa.G = R + 4096 + h * 512; oa.ldg = RET_IN;
                    oa.Out = (bf16_t*)(ws + WS_MIX) + t0 * 2048 + h * 512; oa.ldo = 2048;
                    la::out_unit<256, 512, false>(F.lds + LDS_RING, F.lds + LT_X, oa);
                }
                GRID_BAR();
            }
        }
        if (IN(pb + 7)) {
            const Args& a = fresh_args(); MK_FRAME(F); ARGAS unsigned char* ws = opaque_ws(a.ws);
            pg8::StaticSched S; S.A = (const char*)(ws + WS_MIX); S.nM = NTOK / 256; S.nN = DM / 256; S.G = F.G; S.c = F.bid;
            int K;
            if (!odd) { S.Bt = (const char*)(ws + WS_WOUTE) + (size_t)j * DM * DM * 2; K = DM; } else { S.Bt = (const char*)(ws + WS_WOUTO) + (size_t)j * DM * 2048 * 2; K = 2048; }
            S.lda = K; S.ldb = K;
            pg8::EpiResid E; E.base = (layer == 0) ? a.x : a.out; E.out = a.out; E.gate = (const float*)(ws + WS_MOD) + (size_t)layer * NBATCH * 6144 + 2 * DM; E.gstride = 6144;
            pg8::gemm_phase<pg8::EpiResid, pg8::StaticSched>(F.lds + LDS_RING, pg8::Dims{K, K, K}, S, E);
            GRID_BAR();
        }
        if (IN(pb + 8)) { n2_phase(fresh_args(), layer); GRID_BAR(); }
        if (IN(pb + 9)) { m1_phase(fresh_args(), layer); GRID_BAR(); }
        if (IN(pb + 10)) {
            const Args& a = fresh_args(); MK_FRAME(F); ARGAS unsigned char* ws = opaque_ws(a.ws);
            build_pstart(F, (const unsigned*)(ws + WS_CTL) + CW_CNT + 64 * layer);
            const int nblk = ((LAS int*)(F.lds + LT_PSTART))[32] >> 8;
            MoeSched S; S.blk = (const LAS int*)(F.lds + LT_BLK); S.A = (const char*)(ws + WS_ASORT); S.W = (const char*)(ws + WS_WGU) + (size_t)layer * NEXP * 2048 * DM * 2; S.wstride = (size_t)2048 * DM * 2;
            S.ntile = 8; S.nunits = nblk * 8; S.G = F.G; S.c = F.bid;
            pg8::EpiSwiglu E; E.act = (bf16_t*)(ws + WS_ACT); E.bgu = a.moe_b_gu + (size_t)layer * NEXP * 2048;
            pg8::gemm_phase<pg8::EpiSwiglu, MoeSched>(F.lds + LDS_RING, pg8::Dims{DM, DM, DM}, S, E);
            GRID_BAR();
        }
        if (IN(pb + 11)) {
            const Args& a = fresh_args(); MK_FRAME(F); ARGAS unsigned char* ws = opaque_ws(a.ws);
            build_pstart(F, (const unsigned*)(ws + WS_CTL) + CW_CNT + 64 * layer);
            const int nblk = ((LAS int*)(F.lds + LT_PSTART))[32] >> 8;
            MoeSched S; S.blk = (const LAS int*)(F.lds + LT_BLK); S.A = (const char*)(ws + WS_ACT); S.W = (const char*)(ws + WS_WDN) + (size_t)layer * NEXP * DM * EFF * 2; S.wstride = (size_t)DM * EFF * 2;
            S.ntile = 4; S.nunits = nblk * 4; S.G = F.G; S.c = F.bid;
            pg8::EpiDown E; E.y = (bf16_t*)(ws + WS_Y); E.bd = a.moe_b_down + (size_t)layer * NEXP * DM; E.wrow = (const float*)(ws + WS_WSORT);
            pg8::gemm_phase<pg8::EpiDown, MoeSched>(F.lds + LDS_RING, pg8::Dims{EFF, EFF, EFF}, S, E);
            GRID_BAR();
        }
    }
__global__ void __launch_bounds__(512, 2) fwd_kernel(Args a_kernarg) {
    const Args& a0 = fresh_args();
    LAS unsigned char* lds0 = (LAS unsigned char*)lds_raw;
    for (int u = threadIdx.x; u < 64; u += 512) ((LAS unsigned*)(lds0 + LT_MISC))[u] = 0u;
    __syncthreads();
    const int lo = a0.ph_lo, hi = a0.ph_hi; const bool fused = (hi - lo) > 1;
    if (fused) xcd_barrier_post((gbar_t)(a0.ws + WS_CTL) + CW_BAR);

    if (IN(0)) { p0_prologue(fresh_args()); GRID_BAR(); }

    layer_body<0>(lo, hi, fused); layer_body<1>(lo, hi, fused); layer_body<2>(lo, hi, fused); layer_body<3>(lo, hi, fused);
    if (IN(49)) n1_phase(fresh_args(), DEPTH, true);
}

#undef IN
#undef GRID_BAR
#ifndef MK_ONE_LAUNCH
#define MK_ONE_LAUNCH 1
#endif
extern "C" void kernel_launch(void* const* d_in, const int* in_sizes, int n_in, void* d_out, int out_size, void* d_ws, size_t ws_size, hipStream_t stream) {
    static int grid = 0;
    if (grid == 0) {
        if (n_in != 30 || in_sizes[0] != NTOK * DM || out_size != NTOK * DM || ws_size < WS_END) {
            fprintf(stderr, "kernel_launch: shape mismatch: n_in %d in0 %d out %d ws %zu (need %zu)\n", n_in, n_in > 0 ? in_sizes[0] : -1, out_size, ws_size, (size_t)WS_END); grid = -1; return; }
        int dev = 0, cus = 0, per_cu = 0;
        if (hipGetDevice(&dev) != hipSuccess || hipDeviceGetAttribute(&cus, hipDeviceAttributeMultiprocessorCount, dev) != hipSuccess) { grid = -1; return; }
        if (hipFuncSetAttribute((const void*)fwd_kernel, hipFuncAttributeMaxDynamicSharedMemorySize, LDS_BYTES) != hipSuccess) { fprintf(stderr, "kernel_launch: hipFuncSetAttribute failed\n"); grid = -1; return; }
        if (hipOccupancyMaxActiveBlocksPerMultiprocessor(&per_cu, (const void*)fwd_kernel, 512, LDS_BYTES) != hipSuccess || per_cu < 1) fprintf(stderr, "kernel_launch: occupancy query says %d\n", per_cu);
        (void)hipGetLastError();
        grid = cus;
    }
    if (grid < 0) return;
    (void)hipMemsetAsync((char*)d_ws + WS_CTL, 0, CTL_ZERO_BYTES, stream);
    Args a{};
    a.x = (gcf_t)d_in[0]; a.c = (gcf_t)d_in[1]; a.pos = (gci_t)d_in[2];
    a.ada_w = (gcf_t)d_in[3]; a.ada_b = (gcf_t)d_in[4]; a.norm_mix_g = (gcf_t)d_in[5]; a.norm_ffn_g = (gcf_t)d_in[6];
    a.hy_w_in = (gcf_t)d_in[7]; a.ml_conv_w = (gcf_t)d_in[8]; a.ml_conv_b = (gcf_t)d_in[9]; a.ml_gate_b = (gcf_t)d_in[10]; a.ml_norm_g = (gcf_t)d_in[11];
    a.mla_q_norm_g = (gcf_t)d_in[12]; a.mla_kv_norm_g = (gcf_t)d_in[13]; a.mla_w_qb = (gcf_t)d_in[14]; a.mla_w_kvb = (gcf_t)d_in[15];
    a.mla_qk_q_g = (gcf_t)d_in[16]; a.mla_qk_k_g = (gcf_t)d_in[17]; a.hy_w_out = (gcf_t)d_in[18];
    a.ret_w_in = (gcf_t)d_in[19]; a.ret_decay_f = (gcf_t)d_in[20]; a.ret_decay_b = (gcf_t)d_in[21]; a.ret_gn_g = (gcf_t)d_in[22]; a.ret_w_out = (gcf_t)d_in[23];
    a.moe_router_w = (gcf_t)d_in[24]; a.moe_router_b = (gcf_t)d_in[25]; a.moe_w_gu = (gcf_t)d_in[26]; a.moe_b_gu = (gcf_t)d_in[27]; a.moe_w_down = (gcf_t)d_in[28]; a.moe_b_down = (gcf_t)d_in[29];
    a.out = (ARGAS float*)d_out; a.ws = (ARGAS unsigned char*)d_ws;
#if MK_ONE_LAUNCH
    a.ph_lo = 0; a.ph_hi = NPHASE;
    hipLaunchKernelGGL(fwd_kernel, dim3(grid), dim3(512), LDS_BYTES, stream, a);
#else
    for (int ph = 0; ph < NPHASE; ++ph) {
        if (ph >= 1 && ph < 49) { const int layer = (ph - 1) / 12, k = (ph - 1) % 12; if ((layer & 1) && (k >= 4 && k <= 6)) continue; }
        a.ph_lo = ph; a.ph_hi = ph + 1;
        hipLaunchKernelGGL(fwd_kernel, dim3(grid), dim3(512), LDS_BYTES, stream, a);
    }
#endif
    const hipError_t le = hipPeekAtLastError();
    if (le != hipSuccess) fprintf(stderr, "kernel_launch: launch failed: %s\n", hipGetErrorName(le));
}
```

```cpp
#include <hip/hip_runtime.h>
#include <cstdio>
#include <cstdint>

#define GAS __attribute__((address_space(1)))
#define LAS __attribute__((address_space(3)))
typedef unsigned short bf16_t;
typedef short bf16x8 __attribute__((ext_vector_type(8)));
typedef short s16x4 __attribute__((ext_vector_type(4)));
typedef float f32x2 __attribute__((ext_vector_type(2)));
typedef float f32x4 __attribute__((ext_vector_type(4)));
typedef float f32x8 __attribute__((ext_vector_type(8)));
typedef float f32x16 __attribute__((ext_vector_type(16)));
typedef unsigned u32x2 __attribute__((ext_vector_type(2)));
typedef unsigned u32x4 __attribute__((ext_vector_type(4)));
typedef GAS unsigned gu32;

constexpr int NTOK = 32768, DM = 1024, SEQ = 4096, NBATCH = 8, DEPTH = 4;
constexpr int EVEN_IN = 2480, EVEN_INP = 2560;
constexpr int RET_IN = 6144;
constexpr int NEXP = 32, TOPK = 4, EFF = 1024;
constexpr int NSLOT = NTOK * TOPK;
constexpr int NSLOTP = NSLOT + NEXP * 256;
constexpr float EPS = 1e-6f;

constexpr int PC_QM = 0, PC_KM = 512, PC_VM = 1024, PC_OM = 1536, PC_QA = 2048, PC_KVA = 2304, PC_KR = 2432, PC_GT = 2464;

#define LDS_WAIT() asm volatile("s_waitcnt lgkmcnt(0)" ::: "memory")
#define VM_WAIT() asm volatile("s_waitcnt vmcnt(0)" ::: "memory")
#define SBAR() __builtin_amdgcn_sched_barrier(0)
#define FENCE() do { asm volatile("" ::: "memory"); __builtin_amdgcn_sched_barrier(0); } while (0)

__device__ __forceinline__ unsigned cvt_pk_bf16(float lo, float hi) { unsigned r; asm volatile("v_cvt_pk_bf16_f32 %0, %1, %2" : "=v"(r) : "v"(lo), "v"(hi)); return r; }
__device__ __forceinline__ float bf_lo(unsigned u) { return __builtin_bit_cast(float, u << 16); }
__device__ __forceinline__ float bf_hi(unsigned u) { return __builtin_bit_cast(float, u & 0xffff0000u); }
__device__ __forceinline__ float bf2f(bf16_t b) { return __builtin_bit_cast(float, ((unsigned)b) << 16); }
__device__ __forceinline__ bf16_t f2bf(float f) { unsigned u = __builtin_bit_cast(unsigned, f); return (bf16_t)((u + 0x7fffu + ((u >> 16) & 1u)) >> 16); }
__device__ __forceinline__ float shx(float v, int m, int lane) { return __builtin_bit_cast(float, __builtin_amdgcn_ds_bpermute((lane ^ m) << 2, __builtin_bit_cast(int, v))); }
__device__ __forceinline__ int shxi(int v, int m, int lane) { return __builtin_amdgcn_ds_bpermute((lane ^ m) << 2, v); }
__device__ __forceinline__ float sh_from(float v, int src, int lane) { (void)lane; return __builtin_bit_cast(float, __builtin_amdgcn_ds_bpermute(src << 2, __builtin_bit_cast(int, v))); }
__device__ __forceinline__ int sh_fromi(int v, int src) { return __builtin_amdgcn_ds_bpermute(src << 2, v); }
__device__ __forceinline__ float wave_sum(float v, int lane) {
#pragma unroll
    for (int o = 1; o < 64; o <<= 1) v += shx(v, o, lane);
    return v;
}
__device__ __forceinline__ float wave_max(float v, int lane) {
#pragma unroll
    for (int o = 1; o < 64; o <<= 1) v = fmaxf(v, shx(v, o, lane));
    return v;
}
__device__ __forceinline__ float sigmoidf_(float x) { return 1.f / (1.f + __expf(-x)); }
__device__ __forceinline__ float siluf_(float x) { return x / (1.f + __expf(-x)); }

#define XB_TMO      128
#define XB_XCNT(j)  (256  + 64 * (j))
#define XB_XSUB(j)  (1280 + 64 * (j))
#define XB_XGEN(j)  (2304 + 64 * (j))
#define XB_TOP      3328
#define XB_TOPGEN   3392
#define XCD_BAR_WORDS 3456
#define XB_SPIN_CAP (1u << 22)

typedef GAS unsigned* gbar_t;
__device__ __forceinline__ unsigned xb_ld(gbar_t p)              { return __hip_atomic_load(p, __ATOMIC_RELAXED, __HIP_MEMORY_SCOPE_AGENT); }
__device__ __forceinline__ unsigned xb_add(gbar_t p, unsigned v) { return __hip_atomic_fetch_add(p, v, __ATOMIC_RELAXED, __HIP_MEMORY_SCOPE_AGENT); }
__device__ __forceinline__ unsigned xb_xcc_id() { return (unsigned)__builtin_amdgcn_s_getreg((3 << 11) | 20) & 0xFu; }
#define XB_SPIN(cond, bar) do { unsigned _sp = 0; while (cond) { __builtin_amdgcn_s_sleep(1); \
    if ((++_sp & 255u) == 0u) { if (xb_ld(&(bar)[XB_TMO])) break; if (_sp > XB_SPIN_CAP) { xb_add(&(bar)[XB_TMO], 1u); break; } } } } while (0)

__device__ __forceinline__ void xcd_barrier_post(gbar_t bar) {
    if (threadIdx.x == 0) (void)xb_add(&bar[XB_XCNT(xb_xcc_id())], 1u);
}
__device__ __forceinline__ void xcd_barrier_complete(gbar_t bar, unsigned x, unsigned& nloc, unsigned& nx) {
    const unsigned G = gridDim.x * gridDim.y * gridDim.z;
    unsigned sum, cnt, mine, sp = 0u;
    for (;;) {
        sum = 0u; cnt = 0u; mine = 0u;
#pragma unroll
        for (unsigned j = 0; j < 16; ++j) { const unsigned c = xb_ld(&bar[XB_XCNT(j)]); sum += c; cnt += (c > 0u) ? 1u : 0u; mine = (j == x) ? c : mine; }
        if (sum == G) break;
        __builtin_amdgcn_s_sleep(1);
        if ((++sp & 255u) == 0u) { if (xb_ld(&bar[XB_TMO])) break; if (sp > XB_SPIN_CAP) { xb_add(&bar[XB_TMO], 1u); break; } }
    }
    nloc = mine > 0u ? mine : 1u; nx = cnt > 0u ? cnt : 1u;
}
__device__ __forceinline__ void xcd_barrier(gbar_t bar, volatile LAS unsigned* st) {
    asm volatile("s_waitcnt vmcnt(0)" ::: "memory");
    __syncthreads();
    if (threadIdx.x == 0) {
        const unsigned bx = xb_xcc_id();
        __builtin_amdgcn_s_waitcnt(0);
        unsigned nloc = st[0], nx = st[1];
        if (nloc == 0u) { xcd_barrier_complete(bar, bx, nloc, nx); st[0] = nloc; st[1] = nx; }
        const unsigned old = xb_add(&bar[XB_XSUB(bx)], 1u);
        const unsigned gen = old / nloc;
        if (old + 1u == (gen + 1u) * nloc) {
            __builtin_amdgcn_fence(__ATOMIC_RELEASE, "agent");
            asm volatile("s_waitcnt vmcnt(0)" ::: "memory");
            const unsigned og = xb_add(&bar[XB_TOP], 1u);
            const unsigned tg = og / nx;
            if (og + 1u == (tg + 1u) * nx) xb_add(&bar[XB_TOPGEN], 1u);
            else XB_SPIN(xb_ld(&bar[XB_TOPGEN]) == tg, bar);
            __builtin_amdgcn_fence(__ATOMIC_ACQUIRE, "agent");
            xb_add(&bar[XB_XGEN(bx)], 1u);
            asm volatile("s_waitcnt vmcnt(0)" ::: "memory");
        } else {
            XB_SPIN(xb_ld(&bar[XB_XGEN(bx)]) == gen, bar);
            __builtin_amdgcn_fence(__ATOMIC_ACQUIRE, "agent");
            asm volatile("s_waitcnt vmcnt(0)" ::: "memory");
        }
    }
    __syncthreads();
}
namespace pg8 {
constexpr int BM = 256, BK = 64, HALF = 128, HTB = HALF * BK * 2, STAGE_BYTES = 8 * HTB, NXCD = 8, WGM = 8;
__host__ __device__ __forceinline__ int lds_byte(int r, int c) { const int st = (r >> 4) * 2 + (c >> 5), rr = r & 15, cc = c & 31, ob = rr * 64 + cc * 2; return st * 1024 + (ob ^ (((ob >> 9) & 1) << 5)); }
__host__ __device__ __forceinline__ void stage_rc(int b, int& R, int& C) { const int st = b / 1024, sb = b % 1024, swz = sb ^ (((sb >> 9) & 1) << 5); R = (st >> 1) * 16 + swz / 64; C = (st & 1) * 32 + (swz % 64) / 2; }
__host__ __device__ __forceinline__ int perm32(int rho) { const int n = rho >> 4, i = rho & 15; return 8 * (i >> 2) + 4 * n + (i & 3); }

struct Unit { const char* A; const char* B; int pm, pn, aux; };
struct Dims { int lda, ldb, K; };

__device__ __forceinline__ void static_tile(int L, int nM, int nN, int& pm, int& pn) {
    const int nwg = nM * nN; int wgid = L;
    { const int q = nwg / NXCD, r = nwg % NXCD, xcd = wgid % NXCD, off = wgid / NXCD; wgid = (xcd < r ? xcd * (q + 1) : r * (q + 1) + (xcd - r) * q) + off; }
    const int nig = WGM * nN, gid = wgid / nig, fm = gid * WGM, gsz = (nM - fm) < WGM ? (nM - fm) : WGM;
    pm = fm + ((wgid % nig) % gsz); pn = (wgid % nig) / gsz;
}
struct StaticSched {
    const char* A; const char* Bt; int lda, ldb, nM, nN, G, c;
    __device__ __forceinline__ bool next(int i, Unit& u) const {
        const long L = (long)i * G + c; if (L >= (long)nM * nN) return false;
        int pm, pn; static_tile((int)L, nM, nN, pm, pn);
        u.pm = pm; u.pn = pn; u.aux = 0; u.A = A + (size_t)pm * BM * lda * 2; u.B = Bt + (size_t)pn * BM * ldb * 2; return true;
    }
};

typedef int v8i_t __attribute__((ext_vector_type(8)));
__device__ __forceinline__ v8i_t cat8(bf16x8 a, bf16x8 b) { const u32x4 x = __builtin_bit_cast(u32x4, a), y = __builtin_bit_cast(u32x4, b); return (v8i_t){(int)x.x, (int)x.y, (int)x.z, (int)x.w, (int)y.x, (int)y.y, (int)y.z, (int)y.w}; }
template <class Epi, class Sched, bool ALIGN_EPI = true, bool SP2 = true, bool FP8 = false>
__device__ __forceinline__ void gemm_phase(LAS unsigned char* lds, const Dims g, const Sched& S, const Epi& E) {
    int tid = threadIdx.x; asm volatile("" : "+v"(tid));
    const int wid = __builtin_amdgcn_readfirstlane(tid >> 6), lane = tid & 63, wr = wid >> 2, wc = wid & 3, fr = lane & 15, fq = lane >> 4;
    const int K = g.K, nt = K / BK;
    unsigned voffA[2], voffB[2];
#pragma unroll
    for (int i = 0; i < 2; ++i) { int R, C; stage_rc(tid * 16 + i * 8192, R, C); const int Rb = Epi::PERM ? ((R & ~31) + perm32(R & 31)) : R;
        voffA[i] = (unsigned)(R * g.lda + C) * 2u; voffB[i] = (unsigned)(Rb * g.ldb + C) * 2u; }
    const size_t kstep = (size_t)(BK * 2);
    const size_t hstepA = (size_t)HALF * g.lda * 2, hstepB = (size_t)HALF * g.ldb * 2;
    const unsigned ldsw = (unsigned)wid * 1024u, ldsb_ = (unsigned)(uintptr_t)lds;
    const int aoff = lds_byte(wr * 64 + fr, fq * 8), boff = lds_byte(wc * 32 + fr, fq * 8);
#define PG8_SA(b, h) (((b) * 2 + (h)) * HTB)
#define PG8_SB(b, h) ((4 + (b) * 2 + (h)) * HTB)
#define PG8_STAGE(bufoff, gbase, voff) do { _Pragma("unroll") for (int _i = 0; _i < 2; ++_i) { \
        if constexpr (FP8) { unsigned keep_; asm volatile("s_mov_b32 %0, m0\n\ts_mov_b32 m0, %1\n\ts_nop 0\n\tglobal_load_lds_dwordx4 %2, %3\n\ts_mov_b32 m0, %0" : "=&s"(keep_) : "s"(ldsb_ + (unsigned)(bufoff) + ldsw + _i * 8192u), "v"((voff)[_i]), "s"(gbase) : "memory"); } \
        else __builtin_amdgcn_global_load_lds((const unsigned*)((const char*)(gbase) + (voff)[_i]), (LAS unsigned*)(lds + (bufoff) + ldsw + _i * 8192), 16, 0, 0); } } while (0)
#define PG8_LDA(dst, b, h) do { _Pragma("unroll") for (int m = 0; m < 4; ++m) { if constexpr (FP8) { const u32x4 x_ = *(const LAS u32x4*)(lds + PG8_SA(b, h) + aoff + m * 2048), y_ = *(const LAS u32x4*)(lds + PG8_SA(b, h) + aoff + m * 2048 + 1024); \
        dst##8[m] = (v8i_t){(int)x_.x, (int)x_.y, (int)x_.z, (int)x_.w, (int)y_.x, (int)y_.y, (int)y_.z, (int)y_.w}; } else { _Pragma("unroll") for (int k = 0; k < 2; ++k) dst[m][k] = *(const LAS bf16x8*)(lds + PG8_SA(b, h) + aoff + m * 2048 + k * 1024); } } } while (0)
#define PG8_LDB(dst, b, h) do { _Pragma("unroll") for (int n = 0; n < 2; ++n) { if constexpr (FP8) { const u32x4 x_ = *(const LAS u32x4*)(lds + PG8_SB(b, h) + boff + n * 2048), y_ = *(const LAS u32x4*)(lds + PG8_SB(b, h) + boff + n * 2048 + 1024); \
        dst##8[n] = (v8i_t){(int)x_.x, (int)x_.y, (int)x_.z, (int)x_.w, (int)y_.x, (int)y_.y, (int)y_.z, (int)y_.w}; } else { _Pragma("unroll") for (int k = 0; k < 2; ++k) dst[n][k] = *(const LAS bf16x8*)(lds + PG8_SB(b, h) + boff + n * 2048 + k * 1024); } } } while (0)
#define PG8_MMA(ai, bj, At, Bt) do { __builtin_amdgcn_s_setprio(1); if constexpr (FP8) { _Pragma("unroll") for (int m = 0; m < 4; ++m) _Pragma("unroll") for (int n = 0; n < 2; ++n) \
        acc[ai][bj][m][n] = __builtin_amdgcn_mfma_scale_f32_16x16x128_f8f6f4(Bt##8[n], At##8[m], acc[ai][bj][m][n], 0, 0, 0, 0x7f7f7f7f, 0, 0x7f7f7f7f); } else { \
        _Pragma("unroll") for (int m = 0; m < 4; ++m) _Pragma("unroll") for (int n = 0; n < 2; ++n) _Pragma("unroll") for (int k = 0; k < 2; ++k) \
        acc[ai][bj][m][n] = __builtin_amdgcn_mfma_f32_16x16x32_bf16(Bt[n][k], At[m][k], acc[ai][bj][m][n], 0, 0, 0); } __builtin_amdgcn_s_setprio(0); } while (0)
#define PG8_WAIT_V(n) asm volatile("s_waitcnt vmcnt(" #n ")" ::: "memory")
#define PG8_WAIT_L(n) asm volatile("s_waitcnt lgkmcnt(" #n ")" ::: "memory")
#define PG8_BAR __builtin_amdgcn_s_barrier()
#define PG8_SCHED __builtin_amdgcn_sched_barrier(0)
    Unit cur, nxt; int ui = 0;
    if (!S.next(0, cur)) return;
    f32x4 acc[2][2][4][2];
#pragma unroll
    for (int a = 0; a < 2; ++a)
#pragma unroll
        for (int b = 0; b < 2; ++b)
#pragma unroll
            for (int m = 0; m < 4; ++m)
#pragma unroll
                for (int n = 0; n < 2; ++n) acc[a][b][m][n] = (f32x4){0.f, 0.f, 0.f, 0.f};
    bf16x8 At[4][2], B0[2][2], B1[2][2]; v8i_t At8[4], B08[2], B18[2];
    const char* cA = cur.A; const char* cB = cur.B;
    if constexpr (SP2) {
        PG8_STAGE(PG8_SB(0, 0), cB, voffB); PG8_STAGE(PG8_SB(0, 1), cB + hstepB, voffB); PG8_STAGE(PG8_SA(0, 0), cA, voffA); PG8_STAGE(PG8_SA(0, 1), cA + hstepA, voffA);
        if (wr == 1) PG8_BAR;
        PG8_WAIT_V(2); PG8_BAR;
        PG8_STAGE(PG8_SB(1, 0), cB + kstep, voffB); PG8_STAGE(PG8_SA(1, 0), cA + kstep, voffA); PG8_STAGE(PG8_SB(1, 1), cB + hstepB + kstep, voffB);
        PG8_WAIT_V(6); PG8_BAR;
    } else {
        PG8_STAGE(PG8_SB(0, 0), cB, voffB); PG8_STAGE(PG8_SA(0, 0), cA, voffA); PG8_STAGE(PG8_SB(0, 1), cB + hstepB, voffB); PG8_STAGE(PG8_SA(0, 1), cA + hstepA, voffA);
        if (wr == 1) PG8_BAR;
        PG8_WAIT_V(4); PG8_BAR;
        PG8_STAGE(PG8_SB(1, 0), cB + kstep, voffB); PG8_STAGE(PG8_SA(1, 0), cA + kstep, voffA); PG8_STAGE(PG8_SB(1, 1), cB + hstepB + kstep, voffB);
        PG8_WAIT_V(6); PG8_BAR;
    }
    for (;;) {
        const bool has_next = S.next(ui + 1, nxt);
        const char* nA = has_next ? nxt.A : cA; const char* nB = has_next ? nxt.B : cB;
#pragma unroll 1
        for (int t = 0; t < nt; t += 2) {
            const bool last = (t == nt - 2);
            const char* a1 = cA + (size_t)(t + 1) * kstep;
            const char* a2 = last ? nA : cA + (size_t)(t + 2) * kstep; const char* b2 = last ? nB : cB + (size_t)(t + 2) * kstep;
            const char* a3 = a2 + kstep; const char* b3 = b2 + kstep;
            if constexpr (SP2) {
            PG8_LDB(B0, 0, 0); PG8_LDB(B1, 0, 1); PG8_SCHED; PG8_LDA(At, 0, 0); PG8_STAGE(PG8_SA(1, 1), a1 + hstepA, voffA);
            PG8_WAIT_V(8); PG8_WAIT_L(0); PG8_BAR; PG8_MMA(0, 0, At, B0); PG8_MMA(0, 1, At, B1); PG8_BAR; PG8_SCHED;
            PG8_LDA(At, 0, 1); PG8_STAGE(PG8_SB(0, 0), b2, voffB); PG8_STAGE(PG8_SB(0, 1), b2 + hstepB, voffB); PG8_STAGE(PG8_SA(0, 0), a2, voffA);
            PG8_WAIT_V(8); PG8_WAIT_L(0); PG8_BAR; PG8_MMA(1, 0, At, B0); PG8_MMA(1, 1, At, B1); PG8_BAR; PG8_SCHED;
            PG8_LDB(B0, 1, 0); PG8_LDB(B1, 1, 1); PG8_SCHED; PG8_LDA(At, 1, 0); PG8_STAGE(PG8_SA(0, 1), a2 + hstepA, voffA);
            PG8_WAIT_V(8); PG8_WAIT_L(0); PG8_BAR; PG8_MMA(0, 0, At, B0); PG8_MMA(0, 1, At, B1); PG8_BAR; PG8_SCHED;
            PG8_LDA(At, 1, 1); PG8_STAGE(PG8_SB(1, 0), b3, voffB); PG8_STAGE(PG8_SB(1, 1), b3 + hstepB, voffB); PG8_STAGE(PG8_SA(1, 0), a3, voffA);
            PG8_WAIT_V(8); PG8_WAIT_L(0); PG8_BAR; PG8_MMA(1, 0, At, B0); PG8_MMA(1, 1, At, B1); PG8_BAR; PG8_SCHED;
            } else {
            PG8_LDB(B0, 0, 0); PG8_SCHED; PG8_LDA(At, 0, 0); PG8_STAGE(PG8_SA(1, 1), a1 + hstepA, voffA);
            PG8_WAIT_L(8); PG8_BAR; PG8_WAIT_L(0); PG8_MMA(0, 0, At, B0); PG8_BAR; PG8_SCHED;
            PG8_LDB(B1, 0, 1); PG8_STAGE(PG8_SB(0, 0), b2, voffB);
            PG8_BAR; PG8_WAIT_L(0); PG8_MMA(0, 1, At, B1); PG8_BAR;
            PG8_LDA(At, 0, 1); PG8_STAGE(PG8_SA(0, 0), a2, voffA);
            PG8_BAR; PG8_WAIT_L(0); PG8_MMA(1, 0, At, B0); PG8_BAR; PG8_SCHED;
            PG8_STAGE(PG8_SB(0, 1), b2 + hstepB, voffB);
            PG8_WAIT_V(6); PG8_BAR; PG8_MMA(1, 1, At, B1); PG8_BAR;
            PG8_LDB(B0, 1, 0); PG8_SCHED; PG8_LDA(At, 1, 0); PG8_STAGE(PG8_SA(0, 1), a2 + hstepA, voffA);
            PG8_WAIT_L(8); PG8_BAR; PG8_WAIT_L(0); PG8_MMA(0, 0, At, B0); PG8_BAR; PG8_SCHED;
            PG8_LDB(B1, 1, 1); PG8_STAGE(PG8_SB(1, 0), b3, voffB);
            PG8_BAR; PG8_WAIT_L(0); PG8_MMA(0, 1, At, B1); PG8_BAR;
            PG8_LDA(At, 1, 1); PG8_STAGE(PG8_SA(1, 0), a3, voffA);
            PG8_BAR; PG8_WAIT_L(0); PG8_MMA(1, 0, At, B0); PG8_BAR; PG8_SCHED;
            PG8_STAGE(PG8_SB(1, 1), b3 + hstepB, voffB);
            PG8_WAIT_V(6); PG8_BAR; PG8_MMA(1, 1, At, B1); PG8_BAR;
            }
        }
        if constexpr (ALIGN_EPI) { if (wr == 0) PG8_BAR; }
        { int tz = tid; asm volatile("" : "+v"(tz)); const int ln = tz & 63; E(acc, cur, wr, wc, ln & 15, ln >> 4); }
        if (!has_next) break;
#pragma unroll
        for (int a = 0; a < 2; ++a)
#pragma unroll
            for (int b = 0; b < 2; ++b)
#pragma unroll
                for (int m = 0; m < 4; ++m)
#pragma unroll
                    for (int n = 0; n < 2; ++n) acc[a][b][m][n] = (f32x4){0.f, 0.f, 0.f, 0.f};
        cur = nxt; cA = nA; cB = nB; ++ui;
        if constexpr (ALIGN_EPI) { if (wr == 1) PG8_BAR; }
    }
    PG8_WAIT_V(0);
    if constexpr (!ALIGN_EPI) { if (wr == 0) PG8_BAR; }
    PG8_BAR;
#undef PG8_SA
#undef PG8_SB
#undef PG8_STAGE
#undef PG8_LDA
#undef PG8_LDB
#undef PG8_MMA
#undef PG8_WAIT_V
#undef PG8_WAIT_L
#undef PG8_BAR
#undef PG8_SCHED
}

struct EpiBf16 {
    static constexpr bool PERM = true;
    bf16_t* O0; bf16_t* O1; int ldc0, ldc1; int rope_tiles; int qscale_tiles; float qscale; const GAS f32x2* rope;
    __device__ __forceinline__ void operator()(const f32x4 (&acc)[2][2][4][2], const Unit& u, int wr, int wc, int fr, int fq) const {
        const int row0 = u.pm * BM + wr * 64 + fr, col0 = u.pn * BM + wc * 32 + 8 * fq;
        bf16_t* base = u.aux ? O1 : O0; const int ld = u.aux ? ldc1 : ldc0;
        const bool do_rope = u.pn < rope_tiles; const float sc = (u.pn < qscale_tiles) ? qscale : 1.f;
#pragma unroll
        for (int ai = 0; ai < 2; ++ai)
#pragma unroll
            for (int m = 0; m < 4; ++m) {
                const int row = row0 + ai * HALF + m * 16; bf16_t* rowp = base + (size_t)row * ld + col0;
                f32x4 v00 = acc[ai][0][m][0], v01 = acc[ai][0][m][1], v10 = acc[ai][1][m][0], v11 = acc[ai][1][m][1];
                if (do_rope) {
                    const GAS f32x4* rp = (const GAS f32x4*)(rope + (size_t)row * 128 + wc * 32 + 8 * fq);
                    { const f32x4 t0 = rp[0], t1 = rp[1]; f32x4 a, b;
                      a[0] = v00[0] * t0[0] - v10[0] * t0[1]; b[0] = v10[0] * t0[0] + v00[0] * t0[1];
                      a[1] = v00[1] * t0[2] - v10[1] * t0[3]; b[1] = v10[1] * t0[2] + v00[1] * t0[3];
                      a[2] = v00[2] * t1[0] - v10[2] * t1[1]; b[2] = v10[2] * t1[0] + v00[2] * t1[1];
                      a[3] = v00[3] * t1[2] - v10[3] * t1[3]; b[3] = v10[3] * t1[2] + v00[3] * t1[3];
                      v00 = a; v10 = b; }
                    FENCE();
                    { const f32x4 t2 = rp[2], t3 = rp[3]; f32x4 a, b;
                      a[0] = v01[0] * t2[0] - v11[0] * t2[1]; b[0] = v11[0] * t2[0] + v01[0] * t2[1];
                      a[1] = v01[1] * t2[2] - v11[1] * t2[3]; b[1] = v11[1] * t2[2] + v01[1] * t2[3];
                      a[2] = v01[2] * t3[0] - v11[2] * t3[1]; b[2] = v11[2] * t3[0] + v01[2] * t3[1];
                      a[3] = v01[3] * t3[2] - v11[3] * t3[3]; b[3] = v11[3] * t3[2] + v01[3] * t3[3];
                      v01 = a; v11 = b; }
                }
                v00 = v00 * sc; v01 = v01 * sc; v10 = v10 * sc; v11 = v11 * sc;
                u32x4 w0, w1;
                w0.x = cvt_pk_bf16(v00[0], v00[1]); w0.y = cvt_pk_bf16(v00[2], v00[3]); w0.z = cvt_pk_bf16(v01[0], v01[1]); w0.w = cvt_pk_bf16(v01[2], v01[3]);
                w1.x = cvt_pk_bf16(v10[0], v10[1]); w1.y = cvt_pk_bf16(v10[2], v10[3]); w1.z = cvt_pk_bf16(v11[0], v11[1]); w1.w = cvt_pk_bf16(v11[2], v11[3]);
                *(u32x4*)(rowp) = w0; *(u32x4*)(rowp + HALF) = w1;
                FENCE();
            }
    }
};
struct EpiResid {
    static constexpr bool PERM = false;
    const float* base; float* out; const float* gate; int gstride;
    __device__ __forceinline__ void operator()(const f32x4 (&acc)[2][2][4][2], const Unit& u, int wr, int wc, int fr, int fq) const {
        const int row0 = u.pm * BM + wr * 64 + fr, col0 = u.pn * BM + wc * 32 + 4 * fq;
        const float* gp = gate + (size_t)((u.pm * BM) >> 12) * gstride + col0;
        f32x4 gv[2][2];
#pragma unroll
        for (int bj = 0; bj < 2; ++bj)
#pragma unroll
            for (int n = 0; n < 2; ++n) gv[bj][n] = *(const f32x4*)(gp + bj * HALF + n * 16);
#pragma unroll
        for (int ai = 0; ai < 2; ++ai)
#pragma unroll
            for (int m = 0; m < 4; ++m) { const size_t ro = (size_t)(row0 + ai * HALF + m * 16) * DM + col0;
#pragma unroll
                for (int bj = 0; bj < 2; ++bj)
#pragma unroll
                    for (int n = 0; n < 2; ++n) { const f32x4 bv = *(const f32x4*)(base + ro + bj * HALF + n * 16);
                        *(f32x4*)(out + ro + bj * HALF + n * 16) = bv + gv[bj][n] * acc[ai][bj][m][n]; } }
    }
};
__device__ __forceinline__ unsigned pk4_fp8(float a, float b, float c, float d) { int w = __builtin_amdgcn_cvt_pk_fp8_f32(a, b, 0, false); w = __builtin_amdgcn_cvt_pk_fp8_f32(c, d, w, true); return (unsigned)w; }
struct EpiSwiglu {
    static constexpr bool PERM = true;
    unsigned char* act; const float* bgu; float ascale;
    __device__ __forceinline__ void operator()(const f32x4 (&acc)[2][2][4][2], const Unit& u, int wr, int wc, int fr, int fq) const {
        const int row0 = u.pm * BM + wr * 64 + fr, c0 = u.pn * HALF + wc * 32 + 8 * fq;
        const float* bp = bgu + (size_t)u.aux * 2048 + c0;
        const f32x4 bg0 = *(const f32x4*)(bp), bg1 = *(const f32x4*)(bp + 4), bu0 = *(const f32x4*)(bp + 1024), bu1 = *(const f32x4*)(bp + 1028);
#pragma unroll
        for (int ai = 0; ai < 2; ++ai)
#pragma unroll
            for (int m = 0; m < 4; ++m) {
                const f32x4 g0 = acc[ai][0][m][0] * ascale + bg0, g1 = acc[ai][0][m][1] * ascale + bg1, u0 = acc[ai][1][m][0] * ascale + bu0, u1 = acc[ai][1][m][1] * ascale + bu1;
                float r[8];
#pragma unroll
                for (int j = 0; j < 4; ++j) {
                    float gg = fminf(g0[j], 7.f), uu = fminf(fmaxf(u0[j], -7.f), 7.f); r[j] = 4.f * (uu + 1.f) * gg / (1.f + __expf(-1.702f * gg));
                    gg = fminf(g1[j], 7.f); uu = fminf(fmaxf(u1[j], -7.f), 7.f); r[4 + j] = 4.f * (uu + 1.f) * gg / (1.f + __expf(-1.702f * gg));
                }
                u32x2 w; w.x = pk4_fp8(r[0], r[1], r[2], r[3]); w.y = pk4_fp8(r[4], r[5], r[6], r[7]);
                *(u32x2*)(act + (size_t)(row0 + ai * HALF + m * 16) * EFF + c0) = w;
            }
    }
};
struct EpiDown {
    static constexpr bool PERM = true;
    bf16_t* y; const float* bd; const float* wrow; float ascale;
    __device__ __forceinline__ void operator()(const f32x4 (&acc)[2][2][4][2], const Unit& u, int wr, int wc, int fr, int fq) const {
        const int row0 = u.pm * BM + wr * 64 + fr, col0 = u.pn * BM + wc * 32 + 8 * fq;
        const float* bp = bd + (size_t)u.aux * DM + col0;
        const f32x4 b00 = *(const f32x4*)(bp), b01 = *(const f32x4*)(bp + 4), b10 = *(const f32x4*)(bp + HALF), b11 = *(const f32x4*)(bp + HALF + 4);
#pragma unroll
        for (int ai = 0; ai < 2; ++ai)
#pragma unroll
            for (int m = 0; m < 4; ++m) {
                const int row = row0 + ai * HALF + m * 16; const float w = wrow[row];
                const f32x4 v00 = (acc[ai][0][m][0] * ascale + b00) * w, v01 = (acc[ai][0][m][1] * ascale + b01) * w, v10 = (acc[ai][1][m][0] * ascale + b10) * w, v11 = (acc[ai][1][m][1] * ascale + b11) * w;
                u32x4 w0, w1;
                w0.x = cvt_pk_bf16(v00[0], v00[1]); w0.y = cvt_pk_bf16(v00[2], v00[3]); w0.z = cvt_pk_bf16(v01[0], v01[1]); w0.w = cvt_pk_bf16(v01[2], v01[3]);
                w1.x = cvt_pk_bf16(v10[0], v10[1]); w1.y = cvt_pk_bf16(v10[2], v10[3]); w1.z = cvt_pk_bf16(v11[0], v11[1]); w1.w = cvt_pk_bf16(v11[2], v11[3]);
                bf16_t* rowp = y + (size_t)row * DM + col0;
                *(u32x4*)(rowp) = w0; *(u32x4*)(rowp + HALF) = w1;
            }
    }
};
}
namespace la {
__device__ __forceinline__ unsigned off_a(unsigned row, unsigned ch) { return 2048u * (row >> 3) + 512u * (ch >> 2) + 64u * (row & 7) + 16u * ((ch & 3) ^ ((row >> 2) & 3)); }
__device__ __forceinline__ unsigned r_base(int lane, int e) { const unsigned h = lane >> 5; return 2048u * ((lane & 31) >> 3) + 64u * (lane & 7) + 16u * ((2u * e + h) ^ ((lane >> 2) & 3)); }
__device__ __forceinline__ unsigned t_base(int lane, int t) { const unsigned h = lane >> 5, blk = (lane >> 4) & 1, q = (lane & 15) >> 2, p = lane & 3;
    return 2048u * h + 64u * (4u * t + q) + 16u * ((2u * blk + (p >> 1)) ^ (2u * h + t)) + 8u * (p & 1); }
__device__ __forceinline__ int crow(int r, int hi) { return (r & 3) + 8 * (r >> 2) + 4 * hi; }

__device__ __forceinline__ bf16x8 lds_r128(unsigned addr) { return *(const LAS bf16x8*)(uintptr_t)addr; }
__device__ __forceinline__ bf16x8 lds_tr_frag(unsigned a0, unsigned a1) {
    s16x4 x, y; asm volatile("ds_read_b64_tr_b16 %0, %2\n\tds_read_b64_tr_b16 %1, %3\n\ts_waitcnt lgkmcnt(0)" : "=&v"(x), "=&v"(y) : "v"(a0), "v"(a1) : "memory");
    return (bf16x8){x[0], x[1], x[2], x[3], y[0], y[1], y[2], y[3]};
}
__device__ __forceinline__ bf16x8 scale_frag(bf16x8 f, float s) {
    u32x4 w = __builtin_bit_cast(u32x4, f); u32x4 o;
    o.x = cvt_pk_bf16(bf_lo(w.x) * s, bf_hi(w.x) * s); o.y = cvt_pk_bf16(bf_lo(w.y) * s, bf_hi(w.y) * s);
    o.z = cvt_pk_bf16(bf_lo(w.z) * s, bf_hi(w.z) * s); o.w = cvt_pk_bf16(bf_lo(w.w) * s, bf_hi(w.w) * s);
    return __builtin_bit_cast(bf16x8, o);
}
template <int R, int NP, bool SCALE>
__device__ __forceinline__ void stage_tile(int tid, unsigned lds_base, const bf16_t* g, int ld, const LAS float* rowscale) {
    constexpr int RPI = 32 / NP, NIT = R / RPI;
    static_assert(RPI % 8 == 0 && R % RPI == 0, "stage_tile geometry");
    const int row0 = tid / (16 * NP), cc = tid % (16 * NP), pnl = cc >> 4, ch = cc & 15;
    const unsigned la0 = lds_base + pnl * (R * 256) + off_a(row0, ch), la1 = lds_base + pnl * (R * 256) + off_a(row0 + RPI, ch);
    const bf16_t* gp = g + (size_t)row0 * ld + cc * 8;
    const size_t gstep = (size_t)RPI * ld;
#pragma unroll
    for (int it = 0; it < NIT; ++it) {
        bf16x8 v = *(const bf16x8*)(gp + it * gstep);
        if (SCALE) v = scale_frag(v, rowscale[row0 + it * RPI]);
        const unsigned la = (RPI % 16 == 0) ? la0 + it * (RPI * 256) : ((it & 1) ? la1 + (it >> 1) * (2 * RPI * 256) : la0 + (it >> 1) * (2 * RPI * 256));
        *(LAS bf16x8*)(uintptr_t)la = v;
        if ((it & 3) == 3) FENCE();
    }
}
template <int R, int CW>
__device__ __forceinline__ void stage_tile_narrow(int tid, unsigned lds_base, const bf16_t* g, int ld) {
    static_assert(CW == 64 && R % 64 == 0, "stage_tile_narrow geometry");
    const int row0 = tid >> 3, ch = tid & 7;
    const unsigned la0 = lds_base + off_a(row0, ch);
    const bf16_t* gp = g + (size_t)row0 * ld + ch * 8;
#pragma unroll
    for (int it = 0; it < R / 64; ++it) *(LAS bf16x8*)(uintptr_t)(la0 + it * 16384) = *(const bf16x8*)(gp + (size_t)it * 64 * ld);
}

struct StateArgs {
    const bf16_t* K; int ldk;
    const bf16_t* V; int ldv;
    bf16_t* Cout; int ldc; size_t cstride;
    float* Nout;
    const float* alpha; const float* beta;
    float lgam; int dir;
};
template <int DK, int DVB, bool MLSTM>
__device__ __forceinline__ void state_unit(LAS unsigned char* lds, const StateArgs a) {
    constexpr int NDKB = DK / 32, NDVB = DVB / 32, BPW = (NDKB * NDVB) / 8, NPK = DK / 128;
    static_assert(BPW >= 1 && (NDKB == 8 || NDKB == 4), "state tile geometry");
    int tid = threadIdx.x; asm volatile("" : "+v"(tid));
    const int wid = __builtin_amdgcn_readfirstlane(tid >> 6), lane = tid & 63, r32 = lane & 31, hi = lane >> 5;
    const int dkb = wid % NDKB, dvb0 = (wid / NDKB) * BPW;
    const unsigned ldsb = (unsigned)(uintptr_t)lds;
    const unsigned KP = ldsb, VP = ldsb + NPK * 32768u, WT = VP + 32768u;
    LAS float* wtab = (LAS float*)(lds + NPK * 32768 + 32768);
    const unsigned tb0 = t_base(lane, 0), tb1 = t_base(lane, 1);
    f32x16 acc[BPW];
#pragma unroll
    for (int j = 0; j < BPW; ++j) acc[j] = (f32x16){};
    float nacc = 0.f;
#pragma unroll 1
    for (int ci = 0; ci < 32; ++ci) {
        const int c = a.dir ? 31 - ci : ci; const int t0 = c * 128;
        {
            bf16_t* co = a.Cout + (size_t)c * a.cstride;
#pragma unroll
            for (int j = 0; j < BPW; ++j)
#pragma unroll
                for (int r = 0; r < 16; ++r) co[(size_t)(32 * dkb + crow(r, hi)) * a.ldc + 32 * (dvb0 + j) + r32] = f2bf(acc[j][r]);
            if (MLSTM) { if (a.Nout && tid < DK) a.Nout[(size_t)c * DK + tid] = nacc; }
        }
        float eF;
        if (MLSTM) {
            const float F = a.alpha[t0 + (a.dir ? 0 : 127)];
            if (tid < 128) wtab[tid] = __expf(F - a.alpha[t0 + tid] + a.beta[t0 + tid]);
            eF = __expf(F);
        } else {
            if (tid < 128) { const int sp = a.dir ? 127 - tid : tid; wtab[tid] = __expf((float)(127 - sp) * a.lgam); }
            eF = __expf(128.f * a.lgam);
        }
        __syncthreads();
        stage_tile<128, NPK, true>(tid, KP, a.K + (size_t)t0 * a.ldk, a.ldk, wtab);
        if constexpr (DVB == 128) stage_tile<128, 1, false>(tid, VP, a.V + (size_t)t0 * a.ldv, a.ldv, nullptr);
        else stage_tile_narrow<128, DVB>(tid, VP, a.V + (size_t)t0 * a.ldv, a.ldv);
        __syncthreads();
#pragma unroll
        for (int j = 0; j < BPW; ++j)
#pragma unroll
            for (int r = 0; r < 16; ++r) acc[j][r] *= eF;
#pragma unroll
        for (int ks = 0; ks < 8; ++ks) {
            const unsigned ka = KP + (dkb >> 2) * 32768u + 4096u * ks + 512u * (dkb & 3);
            const bf16x8 af = lds_tr_frag(ka + tb0, ka + tb1);
#pragma unroll
            for (int j = 0; j < BPW; ++j) {
                const unsigned va = VP + 4096u * ks + 512u * (dvb0 + j);
                const bf16x8 bfr = lds_tr_frag(va + tb0, va + tb1);
                acc[j] = __builtin_amdgcn_mfma_f32_32x32x16_bf16(af, bfr, acc[j], 0, 0, 0);
            }
            FENCE();
        }
        if (MLSTM) {
            if (tid < DK) { float s = 0.f; const int pnl = tid >> 7, col = tid & 127;
                for (int p = 0; p < 128; ++p) s += bf2f(*(const LAS bf16_t*)(lds + pnl * 32768 + off_a(p, col >> 3) + (col & 7) * 2));
                nacc = eF * nacc + s; }
        }
        __syncthreads();
    }
    (void)WT;
}

struct OutArgs {
    const bf16_t* Q; int ldq;
    const bf16_t* K; int ldk;
    const bf16_t* V; int ldv;
    const bf16_t* Cf; const bf16_t* Cb;
    const float* Nf; const float* Nb;
    const float* af; const float* bfw; const float* ab; const float* bbw;
    float Mf, Mb;
    float lgf, lgb;
    const float* gain;
    const bf16_t* G; int ldg;
    bf16_t* Out; int ldo;
};
template <int DK, int DV, bool MLSTM>
__device__ __forceinline__ void out_unit(LAS unsigned char* lds, LAS unsigned char* ldstab, const OutArgs a) {
    constexpr int NPK = DK / 128, NB = DV / 64, NPV = DV / 128, NKS = DK / 16, NCP = DK / 64;
    int tid = threadIdx.x; asm volatile("" : "+v"(tid));
    const int wid = __builtin_amdgcn_readfirstlane(tid >> 6), lane = tid & 63, r32 = lane & 31, hi = lane >> 5;
    const int rb = wid & 3, dh = wid >> 2;
    const unsigned ldsb = (unsigned)(uintptr_t)lds;
    const unsigned QP = ldsb, KP = ldsb + NPK * 32768u, SB = KP;
    LAS float* akf = (LAS float*)ldstab; LAS float* akb = akf + 128; LAS float* nf = akb + 128; LAS float* nbv = nf + 256; LAS float* exch = nbv + 256;
    const unsigned rb0 = r_base(lane, 0), rb1 = r_base(lane, 1), tb0 = t_base(lane, 0), tb1 = t_base(lane, 1);
    __syncthreads();
    stage_tile<128, NPK, false>(tid, QP, a.Q, a.ldq, nullptr);
    stage_tile<128, NPK, false>(tid, KP, a.K, a.ldk, nullptr);
    if (tid < 128) {
        if (MLSTM) { akf[tid] = a.af[tid] - a.bfw[tid]; akb[tid] = a.ab[tid] - a.bbw[tid]; }
        else { akf[tid] = (float)(tid + 1) * a.lgf; akb[tid] = (float)(128 - tid) * a.lgb; }
    }
    if (MLSTM) { if (tid < DK) { nf[tid] = a.Nf[tid]; nbv[tid] = a.Nb[tid]; } }
    const int l = 32 * rb + r32;
    float a_fl, a_bl;
    if (MLSTM) { a_fl = a.af[l]; a_bl = a.ab[l]; } else { a_fl = (float)(l + 1) * a.lgf; a_bl = (float)(128 - l) * a.lgb; }
    __syncthreads();
    f32x16 p[4];
#pragma unroll
    for (int kb = 0; kb < 4; ++kb) p[kb] = (f32x16){};
    float qnf = 0.f, qnb = 0.f;
#pragma unroll
    for (int ks = 0; ks < NKS; ++ks) {
        const unsigned po = (ks >> 3) * 32768u + ((ks & 1) ? rb1 : rb0) + 512u * ((ks & 7) >> 1);
        const bf16x8 qf = lds_r128(QP + po + 8192u * rb);
        bf16x8 kf[4];
#pragma unroll
        for (int kb = 0; kb < 4; ++kb) kf[kb] = lds_r128(KP + po + 8192u * kb);
#pragma unroll
        for (int kb = 0; kb < 4; ++kb) p[kb] = __builtin_amdgcn_mfma_f32_32x32x16_bf16(kf[kb], qf, p[kb], 0, 0, 0);
        FENCE();
    }
    if (MLSTM) {
#pragma unroll 1
        for (int ks = 0; ks < NKS; ++ks) {
            const bf16x8 qf = lds_r128(QP + (ks >> 3) * 32768u + ((ks & 1) ? rb1 : rb0) + 512u * ((ks & 7) >> 1) + 8192u * rb);
            const u32x4 w = __builtin_bit_cast(u32x4, qf); const int k0 = 16 * ks + 8 * hi;
            const f32x4 nf0 = *(const LAS f32x4*)(nf + k0), nf1 = *(const LAS f32x4*)(nf + k0 + 4), nb0 = *(const LAS f32x4*)(nbv + k0), nb1 = *(const LAS f32x4*)(nbv + k0 + 4);
            const float q0 = bf_lo(w.x), q1 = bf_hi(w.x), q2 = bf_lo(w.y), q3 = bf_hi(w.y), q4 = bf_lo(w.z), q5 = bf_hi(w.z), q6 = bf_lo(w.w), q7 = bf_hi(w.w);
            qnf += q0 * nf0[0] + q1 * nf0[1] + q2 * nf0[2] + q3 * nf0[3] + q4 * nf1[0] + q5 * nf1[1] + q6 * nf1[2] + q7 * nf1[3];
            qnb += q0 * nb0[0] + q1 * nb0[1] + q2 * nb0[2] + q3 * nb0[3] + q4 * nb1[0] + q5 * nb1[1] + q6 * nb1[2] + q7 * nb1[3];
        }
    }
    float rf = 1.f, rbk = 1.f;
    if (MLSTM) {
        float df = 0.f, db = 0.f;
#pragma unroll
        for (int kb = 0; kb < 4; ++kb) {
#pragma unroll
            for (int r = 0; r < 16; ++r) { const int s = 32 * kb + crow(r, hi);
                const float xf = a_fl - akf[s], xb = a_bl - akb[s];
                const float wf = __expf((s <= l) ? xf : -1.0e30f), wb = __expf((s >= l) ? xb : -1.0e30f);
                df += p[kb][r] * wf; db += p[kb][r] * wb; }
            FENCE(); }
        { auto rr = __builtin_amdgcn_permlane32_swap(__float_as_uint(df), __float_as_uint(df), false, false); df = __uint_as_float(rr[0]) + __uint_as_float(rr[1]); }
        { auto rr = __builtin_amdgcn_permlane32_swap(__float_as_uint(db), __float_as_uint(db), false, false); db = __uint_as_float(rr[0]) + __uint_as_float(rr[1]); }
        { auto rr = __builtin_amdgcn_permlane32_swap(__float_as_uint(qnf), __float_as_uint(qnf), false, false); qnf = __uint_as_float(rr[0]) + __uint_as_float(rr[1]); }
        { auto rr = __builtin_amdgcn_permlane32_swap(__float_as_uint(qnb), __float_as_uint(qnb), false, false); qnb = __uint_as_float(rr[0]) + __uint_as_float(rr[1]); }
        df += __expf(a_fl) * qnf; db += __expf(a_bl) * qnb;
        rf = 1.f / fmaxf(fabsf(df), __expf(-a.Mf)); rbk = 1.f / fmaxf(fabsf(db), __expf(-a.Mb));
        asm volatile("" : "+v"(a_fl), "+v"(a_bl));
    }
    int l2 = l; asm volatile("" : "+v"(l2));
#pragma unroll
    for (int kb = 0; kb < 4; ++kb) {
#pragma unroll
        for (int r = 0; r < 16; ++r) { const int s = 32 * kb + crow(r, hi);
            const float xf = a_fl - akf[s], xb = a_bl - akb[s];
            const float wf = __expf((s <= l2) ? xf : -1.0e30f), wb = __expf((s >= l2) ? xb : -1.0e30f);
            p[kb][r] *= (wf * rf + wb * rbk); }
        FENCE(); }
    const float qsf = __expf(a_fl) * rf, qsb = __expf(a_bl) * rbk;
    bf16x8 pa[8];
#define LA_PK4(P, BASE, OUT) do { unsigned a0 = cvt_pk_bf16(P[BASE + 0], P[BASE + 1]), a1 = cvt_pk_bf16(P[BASE + 2], P[BASE + 3]); \
    unsigned b0 = cvt_pk_bf16(P[BASE + 4], P[BASE + 5]), b1 = cvt_pk_bf16(P[BASE + 6], P[BASE + 7]); \
    auto r0 = __builtin_amdgcn_permlane32_swap(a0, b0, false, false); auto r1 = __builtin_amdgcn_permlane32_swap(a1, b1, false, false); \
    u32x4 w = {r0[0], r1[0], r0[1], r1[1]}; OUT = __builtin_bit_cast(bf16x8, w); } while (0)
#pragma unroll
    for (int kb = 0; kb < 4; ++kb) { LA_PK4(p[kb], 0, pa[2 * kb]); LA_PK4(p[kb], 8, pa[2 * kb + 1]); }
#undef LA_PK4
    f32x16 o[NB];
#pragma unroll
    for (int nb = 0; nb < NB; ++nb) o[nb] = (f32x16){};
#pragma unroll
    for (int pc = 0; pc < 2; ++pc) {
        __syncthreads();
        stage_tile<64, NPV, false>(tid, SB, a.V + (size_t)(64 * pc) * a.ldv, a.ldv, nullptr);
        __syncthreads();
#pragma unroll
        for (int ks = 0; ks < 4; ++ks) {
            const bf16x8 af = pa[4 * pc + ks];
#pragma unroll
            for (int nb = 0; nb < NB; ++nb) { const int cg = dh * NB + nb; const unsigned va = SB + (cg >> 2) * 16384u + 4096u * ks + 512u * (cg & 3);
                const bf16x8 bfr = lds_tr_frag(va + tb0, va + tb1);
                o[nb] = __builtin_amdgcn_mfma_f32_32x32x16_bf16(af, bfr, o[nb], 0, 0, 0); }
            FENCE();
        }
    }
#pragma unroll 1
    for (int pc = 0; pc < 2 * NCP; ++pc) {
        __syncthreads();
        const int dirb = pc >= NCP, cp = dirb ? pc - NCP : pc;
        const bf16_t* src = (dirb ? a.Cb : a.Cf) + (size_t)(64 * cp) * DV;
        const float qs = dirb ? qsb : qsf;
        stage_tile<64, NPV, false>(tid, SB, src, DV, nullptr);
        __syncthreads();
#pragma unroll
        for (int ks = 0; ks < 4; ++ks) {
            const int kq = 4 * cp + ks;
            const bf16x8 qf = lds_r128(QP + (kq >> 3) * 32768u + ((kq & 1) ? rb1 : rb0) + 512u * ((kq & 7) >> 1) + 8192u * rb);
            const bf16x8 af = scale_frag(qf, qs);
#pragma unroll
            for (int nb = 0; nb < NB; ++nb) { const int cg = dh * NB + nb; const unsigned va = SB + (cg >> 2) * 16384u + 4096u * ks + 512u * (cg & 3);
                const bf16x8 bfr = lds_tr_frag(va + tb0, va + tb1);
                o[nb] = __builtin_amdgcn_mfma_f32_32x32x16_bf16(af, bfr, o[nb], 0, 0, 0); }
            FENCE();
        }
    }
    float s1[16], s2[16];
#pragma unroll
    for (int r = 0; r < 16; ++r) { float x1 = 0.f, x2 = 0.f;
#pragma unroll
        for (int nb = 0; nb < NB; ++nb) { x1 += o[nb][r]; x2 += o[nb][r] * o[nb][r]; }
#pragma unroll
        for (int m = 1; m < 32; m <<= 1) { x1 += shx(x1, m, lane); x2 += shx(x2, m, lane); }
        s1[r] = x1; s2[r] = x2; }
    if (r32 == 0) {
#pragma unroll
        for (int r = 0; r < 16; ++r) { const int row = 32 * rb + crow(r, hi); exch[(dh * 128 + row) * 2] = s1[r]; exch[(dh * 128 + row) * 2 + 1] = s2[r]; }
    }
    __syncthreads();
#pragma unroll
    for (int r = 0; r < 16; ++r) {
        const int row = 32 * rb + crow(r, hi);
        const float t1 = s1[r] + exch[((1 - dh) * 128 + row) * 2], t2 = s2[r] + exch[((1 - dh) * 128 + row) * 2 + 1];
        float mean, inv;
        if (MLSTM) { mean = 0.f; inv = rsqrtf(t2 * (1.f / DV) + EPS); }
        else { mean = t1 * (1.f / DV); inv = rsqrtf(fmaxf(t2 * (1.f / DV) - mean * mean, 0.f) + EPS); }
#pragma unroll
        for (int nb = 0; nb < NB; ++nb) {
            const int col = dh * (DV / 2) + 32 * nb + r32;
            const float gpre = bf2f(a.G[(size_t)row * a.ldg + col]);
            const float gate = MLSTM ? sigmoidf_(gpre) : siluf_(gpre);
            a.Out[(size_t)row * a.ldo + col] = f2bf((o[nb][r] - mean) * inv * a.gain[col] * gate);
        }
    }
}
}
namespace att {
constexpr int DQK = 96, DVV = 64, NW = 8, QBLK = 32, KVBLK = 64, KROW = 128;
constexpr float SCALE = 0.10206207261596575f;
constexpr float THR = 8.f;
constexpr size_t SHM_V = KVBLK * DVV * 2, SHM_K = KVBLK * KROW * 2, SHM_ATTN = 2 * SHM_V + 2 * SHM_K + NW * 64 * 4;
#define KSWZ(row, colB) ((row) * 256 + ((colB) ^ (((row) & 7) << 4)))
__device__ __forceinline__ int crow(int r, int hi) { return (r & 3) + 8 * (r >> 2) + 4 * hi; }

__device__ __forceinline__ void partialSM(f32x16& p0, f32x16& p1, float& m_reg, float& mn, float& alpha) {
  constexpr float C = SCALE * 1.4426950408889634f;
  float pmax = p0[0]; for (int r = 1; r < 16; ++r) pmax = fmaxf(pmax, p0[r]); for (int r = 0; r < 16; ++r) pmax = fmaxf(pmax, p1[r]);
  { auto rr = __builtin_amdgcn_permlane32_swap(__float_as_uint(pmax), __float_as_uint(pmax), false, false);
    pmax = fmaxf(__uint_as_float(rr[0]), __uint_as_float(rr[1])); }
  if (__builtin_expect(__all(pmax - m_reg <= THR / SCALE), 1)) { mn = m_reg; alpha = 1.f; }
  else { mn = fmaxf(m_reg, pmax); alpha = __builtin_amdgcn_exp2f((m_reg - mn) * C); m_reg = mn; }
  float mnC = -mn * C;
  for (int r = 0; r < 16; ++r) p0[r] = fmaf(p0[r], C, mnC); for (int r = 0; r < 16; ++r) p1[r] = fmaf(p1[r], C, mnC);
  for (int r = 0; r < 16; ++r) p0[r] = __builtin_amdgcn_exp2f(p0[r]);
}
__device__ __forceinline__ void finishSM(f32x16& p0, f32x16& p1, float alpha, float& l_reg, bf16x8& pa0, bf16x8& pa1, bf16x8& pa2, bf16x8& pa3) {
  for (int r = 0; r < 16; ++r) p1[r] = __builtin_amdgcn_exp2f(p1[r]);
  float ps = 0; for (int r = 0; r < 16; ++r) ps += p0[r]; for (int r = 0; r < 16; ++r) ps += p1[r];
  { auto rr = __builtin_amdgcn_permlane32_swap(__float_as_uint(ps), __float_as_uint(ps), false, false);
    ps = __uint_as_float(rr[0]) + __uint_as_float(rr[1]); }
  l_reg = l_reg * alpha + ps;
#define PK4(P, BASE, OUT) do { unsigned a0 = cvt_pk_bf16(P[BASE + 0], P[BASE + 1]), a1 = cvt_pk_bf16(P[BASE + 2], P[BASE + 3]);   \
    unsigned b0 = cvt_pk_bf16(P[BASE + 4], P[BASE + 5]), b1 = cvt_pk_bf16(P[BASE + 6], P[BASE + 7]);                              \
    auto r0 = __builtin_amdgcn_permlane32_swap(a0, b0, false, false); auto r1 = __builtin_amdgcn_permlane32_swap(a1, b1, false, false); \
    u32x4 w = {r0[0], r1[0], r0[1], r1[1]}; OUT = __builtin_bit_cast(bf16x8, w); } while (0)
  PK4(p0, 0, pa0); PK4(p0, 8, pa1); PK4(p1, 0, pa2); PK4(p1, 8, pa3);
#undef PK4
}
__device__ __forceinline__ void qkt(f32x16& p0, f32x16& p1, const LAS char* Ks, const bf16x8* qr, int r32, int hi) {
  p0 = f32x16{}; p1 = f32x16{};
#pragma unroll
  for (int d0 = 0; d0 < DQK / 16; ++d0) { int cb = (d0 * 16 + hi * 8) * 2;
    bf16x8 b0 = *reinterpret_cast<const LAS bf16x8*>(Ks + KSWZ(r32, cb));
    bf16x8 b1 = *reinterpret_cast<const LAS bf16x8*>(Ks + KSWZ(32 + r32, cb));
    p0 = __builtin_amdgcn_mfma_f32_32x32x16_bf16(b0, qr[d0], p0, 0, 0, 0);
    p1 = __builtin_amdgcn_mfma_f32_32x32x16_bf16(b1, qr[d0], p1, 0, 0, 0); }
}
__device__ __forceinline__ int v_st(int k, int c) { const int kk = (k & ~0xC) | ((k & 4) << 1) | ((k & 8) >> 1); return ((kk >> 3) * 2 + (c >> 5)) * 512 + ((kk & 7) * 32 + (c & 31)) * 2; }
__device__ __forceinline__ int v_rd_base(int lane) { return ((lane & 3) << 3) | (((lane >> 2) & 3) << 6) | (((lane >> 4) & 1) << 5) | (((lane >> 5) & 1) << 8); }
constexpr int v_rd_off(int d0, int ks, int half) { return d0 * 512 + ks * 2048 + half * 1024; }
template <int OFF> __device__ __forceinline__ s16x4 tr_read(int vb) {
  s16x4 r; asm volatile("ds_read_b64_tr_b16 %0, %1 offset:%2" : "=&v"(r) : "v"(vb), "i"(OFF) : "memory"); return r;
}
template <int D0> __device__ __forceinline__ void pv_one(f32x16& od, int vb, bf16x8 pa0, bf16x8 pa1, bf16x8 pa2, bf16x8 pa3) {
  const s16x4 l0 = tr_read<v_rd_off(D0, 0, 0)>(vb), h0 = tr_read<v_rd_off(D0, 0, 1)>(vb), l1 = tr_read<v_rd_off(D0, 1, 0)>(vb), h1 = tr_read<v_rd_off(D0, 1, 1)>(vb);
  const s16x4 l2 = tr_read<v_rd_off(D0, 2, 0)>(vb), h2 = tr_read<v_rd_off(D0, 2, 1)>(vb), l3 = tr_read<v_rd_off(D0, 3, 0)>(vb), h3 = tr_read<v_rd_off(D0, 3, 1)>(vb);
  asm volatile("s_waitcnt lgkmcnt(0)" ::: "memory"); SBAR();
#define PK(L, H) (bf16x8){L[0], L[1], L[2], L[3], H[0], H[1], H[2], H[3]}
  od = __builtin_amdgcn_mfma_f32_32x32x16_bf16(pa0, PK(l0, h0), od, 0, 0, 0);
  od = __builtin_amdgcn_mfma_f32_32x32x16_bf16(pa1, PK(l1, h1), od, 0, 0, 0);
  od = __builtin_amdgcn_mfma_f32_32x32x16_bf16(pa2, PK(l2, h2), od, 0, 0, 0);
  od = __builtin_amdgcn_mfma_f32_32x32x16_bf16(pa3, PK(l3, h3), od, 0, 0, 0);
#undef PK
}
__device__ __forceinline__ void pv_d0(f32x16* o, int vb, bf16x8 pa0, bf16x8 pa1, bf16x8 pa2, bf16x8 pa3) {
  pv_one<0>(o[0], vb, pa0, pa1, pa2, pa3); pv_one<1>(o[1], vb, pa0, pa1, pa2, pa3);
}
__device__ __forceinline__ void attn_body(const bf16_t* __restrict__ Qb, const bf16_t* __restrict__ Kh, const bf16_t* __restrict__ Vh, bf16_t* __restrict__ Ob, int ldo, int seq, LAS char* lds) {
  int tid = threadIdx.x; asm volatile("" : "+v"(tid));
  const int wid = tid >> 6, lane = tid & 63, r32 = lane & 31, hi = lane >> 5;
  LAS char* V_lds = lds; LAS char* K_lds = lds + 2 * SHM_V;
  LAS float* ws = (LAS float*)(lds + 2 * SHM_V + 2 * SHM_K) + wid * 64; LAS float* li_l = ws; LAS float* al_l = ws + 32;
  float m_reg = -1e30f, l_reg = 0; f32x16 o[2] = {}; bf16x8 qr[DQK / 16];
  const bf16_t* Qw = Qb + (long)(wid * QBLK + r32) * DQK + hi * 8;
#pragma unroll
  for (int d0 = 0; d0 < DQK / 16; ++d0) qr[d0] = *reinterpret_cast<const bf16x8*>(Qw + d0 * 16);
  const int sr = tid >> 4, sc = (tid & 15) * 8;
  const int vr = tid >> 3, vc = (tid & 7) * 8, vst0 = v_st(vr, vc);
  const int vb0 = (int)(uintptr_t)V_lds + v_rd_base(lane);
  struct { bf16x8 vs0, ks0, ks1; } sr_[2];
#define SLOAD(i, k0) do { sr_[i].vs0 = *reinterpret_cast<const bf16x8*>(&Vh[(long)((k0) + vr) * DVV + vc]); \
    sr_[i].ks0 = *reinterpret_cast<const bf16x8*>(&Kh[(long)((k0) + sr) * KROW + sc]); sr_[i].ks1 = *reinterpret_cast<const bf16x8*>(&Kh[(long)((k0) + 32 + sr) * KROW + sc]); } while (0)
#define SWRITE(b, i) do { *(LAS bf16x8*)(V_lds + (b) * SHM_V + vst0) = sr_[i].vs0; int kc = sc * 2;               \
    *(LAS bf16x8*)(K_lds + (b) * SHM_K + KSWZ(sr, kc)) = sr_[i].ks0;                       \
    *(LAS bf16x8*)(K_lds + (b) * SHM_K + KSWZ(32 + sr, kc)) = sr_[i].ks1; } while (0)
#define SWAIT() asm volatile("s_waitcnt vmcnt(3)" ::: "memory")
#define RESC(a) do { if (__any((a) < 1.f)) { if (hi == 0) al_l[r32] = (a); asm volatile("s_waitcnt lgkmcnt(0)" ::: "memory"); \
    for (int d = 0; d < 2; ++d) for (int r = 0; r < 16; ++r) o[d][r] *= al_l[crow(r, hi)]; } } while (0)
  f32x16 pA0, pA1, pB0, pB1; float mnA, mnB, alA, alB; bf16x8 pa0, pa1, pa2, pa3; const int NT = seq / KVBLK;
  constexpr int SE = 0, SO = 1;
  SLOAD(SE, 0); asm volatile("s_waitcnt vmcnt(0)" ::: "memory"); SWRITE(0, SE); __syncthreads();
  qkt(pA0, pA1, K_lds, qr, r32, hi); partialSM(pA0, pA1, m_reg, mnA, alA);
  SLOAD(SO, KVBLK); if (2 < NT) SLOAD(SE, 2 * KVBLK);
  SWAIT(); SWRITE(1, SO); __syncthreads();
  for (int j = 1; j + 1 < NT; j += 2) {
    SBAR(); qkt(pB0, pB1, K_lds + SHM_K, qr, r32, hi);
    finishSM(pA0, pA1, alA, l_reg, pa0, pa1, pa2, pa3); SBAR();
    SLOAD(SO, (j + 2) * KVBLK); SBAR();
    pv_d0(o, vb0, pa0, pa1, pa2, pa3); partialSM(pB0, pB1, m_reg, mnB, alB);
    __syncthreads(); SWAIT(); SWRITE(0, SE);
    RESC(alB); __syncthreads();
    SBAR(); qkt(pA0, pA1, K_lds, qr, r32, hi);
    finishSM(pB0, pB1, alB, l_reg, pa0, pa1, pa2, pa3); SBAR();
    if (j + 3 < NT) SLOAD(SE, (j + 3) * KVBLK); SBAR();
    pv_d0(o, vb0 + (int)SHM_V, pa0, pa1, pa2, pa3); partialSM(pA0, pA1, m_reg, mnA, alA);
    __syncthreads(); SWAIT(); SWRITE(1, SO);
    RESC(alA); __syncthreads();
  }
  SBAR(); qkt(pB0, pB1, K_lds + SHM_K, qr, r32, hi);
  finishSM(pA0, pA1, alA, l_reg, pa0, pa1, pa2, pa3); SBAR();
  pv_d0(o, vb0, pa0, pa1, pa2, pa3); partialSM(pB0, pB1, m_reg, mnB, alB);
  __syncthreads(); RESC(alB);
  finishSM(pB0, pB1, alB, l_reg, pa0, pa1, pa2, pa3); SBAR();
  pv_d0(o, vb0 + (int)SHM_V, pa0, pa1, pa2, pa3);
  if (hi == 0) li_l[r32] = l_reg; asm volatile("s_waitcnt lgkmcnt(0)" ::: "memory");
  float rli[16];
#pragma unroll
  for (int r = 0; r < 16; ++r) rli[r] = __builtin_amdgcn_rcpf(li_l[crow(r, hi)]);
  bf16_t* Ow = Ob + (long)(wid * QBLK) * ldo;
#pragma unroll
  for (int r = 0; r < 16; ++r) { int orow = crow(r, hi);
#pragma unroll
    for (int d0 = 0; d0 < 2; ++d0) Ow[(long)orow * ldo + d0 * 32 + r32] = f2bf(o[d0][r] * rli[r]); }
  __syncthreads();
#undef SLOAD
#undef SWRITE
#undef SWAIT
#undef RESC
}
#undef KSWZ
}
constexpr size_t MiB = 1ull << 20;
constexpr size_t WS_CTL = 0, CTL_ZERO_BYTES = 1 * MiB;
constexpr size_t WS_MOD = 1 * MiB;
constexpr size_t WS_MISC = 2 * MiB;
constexpr size_t WS_ROPEO = 8 * MiB;
constexpr size_t WS_ROPEE = 40 * MiB;
constexpr size_t WS_WINE = 48 * MiB;
constexpr size_t WS_WQB = 58 * MiB;
constexpr size_t WS_WKVB = 59 * MiB;
constexpr size_t WS_WOUTE = 60 * MiB;
constexpr size_t WS_WINO = 64 * MiB;
constexpr size_t WS_WOUTO = 88 * MiB;
constexpr size_t WS_WGU = 96 * MiB;
constexpr size_t WS_WDN = 608 * MiB;
constexpr size_t WS_HM = 864 * MiB;
constexpr size_t WS_P = 928 * MiB;
constexpr size_t WS_X1 = 1312 * MiB;
constexpr size_t X1_QC = WS_X1, X1_KC = X1_QC + 32 * MiB, X1_QA = X1_KC + 32 * MiB, X1_KVA = X1_QA + 16 * MiB, X1_QRAW = X1_KVA + 16 * MiB, X1_KVRAW = X1_QRAW + 48 * MiB,
                 X1_QH = X1_KVRAW + 64 * MiB, X1_KH = X1_QH + 48 * MiB, X1_VH = X1_KH + 64 * MiB, X1_CM = X1_VH + 32 * MiB, X1_NM = X1_CM + 64 * MiB;
constexpr size_t WS_MIX = WS_X1 + 512 * MiB;
constexpr size_t WS_LIST = WS_MIX + 128 * MiB;
constexpr size_t WS_WLIST = WS_LIST + 16 * MiB;
constexpr size_t WS_TOKE = WS_WLIST + 16 * MiB;
constexpr size_t WS_WSORT = WS_TOKE + 1 * MiB;
constexpr size_t WS_ASORT = WS_WSORT + 1 * MiB;
constexpr size_t WS_ACT = WS_ASORT + 272 * MiB;
constexpr size_t WS_Y = WS_ACT + 272 * MiB;
constexpr size_t WS_END = WS_Y + 272 * MiB;
static_assert(X1_NM + 1 * MiB <= WS_MIX, "even-layer scratch fits");
constexpr int CW_BAR = 4096;
constexpr int CW_CNT = 8192;
constexpr int CW_QUEUE = 8192 + 1024;

constexpr int LDS_RING = 0;
constexpr int LDS_TAB = 131072;
constexpr int LT_MISC = LDS_TAB;
constexpr int LT_PSTART = LDS_TAB + 256;
constexpr int LT_CNT = LDS_TAB + 512;
constexpr int LT_BLK = LDS_TAB + 1024;
constexpr int LT_X = LDS_TAB + 1024 + 4352;
constexpr int LDS_BYTES = 147456;

#if defined(__HIP_DEVICE_COMPILE__) && __HIP_DEVICE_COMPILE__
#define ARGAS GAS
#else
#define ARGAS
#endif
typedef const ARGAS float* gcf_t; typedef const ARGAS int* gci_t;
struct Args {
    gcf_t x; gcf_t c; gci_t pos; gcf_t ada_w; gcf_t ada_b; gcf_t norm_mix_g; gcf_t norm_ffn_g;
    gcf_t hy_w_in; gcf_t ml_conv_w; gcf_t ml_conv_b; gcf_t ml_gate_b; gcf_t ml_norm_g; gcf_t mla_q_norm_g; gcf_t mla_kv_norm_g;
    gcf_t mla_w_qb; gcf_t mla_w_kvb; gcf_t mla_qk_q_g; gcf_t mla_qk_k_g; gcf_t hy_w_out;
    gcf_t ret_w_in; gcf_t ret_decay_f; gcf_t ret_decay_b; gcf_t ret_gn_g; gcf_t ret_w_out;
    gcf_t moe_router_w; gcf_t moe_router_b; gcf_t moe_w_gu; gcf_t moe_b_gu; gcf_t moe_w_down; gcf_t moe_b_down;
    ARGAS float* out; ARGAS unsigned char* ws; int ph_lo, ph_hi;
};

constexpr float FP8_WSC = 128.f, FP8_HSC = 16.f, FP8_ASC = 4.f;
template <class RowMap>
__device__ __forceinline__ void transpose_item(const float* W, int N, bf16_t* WT, int ldk, LAS float* scr, int kb, int nb, int lane, const RowMap& rm) {
    const int k0 = 64 * kb, n0 = 32 * nb;
#pragma unroll 8
    for (int i = 0; i < 32; ++i) { const int kk = 2 * i + (lane >> 5); scr[kk * 33 + (lane & 31)] = W[(size_t)(k0 + kk) * N + n0 + (lane & 31)]; }
    LDS_WAIT(); asm volatile("" ::: "memory");
    const int c = lane & 7;
#pragma unroll
    for (int j = 0; j < 4; ++j) { const int n = (lane >> 3) + 8 * j; const LAS float* s = scr + (8 * c) * 33 + n;
        u32x4 o; o.x = cvt_pk_bf16(s[0 * 33], s[1 * 33]); o.y = cvt_pk_bf16(s[2 * 33], s[3 * 33]); o.z = cvt_pk_bf16(s[4 * 33], s[5 * 33]); o.w = cvt_pk_bf16(s[6 * 33], s[7 * 33]);
        *(u32x4*)(WT + (size_t)rm(n0 + n) * ldk + k0 + 8 * c) = o; }
    LDS_WAIT(); asm volatile("" ::: "memory");
}
template <class RowMap>
__device__ __forceinline__ void transpose_item8(const float* W, int N, unsigned char* WT, int ldk, LAS float* scr, int kb, int nb, int lane, const RowMap& rm, float scale) {
    const int k0 = 64 * kb, n0 = 32 * nb;
#pragma unroll 8
    for (int i = 0; i < 32; ++i) { const int kk = 2 * i + (lane >> 5); scr[kk * 33 + (lane & 31)] = W[(size_t)(k0 + kk) * N + n0 + (lane & 31)] * scale; }
    LDS_WAIT(); asm volatile("" ::: "memory");
    const int c = lane & 7;
#pragma unroll
    for (int j = 0; j < 4; ++j) { const int n = (lane >> 3) + 8 * j; const LAS float* s = scr + (8 * c) * 33 + n;
        u32x2 o; o.x = pg8::pk4_fp8(s[0 * 33], s[1 * 33], s[2 * 33], s[3 * 33]); o.y = pg8::pk4_fp8(s[4 * 33], s[5 * 33], s[6 * 33], s[7 * 33]);
        *(u32x2*)(WT + (size_t)rm(n0 + n) * ldk + k0 + 8 * c) = o; }
    LDS_WAIT(); asm volatile("" ::: "memory");
}
struct RmId { __device__ __forceinline__ int operator()(int n) const { return n; } };
struct RmWinE { __device__ __forceinline__ int operator()(int n) const {
    if (n < 2048) return n; if (n < 2064) return PC_GT + (n - 2048); if (n < 2320) return PC_QA + (n - 2064); if (n < 2448) return PC_KVA + (n - 2320); return PC_KR + (n - 2448); } };
struct RmGu { __device__ __forceinline__ int operator()(int n) const { const int u = n & 1023; return 256 * (u >> 7) + (n >> 10) * 128 + (u & 127); } };

__device__ __forceinline__ void ld_row16(const float* p, int lane, f32x4 (&v)[4]) {
#pragma unroll
    for (int j = 0; j < 4; ++j) v[j] = *(const f32x4*)(p + 4 * lane + 256 * j);
}
struct Frame { LAS unsigned char* lds; int tid, lane, wave, G, bid; };
extern __shared__ __attribute__((aligned(16))) unsigned char lds_raw[];
#define MK_FRAME(F) Frame F; { int tz_ = threadIdx.x; asm volatile("" : "+v"(tz_)); \
    int g_ = gridDim.x, b_ = blockIdx.x; asm volatile("" : "+s"(g_), "+s"(b_)); \
    F.lds = (LAS unsigned char*)lds_raw; F.tid = tz_; F.lane = tz_ & 63; F.wave = __builtin_amdgcn_readfirstlane(tz_ >> 6); F.G = g_; F.bid = b_; }
typedef const __attribute__((address_space(4))) Args* CArgsP;
__device__ __forceinline__ const Args& fresh_args() { unsigned long long p = (unsigned long long)__builtin_amdgcn_kernarg_segment_ptr(); asm volatile("" : "+s"(p)); return *(const Args*)(CArgsP)p; }
__device__ __forceinline__ ARGAS unsigned char* opaque_ws(const ARGAS unsigned char* p) { unsigned long long v = (unsigned long long)p; asm volatile("" : "+s"(v)); return (ARGAS unsigned char*)v; }

__device__ __forceinline__ void p0_prologue(const Args& a) {
    MK_FRAME(F); ARGAS unsigned char* ws = opaque_ws(a.ws);
    {
        LAS float* cs = (LAS float*)(F.lds); LAS float* red = (LAS float*)(F.lds + 32768);
        for (int i = F.tid; i < NBATCH * DM; i += 512) cs[i] = siluf_(a.c[i]);
        __syncthreads();
        float* mod = (float*)(ws + WS_MOD);
        for (int it = F.bid; it < DEPTH * 48; it += F.G) {
            const int l = it / 48, n = (it % 48) * 128 + (F.tid & 127), ksl = F.tid >> 7;
            const float* w = a.ada_w + ((size_t)l * DM + ksl * 256) * 6144 + n;
            float acc[NBATCH];
#pragma unroll
            for (int b = 0; b < NBATCH; ++b) acc[b] = 0.f;
#pragma unroll 4
            for (int k = 0; k < 256; ++k) { const float wv = w[(size_t)k * 6144];
#pragma unroll
                for (int b = 0; b < NBATCH; ++b) acc[b] += cs[b * DM + ksl * 256 + k] * wv; }
#pragma unroll
            for (int b = 0; b < NBATCH; ++b) red[(ksl * NBATCH + b) * 128 + (F.tid & 127)] = acc[b];
            __syncthreads();
            for (int o = F.tid; o < NBATCH * 128; o += 512) { const int b = o >> 7, nn = o & 127;
                const float s = red[(0 * NBATCH + b) * 128 + nn] + red[(1 * NBATCH + b) * 128 + nn] + red[(2 * NBATCH + b) * 128 + nn] + red[(3 * NBATCH + b) * 128 + nn];
                const int col = (it % 48) * 128 + nn;
                mod[((size_t)l * NBATCH + b) * 6144 + col] = s + a.ada_b[(size_t)l * 6144 + col]; }
            __syncthreads();
        }
        __syncthreads();
    }
    {
        f32x2* ro = (f32x2*)(ws + WS_ROPEO); f32x2* re = (f32x2*)(ws + WS_ROPEE);
        const size_t gt = (size_t)F.bid * 512 + F.tid, GT = (size_t)F.G * 512;
        for (size_t i = gt; i < (size_t)NTOK * 128; i += GT) { const int tok = (int)(i >> 7), f = (int)(i & 127);
            const float inv = powf(10000.f, -(float)(2 * f) / 256.f); const float ang = (float)a.pos[tok] * inv; float s, c; sincosf(ang, &s, &c); ro[i] = (f32x2){c, s}; }
        for (size_t i = gt; i < (size_t)NTOK * 16; i += GT) { const int tok = (int)(i >> 4), f = (int)(i & 15);
            const float inv = powf(10000.f, -(float)(2 * f) / 32.f); const float ang = (float)a.pos[tok] * inv; float s, c; sincosf(ang, &s, &c); re[i] = (f32x2){c, s}; }
        bf16_t* wkv = (bf16_t*)(ws + WS_WKVB);
        for (size_t i = gt; i < (size_t)2 * 1024 * 16; i += GT) { const size_t row = i >> 4, ch = i & 15; *(u32x4*)(wkv + row * 256 + 128 + ch * 8) = (u32x4){0u, 0u, 0u, 0u}; }
    }
    {
        LAS float* scr = (LAS float*)(F.lds + F.wave * 16384);
        const int gw = F.bid * 8 + F.wave, NGW = F.G * 8;
        constexpr int I_WINE = 16 * 78, I_WQB = 4 * 24, I_WKVB = 2 * 32, I_WOUTE = 16 * 32, I_WINO = 16 * 192, I_WOUTO = 32 * 32, I_WGU = 16 * 64, I_WDN = 16 * 32;
        constexpr int T0 = 2 * I_WINE, T1 = T0 + 2 * I_WQB, T2 = T1 + 2 * I_WKVB, T3 = T2 + 2 * I_WOUTE, T4 = T3 + 2 * I_WINO, T5 = T4 + 2 * I_WOUTO, T6 = T5 + 128 * I_WGU, T7 = T6 + 128 * I_WDN;
        for (int it = gw; it < T7; it += NGW) {
            if (it < T0) { const int m = it / I_WINE, r = it % I_WINE, kb = r / 78, nb = r % 78;
                const float* W = a.hy_w_in + (size_t)m * DM * EVEN_IN; bf16_t* WT = (bf16_t*)(ws + WS_WINE) + (size_t)m * EVEN_INP * DM;
                const int k0 = 64 * kb, n0 = 32 * nb; const RmWinE rm;
#pragma unroll 8
                for (int i = 0; i < 32; ++i) { const int kk = 2 * i + (F.lane >> 5), n = n0 + (F.lane & 31); scr[kk * 33 + (F.lane & 31)] = (n < EVEN_IN) ? W[(size_t)(k0 + kk) * EVEN_IN + n] : 0.f; }
                LDS_WAIT(); asm volatile("" ::: "memory");
                const int c = F.lane & 7;
#pragma unroll
                for (int j = 0; j < 4; ++j) { const int n = (F.lane >> 3) + 8 * j; const LAS float* s = scr + (8 * c) * 33 + n;
                    u32x4 o; o.x = cvt_pk_bf16(s[0 * 33], s[1 * 33]); o.y = cvt_pk_bf16(s[2 * 33], s[3 * 33]); o.z = cvt_pk_bf16(s[4 * 33], s[5 * 33]); o.w = cvt_pk_bf16(s[6 * 33], s[7 * 33]);
                    if (n0 + n < EVEN_IN) *(u32x4*)(WT + (size_t)rm(n0 + n) * DM + k0 + 8 * c) = o; }
                LDS_WAIT(); asm volatile("" ::: "memory");
                continue; }
            if (it < T1) { const int q = it - T0, m = q / I_WQB, r = q % I_WQB; transpose_item(a.mla_w_qb + (size_t)m * 256 * 768, 768, (bf16_t*)(ws + WS_WQB) + (size_t)m * 768 * 256, 256, scr, r / 24, r % 24, F.lane, RmId()); continue; }
            if (it < T2) { const int q = it - T1, m = q / I_WKVB, r = q % I_WKVB; transpose_item(a.mla_w_kvb + (size_t)m * 128 * 1024, 1024, (bf16_t*)(ws + WS_WKVB) + (size_t)m * 1024 * 256, 256, scr, r / 32, r % 32, F.lane, RmId()); continue; }
            if (it < T3) { const int q = it - T2, m = q / I_WOUTE, r = q % I_WOUTE; transpose_item(a.hy_w_out + (size_t)m * DM * DM, DM, (bf16_t*)(ws + WS_WOUTE) + (size_t)m * DM * DM, DM, scr, r / 32, r % 32, F.lane, RmId()); continue; }
            if (it < T4) { const int q = it - T3, m = q / I_WINO, r = q % I_WINO; transpose_item(a.ret_w_in + (size_t)m * DM * RET_IN, RET_IN, (bf16_t*)(ws + WS_WINO) + (size_t)m * RET_IN * DM, DM, scr, r / 192, r % 192, F.lane, RmId()); continue; }
            if (it < T5) { const int q = it - T4, m = q / I_WOUTO, r = q % I_WOUTO; transpose_item(a.ret_w_out + (size_t)m * 2048 * DM, DM, (bf16_t*)(ws + WS_WOUTO) + (size_t)m * DM * 2048, 2048, scr, r / 32, r % 32, F.lane, RmId()); continue; }
            if (it < T6) { const int q = it - T5, m = q / I_WGU, r = q % I_WGU; transpose_item8(a.moe_w_gu + (size_t)m * DM * 2048, 2048, (unsigned char*)(ws + WS_WGU) + (size_t)m * 2048 * DM, DM, scr, r / 64, r % 64, F.lane, RmGu(), FP8_WSC); continue; }
            { const int q = it - T6, m = q / I_WDN, r = q % I_WDN; transpose_item8(a.moe_w_down + (size_t)m * EFF * DM, DM, (unsigned char*)(ws + WS_WDN) + (size_t)m * DM * EFF, EFF, scr, r / 32, r % 32, F.lane, RmId(), FP8_WSC); }
        }
    }
}

__device__ __forceinline__ void build_pstart(const Frame& F, const unsigned* cnt) {
    LAS int* ps = (LAS int*)(F.lds + LT_PSTART); LAS int* lc = (LAS int*)(F.lds + LT_CNT); LAS int* blk = (LAS int*)(F.lds + LT_BLK);
    __syncthreads();
    if (F.tid < 64) {
        const int e = F.tid & 31; const int c = (int)xb_ld((gbar_t)cnt + e); const int pad = (c + 255) & ~255;
        int incl = pad;
#pragma unroll
        for (int o = 1; o < 32; o <<= 1) { const int t = sh_fromi(incl, (e >= o) ? F.tid - o : F.tid); if (e >= o) incl += t; }
        if (F.tid < 32) { ps[e] = incl - pad; lc[e] = c; if (e == 31) ps[32] = incl; }
    }
    __syncthreads();
    const int nblk = ps[32] >> 8;
    for (int g = F.tid; g < nblk; g += 512) { int e = 0;
#pragma unroll
        for (int s = 16; s >= 1; s >>= 1) if (e + s < 32 && (ps[e + s] >> 8) <= g) e += s;
        blk[2 * g] = e; blk[2 * g + 1] = g - (ps[e] >> 8); }
    __syncthreads();
}

__device__ __forceinline__ void n1_phase(const Args& a, int layer, bool final_only) {
    MK_FRAME(F); ARGAS unsigned char* ws = opaque_ws(a.ws);
    const float* mod = (const float*)(ws + WS_MOD);
    const bool combine = layer > 0;
    const float* xsrc = (layer == 0) ? a.x : a.out;
    const int* toke = (const int*)(ws + WS_TOKE); const int* tokr = toke + NTOK * 4;
    const bf16_t* Y = (const bf16_t*)(ws + WS_Y);
    bf16_t* HM = (bf16_t*)(ws + WS_HM);
    LAS int* ps = (LAS int*)(F.lds + LT_PSTART);
    if (combine) build_pstart(F, (const unsigned*)(ws + WS_CTL) + CW_CNT + 64 * (layer - 1));
    const float* gmix = a.norm_mix_g + (size_t)(final_only ? 0 : layer) * DM;
    for (int tok = F.bid * 8 + F.wave; tok < NTOK; tok += F.G * 8) {
        const int b = tok >> 12;
        f32x4 v[4]; ld_row16(xsrc + (size_t)tok * DM, F.lane, v);
        if (combine) {
            const float* g2 = mod + ((size_t)(layer - 1) * NBATCH + b) * 6144 + 5 * DM;
            f32x4 ysum[4];
#pragma unroll
            for (int j = 0; j < 4; ++j) ysum[j] = (f32x4){0.f, 0.f, 0.f, 0.f};
#pragma unroll
            for (int k = 0; k < 4; ++k) { const int e = toke[tok * 4 + k], r = tokr[tok * 4 + k]; const size_t slot = (size_t)ps[e] + r;
                const bf16_t* yr = Y + slot * DM + 4 * F.lane;
#pragma unroll
                for (int j = 0; j < 4; ++j) { const u32x2 w = *(const u32x2*)(yr + 256 * j); ysum[j][0] += bf_lo(w.x); ysum[j][1] += bf_hi(w.x); ysum[j][2] += bf_lo(w.y); ysum[j][3] += bf_hi(w.y); } }
#pragma unroll
            for (int j = 0; j < 4; ++j) { const f32x4 g = *(const f32x4*)(g2 + 4 * F.lane + 256 * j); v[j] = v[j] + g * ysum[j]; *(f32x4*)(a.out + (size_t)tok * DM + 4 * F.lane + 256 * j) = v[j]; }
        }
        if (final_only) continue;
        float ss = 0.f;
#pragma unroll
        for (int j = 0; j < 4; ++j) ss += v[j][0] * v[j][0] + v[j][1] * v[j][1] + v[j][2] * v[j][2] + v[j][3] * v[j][3];
        const float inv = rsqrtf(wave_sum(ss, F.lane) * (1.f / DM) + EPS);
        const float* sh = mod + ((size_t)layer * NBATCH + b) * 6144; const float* sc = sh + DM;
#pragma unroll
        for (int j = 0; j < 4; ++j) { const int c0 = 4 * F.lane + 256 * j; const f32x4 g = *(const f32x4*)(gmix + c0), s1 = *(const f32x4*)(sc + c0), s0 = *(const f32x4*)(sh + c0);
            const f32x4 h = v[j] * inv * g * (s1 + 1.f) + s0;
            u32x2 o; o.x = cvt_pk_bf16(h[0], h[1]); o.y = cvt_pk_bf16(h[2], h[3]); *(u32x2*)(HM + (size_t)tok * DM + c0) = o; }
    }
}

__device__ __forceinline__ void e2_phase(const Args& a, int j) {
    MK_FRAME(F); ARGAS unsigned char* ws = opaque_ws(a.ws);
    const bf16_t* P = (const bf16_t*)(ws + WS_P);
    bf16_t* QC = (bf16_t*)(ws + X1_QC); bf16_t* KC = (bf16_t*)(ws + X1_KC); bf16_t* QA = (bf16_t*)(ws + X1_QA); bf16_t* KVA = (bf16_t*)(ws + X1_KVA);
    const float* cw = a.ml_conv_w + (size_t)j * 5 * 1024; const float* cb = a.ml_conv_b + (size_t)j * 1024;
    const float* qg = a.mla_q_norm_g + (size_t)j * 256; const float* kvg = a.mla_kv_norm_g + (size_t)j * 128;
    {
        float* ALPHA = (float*)(ws + WS_MISC); float* BETA = ALPHA + 2 * 32 * SEQ; float* MG = BETA + 2 * 32 * SEQ;
        LAS float* redm = (LAS float*)(F.lds);
        for (int u = F.bid; u < 64; u += F.G) {
            const int dir = u >> 5, bh = u & 31, b = bh >> 2, h = bh & 3;
            const float bi = a.ml_gate_b[j * 16 + (2 * dir) * 4 + h], bfg = a.ml_gate_b[j * 16 + (2 * dir + 1) * 4 + h];
            float li[8], lf[8];
#pragma unroll
            for (int i = 0; i < 8; ++i) { const size_t row = (size_t)b * SEQ + 8 * F.tid + i;
                li[i] = bf2f(P[row * EVEN_INP + PC_GT + (2 * dir) * 4 + h]) + bi;
                const float xf = bf2f(P[row * EVEN_INP + PC_GT + (2 * dir + 1) * 4 + h]) + bfg;
                lf[i] = fminf(xf, 0.f) - log1pf(__expf(-fabsf(xf))); }
            float mx = li[0];
#pragma unroll
            for (int i = 1; i < 8; ++i) mx = fmaxf(mx, li[i]);
            mx = wave_max(mx, F.lane); if (F.lane == 0) redm[F.wave] = mx;
            __syncthreads();
            float M = redm[0];
#pragma unroll
            for (int w = 1; w < 8; ++w) M = fmaxf(M, redm[w]);
            float al[8];
            if (dir == 0) { float s = 0.f;
#pragma unroll
                for (int i = 0; i < 8; ++i) { s += lf[i]; al[i] = s; }
                float tot = s, ex = 0.f;
#pragma unroll
                for (int o = 1; o < 16; o <<= 1) { const float t = sh_from(tot, ((F.lane & 15) >= o) ? F.lane - o : F.lane, F.lane); if ((F.lane & 15) >= o) tot += t; }
                ex = tot - s;
#pragma unroll
                for (int i = 0; i < 8; ++i) al[i] += ex;
            } else { float s = 0.f;
#pragma unroll
                for (int i = 7; i >= 0; --i) { s += lf[i]; al[i] = s; }
                float tot = s, ex = 0.f;
#pragma unroll
                for (int o = 1; o < 16; o <<= 1) { const float t = sh_from(tot, ((F.lane & 15) + o < 16) ? F.lane + o : F.lane, F.lane); if ((F.lane & 15) + o < 16) tot += t; }
                ex = tot - s;
#pragma unroll
                for (int i = 0; i < 8; ++i) al[i] += ex;
            }
            float* ao = ALPHA + ((size_t)dir * 32 + bh) * SEQ + 8 * F.tid; float* bo = BETA + ((size_t)dir * 32 + bh) * SEQ + 8 * F.tid;
            *(f32x4*)(ao) = (f32x4){al[0], al[1], al[2], al[3]}; *(f32x4*)(ao + 4) = (f32x4){al[4], al[5], al[6], al[7]};
            *(f32x4*)(bo) = (f32x4){li[0] - M, li[1] - M, li[2] - M, li[3] - M}; *(f32x4*)(bo + 4) = (f32x4){li[4] - M, li[5] - M, li[6] - M, li[7] - M};
            if (F.tid == 0) MG[dir * 32 + bh] = M;
            __syncthreads();
        }
    }
    for (int tok = F.bid * 8 + F.wave; tok < NTOK; tok += F.G * 8) {
        const int s = tok & (SEQ - 1);
        float aq[8], ak[8];
        { const f32x4 b0 = *(const f32x4*)(cb + 8 * F.lane), b1 = *(const f32x4*)(cb + 8 * F.lane + 4), b2 = *(const f32x4*)(cb + 512 + 8 * F.lane), b3 = *(const f32x4*)(cb + 512 + 8 * F.lane + 4);
#pragma unroll
          for (int i = 0; i < 4; ++i) { aq[i] = b0[i]; aq[4 + i] = b1[i]; ak[i] = b2[i]; ak[4 + i] = b3[i]; } }
#pragma unroll
        for (int t = 0; t < 5; ++t) { const int s2 = s + t - 2;
            if (s2 >= 0 && s2 < SEQ) { const bf16_t* pr = P + (size_t)(tok + t - 2) * EVEN_INP;
                const u32x4 q = *(const u32x4*)(pr + PC_QM + 8 * F.lane), k = *(const u32x4*)(pr + PC_KM + 8 * F.lane);
                const float* wq = cw + t * 1024 + 8 * F.lane; const float* wk = wq + 512;
                const f32x4 wq0 = *(const f32x4*)wq, wq1 = *(const f32x4*)(wq + 4), wk0 = *(const f32x4*)wk, wk1 = *(const f32x4*)(wk + 4);
                aq[0] += bf_lo(q.x) * wq0[0]; aq[1] += bf_hi(q.x) * wq0[1]; aq[2] += bf_lo(q.y) * wq0[2]; aq[3] += bf_hi(q.y) * wq0[3];
                aq[4] += bf_lo(q.z) * wq1[0]; aq[5] += bf_hi(q.z) * wq1[1]; aq[6] += bf_lo(q.w) * wq1[2]; aq[7] += bf_hi(q.w) * wq1[3];
                ak[0] += bf_lo(k.x) * wk0[0]; ak[1] += bf_hi(k.x) * wk0[1]; ak[2] += bf_lo(k.y) * wk0[2]; ak[3] += bf_hi(k.y) * wk0[3];
                ak[4] += bf_lo(k.z) * wk1[0]; ak[5] += bf_hi(k.z) * wk1[1]; ak[6] += bf_lo(k.w) * wk1[2]; ak[7] += bf_hi(k.w) * wk1[3]; } }
        constexpr float KS = 0.08838834764831845f;
#pragma unroll
        for (int i = 0; i < 8; ++i) { aq[i] = siluf_(aq[i]); ak[i] = siluf_(ak[i]) * KS; }
        u32x4 oq, ok; oq.x = cvt_pk_bf16(aq[0], aq[1]); oq.y = cvt_pk_bf16(aq[2], aq[3]); oq.z = cvt_pk_bf16(aq[4], aq[5]); oq.w = cvt_pk_bf16(aq[6], aq[7]);
        ok.x = cvt_pk_bf16(ak[0], ak[1]); ok.y = cvt_pk_bf16(ak[2], ak[3]); ok.z = cvt_pk_bf16(ak[4], ak[5]); ok.w = cvt_pk_bf16(ak[6], ak[7]);
        *(u32x4*)(QC + (size_t)tok * 512 + 8 * F.lane) = oq; *(u32x4*)(KC + (size_t)tok * 512 + 8 * F.lane) = ok;
        const bf16_t* pr = P + (size_t)tok * EVEN_INP;
        { const u32x2 w = *(const u32x2*)(pr + PC_QA + 4 * F.lane); const float x0 = bf_lo(w.x), x1 = bf_hi(w.x), x2 = bf_lo(w.y), x3 = bf_hi(w.y);
          const float inv = rsqrtf(wave_sum(x0 * x0 + x1 * x1 + x2 * x2 + x3 * x3, F.lane) * (1.f / 256.f) + EPS); const f32x4 g = *(const f32x4*)(qg + 4 * F.lane);
          u32x2 o; o.x = cvt_pk_bf16(x0 * inv * g[0], x1 * inv * g[1]); o.y = cvt_pk_bf16(x2 * inv * g[2], x3 * inv * g[3]); *(u32x2*)(QA + (size_t)tok * 256 + 4 * F.lane) = o; }
        { const unsigned w = *(const unsigned*)(pr + PC_KVA + 2 * F.lane); const float x0 = bf_lo(w), x1 = bf_hi(w);
          const float inv = rsqrtf(wave_sum(x0 * x0 + x1 * x1, F.lane) * (1.f / 128.f) + EPS); const f32x2 g = *(const f32x2*)(kvg + 2 * F.lane);
          *(unsigned*)(KVA + (size_t)tok * 256 + 2 * F.lane) = cvt_pk_bf16(x0 * inv * g[0], x1 * inv * g[1]); *(unsigned*)(KVA + (size_t)tok * 256 + 128 + 2 * F.lane) = 0u; }
    }
}

__device__ __forceinline__ void e4_phase(const Args& a, int j) {
    MK_FRAME(F); ARGAS unsigned char* ws = opaque_ws(a.ws);
    const bf16_t* P = (const bf16_t*)(ws + WS_P); const bf16_t* QRAW = (const bf16_t*)(ws + X1_QRAW); const bf16_t* KVRAW = (const bf16_t*)(ws + X1_KVRAW);
    bf16_t* QH = (bf16_t*)(ws + X1_QH); bf16_t* KH = (bf16_t*)(ws + X1_KH); bf16_t* VH = (bf16_t*)(ws + X1_VH);
    const f32x2* re = (const f32x2*)(ws + WS_ROPEE);
    const float* gq = a.mla_qk_q_g + (size_t)j * 96; const float* gk = a.mla_qk_k_g + (size_t)j * 96;
    const int h = F.lane >> 3, part = F.lane & 7;
    for (int tok = F.bid * 8 + F.wave; tok < NTOK; tok += F.G * 8) {
        const int b = tok >> 12, s = tok & (SEQ - 1);
        const f32x4 cs = *(const f32x4*)(re + (size_t)tok * 16 + 2 * part);
        const size_t hrow = ((size_t)(b * 8 + h)) * SEQ + s;
#pragma unroll
        for (int qk = 0; qk < 2; ++qk) {
            float v[12]; u32x4 w; unsigned w1, w2;
            if (qk == 0) { const bf16_t* src = QRAW + (size_t)tok * 768 + h * 96; w = *(const u32x4*)(src + 8 * part); w1 = *(const unsigned*)(src + 64 + 2 * part); w2 = *(const unsigned*)(src + 80 + 2 * part); }
            else { w = *(const u32x4*)(KVRAW + (size_t)tok * 1024 + h * 128 + 8 * part); const bf16_t* kr = P + (size_t)tok * EVEN_INP + PC_KR; w1 = *(const unsigned*)(kr + 2 * part); w2 = *(const unsigned*)(kr + 16 + 2 * part); }
            v[0] = bf_lo(w.x); v[1] = bf_hi(w.x); v[2] = bf_lo(w.y); v[3] = bf_hi(w.y); v[4] = bf_lo(w.z); v[5] = bf_hi(w.z); v[6] = bf_lo(w.w); v[7] = bf_hi(w.w);
            v[8] = bf_lo(w1); v[9] = bf_hi(w1); v[10] = bf_lo(w2); v[11] = bf_hi(w2);
            float ss = 0.f;
#pragma unroll
            for (int i = 0; i < 12; ++i) ss += v[i] * v[i];
            ss += shx(ss, 1, F.lane); ss += shx(ss, 2, F.lane); ss += shx(ss, 4, F.lane);
            const float inv = rsqrtf(ss * (1.f / 96.f) + EPS);
            const float* g = qk == 0 ? gq : gk;
            const f32x4 g0 = *(const f32x4*)(g + 8 * part), g1 = *(const f32x4*)(g + 8 * part + 4); const f32x2 ga = *(const f32x2*)(g + 64 + 2 * part), gb = *(const f32x2*)(g + 80 + 2 * part);
            v[0] *= inv * g0[0]; v[1] *= inv * g0[1]; v[2] *= inv * g0[2]; v[3] *= inv * g0[3]; v[4] *= inv * g1[0]; v[5] *= inv * g1[1]; v[6] *= inv * g1[2]; v[7] *= inv * g1[3];
            const float x10 = v[8] * inv * ga[0], x11 = v[9] * inv * ga[1], x20 = v[10] * inv * gb[0], x21 = v[11] * inv * gb[1];
            const float o10 = x10 * cs[0] - x20 * cs[1], o20 = x20 * cs[0] + x10 * cs[1], o11 = x11 * cs[2] - x21 * cs[3], o21 = x21 * cs[2] + x11 * cs[3];
            u32x4 o; o.x = cvt_pk_bf16(v[0], v[1]); o.y = cvt_pk_bf16(v[2], v[3]); o.z = cvt_pk_bf16(v[4], v[5]); o.w = cvt_pk_bf16(v[6], v[7]);
            bf16_t* dst = qk == 0 ? QH + hrow * 96 : KH + hrow * 128;
            *(u32x4*)(dst + 8 * part) = o; *(unsigned*)(dst + 64 + 2 * part) = cvt_pk_bf16(o10, o11); *(unsigned*)(dst + 80 + 2 * part) = cvt_pk_bf16(o20, o21);
            if (qk == 1) { *(u32x2*)(dst + 96 + 4 * part) = (u32x2){0u, 0u}; }
        }
        *(u32x4*)(VH + hrow * 64 + 8 * part) = *(const u32x4*)(KVRAW + (size_t)tok * 1024 + h * 128 + 64 + 8 * part);
    }
}
__device__ __forceinline__ void n2_phase(const Args& a, int layer) {
    MK_FRAME(F); ARGAS unsigned char* ws = opaque_ws(a.ws);
    const float* mod = (const float*)(ws + WS_MOD);
    unsigned char* HF8 = (unsigned char*)(ws + WS_HM);
    int* LIST = (int*)(ws + WS_LIST); float* WLIST = (float*)(ws + WS_WLIST); int* toke = (int*)(ws + WS_TOKE); int* tokr = toke + NTOK * 4;
    unsigned* gcnt = (unsigned*)(ws + WS_CTL) + CW_CNT + 64 * layer;
    LAS float* rwT = (LAS float*)(F.lds);
    LAS int* te = (LAS int*)(F.lds + LT_X); LAS int* tlr = te + 512; LAS float* tw = (LAS float*)(tlr + 512); LAS int* hist = (LAS int*)(tw + 512); LAS int* base = hist + 32;
    const float* rw = a.moe_router_w + (size_t)layer * DM * NEXP; const float* rbias = a.moe_router_b + (size_t)layer * NEXP;
    const float* gffn = a.norm_ffn_g + (size_t)layer * DM;
    __syncthreads();
    for (int i4 = F.tid; i4 < DM * NEXP / 4; i4 += 512) { const f32x4 v = *(const f32x4*)(rw + 4 * i4); const int k = i4 >> 3, e0 = (i4 & 7) * 4;
        rwT[(e0 + 0) * DM + k] = v[0]; rwT[(e0 + 1) * DM + k] = v[1]; rwT[(e0 + 2) * DM + k] = v[2]; rwT[(e0 + 3) * DM + k] = v[3]; }
    if (F.tid < 32) hist[F.tid] = 0;
    __syncthreads();
    const int myexp = F.lane; const float mybias = F.lane < 32 ? rbias[F.lane] : 0.f;
#pragma unroll 1
    for (int grp = F.bid; grp < NTOK / 128; grp += F.G) {
#pragma unroll 1
        for (int q = 0; q < 8; ++q) {
            const int ti0 = F.wave * 16 + q * 2;
            const int tok0 = grp * 128 + ti0; const int b = tok0 >> 12;
            const float* sh = mod + ((size_t)layer * NBATCH + b) * 6144 + 3 * DM; const float* sc = sh + DM;
            f32x4 hf[2][4];
#pragma unroll
            for (int t = 0; t < 2; ++t) {
                f32x4 v[4]; ld_row16(a.out + (size_t)(tok0 + t) * DM, F.lane, v);
                float ss = 0.f;
#pragma unroll
                for (int j = 0; j < 4; ++j) ss += v[j][0] * v[j][0] + v[j][1] * v[j][1] + v[j][2] * v[j][2] + v[j][3] * v[j][3];
                const float inv = rsqrtf(wave_sum(ss, F.lane) * (1.f / DM) + EPS);
#pragma unroll
                for (int j = 0; j < 4; ++j) { const int c0 = 4 * F.lane + 256 * j; const f32x4 g = *(const f32x4*)(gffn + c0), s1 = *(const f32x4*)(sc + c0), s0 = *(const f32x4*)(sh + c0);
                    const f32x4 h = v[j] * inv * g * (s1 + 1.f) + s0; hf[t][j] = h;
                    *(unsigned*)(HF8 + (size_t)(tok0 + t) * DM + c0) = pg8::pk4_fp8(h[0] * FP8_HSC, h[1] * FP8_HSC, h[2] * FP8_HSC, h[3] * FP8_HSC); }
            }
            float lg0 = -3.0e38f, lg1 = -3.0e38f;
#pragma unroll 1
            for (int e = 0; e < 32; ++e) {
                float d0 = 0.f, d1 = 0.f;
#pragma unroll
                for (int j = 0; j < 4; ++j) { const f32x4 wv = *(const LAS f32x4*)(rwT + e * DM + 4 * F.lane + 256 * j);
                    d0 += hf[0][j][0] * wv[0] + hf[0][j][1] * wv[1] + hf[0][j][2] * wv[2] + hf[0][j][3] * wv[3];
                    d1 += hf[1][j][0] * wv[0] + hf[1][j][1] * wv[1] + hf[1][j][2] * wv[2] + hf[1][j][3] * wv[3]; }
                d0 = wave_sum(d0, F.lane); d1 = wave_sum(d1, F.lane);
                if (F.lane == e) { lg0 = d0; lg1 = d1; }
            }
#pragma unroll
            for (int t = 0; t < 2; ++t) {
                float logit = (t == 0 ? lg0 : lg1) + mybias;
                float tv[4]; int tix[4];
#pragma unroll
                for (int k = 0; k < 4; ++k) { float v = logit; int ix = myexp;
#pragma unroll
                    for (int m = 1; m < 64; m <<= 1) { const float ov = shx(v, m, F.lane); const int oi = shxi(ix, m, F.lane); if (ov > v || (ov == v && oi < ix)) { v = ov; ix = oi; } }
                    tv[k] = v; tix[k] = ix; if (myexp == ix) logit = -3.0e38f; }
                const float e1 = __expf(tv[1] - tv[0]), e2 = __expf(tv[2] - tv[0]), e3 = __expf(tv[3] - tv[0]); const float rs = 1.f / (1.f + e1 + e2 + e3);
                if (F.lane < 4) { const int ex = F.lane == 0 ? tix[0] : F.lane == 1 ? tix[1] : F.lane == 2 ? tix[2] : tix[3];
                    const float wk = (F.lane == 0 ? 1.f : F.lane == 1 ? e1 : F.lane == 2 ? e2 : e3) * rs;
                    const int lr = __hip_atomic_fetch_add(hist + ex, 1, __ATOMIC_RELAXED, __HIP_MEMORY_SCOPE_WORKGROUP);
                    const int pidx = (ti0 + t) * 4 + F.lane; te[pidx] = ex; tlr[pidx] = lr; tw[pidx] = wk; }
            }
        }
        __syncthreads();
        if (F.tid < 32) { const int h = hist[F.tid]; base[F.tid] = h > 0 ? (int)xb_add((gbar_t)gcnt + F.tid, (unsigned)h) : 0; }
        __syncthreads();
        { const int p = F.tid; const int e = te[p], rank = base[e] + tlr[p]; const int tok = grp * 128 + (p >> 2);
          LIST[(size_t)e * NSLOT + rank] = tok; WLIST[(size_t)e * NSLOT + rank] = tw[p]; toke[tok * 4 + (p & 3)] = e; tokr[tok * 4 + (p & 3)] = rank; }
        __syncthreads();
        if (F.tid < 32) hist[F.tid] = 0;
        __syncthreads();
    }
}

__device__ __forceinline__ void m1_phase(const Args& a, int layer) {
    MK_FRAME(F); ARGAS unsigned char* ws = opaque_ws(a.ws);
    build_pstart(F, (const unsigned*)(ws + WS_CTL) + CW_CNT + 64 * layer);
    LAS int* ps = (LAS int*)(F.lds + LT_PSTART); LAS int* lc = (LAS int*)(F.lds + LT_CNT); LAS int* blk = (LAS int*)(F.lds + LT_BLK);
    const unsigned char* HF8 = (const unsigned char*)(ws + WS_HM); unsigned char* AS = (unsigned char*)(ws + WS_ASORT); float* WS_ = (float*)(ws + WS_WSORT);
    const int* LIST = (const int*)(ws + WS_LIST); const float* WLIST = (const float*)(ws + WS_WLIST);
    const int total = ps[32];
    for (int r = F.bid * 8 + F.wave; r < total; r += F.G * 8) {
        const int g = r >> 8, e = blk[2 * g], rank = blk[2 * g + 1] * 256 + (r & 255); const bool valid = rank < lc[e];
        u32x4 v0 = (u32x4){0u, 0u, 0u, 0u}; float w = 0.f;
        if (valid) { const int tok = LIST[(size_t)e * NSLOT + rank]; w = WLIST[(size_t)e * NSLOT + rank];
            v0 = *(const u32x4*)(HF8 + (size_t)tok * DM + 16 * F.lane); }
        *(u32x4*)(AS + (size_t)r * DM + 16 * F.lane) = v0;
        if (F.lane == 0) WS_[r] = w;
    }
}

struct MoeSched {
    const LAS int* blk; const char* A; const char* W; size_t wstride, tile_bytes; int ntile, nunits, G, c;
    __device__ __forceinline__ bool next(int i, pg8::Unit& u) const {
        const long L = (long)i * G + c; if (L >= nunits) return false;
        const int g = (int)L / ntile, pn = (int)L % ntile, e = __builtin_amdgcn_readfirstlane(blk[2 * g]);
        u.pm = g; u.pn = pn; u.aux = e; u.A = A + (size_t)g * tile_bytes; u.B = W + (size_t)e * wstride + (size_t)pn * tile_bytes; return true;
    }
};
struct MlaSched {
    const char* QA; const char* KVA; const char* Wq; const char* Wkv; int G, c;
    __device__ __forceinline__ bool next(int i, pg8::Unit& u) const {
        const long L = (long)i * G + c; if (L >= 128 * 7) return false;
        const int pm = (int)L / 7, t = (int)L % 7;
        u.pm = pm; if (t < 3) { u.pn = t; u.aux = 0; u.A = QA + (size_t)pm * 256 * 256 * 2; u.B = Wq + (size_t)t * 256 * 256 * 2; }
        else { u.pn = t - 3; u.aux = 1; u.A = KVA + (size_t)pm * 256 * 256 * 2; u.B = Wkv + (size_t)(t - 3) * 256 * 256 * 2; }
        return true;
    }
};

constexpr int NPHASE = 50;
#define IN(k) (lo <= (k) && (k) < hi)
#ifndef PROBE_MASK
#define PROBE_MASK 0
#endif
#define REP(k) for (int rep_ = 0; rep_ < ((PROBE_MASK >> (k)) & 1) + 1; ++rep_)
#define GRID_BAR() do { if (fused) { xcd_barrier((gbar_t)(fresh_args().ws + WS_CTL) + CW_BAR, (volatile LAS unsigned*)((LAS unsigned char*)lds_raw + LT_MISC) + 8); } } while (0)
template <int LAYER>
__device__ __forceinline__ void layer_body(const int lo, const int hi, const bool fused) {
    constexpr int layer = LAYER;
        constexpr int pb = 1 + 12 * layer; constexpr bool odd = (layer & 1) != 0; constexpr int j = layer >> 1;
        if (IN(pb + 0)) { n1_phase(fresh_args(), layer, false); GRID_BAR(); }
        REP(1) if (IN(pb + 1)) {
            const Args& a = fresh_args(); MK_FRAME(F); ARGAS unsigned char* ws = opaque_ws(a.ws);
            pg8::StaticSched S; S.A = (const char*)(ws + WS_HM); S.lda = DM; S.ldb = DM; S.nM = NTOK / 256; S.G = F.G; S.c = F.bid;
            pg8::EpiBf16 E; E.O0 = (bf16_t*)(ws + WS_P); E.O1 = E.O0; E.rope = (const GAS f32x2*)(ws + WS_ROPEO); E.qscale = 0.0625f;
            if (!odd) { S.Bt = (const char*)(ws + WS_WINE) + (size_t)j * EVEN_INP * DM * 2; S.nN = EVEN_INP / 256; E.ldc0 = E.ldc1 = EVEN_INP; E.rope_tiles = 0; E.qscale_tiles = 0; }
            else { S.Bt = (const char*)(ws + WS_WINO) + (size_t)j * RET_IN * DM * 2; S.nN = RET_IN / 256; E.ldc0 = E.ldc1 = RET_IN; E.rope_tiles = 8; E.qscale_tiles = 4; }
            pg8::gemm_phase<pg8::EpiBf16, pg8::StaticSched>(F.lds + LDS_RING, pg8::Dims{DM, DM, DM}, S, E);
            GRID_BAR();
        }
        if constexpr (!odd) {
            REP(2) if (IN(pb + 2)) { e2_phase(fresh_args(), j); GRID_BAR(); }
            REP(3) if (IN(pb + 3)) {
                const Args& a = fresh_args(); MK_FRAME(F); ARGAS unsigned char* ws = opaque_ws(a.ws);
                MlaSched S; S.QA = (const char*)(ws + X1_QA); S.KVA = (const char*)(ws + X1_KVA); S.Wq = (const char*)(ws + WS_WQB) + (size_t)j * 768 * 256 * 2; S.Wkv = (const char*)(ws + WS_WKVB) + (size_t)j * 1024 * 256 * 2; S.G = F.G; S.c = F.bid;
                pg8::EpiBf16 E; E.O0 = (bf16_t*)(ws + X1_QRAW); E.O1 = (bf16_t*)(ws + X1_KVRAW); E.ldc0 = 768; E.ldc1 = 1024; E.rope_tiles = 0; E.qscale_tiles = 0; E.qscale = 1.f; E.rope = nullptr;
                pg8::gemm_phase<pg8::EpiBf16, MlaSched>(F.lds + LDS_RING, pg8::Dims{256, 256, 256}, S, E);
                GRID_BAR();
            }
            REP(4) if (IN(pb + 4)) { e4_phase(fresh_args(), j); GRID_BAR(); }
            REP(5) if (IN(pb + 5)) {
                const Args& a = fresh_args(); MK_FRAME(F); ARGAS unsigned char* ws = opaque_ws(a.ws);
                const float* ALPHA = (const float*)(ws + WS_MISC); const float* BETA = ALPHA + 2 * 32 * SEQ;
                for (int u = F.bid; u < 128; u += F.G) {
                    const int bh = u >> 2, dir = (u >> 1) & 1, dvb = u & 1, b = bh >> 2, h = bh & 3;
                    la::StateArgs sa; sa.K = (const bf16_t*)(ws + X1_KC) + (size_t)b * SEQ * 512 + h * 128; sa.ldk = 512;
                    sa.V = (const bf16_t*)(ws + WS_P) + (size_t)b * SEQ * EVEN_INP + PC_VM + h * 128 + dvb * 64; sa.ldv = EVEN_INP;
                    sa.Cout = (bf16_t*)(ws + X1_CM) + ((size_t)(bh * 2 + dir) * 32) * 128 * 128 + dvb * 64; sa.ldc = 128; sa.cstride = 128 * 128;
                    sa.Nout = dvb == 0 ? (float*)(ws + X1_NM) + ((size_t)(bh * 2 + dir) * 32) * 128 : nullptr;
                    sa.alpha = ALPHA + ((size_t)dir * 32 + bh) * SEQ; sa.beta = BETA + ((size_t)dir * 32 + bh) * SEQ; sa.lgam = 0.f; sa.dir = dir;
                    la::state_unit<128, 64, true>(F.lds + LDS_RING, sa);
                }
                __syncthreads();
                unsigned* qh = (unsigned*)(ws + WS_CTL) + CW_QUEUE + 64 * j + 128 * rep_; LAS unsigned* qslot = (LAS unsigned*)(F.lds + LT_MISC) + 16;
                for (;;) {
                    if (F.tid == 0) *qslot = xb_add((gbar_t)qh, 1u);
                    __syncthreads();
                    const unsigned u = *qslot;
                    __syncthreads();
                    if (u >= 1024u) break;
                    const int bh = u >> 4, qb = u & 15, b = bh >> 3, h = bh & 7;
                    att::attn_body((const bf16_t*)(ws + X1_QH) + ((size_t)bh * SEQ + qb * 256) * 96, (const bf16_t*)(ws + X1_KH) + (size_t)bh * SEQ * 128, (const bf16_t*)(ws + X1_VH) + (size_t)bh * SEQ * 64,
                                   (bf16_t*)(ws + WS_MIX) + ((size_t)b * SEQ + qb * 256) * DM + 512 + h * 64, DM, SEQ, (LAS char*)(F.lds + LDS_RING));
                }
                GRID_BAR();
            }
            REP(6) if (IN(pb + 6)) {
                const Args& a = fresh_args(); MK_FRAME(F); ARGAS unsigned char* ws = opaque_ws(a.ws);
                const float* ALPHA = (const float*)(ws + WS_MISC); const float* BETA = ALPHA + 2 * 32 * SEQ; const float* MG = BETA + 2 * 32 * SEQ;
                for (int u = F.bid; u < 1024; u += F.G) {
                    const int bh = u >> 5, c = u & 31, b = bh >> 2, h = bh & 3; const size_t t0 = (size_t)b * SEQ + c * 128;
                    la::OutArgs oa; oa.Q = (const bf16_t*)(ws + X1_QC) + t0 * 512 + h * 128; oa.ldq = 512; oa.K = (const bf16_t*)(ws + X1_KC) + t0 * 512 + h * 128; oa.ldk = 512;
                    oa.V = (const bf16_t*)(ws + WS_P) + t0 * EVEN_INP + PC_VM + h * 128; oa.ldv = EVEN_INP;
                    oa.Cf = (const bf16_t*)(ws + X1_CM) + ((size_t)(bh * 2 + 0) * 32 + c) * 128 * 128; oa.Cb = (const bf16_t*)(ws + X1_CM) + ((size_t)(bh * 2 + 1) * 32 + c) * 128 * 128;
                    oa.Nf = (const float*)(ws + X1_NM) + ((size_t)(bh * 2 + 0) * 32 + c) * 128; oa.Nb = (const float*)(ws + X1_NM) + ((size_t)(bh * 2 + 1) * 32 + c) * 128;
                    oa.af = ALPHA + ((size_t)0 * 32 + bh) * SEQ + c * 128; oa.bfw = BETA + ((size_t)0 * 32 + bh) * SEQ + c * 128; oa.ab = ALPHA + ((size_t)1 * 32 + bh) * SEQ + c * 128; oa.bbw = BETA + ((size_t)1 * 32 + bh) * SEQ + c * 128;
                    oa.Mf = MG[bh]; oa.Mb = MG[32 + bh]; oa.lgf = 0.f; oa.lgb = 0.f;
                    oa.gain = a.ml_norm_g + (size_t)j * 512 + h * 128; oa.G = (const bf16_t*)(ws + WS_P) + t0 * EVEN_INP + PC_OM + h * 128; oa.ldg = EVEN_INP;
                    oa.Out = (bf16_t*)(ws + WS_MIX) + t0 * DM + h * 128; oa.ldo = DM;
                    la::out_unit<128, 128, true>(F.lds + LDS_RING, F.lds + LT_X, oa);
                }
                GRID_BAR();
            }
        } else {
            REP(2) if (IN(pb + 2)) {
                const Args& a = fresh_args(); MK_FRAME(F); ARGAS unsigned char* ws = opaque_ws(a.ws);
                for (int u = F.bid; u < 256; u += F.G) {
                    const int bh = u >> 3, dir = (u >> 2) & 1, dvb = u & 3, b = bh >> 2, h = bh & 3;
                    const float dl = (dir ? a.ret_decay_b : a.ret_decay_f)[j * 4 + h];
                    la::StateArgs sa; sa.K = (const bf16_t*)(ws + WS_P) + (size_t)b * SEQ * RET_IN + 1024 + h * 256; sa.ldk = RET_IN;
                    sa.V = (const bf16_t*)(ws + WS_P) + (size_t)b * SEQ * RET_IN + 2048 + h * 512 + dvb * 128; sa.ldv = RET_IN;
                    sa.Cout = (bf16_t*)(ws + WS_X1) + ((size_t)(bh * 2 + dir) * 32) * 256 * 512 + dvb * 128; sa.ldc = 512; sa.cstride = 256 * 512; sa.Nout = nullptr;
                    sa.alpha = nullptr; sa.beta = nullptr; sa.lgam = fminf(dl, 0.f) - log1pf(__expf(-fabsf(dl))); sa.dir = dir;
                    la::state_unit<256, 128, false>(F.lds + LDS_RING, sa);
                }
                GRID_BAR();
            }
            REP(3) if (IN(pb + 3)) {
                const Args& a = fresh_args(); MK_FRAME(F); ARGAS unsigned char* ws = opaque_ws(a.ws);
                for (int u = F.bid; u < 1024; u += F.G) {
                    const int bh = u >> 5, c = u & 31, b = bh >> 2, h = bh & 3; const size_t t0 = (size_t)b * SEQ + c * 128;
                    const bf16_t* R = (const bf16_t*)(ws + WS_P) + t0 * RET_IN;
                    const float dlf = a.ret_decay_f[j * 4 + h], dlb = a.ret_decay_b[j * 4 + h];
                    la::OutArgs oa; oa.Q = R + h * 256; oa.ldq = RET_IN; oa.K = R + 1024 + h * 256; oa.ldk = RET_IN; oa.V = R + 2048 + h * 512; oa.ldv = RET_IN;
                    oa.Cf = (const bf16_t*)(ws + WS_X1) + ((size_t)(bh * 2 + 0) * 32 + c) * 256 * 512; oa.Cb = (const bf16_t*)(ws + WS_X1) + ((size_t)(bh * 2 + 1) * 32 + c) * 256 * 512;
                    oa.Nf = nullptr; oa.Nb = nullptr; oa.af = oa.bfw = oa.ab = oa.bbw = nullptr; oa.Mf = 0.f; oa.Mb = 0.f;
                    oa.lgf = fminf(dlf, 0.f) - log1pf(__expf(-fabsf(dlf))); oa.lgb = fminf(dlb, 0.f) - log1pf(__expf(-fabsf(dlb)));
                    oa.gain = a.ret_gn_g + (size_t)j * 2048 + h * 512; oa.G = R + 4096 + h * 512; oa.ldg = RET_IN;
                    oa.Out = (bf16_t*)(ws + WS_MIX) + t0 * 2048 + h * 512; oa.ldo = 2048;
                    la::out_unit<256, 512, false>(F.lds + LDS_RING, F.lds + LT_X, oa);
                }
                GRID_BAR();
            }
        }
        if (IN(pb + 7)) {
            const Args& a = fresh_args(); MK_FRAME(F); ARGAS unsigned char* ws = opaque_ws(a.ws);
            pg8::StaticSched S; S.A = (const char*)(ws + WS_MIX); S.nM = NTOK / 256; S.nN = DM / 256; S.G = F.G; S.c = F.bid;
            int K;
            if (!odd) { S.Bt = (const char*)(ws + WS_WOUTE) + (size_t)j * DM * DM * 2; K = DM; } else { S.Bt = (const char*)(ws + WS_WOUTO) + (size_t)j * DM * 2048 * 2; K = 2048; }
            S.lda = K; S.ldb = K;
            pg8::EpiResid E; E.base = (layer == 0) ? a.x : a.out; E.out = a.out; E.gate = (const float*)(ws + WS_MOD) + (size_t)layer * NBATCH * 6144 + 2 * DM; E.gstride = 6144;
            pg8::gemm_phase<pg8::EpiResid, pg8::StaticSched>(F.lds + LDS_RING, pg8::Dims{K, K, K}, S, E);
            GRID_BAR();
        }
        if (IN(pb + 8)) { n2_phase(fresh_args(), layer); GRID_BAR(); }
        REP(9) if (IN(pb + 9)) { m1_phase(fresh_args(), layer); GRID_BAR(); }
        REP(10) if (IN(pb + 10)) {
            const Args& a = fresh_args(); MK_FRAME(F); ARGAS unsigned char* ws = opaque_ws(a.ws);
            build_pstart(F, (const unsigned*)(ws + WS_CTL) + CW_CNT + 64 * layer);
            const int nblk = ((LAS int*)(F.lds + LT_PSTART))[32] >> 8;
            MoeSched S; S.blk = (const LAS int*)(F.lds + LT_BLK); S.A = (const char*)(ws + WS_ASORT); S.W = (const char*)(ws + WS_WGU) + (size_t)layer * NEXP * 2048 * DM; S.wstride = (size_t)2048 * DM; S.tile_bytes = (size_t)256 * DM;
            S.ntile = 8; S.nunits = nblk * 8; S.G = F.G; S.c = F.bid;
            pg8::EpiSwiglu E; E.act = (unsigned char*)(ws + WS_ACT); E.bgu = a.moe_b_gu + (size_t)layer * NEXP * 2048; E.ascale = 1.f / (FP8_HSC * FP8_WSC);
            pg8::gemm_phase<pg8::EpiSwiglu, MoeSched, true, true, true>(F.lds + LDS_RING, pg8::Dims{DM / 2, DM / 2, DM / 2}, S, E);
            GRID_BAR();
        }
        REP(11) if (IN(pb + 11)) {
            const Args& a = fresh_args(); MK_FRAME(F); ARGAS unsigned char* ws = opaque_ws(a.ws);
            build_pstart(F, (const unsigned*)(ws + WS_CTL) + CW_CNT + 64 * layer);
            const int nblk = ((LAS int*)(F.lds + LT_PSTART))[32] >> 8;
            MoeSched S; S.blk = (const LAS int*)(F.lds + LT_BLK); S.A = (const char*)(ws + WS_ACT); S.W = (const char*)(ws + WS_WDN) + (size_t)layer * NEXP * DM * EFF; S.wstride = (size_t)DM * EFF; S.tile_bytes = (size_t)256 * EFF;
            S.ntile = 4; S.nunits = nblk * 4; S.G = F.G; S.c = F.bid;
            pg8::EpiDown E; E.y = (bf16_t*)(ws + WS_Y); E.bd = a.moe_b_down + (size_t)layer * NEXP * DM; E.wrow = (const float*)(ws + WS_WSORT); E.ascale = 1.f / (FP8_ASC * FP8_WSC);
            pg8::gemm_phase<pg8::EpiDown, MoeSched, true, true, true>(F.lds + LDS_RING, pg8::Dims{EFF / 2, EFF / 2, EFF / 2}, S, E);
            GRID_BAR();
        }
    }
__global__ void __launch_bounds__(512, 2) fwd_kernel(Args a_kernarg) {
    const Args& a0 = fresh_args();
    LAS unsigned char* lds0 = (LAS unsigned char*)lds_raw;
    for (int u = threadIdx.x; u < 64; u += 512) ((LAS unsigned*)(lds0 + LT_MISC))[u] = 0u;
    __syncthreads();
    const int lo = a0.ph_lo, hi = a0.ph_hi; const bool fused = (hi - lo) > 1;
    if (fused) xcd_barrier_post((gbar_t)(a0.ws + WS_CTL) + CW_BAR);

    REP(12) if (IN(0)) { p0_prologue(fresh_args()); GRID_BAR(); }

    layer_body<0>(lo, hi, fused); layer_body<1>(lo, hi, fused); layer_body<2>(lo, hi, fused); layer_body<3>(lo, hi, fused);
    if (IN(49)) n1_phase(fresh_args(), DEPTH, true);
}

#undef IN
#undef GRID_BAR
#ifndef MK_ONE_LAUNCH
#define MK_ONE_LAUNCH 1
#endif
extern "C" void kernel_launch(void* const* d_in, const int* in_sizes, int n_in, void* d_out, int out_size, void* d_ws, size_t ws_size, hipStream_t stream) {
    static int grid = 0;
    if (grid == 0) {
        if (n_in != 30 || in_sizes[0] != NTOK * DM || out_size != NTOK * DM || ws_size < WS_END) {
            fprintf(stderr, "kernel_launch: shape mismatch: n_in %d in0 %d out %d ws %zu (need %zu)\n", n_in, n_in > 0 ? in_sizes[0] : -1, out_size, ws_size, (size_t)WS_END); grid = -1; return; }
        int dev = 0, cus = 0, per_cu = 0;
        if (hipGetDevice(&dev) != hipSuccess || hipDeviceGetAttribute(&cus, hipDeviceAttributeMultiprocessorCount, dev) != hipSuccess) { grid = -1; return; }
        if (hipFuncSetAttribute((const void*)fwd_kernel, hipFuncAttributeMaxDynamicSharedMemorySize, LDS_BYTES) != hipSuccess) { fprintf(stderr, "kernel_launch: hipFuncSetAttribute failed\n"); grid = -1; return; }
        if (hipOccupancyMaxActiveBlocksPerMultiprocessor(&per_cu, (const void*)fwd_kernel, 512, LDS_BYTES) != hipSuccess || per_cu < 1) fprintf(stderr, "kernel_launch: occupancy query says %d\n", per_cu);
        (void)hipGetLastError();
        grid = cus;
    }
    if (grid < 0) return;
    (void)hipMemsetAsync((char*)d_ws + WS_CTL, 0, CTL_ZERO_BYTES, stream);
    Args a{};
    a.x = (gcf_t)d_in[0]; a.c = (gcf_t)d_in[1]; a.pos = (gci_t)d_in[2];
    a.ada_w = (gcf_t)d_in[3]; a.ada_b = (gcf_t)d_in[4]; a.norm_mix_g = (gcf_t)d_in[5]; a.norm_ffn_g = (gcf_t)d_in[6];
    a.hy_w_in = (gcf_t)d_in[7]; a.ml_conv_w = (gcf_t)d_in[8]; a.ml_conv_b = (gcf_t)d_in[9]; a.ml_gate_b = (gcf_t)d_in[10]; a.ml_norm_g = (gcf_t)d_in[11];
    a.mla_q_norm_g = (gcf_t)d_in[12]; a.mla_kv_norm_g = (gcf_t)d_in[13]; a.mla_w_qb = (gcf_t)d_in[14]; a.mla_w_kvb = (gcf_t)d_in[15];
    a.mla_qk_q_g = (gcf_t)d_in[16]; a.mla_qk_k_g = (gcf_t)d_in[17]; a.hy_w_out = (gcf_t)d_in[18];
    a.ret_w_in = (gcf_t)d_in[19]; a.ret_decay_f = (gcf_t)d_in[20]; a.ret_decay_b = (gcf_t)d_in[21]; a.ret_gn_g = (gcf_t)d_in[22]; a.ret_w_out = (gcf_t)d_in[23];
    a.moe_router_w = (gcf_t)d_in[24]; a.moe_router_b = (gcf_t)d_in[25]; a.moe_w_gu = (gcf_t)d_in[26]; a.moe_b_gu = (gcf_t)d_in[27]; a.moe_w_down = (gcf_t)d_in[28]; a.moe_b_down = (gcf_t)d_in[29];
    a.out = (ARGAS float*)d_out; a.ws = (ARGAS unsigned char*)d_ws;
#if MK_ONE_LAUNCH
    a.ph_lo = 0; a.ph_hi = NPHASE;
    hipLaunchKernelGGL(fwd_kernel, dim3(grid), dim3(512), LDS_BYTES, stream, a);
#else
    for (int ph = 0; ph < NPHASE; ++ph) {
        if (ph >= 1 && ph < 49) { const int layer = (ph - 1) / 12, k = (ph - 1) % 12; if ((layer & 1) && (k >= 4 && k <= 6)) continue; }
        a.ph_lo = ph; a.ph_hi = ph + 1;
        hipLaunchKernelGGL(fwd_kernel, dim3(grid), dim3(512), LDS_BYTES, stream, a);
    }
#endif
    const hipError_t le = hipPeekAtLastError();
    if (le != hipSuccess) fprintf(stderr, "kernel_launch: launch failed: %s\n", hipGetErrorName(le));
}
```

```cpp
#include <hip/hip_runtime.h>
#include <cstdio>
#include <cstdint>

#define GAS __attribute__((address_space(1)))
#define LAS __attribute__((address_space(3)))
typedef unsigned short bf16_t;
typedef short bf16x8 __attribute__((ext_vector_type(8)));
typedef short s16x4 __attribute__((ext_vector_type(4)));
typedef float f32x2 __attribute__((ext_vector_type(2)));
typedef float f32x4 __attribute__((ext_vector_type(4)));
typedef float f32x8 __attribute__((ext_vector_type(8)));
typedef float f32x16 __attribute__((ext_vector_type(16)));
typedef unsigned u32x2 __attribute__((ext_vector_type(2)));
typedef unsigned u32x4 __attribute__((ext_vector_type(4)));
typedef GAS unsigned gu32;

constexpr int NTOK = 32768, DM = 1024, SEQ = 4096, NBATCH = 8, DEPTH = 4;
constexpr int EVEN_IN = 2480, EVEN_INP = 2560;
constexpr int RET_IN = 6144;
constexpr int NEXP = 32, TOPK = 4, EFF = 1024;
constexpr int NSLOT = NTOK * TOPK;
constexpr int NSLOTP = NSLOT + NEXP * 256;
constexpr float EPS = 1e-6f;

constexpr int PC_QM = 0, PC_KM = 512, PC_VM = 1024, PC_OM = 1536, PC_QA = 2048, PC_KVA = 2304, PC_KR = 2432, PC_GT = 2464;

#define LDS_WAIT() asm volatile("s_waitcnt lgkmcnt(0)" ::: "memory")
#define VM_WAIT() asm volatile("s_waitcnt vmcnt(0)" ::: "memory")
#define SBAR() __builtin_amdgcn_sched_barrier(0)
#define FENCE() do { asm volatile("" ::: "memory"); __builtin_amdgcn_sched_barrier(0); } while (0)

__device__ __forceinline__ unsigned cvt_pk_bf16(float lo, float hi) { unsigned r; asm volatile("v_cvt_pk_bf16_f32 %0, %1, %2" : "=v"(r) : "v"(lo), "v"(hi)); return r; }
__device__ __forceinline__ float bf_lo(unsigned u) { return __builtin_bit_cast(float, u << 16); }
__device__ __forceinline__ float bf_hi(unsigned u) { return __builtin_bit_cast(float, u & 0xffff0000u); }
__device__ __forceinline__ float bf2f(bf16_t b) { return __builtin_bit_cast(float, ((unsigned)b) << 16); }
__device__ __forceinline__ bf16_t f2bf(float f) { unsigned u = __builtin_bit_cast(unsigned, f); return (bf16_t)((u + 0x7fffu + ((u >> 16) & 1u)) >> 16); }
__device__ __forceinline__ float shx(float v, int m, int lane) { return __builtin_bit_cast(float, __builtin_amdgcn_ds_bpermute((lane ^ m) << 2, __builtin_bit_cast(int, v))); }
__device__ __forceinline__ int shxi(int v, int m, int lane) { return __builtin_amdgcn_ds_bpermute((lane ^ m) << 2, v); }
__device__ __forceinline__ float sh_from(float v, int src, int lane) { (void)lane; return __builtin_bit_cast(float, __builtin_amdgcn_ds_bpermute(src << 2, __builtin_bit_cast(int, v))); }
__device__ __forceinline__ int sh_fromi(int v, int src) { return __builtin_amdgcn_ds_bpermute(src << 2, v); }
__device__ __forceinline__ float wave_sum(float v, int lane) {
#pragma unroll
    for (int o = 1; o < 64; o <<= 1) v += shx(v, o, lane);
    return v;
}
__device__ __forceinline__ float wave_max(float v, int lane) {
#pragma unroll
    for (int o = 1; o < 64; o <<= 1) v = fmaxf(v, shx(v, o, lane));
    return v;
}
__device__ __forceinline__ float sigmoidf_(float x) { return 1.f / (1.f + __expf(-x)); }
__device__ __forceinline__ float siluf_(float x) { return x / (1.f + __expf(-x)); }

#define XB_TMO      128
#define XB_XCNT(j)  (256  + 64 * (j))
#define XB_XSUB(j)  (1280 + 64 * (j))
#define XB_XGEN(j)  (2304 + 64 * (j))
#define XB_TOP      3328
#define XB_TOPGEN   3392
#define XCD_BAR_WORDS 3456
#define XB_SPIN_CAP (1u << 22)

typedef GAS unsigned* gbar_t;
__device__ __forceinline__ unsigned xb_ld(gbar_t p)              { return __hip_atomic_load(p, __ATOMIC_RELAXED, __HIP_MEMORY_SCOPE_AGENT); }
__device__ __forceinline__ unsigned xb_add(gbar_t p, unsigned v) { return __hip_atomic_fetch_add(p, v, __ATOMIC_RELAXED, __HIP_MEMORY_SCOPE_AGENT); }
__device__ __forceinline__ unsigned xb_xcc_id() { return (unsigned)__builtin_amdgcn_s_getreg((3 << 11) | 20) & 0xFu; }
#define XB_SPIN(cond, bar) do { unsigned _sp = 0; while (cond) { __builtin_amdgcn_s_sleep(1); \
    if ((++_sp & 255u) == 0u) { if (xb_ld(&(bar)[XB_TMO])) break; if (_sp > XB_SPIN_CAP) { xb_add(&(bar)[XB_TMO], 1u); break; } } } } while (0)

__device__ __forceinline__ void xcd_barrier_post(gbar_t bar) {
    if (threadIdx.x == 0) (void)xb_add(&bar[XB_XCNT(xb_xcc_id())], 1u);
}
__device__ __forceinline__ void xcd_barrier_complete(gbar_t bar, unsigned x, unsigned& nloc, unsigned& nx) {
    const unsigned G = gridDim.x * gridDim.y * gridDim.z;
    unsigned sum, cnt, mine, sp = 0u;
    for (;;) {
        sum = 0u; cnt = 0u; mine = 0u;
#pragma unroll
        for (unsigned j = 0; j < 16; ++j) { const unsigned c = xb_ld(&bar[XB_XCNT(j)]); sum += c; cnt += (c > 0u) ? 1u : 0u; mine = (j == x) ? c : mine; }
        if (sum == G) break;
        __builtin_amdgcn_s_sleep(1);
        if ((++sp & 255u) == 0u) { if (xb_ld(&bar[XB_TMO])) break; if (sp > XB_SPIN_CAP) { xb_add(&bar[XB_TMO], 1u); break; } }
    }
    nloc = mine > 0u ? mine : 1u; nx = cnt > 0u ? cnt : 1u;
}
__device__ __forceinline__ void xcd_barrier(gbar_t bar, volatile LAS unsigned* st) {
    asm volatile("s_waitcnt vmcnt(0)" ::: "memory");
    __syncthreads();
    if (threadIdx.x == 0) {
        const unsigned bx = xb_xcc_id();
        __builtin_amdgcn_s_waitcnt(0);
        unsigned nloc = st[0], nx = st[1];
        if (nloc == 0u) { xcd_barrier_complete(bar, bx, nloc, nx); st[0] = nloc; st[1] = nx; }
        const unsigned old = xb_add(&bar[XB_XSUB(bx)], 1u);
        const unsigned gen = old / nloc;
        if (old + 1u == (gen + 1u) * nloc) {
            __builtin_amdgcn_fence(__ATOMIC_RELEASE, "agent");
            asm volatile("s_waitcnt vmcnt(0)" ::: "memory");
            const unsigned og = xb_add(&bar[XB_TOP], 1u);
            const unsigned tg = og / nx;
            if (og + 1u == (tg + 1u) * nx) xb_add(&bar[XB_TOPGEN], 1u);
            else XB_SPIN(xb_ld(&bar[XB_TOPGEN]) == tg, bar);
            __builtin_amdgcn_fence(__ATOMIC_ACQUIRE, "agent");
            xb_add(&bar[XB_XGEN(bx)], 1u);
            asm volatile("s_waitcnt vmcnt(0)" ::: "memory");
        } else {
            XB_SPIN(xb_ld(&bar[XB_XGEN(bx)]) == gen, bar);
            __builtin_amdgcn_fence(__ATOMIC_ACQUIRE, "agent");
            asm volatile("s_waitcnt vmcnt(0)" ::: "memory");
        }
    }
    __syncthreads();
}
namespace pg8 {
constexpr int BM = 256, BK = 64, HALF = 128, HTB = HALF * BK * 2, STAGE_BYTES = 8 * HTB, NXCD = 8, WGM = 8;
__host__ __device__ __forceinline__ int lds_byte(int r, int c) { const int st = (r >> 4) * 2 + (c >> 5), rr = r & 15, cc = c & 31, ob = rr * 64 + cc * 2; return st * 1024 + (ob ^ (((ob >> 9) & 1) << 5)); }
__host__ __device__ __forceinline__ void stage_rc(int b, int& R, int& C) { const int st = b / 1024, sb = b % 1024, swz = sb ^ (((sb >> 9) & 1) << 5); R = (st >> 1) * 16 + swz / 64; C = (st & 1) * 32 + (swz % 64) / 2; }
__host__ __device__ __forceinline__ int perm32(int rho) { const int n = rho >> 4, i = rho & 15; return 8 * (i >> 2) + 4 * n + (i & 3); }

struct Unit { const char* A; const char* B; int pm, pn, aux; };
struct Dims { int lda, ldb, K; };

__device__ __forceinline__ void static_tile(int L, int nM, int nN, int& pm, int& pn) {
    const int nwg = nM * nN; int wgid = L;
    { const int q = nwg / NXCD, r = nwg % NXCD, xcd = wgid % NXCD, off = wgid / NXCD; wgid = (xcd < r ? xcd * (q + 1) : r * (q + 1) + (xcd - r) * q) + off; }
    const int nig = WGM * nN, gid = wgid / nig, fm = gid * WGM, gsz = (nM - fm) < WGM ? (nM - fm) : WGM;
    pm = fm + ((wgid % nig) % gsz); pn = (wgid % nig) / gsz;
}
struct StaticSched {
    const char* A; const char* Bt; int lda, ldb, nM, nN, G, c;
    __device__ __forceinline__ bool next(int i, Unit& u) const {
        const long L = (long)i * G + c; if (L >= (long)nM * nN) return false;
        int pm, pn; static_tile((int)L, nM, nN, pm, pn);
        u.pm = pm; u.pn = pn; u.aux = 0; u.A = A + (size_t)pm * BM * lda * 2; u.B = Bt + (size_t)pn * BM * ldb * 2; return true;
    }
};

typedef int v8i_t __attribute__((ext_vector_type(8)));
__device__ __forceinline__ v8i_t cat8(bf16x8 a, bf16x8 b) { const u32x4 x = __builtin_bit_cast(u32x4, a), y = __builtin_bit_cast(u32x4, b); return (v8i_t){(int)x.x, (int)x.y, (int)x.z, (int)x.w, (int)y.x, (int)y.y, (int)y.z, (int)y.w}; }
template <class Epi, class Sched, bool ALIGN_EPI = true, bool SP2 = true, bool FP8 = false>
__device__ __forceinline__ void gemm_phase(LAS unsigned char* lds, const Dims g, const Sched& S, const Epi& E) {
    int tid = threadIdx.x; asm volatile("" : "+v"(tid));
    const int wid = __builtin_amdgcn_readfirstlane(tid >> 6), lane = tid & 63, wr = wid >> 2, wc = wid & 3, fr = lane & 15, fq = lane >> 4;
    const int K = g.K, nt = K / BK;
    unsigned voffA[2], voffB[2];
#pragma unroll
    for (int i = 0; i < 2; ++i) { int R, C; stage_rc(tid * 16 + i * 8192, R, C); const int Rb = Epi::PERM ? ((R & ~31) + perm32(R & 31)) : R;
        voffA[i] = (unsigned)(R * g.lda + C) * 2u; voffB[i] = (unsigned)(Rb * g.ldb + C) * 2u; }
    const size_t kstep = (size_t)(BK * 2);
    const size_t hstepA = (size_t)HALF * g.lda * 2, hstepB = (size_t)HALF * g.ldb * 2;
    const unsigned ldsw = (unsigned)wid * 1024u, ldsb_ = (unsigned)(uintptr_t)lds;
    const int aoff = lds_byte(wr * 64 + fr, fq * 8), boff = lds_byte(wc * 32 + fr, fq * 8);
#define PG8_SA(b, h) (((b) * 2 + (h)) * HTB)
#define PG8_SB(b, h) ((4 + (b) * 2 + (h)) * HTB)
#define PG8_STAGE(bufoff, gbase, voff) do { _Pragma("unroll") for (int _i = 0; _i < 2; ++_i) { \
        if constexpr (FP8) { unsigned keep_; asm volatile("s_mov_b32 %0, m0\n\ts_mov_b32 m0, %1\n\ts_nop 0\n\tglobal_load_lds_dwordx4 %2, %3\n\ts_mov_b32 m0, %0" : "=&s"(keep_) : "s"(ldsb_ + (unsigned)(bufoff) + ldsw + _i * 8192u), "v"((voff)[_i]), "s"(gbase) : "memory"); } \
        else __builtin_amdgcn_global_load_lds((const unsigned*)((const char*)(gbase) + (voff)[_i]), (LAS unsigned*)(lds + (bufoff) + ldsw + _i * 8192), 16, 0, 0); } } while (0)
#define PG8_LDA(dst, b, h) do { _Pragma("unroll") for (int m = 0; m < 4; ++m) { if constexpr (FP8) { const u32x4 x_ = *(const LAS u32x4*)(lds + PG8_SA(b, h) + aoff + m * 2048), y_ = *(const LAS u32x4*)(lds + PG8_SA(b, h) + aoff + m * 2048 + 1024); \
        dst##8[m] = (v8i_t){(int)x_.x, (int)x_.y, (int)x_.z, (int)x_.w, (int)y_.x, (int)y_.y, (int)y_.z, (int)y_.w}; } else { _Pragma("unroll") for (int k = 0; k < 2; ++k) dst[m][k] = *(const LAS bf16x8*)(lds + PG8_SA(b, h) + aoff + m * 2048 + k * 1024); } } } while (0)
#define PG8_LDB(dst, b, h) do { _Pragma("unroll") for (int n = 0; n < 2; ++n) { if constexpr (FP8) { const u32x4 x_ = *(const LAS u32x4*)(lds + PG8_SB(b, h) + boff + n * 2048), y_ = *(const LAS u32x4*)(lds + PG8_SB(b, h) + boff + n * 2048 + 1024); \
        dst##8[n] = (v8i_t){(int)x_.x, (int)x_.y, (int)x_.z, (int)x_.w, (int)y_.x, (int)y_.y, (int)y_.z, (int)y_.w}; } else { _Pragma("unroll") for (int k = 0; k < 2; ++k) dst[n][k] = *(const LAS bf16x8*)(lds + PG8_SB(b, h) + boff + n * 2048 + k * 1024); } } } while (0)
#define PG8_MMA(ai, bj, At, Bt) do { __builtin_amdgcn_s_setprio(1); if constexpr (FP8) { _Pragma("unroll") for (int m = 0; m < 4; ++m) _Pragma("unroll") for (int n = 0; n < 2; ++n) \
        acc[ai][bj][m][n] = __builtin_amdgcn_mfma_scale_f32_16x16x128_f8f6f4(Bt##8[n], At##8[m], acc[ai][bj][m][n], 0, 0, 0, 0x7f7f7f7f, 0, 0x7f7f7f7f); } else { \
        _Pragma("unroll") for (int m = 0; m < 4; ++m) _Pragma("unroll") for (int n = 0; n < 2; ++n) _Pragma("unroll") for (int k = 0; k < 2; ++k) \
        acc[ai][bj][m][n] = __builtin_amdgcn_mfma_f32_16x16x32_bf16(Bt[n][k], At[m][k], acc[ai][bj][m][n], 0, 0, 0); } __builtin_amdgcn_s_setprio(0); } while (0)
#define PG8_WAIT_V(n) asm volatile("s_waitcnt vmcnt(" #n ")" ::: "memory")
#define PG8_WAIT_L(n) asm volatile("s_waitcnt lgkmcnt(" #n ")" ::: "memory")
#define PG8_BAR __builtin_amdgcn_s_barrier()
#define PG8_SCHED __builtin_amdgcn_sched_barrier(0)
    Unit cur, nxt; int ui = 0;
    if (!S.next(0, cur)) return;
    f32x4 acc[2][2][4][2];
#pragma unroll
    for (int a = 0; a < 2; ++a)
#pragma unroll
        for (int b = 0; b < 2; ++b)
#pragma unroll
            for (int m = 0; m < 4; ++m)
#pragma unroll
                for (int n = 0; n < 2; ++n) acc[a][b][m][n] = (f32x4){0.f, 0.f, 0.f, 0.f};
    bf16x8 At[4][2], B0[2][2], B1[2][2]; v8i_t At8[4], B08[2], B18[2];
    const char* cA = cur.A; const char* cB = cur.B;
    if constexpr (SP2) {
        PG8_STAGE(PG8_SB(0, 0), cB, voffB); PG8_STAGE(PG8_SB(0, 1), cB + hstepB, voffB); PG8_STAGE(PG8_SA(0, 0), cA, voffA); PG8_STAGE(PG8_SA(0, 1), cA + hstepA, voffA);
        if (wr == 1) PG8_BAR;
        PG8_WAIT_V(2); PG8_BAR;
        PG8_STAGE(PG8_SB(1, 0), cB + kstep, voffB); PG8_STAGE(PG8_SA(1, 0), cA + kstep, voffA); PG8_STAGE(PG8_SB(1, 1), cB + hstepB + kstep, voffB);
        PG8_WAIT_V(6); PG8_BAR;
    } else {
        PG8_STAGE(PG8_SB(0, 0), cB, voffB); PG8_STAGE(PG8_SA(0, 0), cA, voffA); PG8_STAGE(PG8_SB(0, 1), cB + hstepB, voffB); PG8_STAGE(PG8_SA(0, 1), cA + hstepA, voffA);
        if (wr == 1) PG8_BAR;
        PG8_WAIT_V(4); PG8_BAR;
        PG8_STAGE(PG8_SB(1, 0), cB + kstep, voffB); PG8_STAGE(PG8_SA(1, 0), cA + kstep, voffA); PG8_STAGE(PG8_SB(1, 1), cB + hstepB + kstep, voffB);
        PG8_WAIT_V(6); PG8_BAR;
    }
    for (;;) {
        const bool has_next = S.next(ui + 1, nxt);
        const char* nA = has_next ? nxt.A : cA; const char* nB = has_next ? nxt.B : cB;
#pragma unroll 1
        for (int t = 0; t < nt; t += 2) {
            const bool last = (t == nt - 2);
            const char* a1 = cA + (size_t)(t + 1) * kstep;
            const char* a2 = last ? nA : cA + (size_t)(t + 2) * kstep; const char* b2 = last ? nB : cB + (size_t)(t + 2) * kstep;
            const char* a3 = a2 + kstep; const char* b3 = b2 + kstep;
            if constexpr (SP2) {
            PG8_LDB(B0, 0, 0); PG8_LDB(B1, 0, 1); PG8_SCHED; PG8_LDA(At, 0, 0); PG8_STAGE(PG8_SA(1, 1), a1 + hstepA, voffA);
            PG8_WAIT_V(8); PG8_WAIT_L(0); PG8_BAR; PG8_MMA(0, 0, At, B0); PG8_MMA(0, 1, At, B1); PG8_BAR; PG8_SCHED;
            PG8_LDA(At, 0, 1); PG8_STAGE(PG8_SB(0, 0), b2, voffB); PG8_STAGE(PG8_SB(0, 1), b2 + hstepB, voffB); PG8_STAGE(PG8_SA(0, 0), a2, voffA);
            PG8_WAIT_V(8); PG8_WAIT_L(0); PG8_BAR; PG8_MMA(1, 0, At, B0); PG8_MMA(1, 1, At, B1); PG8_BAR; PG8_SCHED;
            PG8_LDB(B0, 1, 0); PG8_LDB(B1, 1, 1); PG8_SCHED; PG8_LDA(At, 1, 0); PG8_STAGE(PG8_SA(0, 1), a2 + hstepA, voffA);
            PG8_WAIT_V(8); PG8_WAIT_L(0); PG8_BAR; PG8_MMA(0, 0, At, B0); PG8_MMA(0, 1, At, B1); PG8_BAR; PG8_SCHED;
            PG8_LDA(At, 1, 1); PG8_STAGE(PG8_SB(1, 0), b3, voffB); PG8_STAGE(PG8_SB(1, 1), b3 + hstepB, voffB); PG8_STAGE(PG8_SA(1, 0), a3, voffA);
            PG8_WAIT_V(8); PG8_WAIT_L(0); PG8_BAR; PG8_MMA(1, 0, At, B0); PG8_MMA(1, 1, At, B1); PG8_BAR; PG8_SCHED;
            } else {
            PG8_LDB(B0, 0, 0); PG8_SCHED; PG8_LDA(At, 0, 0); PG8_STAGE(PG8_SA(1, 1), a1 + hstepA, voffA);
            PG8_WAIT_L(8); PG8_BAR; PG8_WAIT_L(0); PG8_MMA(0, 0, At, B0); PG8_BAR; PG8_SCHED;
            PG8_LDB(B1, 0, 1); PG8_STAGE(PG8_SB(0, 0), b2, voffB);
            PG8_BAR; PG8_WAIT_L(0); PG8_MMA(0, 1, At, B1); PG8_BAR;
            PG8_LDA(At, 0, 1); PG8_STAGE(PG8_SA(0, 0), a2, voffA);
            PG8_BAR; PG8_WAIT_L(0); PG8_MMA(1, 0, At, B0); PG8_BAR; PG8_SCHED;
            PG8_STAGE(PG8_SB(0, 1), b2 + hstepB, voffB);
            PG8_WAIT_V(6); PG8_BAR; PG8_MMA(1, 1, At, B1); PG8_BAR;
            PG8_LDB(B0, 1, 0); PG8_SCHED; PG8_LDA(At, 1, 0); PG8_STAGE(PG8_SA(0, 1), a2 + hstepA, voffA);
            PG8_WAIT_L(8); PG8_BAR; PG8_WAIT_L(0); PG8_MMA(0, 0, At, B0); PG8_BAR; PG8_SCHED;
            PG8_LDB(B1, 1, 1); PG8_STAGE(PG8_SB(1, 0), b3, voffB);
            PG8_BAR; PG8_WAIT_L(0); PG8_MMA(0, 1, At, B1); PG8_BAR;
            PG8_LDA(At, 1, 1); PG8_STAGE(PG8_SA(1, 0), a3, voffA);
            PG8_BAR; PG8_WAIT_L(0); PG8_MMA(1, 0, At, B0); PG8_BAR; PG8_SCHED;
            PG8_STAGE(PG8_SB(1, 1), b3 + hstepB, voffB);
            PG8_WAIT_V(6); PG8_BAR; PG8_MMA(1, 1, At, B1); PG8_BAR;
            }
        }
        if constexpr (ALIGN_EPI) { if (wr == 0) PG8_BAR; }
        { int tz = tid; asm volatile("" : "+v"(tz)); const int ln = tz & 63; E(acc, cur, wr, wc, ln & 15, ln >> 4); }
        if (!has_next) break;
#pragma unroll
        for (int a = 0; a < 2; ++a)
#pragma unroll
            for (int b = 0; b < 2; ++b)
#pragma unroll
                for (int m = 0; m < 4; ++m)
#pragma unroll
                    for (int n = 0; n < 2; ++n) acc[a][b][m][n] = (f32x4){0.f, 0.f, 0.f, 0.f};
        cur = nxt; cA = nA; cB = nB; ++ui;
        if constexpr (ALIGN_EPI) { if (wr == 1) PG8_BAR; }
    }
    PG8_WAIT_V(0);
    if constexpr (!ALIGN_EPI) { if (wr == 0) PG8_BAR; }
    PG8_BAR;
#undef PG8_SA
#undef PG8_SB
#undef PG8_STAGE
#undef PG8_LDA
#undef PG8_LDB
#undef PG8_MMA
#undef PG8_WAIT_V
#undef PG8_WAIT_L
#undef PG8_BAR
#undef PG8_SCHED
}

struct EpiBf16 {
    static constexpr bool PERM = true;
    bf16_t* O0; bf16_t* O1; int ldc0, ldc1; int rope_tiles; int qscale_tiles; float qscale; const GAS f32x2* rope;
    __device__ __forceinline__ void operator()(const f32x4 (&acc)[2][2][4][2], const Unit& u, int wr, int wc, int fr, int fq) const {
        const int row0 = u.pm * BM + wr * 64 + fr, col0 = u.pn * BM + wc * 32 + 8 * fq;
        bf16_t* base = u.aux ? O1 : O0; const int ld = u.aux ? ldc1 : ldc0;
        const bool do_rope = u.pn < rope_tiles; const float sc = (u.pn < qscale_tiles) ? qscale : 1.f;
#pragma unroll
        for (int ai = 0; ai < 2; ++ai)
#pragma unroll
            for (int m = 0; m < 4; ++m) {
                const int row = row0 + ai * HALF + m * 16; bf16_t* rowp = base + (size_t)row * ld + col0;
                f32x4 v00 = acc[ai][0][m][0], v01 = acc[ai][0][m][1], v10 = acc[ai][1][m][0], v11 = acc[ai][1][m][1];
                if (do_rope) {
                    const GAS f32x4* rp = (const GAS f32x4*)(rope + (size_t)row * 128 + wc * 32 + 8 * fq);
                    { const f32x4 t0 = rp[0], t1 = rp[1]; f32x4 a, b;
                      a[0] = v00[0] * t0[0] - v10[0] * t0[1]; b[0] = v10[0] * t0[0] + v00[0] * t0[1];
                      a[1] = v00[1] * t0[2] - v10[1] * t0[3]; b[1] = v10[1] * t0[2] + v00[1] * t0[3];
                      a[2] = v00[2] * t1[0] - v10[2] * t1[1]; b[2] = v10[2] * t1[0] + v00[2] * t1[1];
                      a[3] = v00[3] * t1[2] - v10[3] * t1[3]; b[3] = v10[3] * t1[2] + v00[3] * t1[3];
                      v00 = a; v10 = b; }
                    FENCE();
                    { const f32x4 t2 = rp[2], t3 = rp[3]; f32x4 a, b;
                      a[0] = v01[0] * t2[0] - v11[0] * t2[1]; b[0] = v11[0] * t2[0] + v01[0] * t2[1];
                      a[1] = v01[1] * t2[2] - v11[1] * t2[3]; b[1] = v11[1] * t2[2] + v01[1] * t2[3];
                      a[2] = v01[2] * t3[0] - v11[2] * t3[1]; b[2] = v11[2] * t3[0] + v01[2] * t3[1];
                      a[3] = v01[3] * t3[2] - v11[3] * t3[3]; b[3] = v11[3] * t3[2] + v01[3] * t3[3];
                      v01 = a; v11 = b; }
                }
                v00 = v00 * sc; v01 = v01 * sc; v10 = v10 * sc; v11 = v11 * sc;
                u32x4 w0, w1;
                w0.x = cvt_pk_bf16(v00[0], v00[1]); w0.y = cvt_pk_bf16(v00[2], v00[3]); w0.z = cvt_pk_bf16(v01[0], v01[1]); w0.w = cvt_pk_bf16(v01[2], v01[3]);
                w1.x = cvt_pk_bf16(v10[0], v10[1]); w1.y = cvt_pk_bf16(v10[2], v10[3]); w1.z = cvt_pk_bf16(v11[0], v11[1]); w1.w = cvt_pk_bf16(v11[2], v11[3]);
                *(u32x4*)(rowp) = w0; *(u32x4*)(rowp + HALF) = w1;
                FENCE();
            }
    }
};
struct EpiResid {
    static constexpr bool PERM = false;
    const float* base; float* out; const float* gate; int gstride;
    __device__ __forceinline__ void operator()(const f32x4 (&acc)[2][2][4][2], const Unit& u, int wr, int wc, int fr, int fq) const {
        const int row0 = u.pm * BM + wr * 64 + fr, col0 = u.pn * BM + wc * 32 + 4 * fq;
        const float* gp = gate + (size_t)((u.pm * BM) >> 12) * gstride + col0;
        f32x4 gv[2][2];
#pragma unroll
        for (int bj = 0; bj < 2; ++bj)
#pragma unroll
            for (int n = 0; n < 2; ++n) gv[bj][n] = *(const f32x4*)(gp + bj * HALF + n * 16);
#pragma unroll
        for (int ai = 0; ai < 2; ++ai)
#pragma unroll
            for (int m = 0; m < 4; ++m) { const size_t ro = (size_t)(row0 + ai * HALF + m * 16) * DM + col0;
#pragma unroll
                for (int bj = 0; bj < 2; ++bj)
#pragma unroll
                    for (int n = 0; n < 2; ++n) { const f32x4 bv = *(const f32x4*)(base + ro + bj * HALF + n * 16);
                        *(f32x4*)(out + ro + bj * HALF + n * 16) = bv + gv[bj][n] * acc[ai][bj][m][n]; } }
    }
};
__device__ __forceinline__ unsigned pk4_fp8(float a, float b, float c, float d) { int w = __builtin_amdgcn_cvt_pk_fp8_f32(a, b, 0, false); w = __builtin_amdgcn_cvt_pk_fp8_f32(c, d, w, true); return (unsigned)w; }
struct EpiSwiglu {
    static constexpr bool PERM = true;
    unsigned char* act; const float* bgu; float ascale;
    __device__ __forceinline__ void operator()(const f32x4 (&acc)[2][2][4][2], const Unit& u, int wr, int wc, int fr, int fq) const {
        const int row0 = u.pm * BM + wr * 64 + fr, c0 = u.pn * HALF + wc * 32 + 8 * fq;
        const float* bp = bgu + (size_t)u.aux * 2048 + c0;
        const f32x4 bg0 = *(const f32x4*)(bp), bg1 = *(const f32x4*)(bp + 4), bu0 = *(const f32x4*)(bp + 1024), bu1 = *(const f32x4*)(bp + 1028);
#pragma unroll
        for (int ai = 0; ai < 2; ++ai)
#pragma unroll
            for (int m = 0; m < 4; ++m) {
                const f32x4 g0 = acc[ai][0][m][0] * ascale + bg0, g1 = acc[ai][0][m][1] * ascale + bg1, u0 = acc[ai][1][m][0] * ascale + bu0, u1 = acc[ai][1][m][1] * ascale + bu1;
                float r[8];
#pragma unroll
                for (int j = 0; j < 4; ++j) {
                    float gg = fminf(g0[j], 7.f), uu = fminf(fmaxf(u0[j], -7.f), 7.f); r[j] = 4.f * (uu + 1.f) * gg * __builtin_amdgcn_rcpf(1.f + __expf(-1.702f * gg));
                    gg = fminf(g1[j], 7.f); uu = fminf(fmaxf(u1[j], -7.f), 7.f); r[4 + j] = 4.f * (uu + 1.f) * gg * __builtin_amdgcn_rcpf(1.f + __expf(-1.702f * gg));
                }
                u32x2 w; w.x = pk4_fp8(r[0], r[1], r[2], r[3]); w.y = pk4_fp8(r[4], r[5], r[6], r[7]);
                *(u32x2*)(act + (size_t)(row0 + ai * HALF + m * 16) * EFF + c0) = w;
            }
    }
};
struct EpiDown {
    static constexpr bool PERM = true;
    bf16_t* y; const float* bd; const float* wrow; float ascale;
    __device__ __forceinline__ void operator()(const f32x4 (&acc)[2][2][4][2], const Unit& u, int wr, int wc, int fr, int fq) const {
        const int row0 = u.pm * BM + wr * 64 + fr, col0 = u.pn * BM + wc * 32 + 8 * fq;
        const float* bp = bd + (size_t)u.aux * DM + col0;
        const f32x4 b00 = *(const f32x4*)(bp), b01 = *(const f32x4*)(bp + 4), b10 = *(const f32x4*)(bp + HALF), b11 = *(const f32x4*)(bp + HALF + 4);
        float wv[8];
#pragma unroll
        for (int i = 0; i < 8; ++i) wv[i] = wrow[row0 + (i >> 2) * HALF + (i & 3) * 16];
#pragma unroll
        for (int ai = 0; ai < 2; ++ai)
#pragma unroll
            for (int m = 0; m < 4; ++m) {
                const int row = row0 + ai * HALF + m * 16; const float w = wv[ai * 4 + m];
                const f32x4 v00 = (acc[ai][0][m][0] * ascale + b00) * w, v01 = (acc[ai][0][m][1] * ascale + b01) * w, v10 = (acc[ai][1][m][0] * ascale + b10) * w, v11 = (acc[ai][1][m][1] * ascale + b11) * w;
                u32x4 w0, w1;
                w0.x = cvt_pk_bf16(v00[0], v00[1]); w0.y = cvt_pk_bf16(v00[2], v00[3]); w0.z = cvt_pk_bf16(v01[0], v01[1]); w0.w = cvt_pk_bf16(v01[2], v01[3]);
                w1.x = cvt_pk_bf16(v10[0], v10[1]); w1.y = cvt_pk_bf16(v10[2], v10[3]); w1.z = cvt_pk_bf16(v11[0], v11[1]); w1.w = cvt_pk_bf16(v11[2], v11[3]);
                bf16_t* rowp = y + (size_t)row * DM + col0;
                *(u32x4*)(rowp) = w0; *(u32x4*)(rowp + HALF) = w1;
            }
    }
};
}
namespace la {
__device__ __forceinline__ unsigned off_a(unsigned row, unsigned ch) { return 2048u * (row >> 3) + 512u * (ch >> 2) + 64u * (row & 7) + 16u * ((ch & 3) ^ ((row >> 2) & 3)); }
__device__ __forceinline__ unsigned r_base(int lane, int e) { const unsigned h = lane >> 5; return 2048u * ((lane & 31) >> 3) + 64u * (lane & 7) + 16u * ((2u * e + h) ^ ((lane >> 2) & 3)); }
__device__ __forceinline__ unsigned t_base(int lane, int t) { const unsigned h = lane >> 5, blk = (lane >> 4) & 1, q = (lane & 15) >> 2, p = lane & 3;
    return 2048u * h + 64u * (4u * t + q) + 16u * ((2u * blk + (p >> 1)) ^ (2u * h + t)) + 8u * (p & 1); }
__device__ __forceinline__ int crow(int r, int hi) { return (r & 3) + 8 * (r >> 2) + 4 * hi; }

__device__ __forceinline__ bf16x8 lds_r128(unsigned addr) { return *(const LAS bf16x8*)(uintptr_t)addr; }
__device__ __forceinline__ bf16x8 lds_tr_frag(unsigned a0, unsigned a1) {
    s16x4 x, y; asm volatile("ds_read_b64_tr_b16 %0, %2\n\tds_read_b64_tr_b16 %1, %3\n\ts_waitcnt lgkmcnt(0)" : "=&v"(x), "=&v"(y) : "v"(a0), "v"(a1) : "memory");
    return (bf16x8){x[0], x[1], x[2], x[3], y[0], y[1], y[2], y[3]};
}
__device__ __forceinline__ bf16x8 scale_frag(bf16x8 f, float s) {
    u32x4 w = __builtin_bit_cast(u32x4, f); u32x4 o;
    o.x = cvt_pk_bf16(bf_lo(w.x) * s, bf_hi(w.x) * s); o.y = cvt_pk_bf16(bf_lo(w.y) * s, bf_hi(w.y) * s);
    o.z = cvt_pk_bf16(bf_lo(w.z) * s, bf_hi(w.z) * s); o.w = cvt_pk_bf16(bf_lo(w.w) * s, bf_hi(w.w) * s);
    return __builtin_bit_cast(bf16x8, o);
}
template <int R, int NP, bool SCALE>
__device__ __forceinline__ void stage_tile(int tid, unsigned lds_base, const bf16_t* g, int ld, const LAS float* rowscale) {
    constexpr int RPI = 32 / NP, NIT = R / RPI;
    static_assert(RPI % 8 == 0 && R % RPI == 0, "stage_tile geometry");
    const int row0 = tid / (16 * NP), cc = tid % (16 * NP), pnl = cc >> 4, ch = cc & 15;
    const unsigned la0 = lds_base + pnl * (R * 256) + off_a(row0, ch), la1 = lds_base + pnl * (R * 256) + off_a(row0 + RPI, ch);
    const bf16_t* gp = g + (size_t)row0 * ld + cc * 8;
    const size_t gstep = (size_t)RPI * ld;
#pragma unroll
    for (int it = 0; it < NIT; ++it) {
        bf16x8 v = *(const bf16x8*)(gp + it * gstep);
        if (SCALE) v = scale_frag(v, rowscale[row0 + it * RPI]);
        const unsigned la = (RPI % 16 == 0) ? la0 + it * (RPI * 256) : ((it & 1) ? la1 + (it >> 1) * (2 * RPI * 256) : la0 + (it >> 1) * (2 * RPI * 256));
        *(LAS bf16x8*)(uintptr_t)la = v;
        if ((it & 3) == 3) FENCE();
    }
}
template <int R, int CW>
__device__ __forceinline__ void stage_tile_narrow(int tid, unsigned lds_base, const bf16_t* g, int ld) {
    static_assert(CW == 64 && R % 64 == 0, "stage_tile_narrow geometry");
    const int row0 = tid >> 3, ch = tid & 7;
    const unsigned la0 = lds_base + off_a(row0, ch);
    const bf16_t* gp = g + (size_t)row0 * ld + ch * 8;
#pragma unroll
    for (int it = 0; it < R / 64; ++it) *(LAS bf16x8*)(uintptr_t)(la0 + it * 16384) = *(const bf16x8*)(gp + (size_t)it * 64 * ld);
}

struct StateArgs {
    const bf16_t* K; int ldk;
    const bf16_t* V; int ldv;
    bf16_t* Cout; int ldc; size_t cstride;
    float* Nout;
    const float* alpha; const float* beta;
    float lgam; int dir;
};
template <int DK, int DVB, bool MLSTM>
__device__ __forceinline__ void state_unit(LAS unsigned char* lds, const StateArgs a) {
    constexpr int NDKB = DK / 32, NDVB = DVB / 32, BPW = (NDKB * NDVB) / 8, NPK = DK / 128;
    static_assert(BPW >= 1 && (NDKB == 8 || NDKB == 4), "state tile geometry");
    int tid = threadIdx.x; asm volatile("" : "+v"(tid));
    const int wid = __builtin_amdgcn_readfirstlane(tid >> 6), lane = tid & 63, r32 = lane & 31, hi = lane >> 5;
    const int dkb = wid % NDKB, dvb0 = (wid / NDKB) * BPW;
    const unsigned ldsb = (unsigned)(uintptr_t)lds;
    const unsigned KP = ldsb, VP = ldsb + NPK * 32768u, WT = VP + 32768u;
    LAS float* wtab = (LAS float*)(lds + NPK * 32768 + 32768);
    const unsigned tb0 = t_base(lane, 0), tb1 = t_base(lane, 1);
    f32x16 acc[BPW];
#pragma unroll
    for (int j = 0; j < BPW; ++j) acc[j] = (f32x16){};
    float nacc = 0.f;
#pragma unroll 1
    for (int ci = 0; ci < 32; ++ci) {
        const int c = a.dir ? 31 - ci : ci; const int t0 = c * 128;
        {
            bf16_t* co = a.Cout + (size_t)c * a.cstride;
#pragma unroll
            for (int j = 0; j < BPW; ++j)
#pragma unroll
                for (int r = 0; r < 16; ++r) co[(size_t)(32 * dkb + crow(r, hi)) * a.ldc + 32 * (dvb0 + j) + r32] = f2bf(acc[j][r]);
            if (MLSTM) { if (a.Nout && tid < DK) a.Nout[(size_t)c * DK + tid] = nacc; }
        }
        float eF;
        if (MLSTM) {
            const float F = a.alpha[t0 + (a.dir ? 0 : 127)];
            if (tid < 128) wtab[tid] = __expf(F - a.alpha[t0 + tid] + a.beta[t0 + tid]);
            eF = __expf(F);
        } else {
            if (tid < 128) { const int sp = a.dir ? 127 - tid : tid; wtab[tid] = __expf((float)(127 - sp) * a.lgam); }
            eF = __expf(128.f * a.lgam);
        }
        __syncthreads();
        stage_tile<128, NPK, true>(tid, KP, a.K + (size_t)t0 * a.ldk, a.ldk, wtab);
        if constexpr (DVB == 128) stage_tile<128, 1, false>(tid, VP, a.V + (size_t)t0 * a.ldv, a.ldv, nullptr);
        else stage_tile_narrow<128, DVB>(tid, VP, a.V + (size_t)t0 * a.ldv, a.ldv);
        __syncthreads();
#pragma unroll
        for (int j = 0; j < BPW; ++j)
#pragma unroll
            for (int r = 0; r < 16; ++r) acc[j][r] *= eF;
#pragma unroll
        for (int ks = 0; ks < 8; ++ks) {
            const unsigned ka = KP + (dkb >> 2) * 32768u + 4096u * ks + 512u * (dkb & 3);
            const bf16x8 af = lds_tr_frag(ka + tb0, ka + tb1);
#pragma unroll
            for (int j = 0; j < BPW; ++j) {
                const unsigned va = VP + 4096u * ks + 512u * (dvb0 + j);
                const bf16x8 bfr = lds_tr_frag(va + tb0, va + tb1);
                acc[j] = __builtin_amdgcn_mfma_f32_32x32x16_bf16(af, bfr, acc[j], 0, 0, 0);
            }
            FENCE();
        }
        if (MLSTM) {
            if (tid < DK) { float s = 0.f; const int pnl = tid >> 7, col = tid & 127;
                for (int p = 0; p < 128; ++p) s += bf2f(*(const LAS bf16_t*)(lds + pnl * 32768 + off_a(p, col >> 3) + (col & 7) * 2));
                nacc = eF * nacc + s; }
        }
        __syncthreads();
    }
    (void)WT;
}

struct OutArgs {
    const bf16_t* Q; int ldq;
    const bf16_t* K; int ldk;
    const bf16_t* V; int ldv;
    const bf16_t* Cf; const bf16_t* Cb;
    const float* Nf; const float* Nb;
    const float* af; const float* bfw; const float* ab; const float* bbw;
    float Mf, Mb;
    float lgf, lgb;
    const float* gain;
    const bf16_t* G; int ldg;
    bf16_t* Out; int ldo;
};
template <int DK, int DV, bool MLSTM>
__device__ __forceinline__ void out_unit(LAS unsigned char* lds, LAS unsigned char* ldstab, const OutArgs a) {
    constexpr int NPK = DK / 128, NB = DV / 64, NPV = DV / 128, NKS = DK / 16, NCP = DK / 64;
    int tid = threadIdx.x; asm volatile("" : "+v"(tid));
    const int wid = __builtin_amdgcn_readfirstlane(tid >> 6), lane = tid & 63, r32 = lane & 31, hi = lane >> 5;
    const int rb = wid & 3, dh = wid >> 2;
    const unsigned ldsb = (unsigned)(uintptr_t)lds;
    const unsigned QP = ldsb, KP = ldsb + NPK * 32768u, SB = KP;
    LAS float* akf = (LAS float*)ldstab; LAS float* akb = akf + 128; LAS float* nf = akb + 128; LAS float* nbv = nf + 256; LAS float* exch = nbv + 256;
    const unsigned rb0 = r_base(lane, 0), rb1 = r_base(lane, 1), tb0 = t_base(lane, 0), tb1 = t_base(lane, 1);
    __syncthreads();
    stage_tile<128, NPK, false>(tid, QP, a.Q, a.ldq, nullptr);
    stage_tile<128, NPK, false>(tid, KP, a.K, a.ldk, nullptr);
    if (tid < 128) {
        if (MLSTM) { akf[tid] = a.af[tid] - a.bfw[tid]; akb[tid] = a.ab[tid] - a.bbw[tid]; }
        else { akf[tid] = (float)(tid + 1) * a.lgf; akb[tid] = (float)(128 - tid) * a.lgb; }
    }
    if (MLSTM) { if (tid < DK) { nf[tid] = a.Nf[tid]; nbv[tid] = a.Nb[tid]; } }
    const int l = 32 * rb + r32;
    float a_fl, a_bl;
    if (MLSTM) { a_fl = a.af[l]; a_bl = a.ab[l]; } else { a_fl = (float)(l + 1) * a.lgf; a_bl = (float)(128 - l) * a.lgb; }
    __syncthreads();
    f32x16 p[4];
#pragma unroll
    for (int kb = 0; kb < 4; ++kb) p[kb] = (f32x16){};
    float qnf = 0.f, qnb = 0.f;
#pragma unroll
    for (int ks = 0; ks < NKS; ++ks) {
        const unsigned po = (ks >> 3) * 32768u + ((ks & 1) ? rb1 : rb0) + 512u * ((ks & 7) >> 1);
        const bf16x8 qf = lds_r128(QP + po + 8192u * rb);
        bf16x8 kf[4];
#pragma unroll
        for (int kb = 0; kb < 4; ++kb) kf[kb] = lds_r128(KP + po + 8192u * kb);
#pragma unroll
        for (int kb = 0; kb < 4; ++kb) p[kb] = __builtin_amdgcn_mfma_f32_32x32x16_bf16(kf[kb], qf, p[kb], 0, 0, 0);
        FENCE();
    }
    if (MLSTM) {
#pragma unroll 1
        for (int ks = 0; ks < NKS; ++ks) {
            const bf16x8 qf = lds_r128(QP + (ks >> 3) * 32768u + ((ks & 1) ? rb1 : rb0) + 512u * ((ks & 7) >> 1) + 8192u * rb);
            const u32x4 w = __builtin_bit_cast(u32x4, qf); const int k0 = 16 * ks + 8 * hi;
            const f32x4 nf0 = *(const LAS f32x4*)(nf + k0), nf1 = *(const LAS f32x4*)(nf + k0 + 4), nb0 = *(const LAS f32x4*)(nbv + k0), nb1 = *(const LAS f32x4*)(nbv + k0 + 4);
            const float q0 = bf_lo(w.x), q1 = bf_hi(w.x), q2 = bf_lo(w.y), q3 = bf_hi(w.y), q4 = bf_lo(w.z), q5 = bf_hi(w.z), q6 = bf_lo(w.w), q7 = bf_hi(w.w);
            qnf += q0 * nf0[0] + q1 * nf0[1] + q2 * nf0[2] + q3 * nf0[3] + q4 * nf1[0] + q5 * nf1[1] + q6 * nf1[2] + q7 * nf1[3];
            qnb += q0 * nb0[0] + q1 * nb0[1] + q2 * nb0[2] + q3 * nb0[3] + q4 * nb1[0] + q5 * nb1[1] + q6 * nb1[2] + q7 * nb1[3];
        }
    }
    float rf = 1.f, rbk = 1.f;
    if (MLSTM) {
        float df = 0.f, db = 0.f;
#pragma unroll
        for (int kb = 0; kb < 4; ++kb) {
#pragma unroll
            for (int r = 0; r < 16; ++r) { const int s = 32 * kb + crow(r, hi);
                const float xf = a_fl - akf[s], xb = a_bl - akb[s];
                const float wf = __expf((s <= l) ? xf : -1.0e30f), wb = __expf((s >= l) ? xb : -1.0e30f);
                df += p[kb][r] * wf; db += p[kb][r] * wb; }
            FENCE(); }
        { auto rr = __builtin_amdgcn_permlane32_swap(__float_as_uint(df), __float_as_uint(df), false, false); df = __uint_as_float(rr[0]) + __uint_as_float(rr[1]); }
        { auto rr = __builtin_amdgcn_permlane32_swap(__float_as_uint(db), __float_as_uint(db), false, false); db = __uint_as_float(rr[0]) + __uint_as_float(rr[1]); }
        { auto rr = __builtin_amdgcn_permlane32_swap(__float_as_uint(qnf), __float_as_uint(qnf), false, false); qnf = __uint_as_float(rr[0]) + __uint_as_float(rr[1]); }
        { auto rr = __builtin_amdgcn_permlane32_swap(__float_as_uint(qnb), __float_as_uint(qnb), false, false); qnb = __uint_as_float(rr[0]) + __uint_as_float(rr[1]); }
        df += __expf(a_fl) * qnf; db += __expf(a_bl) * qnb;
        rf = 1.f / fmaxf(fabsf(df), __expf(-a.Mf)); rbk = 1.f / fmaxf(fabsf(db), __expf(-a.Mb));
        asm volatile("" : "+v"(a_fl), "+v"(a_bl));
    }
    int l2 = l; asm volatile("" : "+v"(l2));
#pragma unroll
    for (int kb = 0; kb < 4; ++kb) {
#pragma unroll
        for (int r = 0; r < 16; ++r) { const int s = 32 * kb + crow(r, hi);
            const float xf = a_fl - akf[s], xb = a_bl - akb[s];
            const float wf = __expf((s <= l2) ? xf : -1.0e30f), wb = __expf((s >= l2) ? xb : -1.0e30f);
            p[kb][r] *= (wf * rf + wb * rbk); }
        FENCE(); }
    const float qsf = __expf(a_fl) * rf, qsb = __expf(a_bl) * rbk;
    bf16x8 pa[8];
#define LA_PK4(P, BASE, OUT) do { unsigned a0 = cvt_pk_bf16(P[BASE + 0], P[BASE + 1]), a1 = cvt_pk_bf16(P[BASE + 2], P[BASE + 3]); \
    unsigned b0 = cvt_pk_bf16(P[BASE + 4], P[BASE + 5]), b1 = cvt_pk_bf16(P[BASE + 6], P[BASE + 7]); \
    auto r0 = __builtin_amdgcn_permlane32_swap(a0, b0, false, false); auto r1 = __builtin_amdgcn_permlane32_swap(a1, b1, false, false); \
    u32x4 w = {r0[0], r1[0], r0[1], r1[1]}; OUT = __builtin_bit_cast(bf16x8, w); } while (0)
#pragma unroll
    for (int kb = 0; kb < 4; ++kb) { LA_PK4(p[kb], 0, pa[2 * kb]); LA_PK4(p[kb], 8, pa[2 * kb + 1]); }
#undef LA_PK4
    f32x16 o[NB];
#pragma unroll
    for (int nb = 0; nb < NB; ++nb) o[nb] = (f32x16){};
#pragma unroll
    for (int pc = 0; pc < 2; ++pc) {
        __syncthreads();
        stage_tile<64, NPV, false>(tid, SB, a.V + (size_t)(64 * pc) * a.ldv, a.ldv, nullptr);
        __syncthreads();
#pragma unroll
        for (int ks = 0; ks < 4; ++ks) {
            const bf16x8 af = pa[4 * pc + ks];
#pragma unroll
            for (int nb = 0; nb < NB; ++nb) { const int cg = dh * NB + nb; const unsigned va = SB + (cg >> 2) * 16384u + 4096u * ks + 512u * (cg & 3);
                const bf16x8 bfr = lds_tr_frag(va + tb0, va + tb1);
                o[nb] = __builtin_amdgcn_mfma_f32_32x32x16_bf16(af, bfr, o[nb], 0, 0, 0); }
            FENCE();
        }
    }
#pragma unroll 1
    for (int pc = 0; pc < 2 * NCP; ++pc) {
        __syncthreads();
        const int dirb = pc >= NCP, cp = dirb ? pc - NCP : pc;
        const bf16_t* src = (dirb ? a.Cb : a.Cf) + (size_t)(64 * cp) * DV;
        const float qs = dirb ? qsb : qsf;
        stage_tile<64, NPV, false>(tid, SB, src, DV, nullptr);
        __syncthreads();
#pragma unroll
        for (int ks = 0; ks < 4; ++ks) {
            const int kq = 4 * cp + ks;
            const bf16x8 qf = lds_r128(QP + (kq >> 3) * 32768u + ((kq & 1) ? rb1 : rb0) + 512u * ((kq & 7) >> 1) + 8192u * rb);
            const bf16x8 af = scale_frag(qf, qs);
#pragma unroll
            for (int nb = 0; nb < NB; ++nb) { const int cg = dh * NB + nb; const unsigned va = SB + (cg >> 2) * 16384u + 4096u * ks + 512u * (cg & 3);
                const bf16x8 bfr = lds_tr_frag(va + tb0, va + tb1);
                o[nb] = __builtin_amdgcn_mfma_f32_32x32x16_bf16(af, bfr, o[nb], 0, 0, 0); }
            FENCE();
        }
    }
    float s1[16], s2[16];
#pragma unroll
    for (int r = 0; r < 16; ++r) { float x1 = 0.f, x2 = 0.f;
#pragma unroll
        for (int nb = 0; nb < NB; ++nb) { x1 += o[nb][r]; x2 += o[nb][r] * o[nb][r]; }
#pragma unroll
        for (int m = 1; m < 32; m <<= 1) { x1 += shx(x1, m, lane); x2 += shx(x2, m, lane); }
        s1[r] = x1; s2[r] = x2; }
    if (r32 == 0) {
#pragma unroll
        for (int r = 0; r < 16; ++r) { const int row = 32 * rb + crow(r, hi); exch[(dh * 128 + row) * 2] = s1[r]; exch[(dh * 128 + row) * 2 + 1] = s2[r]; }
    }
    __syncthreads();
#pragma unroll
    for (int r = 0; r < 16; ++r) {
        const int row = 32 * rb + crow(r, hi);
        const float t1 = s1[r] + exch[((1 - dh) * 128 + row) * 2], t2 = s2[r] + exch[((1 - dh) * 128 + row) * 2 + 1];
        float mean, inv;
        if (MLSTM) { mean = 0.f; inv = rsqrtf(t2 * (1.f / DV) + EPS); }
        else { mean = t1 * (1.f / DV); inv = rsqrtf(fmaxf(t2 * (1.f / DV) - mean * mean, 0.f) + EPS); }
#pragma unroll
        for (int nb = 0; nb < NB; ++nb) {
            const int col = dh * (DV / 2) + 32 * nb + r32;
            const float gpre = bf2f(a.G[(size_t)row * a.ldg + col]);
            const float gate = MLSTM ? sigmoidf_(gpre) : siluf_(gpre);
            a.Out[(size_t)row * a.ldo + col] = f2bf((o[nb][r] - mean) * inv * a.gain[col] * gate);
        }
    }
}
}
namespace att {
constexpr int DQK = 96, DVV = 64, NW = 8, QBLK = 32, KVBLK = 64, KROW = 128;
constexpr float SCALE = 0.10206207261596575f;
constexpr float THR = 8.f;
constexpr size_t SHM_V = KVBLK * DVV * 2, SHM_K = KVBLK * KROW * 2, SHM_ATTN = 2 * SHM_V + 2 * SHM_K + NW * 64 * 4;
#define KSWZ(row, colB) ((row) * 256 + ((colB) ^ (((row) & 7) << 4)))
__device__ __forceinline__ int crow(int r, int hi) { return (r & 3) + 8 * (r >> 2) + 4 * hi; }

__device__ __forceinline__ void partialSM(f32x16& p0, f32x16& p1, float& m_reg, float& mn, float& alpha) {
  constexpr float C = SCALE * 1.4426950408889634f;
  float pmax = p0[0]; for (int r = 1; r < 16; ++r) pmax = fmaxf(pmax, p0[r]); for (int r = 0; r < 16; ++r) pmax = fmaxf(pmax, p1[r]);
  { auto rr = __builtin_amdgcn_permlane32_swap(__float_as_uint(pmax), __float_as_uint(pmax), false, false);
    pmax = fmaxf(__uint_as_float(rr[0]), __uint_as_float(rr[1])); }
  if (__builtin_expect(__all(pmax - m_reg <= THR / SCALE), 1)) { mn = m_reg; alpha = 1.f; }
  else { mn = fmaxf(m_reg, pmax); alpha = __builtin_amdgcn_exp2f((m_reg - mn) * C); m_reg = mn; }
  float mnC = -mn * C;
  for (int r = 0; r < 16; ++r) p0[r] = fmaf(p0[r], C, mnC); for (int r = 0; r < 16; ++r) p1[r] = fmaf(p1[r], C, mnC);
  for (int r = 0; r < 16; ++r) p0[r] = __builtin_amdgcn_exp2f(p0[r]);
}
__device__ __forceinline__ void finishSM(f32x16& p0, f32x16& p1, float alpha, float& l_reg, bf16x8& pa0, bf16x8& pa1, bf16x8& pa2, bf16x8& pa3) {
  for (int r = 0; r < 16; ++r) p1[r] = __builtin_amdgcn_exp2f(p1[r]);
  float ps = 0; for (int r = 0; r < 16; ++r) ps += p0[r]; for (int r = 0; r < 16; ++r) ps += p1[r];
  { auto rr = __builtin_amdgcn_permlane32_swap(__float_as_uint(ps), __float_as_uint(ps), false, false);
    ps = __uint_as_float(rr[0]) + __uint_as_float(rr[1]); }
  l_reg = l_reg * alpha + ps;
#define PK4(P, BASE, OUT) do { unsigned a0 = cvt_pk_bf16(P[BASE + 0], P[BASE + 1]), a1 = cvt_pk_bf16(P[BASE + 2], P[BASE + 3]);   \
    unsigned b0 = cvt_pk_bf16(P[BASE + 4], P[BASE + 5]), b1 = cvt_pk_bf16(P[BASE + 6], P[BASE + 7]);                              \
    auto r0 = __builtin_amdgcn_permlane32_swap(a0, b0, false, false); auto r1 = __builtin_amdgcn_permlane32_swap(a1, b1, false, false); \
    u32x4 w = {r0[0], r1[0], r0[1], r1[1]}; OUT = __builtin_bit_cast(bf16x8, w); } while (0)
  PK4(p0, 0, pa0); PK4(p0, 8, pa1); PK4(p1, 0, pa2); PK4(p1, 8, pa3);
#undef PK4
}
__device__ __forceinline__ void qkt(f32x16& p0, f32x16& p1, const LAS char* Ks, const bf16x8* qr, int r32, int hi) {
  p0 = f32x16{}; p1 = f32x16{};
#pragma unroll
  for (int d0 = 0; d0 < DQK / 16; ++d0) { int cb = (d0 * 16 + hi * 8) * 2;
    bf16x8 b0 = *reinterpret_cast<const LAS bf16x8*>(Ks + KSWZ(r32, cb));
    bf16x8 b1 = *reinterpret_cast<const LAS bf16x8*>(Ks + KSWZ(32 + r32, cb));
    p0 = __builtin_amdgcn_mfma_f32_32x32x16_bf16(b0, qr[d0], p0, 0, 0, 0);
    p1 = __builtin_amdgcn_mfma_f32_32x32x16_bf16(b1, qr[d0], p1, 0, 0, 0); }
}
__device__ __forceinline__ int v_st(int k, int c) { const int kk = (k & ~0xC) | ((k & 4) << 1) | ((k & 8) >> 1); return ((kk >> 3) * 2 + (c >> 5)) * 512 + ((kk & 7) * 32 + (c & 31)) * 2; }
__device__ __forceinline__ int v_rd_base(int lane) { return ((lane & 3) << 3) | (((lane >> 2) & 3) << 6) | (((lane >> 4) & 1) << 5) | (((lane >> 5) & 1) << 8); }
constexpr int v_rd_off(int d0, int ks, int half) { return d0 * 512 + ks * 2048 + half * 1024; }
template <int OFF> __device__ __forceinline__ s16x4 tr_read(int vb) {
  s16x4 r; asm volatile("ds_read_b64_tr_b16 %0, %1 offset:%2" : "=&v"(r) : "v"(vb), "i"(OFF) : "memory"); return r;
}
template <int D0> __device__ __forceinline__ void pv_one(f32x16& od, int vb, bf16x8 pa0, bf16x8 pa1, bf16x8 pa2, bf16x8 pa3) {
  const s16x4 l0 = tr_read<v_rd_off(D0, 0, 0)>(vb), h0 = tr_read<v_rd_off(D0, 0, 1)>(vb), l1 = tr_read<v_rd_off(D0, 1, 0)>(vb), h1 = tr_read<v_rd_off(D0, 1, 1)>(vb);
  const s16x4 l2 = tr_read<v_rd_off(D0, 2, 0)>(vb), h2 = tr_read<v_rd_off(D0, 2, 1)>(vb), l3 = tr_read<v_rd_off(D0, 3, 0)>(vb), h3 = tr_read<v_rd_off(D0, 3, 1)>(vb);
  asm volatile("s_waitcnt lgkmcnt(0)" ::: "memory"); SBAR();
#define PK(L, H) (bf16x8){L[0], L[1], L[2], L[3], H[0], H[1], H[2], H[3]}
  od = __builtin_amdgcn_mfma_f32_32x32x16_bf16(pa0, PK(l0, h0), od, 0, 0, 0);
  od = __builtin_amdgcn_mfma_f32_32x32x16_bf16(pa1, PK(l1, h1), od, 0, 0, 0);
  od = __builtin_amdgcn_mfma_f32_32x32x16_bf16(pa2, PK(l2, h2), od, 0, 0, 0);
  od = __builtin_amdgcn_mfma_f32_32x32x16_bf16(pa3, PK(l3, h3), od, 0, 0, 0);
#undef PK
}
__device__ __forceinline__ void pv_d0(f32x16* o, int vb, bf16x8 pa0, bf16x8 pa1, bf16x8 pa2, bf16x8 pa3) {
  pv_one<0>(o[0], vb, pa0, pa1, pa2, pa3); pv_one<1>(o[1], vb, pa0, pa1, pa2, pa3);
}
__device__ __forceinline__ void attn_body(const bf16_t* __restrict__ Qb, const bf16_t* __restrict__ Kh, const bf16_t* __restrict__ Vh, bf16_t* __restrict__ Ob, int ldo, int seq, LAS char* lds) {
  int tid = threadIdx.x; asm volatile("" : "+v"(tid));
  const int wid = tid >> 6, lane = tid & 63, r32 = lane & 31, hi = lane >> 5;
  LAS char* V_lds = lds; LAS char* K_lds = lds + 2 * SHM_V;
  LAS float* ws = (LAS float*)(lds + 2 * SHM_V + 2 * SHM_K) + wid * 64; LAS float* li_l = ws; LAS float* al_l = ws + 32;
  float m_reg = -1e30f, l_reg = 0; f32x16 o[2] = {}; bf16x8 qr[DQK / 16];
  const bf16_t* Qw = Qb + (long)(wid * QBLK + r32) * DQK + hi * 8;
#pragma unroll
  for (int d0 = 0; d0 < DQK / 16; ++d0) qr[d0] = *reinterpret_cast<const bf16x8*>(Qw + d0 * 16);
  const int sr = tid >> 4, sc = (tid & 15) * 8;
  const int vr = tid >> 3, vc = (tid & 7) * 8, vst0 = v_st(vr, vc);
  const int vb0 = (int)(uintptr_t)V_lds + v_rd_base(lane);
  struct { bf16x8 vs0, ks0, ks1; } sr_[2];
#define SLOAD(i, k0) do { sr_[i].vs0 = *reinterpret_cast<const bf16x8*>(&Vh[(long)((k0) + vr) * DVV + vc]); \
    sr_[i].ks0 = *reinterpret_cast<const bf16x8*>(&Kh[(long)((k0) + sr) * KROW + sc]); sr_[i].ks1 = *reinterpret_cast<const bf16x8*>(&Kh[(long)((k0) + 32 + sr) * KROW + sc]); } while (0)
#define SWRITE(b, i) do { *(LAS bf16x8*)(V_lds + (b) * SHM_V + vst0) = sr_[i].vs0; int kc = sc * 2;               \
    *(LAS bf16x8*)(K_lds + (b) * SHM_K + KSWZ(sr, kc)) = sr_[i].ks0;                       \
    *(LAS bf16x8*)(K_lds + (b) * SHM_K + KSWZ(32 + sr, kc)) = sr_[i].ks1; } while (0)
#define SWAIT() asm volatile("s_waitcnt vmcnt(3)" ::: "memory")
#define RESC(a) do { if (__any((a) < 1.f)) { if (hi == 0) al_l[r32] = (a); asm volatile("s_waitcnt lgkmcnt(0)" ::: "memory"); \
    for (int d = 0; d < 2; ++d) for (int r = 0; r < 16; ++r) o[d][r] *= al_l[crow(r, hi)]; } } while (0)
  f32x16 pA0, pA1, pB0, pB1; float mnA, mnB, alA, alB; bf16x8 pa0, pa1, pa2, pa3; const int NT = seq / KVBLK;
  constexpr int SE = 0, SO = 1;
  SLOAD(SE, 0); asm volatile("s_waitcnt vmcnt(0)" ::: "memory"); SWRITE(0, SE); __syncthreads();
  qkt(pA0, pA1, K_lds, qr, r32, hi); partialSM(pA0, pA1, m_reg, mnA, alA);
  SLOAD(SO, KVBLK); if (2 < NT) SLOAD(SE, 2 * KVBLK);
  SWAIT(); SWRITE(1, SO); __syncthreads();
  for (int j = 1; j + 1 < NT; j += 2) {
    SBAR(); qkt(pB0, pB1, K_lds + SHM_K, qr, r32, hi);
    finishSM(pA0, pA1, alA, l_reg, pa0, pa1, pa2, pa3); SBAR();
    SLOAD(SO, (j + 2) * KVBLK); SBAR();
    pv_d0(o, vb0, pa0, pa1, pa2, pa3); partialSM(pB0, pB1, m_reg, mnB, alB);
    __syncthreads(); SWAIT(); SWRITE(0, SE);
    RESC(alB); __syncthreads();
    SBAR(); qkt(pA0, pA1, K_lds, qr, r32, hi);
    finishSM(pB0, pB1, alB, l_reg, pa0, pa1, pa2, pa3); SBAR();
    if (j + 3 < NT) SLOAD(SE, (j + 3) * KVBLK); SBAR();
    pv_d0(o, vb0 + (int)SHM_V, pa0, pa1, pa2, pa3); partialSM(pA0, pA1, m_reg, mnA, alA);
    __syncthreads(); SWAIT(); SWRITE(1, SO);
    RESC(alA); __syncthreads();
  }
  SBAR(); qkt(pB0, pB1, K_lds + SHM_K, qr, r32, hi);
  finishSM(pA0, pA1, alA, l_reg, pa0, pa1, pa2, pa3); SBAR();
  pv_d0(o, vb0, pa0, pa1, pa2, pa3); partialSM(pB0, pB1, m_reg, mnB, alB);
  __syncthreads(); RESC(alB);
  finishSM(pB0, pB1, alB, l_reg, pa0, pa1, pa2, pa3); SBAR();
  pv_d0(o, vb0 + (int)SHM_V, pa0, pa1, pa2, pa3);
  if (hi == 0) li_l[r32] = l_reg; asm volatile("s_waitcnt lgkmcnt(0)" ::: "memory");
  float rli[16];
#pragma unroll
  for (int r = 0; r < 16; ++r) rli[r] = __builtin_amdgcn_rcpf(li_l[crow(r, hi)]);
  bf16_t* Ow = Ob + (long)(wid * QBLK) * ldo;
#pragma unroll
  for (int r = 0; r < 16; ++r) { int orow = crow(r, hi);
#pragma unroll
    for (int d0 = 0; d0 < 2; ++d0) Ow[(long)orow * ldo + d0 * 32 + r32] = f2bf(o[d0][r] * rli[r]); }
  __syncthreads();
#undef SLOAD
#undef SWRITE
#undef SWAIT
#undef RESC
}
#undef KSWZ
}
constexpr size_t MiB = 1ull << 20;
constexpr size_t WS_CTL = 0, CTL_ZERO_BYTES = 1 * MiB;
constexpr size_t WS_MOD = 1 * MiB;
constexpr size_t WS_MISC = 2 * MiB;
constexpr size_t WS_ROPEO = 8 * MiB;
constexpr size_t WS_ROPEE = 40 * MiB;
constexpr size_t WS_WINE = 48 * MiB;
constexpr size_t WS_WQB = 58 * MiB;
constexpr size_t WS_WKVB = 59 * MiB;
constexpr size_t WS_WOUTE = 60 * MiB;
constexpr size_t WS_WINO = 64 * MiB;
constexpr size_t WS_WOUTO = 88 * MiB;
constexpr size_t WS_WGU = 96 * MiB;
constexpr size_t WS_WDN = 608 * MiB;
constexpr size_t WS_HM = 864 * MiB;
constexpr size_t WS_P = 928 * MiB;
constexpr size_t WS_X1 = 1312 * MiB;
constexpr size_t X1_QC = WS_X1, X1_KC = X1_QC + 32 * MiB, X1_QA = X1_KC + 32 * MiB, X1_KVA = X1_QA + 16 * MiB, X1_QRAW = X1_KVA + 16 * MiB, X1_KVRAW = X1_QRAW + 48 * MiB,
                 X1_QH = X1_KVRAW + 64 * MiB, X1_KH = X1_QH + 48 * MiB, X1_VH = X1_KH + 64 * MiB, X1_CM = X1_VH + 32 * MiB, X1_NM = X1_CM + 64 * MiB;
constexpr size_t WS_MIX = WS_X1 + 512 * MiB;
constexpr size_t WS_LIST = WS_MIX + 128 * MiB;
constexpr size_t WS_WLIST = WS_LIST + 16 * MiB;
constexpr size_t WS_TOKE = WS_WLIST + 16 * MiB;
constexpr size_t WS_WSORT = WS_TOKE + 1 * MiB;
constexpr size_t WS_ASORT = WS_WSORT + 1 * MiB;
constexpr size_t WS_ACT = WS_ASORT + 272 * MiB;
constexpr size_t WS_Y = WS_ACT + 272 * MiB;
constexpr size_t WS_END = WS_Y + 272 * MiB;
static_assert(X1_NM + 1 * MiB <= WS_MIX, "even-layer scratch fits");
constexpr int CW_BAR = 4096;
constexpr int CW_CNT = 8192;
constexpr int CW_QUEUE = 8192 + 1024;

constexpr int LDS_RING = 0;
constexpr int LDS_TAB = 131072;
constexpr int LT_MISC = LDS_TAB;
constexpr int LT_PSTART = LDS_TAB + 256;
constexpr int LT_CNT = LDS_TAB + 512;
constexpr int LT_BLK = LDS_TAB + 1024;
constexpr int LT_X = LDS_TAB + 1024 + 4352;
constexpr int LDS_BYTES = 147456;

#if defined(__HIP_DEVICE_COMPILE__) && __HIP_DEVICE_COMPILE__
#define ARGAS GAS
#else
#define ARGAS
#endif
typedef const ARGAS float* gcf_t; typedef const ARGAS int* gci_t;
struct Args {
    gcf_t x; gcf_t c; gci_t pos; gcf_t ada_w; gcf_t ada_b; gcf_t norm_mix_g; gcf_t norm_ffn_g;
    gcf_t hy_w_in; gcf_t ml_conv_w; gcf_t ml_conv_b; gcf_t ml_gate_b; gcf_t ml_norm_g; gcf_t mla_q_norm_g; gcf_t mla_kv_norm_g;
    gcf_t mla_w_qb; gcf_t mla_w_kvb; gcf_t mla_qk_q_g; gcf_t mla_qk_k_g; gcf_t hy_w_out;
    gcf_t ret_w_in; gcf_t ret_decay_f; gcf_t ret_decay_b; gcf_t ret_gn_g; gcf_t ret_w_out;
    gcf_t moe_router_w; gcf_t moe_router_b; gcf_t moe_w_gu; gcf_t moe_b_gu; gcf_t moe_w_down; gcf_t moe_b_down;
    ARGAS float* out; ARGAS unsigned char* ws; int ph_lo, ph_hi;
};

constexpr float FP8_WSC = 128.f, FP8_HSC = 16.f, FP8_ASC = 4.f;
template <class RowMap>
__device__ __forceinline__ void transpose_item(const float* W, int N, bf16_t* WT, int ldk, LAS float* scr, int kb, int nb, int lane, const RowMap& rm) {
    const int k0 = 64 * kb, n0 = 32 * nb;
#pragma unroll 8
    for (int i = 0; i < 32; ++i) { const int kk = 2 * i + (lane >> 5); scr[kk * 33 + (lane & 31)] = W[(size_t)(k0 + kk) * N + n0 + (lane & 31)]; }
    LDS_WAIT(); asm volatile("" ::: "memory");
    const int c = lane & 7;
#pragma unroll
    for (int j = 0; j < 4; ++j) { const int n = (lane >> 3) + 8 * j; const LAS float* s = scr + (8 * c) * 33 + n;
        u32x4 o; o.x = cvt_pk_bf16(s[0 * 33], s[1 * 33]); o.y = cvt_pk_bf16(s[2 * 33], s[3 * 33]); o.z = cvt_pk_bf16(s[4 * 33], s[5 * 33]); o.w = cvt_pk_bf16(s[6 * 33], s[7 * 33]);
        *(u32x4*)(WT + (size_t)rm(n0 + n) * ldk + k0 + 8 * c) = o; }
    LDS_WAIT(); asm volatile("" ::: "memory");
}
template <class RowMap>
__device__ __forceinline__ void transpose_item8(const float* W, int N, unsigned char* WT, int ldk, LAS float* scr, int kb, int nb, int lane, const RowMap& rm, float scale) {
    const int k0 = 64 * kb, n0 = 32 * nb;
#pragma unroll 8
    for (int i = 0; i < 32; ++i) { const int kk = 2 * i + (lane >> 5); scr[kk * 33 + (lane & 31)] = W[(size_t)(k0 + kk) * N + n0 + (lane & 31)] * scale; }
    LDS_WAIT(); asm volatile("" ::: "memory");
    const int c = lane & 7;
#pragma unroll
    for (int j = 0; j < 4; ++j) { const int n = (lane >> 3) + 8 * j; const LAS float* s = scr + (8 * c) * 33 + n;
        u32x2 o; o.x = pg8::pk4_fp8(s[0 * 33], s[1 * 33], s[2 * 33], s[3 * 33]); o.y = pg8::pk4_fp8(s[4 * 33], s[5 * 33], s[6 * 33], s[7 * 33]);
        *(u32x2*)(WT + (size_t)rm(n0 + n) * ldk + k0 + 8 * c) = o; }
    LDS_WAIT(); asm volatile("" ::: "memory");
}
struct RmId { __device__ __forceinline__ int operator()(int n) const { return n; } };
struct RmWinE { __device__ __forceinline__ int operator()(int n) const {
    if (n < 2048) return n; if (n < 2064) return PC_GT + (n - 2048); if (n < 2320) return PC_QA + (n - 2064); if (n < 2448) return PC_KVA + (n - 2320); return PC_KR + (n - 2448); } };
struct RmGu { __device__ __forceinline__ int operator()(int n) const { const int u = n & 1023; return 256 * (u >> 7) + (n >> 10) * 128 + (u & 127); } };

__device__ __forceinline__ void ld_row16(const float* p, int lane, f32x4 (&v)[4]) {
#pragma unroll
    for (int j = 0; j < 4; ++j) v[j] = *(const f32x4*)(p + 4 * lane + 256 * j);
}
struct Frame { LAS unsigned char* lds; int tid, lane, wave, G, bid; };
extern __shared__ __attribute__((aligned(16))) unsigned char lds_raw[];
#define MK_FRAME(F) Frame F; { int tz_ = threadIdx.x; asm volatile("" : "+v"(tz_)); \
    int g_ = gridDim.x, b_ = blockIdx.x; asm volatile("" : "+s"(g_), "+s"(b_)); \
    F.lds = (LAS unsigned char*)lds_raw; F.tid = tz_; F.lane = tz_ & 63; F.wave = __builtin_amdgcn_readfirstlane(tz_ >> 6); F.G = g_; F.bid = b_; }
typedef const __attribute__((address_space(4))) Args* CArgsP;
__device__ __forceinline__ const Args& fresh_args() { unsigned long long p = (unsigned long long)__builtin_amdgcn_kernarg_segment_ptr(); asm volatile("" : "+s"(p)); return *(const Args*)(CArgsP)p; }
__device__ __forceinline__ ARGAS unsigned char* opaque_ws(const ARGAS unsigned char* p) { unsigned long long v = (unsigned long long)p; asm volatile("" : "+s"(v)); return (ARGAS unsigned char*)v; }

__device__ __forceinline__ void p0_prologue(const Args& a) {
    MK_FRAME(F); ARGAS unsigned char* ws = opaque_ws(a.ws);
    {
        LAS float* cs = (LAS float*)(F.lds); LAS float* red = (LAS float*)(F.lds + 32768);
        for (int i = F.tid; i < NBATCH * DM; i += 512) cs[i] = siluf_(a.c[i]);
        __syncthreads();
        float* mod = (float*)(ws + WS_MOD);
        for (int it = F.bid; it < DEPTH * 48; it += F.G) {
            const int l = it / 48, n = (it % 48) * 128 + (F.tid & 127), ksl = F.tid >> 7;
            const float* w = a.ada_w + ((size_t)l * DM + ksl * 256) * 6144 + n;
            float acc[NBATCH];
#pragma unroll
            for (int b = 0; b < NBATCH; ++b) acc[b] = 0.f;
#pragma unroll 4
            for (int k = 0; k < 256; ++k) { const float wv = w[(size_t)k * 6144];
#pragma unroll
                for (int b = 0; b < NBATCH; ++b) acc[b] += cs[b * DM + ksl * 256 + k] * wv; }
#pragma unroll
            for (int b = 0; b < NBATCH; ++b) red[(ksl * NBATCH + b) * 128 + (F.tid & 127)] = acc[b];
            __syncthreads();
            for (int o = F.tid; o < NBATCH * 128; o += 512) { const int b = o >> 7, nn = o & 127;
                const float s = red[(0 * NBATCH + b) * 128 + nn] + red[(1 * NBATCH + b) * 128 + nn] + red[(2 * NBATCH + b) * 128 + nn] + red[(3 * NBATCH + b) * 128 + nn];
                const int col = (it % 48) * 128 + nn;
                mod[((size_t)l * NBATCH + b) * 6144 + col] = s + a.ada_b[(size_t)l * 6144 + col]; }
            __syncthreads();
        }
        __syncthreads();
    }
    {
        f32x2* ro = (f32x2*)(ws + WS_ROPEO); f32x2* re = (f32x2*)(ws + WS_ROPEE);
        const size_t gt = (size_t)F.bid * 512 + F.tid, GT = (size_t)F.G * 512;
        for (size_t i = gt; i < (size_t)NTOK * 128; i += GT) { const int tok = (int)(i >> 7), f = (int)(i & 127);
            const float inv = powf(10000.f, -(float)(2 * f) / 256.f); const float ang = (float)a.pos[tok] * inv; float s, c; sincosf(ang, &s, &c); ro[i] = (f32x2){c, s}; }
        for (size_t i = gt; i < (size_t)NTOK * 16; i += GT) { const int tok = (int)(i >> 4), f = (int)(i & 15);
            const float inv = powf(10000.f, -(float)(2 * f) / 32.f); const float ang = (float)a.pos[tok] * inv; float s, c; sincosf(ang, &s, &c); re[i] = (f32x2){c, s}; }
        bf16_t* wkv = (bf16_t*)(ws + WS_WKVB);
        for (size_t i = gt; i < (size_t)2 * 1024 * 16; i += GT) { const size_t row = i >> 4, ch = i & 15; *(u32x4*)(wkv + row * 256 + 128 + ch * 8) = (u32x4){0u, 0u, 0u, 0u}; }
    }
    {
        LAS float* scr = (LAS float*)(F.lds + F.wave * 16384);
        const int gw = F.bid * 8 + F.wave, NGW = F.G * 8;
        constexpr int I_WINE = 16 * 78, I_WQB = 4 * 24, I_WKVB = 2 * 32, I_WOUTE = 16 * 32, I_WINO = 16 * 192, I_WOUTO = 32 * 32, I_WGU = 16 * 64, I_WDN = 16 * 32;
        constexpr int T0 = 2 * I_WINE, T1 = T0 + 2 * I_WQB, T2 = T1 + 2 * I_WKVB, T3 = T2 + 2 * I_WOUTE, T4 = T3 + 2 * I_WINO, T5 = T4 + 2 * I_WOUTO, T6 = T5 + 128 * I_WGU, T7 = T6 + 128 * I_WDN;
        for (int it = gw; it < T7; it += NGW) {
            if (it < T0) { const int m = it / I_WINE, r = it % I_WINE, kb = r / 78, nb = r % 78;
                const float* W = a.hy_w_in + (size_t)m * DM * EVEN_IN; bf16_t* WT = (bf16_t*)(ws + WS_WINE) + (size_t)m * EVEN_INP * DM;
                const int k0 = 64 * kb, n0 = 32 * nb; const RmWinE rm;
#pragma unroll 8
                for (int i = 0; i < 32; ++i) { const int kk = 2 * i + (F.lane >> 5), n = n0 + (F.lane & 31); scr[kk * 33 + (F.lane & 31)] = (n < EVEN_IN) ? W[(size_t)(k0 + kk) * EVEN_IN + n] : 0.f; }
                LDS_WAIT(); asm volatile("" ::: "memory");
                const int c = F.lane & 7;
#pragma unroll
                for (int j = 0; j < 4; ++j) { const int n = (F.lane >> 3) + 8 * j; const LAS float* s = scr + (8 * c) * 33 + n;
                    u32x4 o; o.x = cvt_pk_bf16(s[0 * 33], s[1 * 33]); o.y = cvt_pk_bf16(s[2 * 33], s[3 * 33]); o.z = cvt_pk_bf16(s[4 * 33], s[5 * 33]); o.w = cvt_pk_bf16(s[6 * 33], s[7 * 33]);
                    if (n0 + n < EVEN_IN) *(u32x4*)(WT + (size_t)rm(n0 + n) * DM + k0 + 8 * c) = o; }
                LDS_WAIT(); asm volatile("" ::: "memory");
                continue; }
            if (it < T1) { const int q = it - T0, m = q / I_WQB, r = q % I_WQB; transpose_item(a.mla_w_qb + (size_t)m * 256 * 768, 768, (bf16_t*)(ws + WS_WQB) + (size_t)m * 768 * 256, 256, scr, r / 24, r % 24, F.lane, RmId()); continue; }
            if (it < T2) { const int q = it - T1, m = q / I_WKVB, r = q % I_WKVB; transpose_item(a.mla_w_kvb + (size_t)m * 128 * 1024, 1024, (bf16_t*)(ws + WS_WKVB) + (size_t)m * 1024 * 256, 256, scr, r / 32, r % 32, F.lane, RmId()); continue; }
            if (it < T3) { const int q = it - T2, m = q / I_WOUTE, r = q % I_WOUTE; transpose_item(a.hy_w_out + (size_t)m * DM * DM, DM, (bf16_t*)(ws + WS_WOUTE) + (size_t)m * DM * DM, DM, scr, r / 32, r % 32, F.lane, RmId()); continue; }
            if (it < T4) { const int q = it - T3, m = q / I_WINO, r = q % I_WINO; transpose_item(a.ret_w_in + (size_t)m * DM * RET_IN, RET_IN, (bf16_t*)(ws + WS_WINO) + (size_t)m * RET_IN * DM, DM, scr, r / 192, r % 192, F.lane, RmId()); continue; }
            if (it < T5) { const int q = it - T4, m = q / I_WOUTO, r = q % I_WOUTO; transpose_item(a.ret_w_out + (size_t)m * 2048 * DM, DM, (bf16_t*)(ws + WS_WOUTO) + (size_t)m * DM * 2048, 2048, scr, r / 32, r % 32, F.lane, RmId()); continue; }
            if (it < T6) { const int q = it - T5, m = q / I_WGU, r = q % I_WGU; transpose_item8(a.moe_w_gu + (size_t)m * DM * 2048, 2048, (unsigned char*)(ws + WS_WGU) + (size_t)m * 2048 * DM, DM, scr, r / 64, r % 64, F.lane, RmGu(), FP8_WSC); continue; }
            { const int q = it - T6, m = q / I_WDN, r = q % I_WDN; transpose_item8(a.moe_w_down + (size_t)m * EFF * DM, DM, (unsigned char*)(ws + WS_WDN) + (size_t)m * DM * EFF, EFF, scr, r / 32, r % 32, F.lane, RmId(), FP8_WSC); }
        }
    }
}

__device__ __forceinline__ void build_pstart(const Frame& F, const unsigned* cnt) {
    LAS int* ps = (LAS int*)(F.lds + LT_PSTART); LAS int* lc = (LAS int*)(F.lds + LT_CNT); LAS int* blk = (LAS int*)(F.lds + LT_BLK);
    __syncthreads();
    if (F.tid < 64) {
        const int e = F.tid & 31; const int c = (int)xb_ld((gbar_t)cnt + e); const int pad = (c + 255) & ~255;
        int incl = pad;
#pragma unroll
        for (int o = 1; o < 32; o <<= 1) { const int t = sh_fromi(incl, (e >= o) ? F.tid - o : F.tid); if (e >= o) incl += t; }
        if (F.tid < 32) { ps[e] = incl - pad; lc[e] = c; if (e == 31) ps[32] = incl; }
    }
    __syncthreads();
    const int nblk = ps[32] >> 8;
    for (int g = F.tid; g < nblk; g += 512) { int e = 0;
#pragma unroll
        for (int s = 16; s >= 1; s >>= 1) if (e + s < 32 && (ps[e + s] >> 8) <= g) e += s;
        blk[2 * g] = e; blk[2 * g + 1] = g - (ps[e] >> 8); }
    __syncthreads();
}

__device__ __forceinline__ void n1_phase(const Args& a, int layer, bool final_only) {
    MK_FRAME(F); ARGAS unsigned char* ws = opaque_ws(a.ws);
    const float* mod = (const float*)(ws + WS_MOD);
    const bool combine = layer > 0;
    const float* xsrc = (layer == 0) ? a.x : a.out;
    const int* toke = (const int*)(ws + WS_TOKE); const int* tokr = toke + NTOK * 4;
    const bf16_t* Y = (const bf16_t*)(ws + WS_Y);
    bf16_t* HM = (bf16_t*)(ws + WS_HM);
    LAS int* ps = (LAS int*)(F.lds + LT_PSTART);
    if (combine) build_pstart(F, (const unsigned*)(ws + WS_CTL) + CW_CNT + 64 * (layer - 1));
    const float* gmix = a.norm_mix_g + (size_t)(final_only ? 0 : layer) * DM;
    for (int tok = F.bid * 8 + F.wave; tok < NTOK; tok += F.G * 8) {
        const int b = tok >> 12;
        f32x4 v[4]; ld_row16(xsrc + (size_t)tok * DM, F.lane, v);
        if (combine) {
            const float* g2 = mod + ((size_t)(layer - 1) * NBATCH + b) * 6144 + 5 * DM;
            f32x4 ysum[4];
#pragma unroll
            for (int j = 0; j < 4; ++j) ysum[j] = (f32x4){0.f, 0.f, 0.f, 0.f};
#pragma unroll
            for (int k = 0; k < 4; ++k) { const int e = toke[tok * 4 + k], r = tokr[tok * 4 + k]; const size_t slot = (size_t)ps[e] + r;
                const bf16_t* yr = Y + slot * DM + 4 * F.lane;
#pragma unroll
                for (int j = 0; j < 4; ++j) { const u32x2 w = *(const u32x2*)(yr + 256 * j); ysum[j][0] += bf_lo(w.x); ysum[j][1] += bf_hi(w.x); ysum[j][2] += bf_lo(w.y); ysum[j][3] += bf_hi(w.y); } }
#pragma unroll
            for (int j = 0; j < 4; ++j) { const f32x4 g = *(const f32x4*)(g2 + 4 * F.lane + 256 * j); v[j] = v[j] + g * ysum[j]; *(f32x4*)(a.out + (size_t)tok * DM + 4 * F.lane + 256 * j) = v[j]; }
        }
        if (final_only) continue;
        float ss = 0.f;
#pragma unroll
        for (int j = 0; j < 4; ++j) ss += v[j][0] * v[j][0] + v[j][1] * v[j][1] + v[j][2] * v[j][2] + v[j][3] * v[j][3];
        const float inv = rsqrtf(wave_sum(ss, F.lane) * (1.f / DM) + EPS);
        const float* sh = mod + ((size_t)layer * NBATCH + b) * 6144; const float* sc = sh + DM;
#pragma unroll
        for (int j = 0; j < 4; ++j) { const int c0 = 4 * F.lane + 256 * j; const f32x4 g = *(const f32x4*)(gmix + c0), s1 = *(const f32x4*)(sc + c0), s0 = *(const f32x4*)(sh + c0);
            const f32x4 h = v[j] * inv * g * (s1 + 1.f) + s0;
            u32x2 o; o.x = cvt_pk_bf16(h[0], h[1]); o.y = cvt_pk_bf16(h[2], h[3]); *(u32x2*)(HM + (size_t)tok * DM + c0) = o; }
    }
}

__device__ __forceinline__ void e2_phase(const Args& a, int j) {
    MK_FRAME(F); ARGAS unsigned char* ws = opaque_ws(a.ws);
    const bf16_t* P = (const bf16_t*)(ws + WS_P);
    bf16_t* QC = (bf16_t*)(ws + X1_QC); bf16_t* KC = (bf16_t*)(ws + X1_KC); bf16_t* QA = (bf16_t*)(ws + X1_QA); bf16_t* KVA = (bf16_t*)(ws + X1_KVA);
    const float* cw = a.ml_conv_w + (size_t)j * 5 * 1024; const float* cb = a.ml_conv_b + (size_t)j * 1024;
    const float* qg = a.mla_q_norm_g + (size_t)j * 256; const float* kvg = a.mla_kv_norm_g + (size_t)j * 128;
    {
        float* ALPHA = (float*)(ws + WS_MISC); float* BETA = ALPHA + 2 * 32 * SEQ; float* MG = BETA + 2 * 32 * SEQ;
        LAS float* redm = (LAS float*)(F.lds);
        for (int u = F.bid; u < 64; u += F.G) {
            const int dir = u >> 5, bh = u & 31, b = bh >> 2, h = bh & 3;
            const float bi = a.ml_gate_b[j * 16 + (2 * dir) * 4 + h], bfg = a.ml_gate_b[j * 16 + (2 * dir + 1) * 4 + h];
            float li[8], lf[8];
#pragma unroll
            for (int i = 0; i < 8; ++i) { const size_t row = (size_t)b * SEQ + 8 * F.tid + i;
                li[i] = bf2f(P[row * EVEN_INP + PC_GT + (2 * dir) * 4 + h]) + bi;
                const float xf = bf2f(P[row * EVEN_INP + PC_GT + (2 * dir + 1) * 4 + h]) + bfg;
                lf[i] = fminf(xf, 0.f) - log1pf(__expf(-fabsf(xf))); }
            float mx = li[0];
#pragma unroll
            for (int i = 1; i < 8; ++i) mx = fmaxf(mx, li[i]);
            mx = wave_max(mx, F.lane); if (F.lane == 0) redm[F.wave] = mx;
            __syncthreads();
            float M = redm[0];
#pragma unroll
            for (int w = 1; w < 8; ++w) M = fmaxf(M, redm[w]);
            float al[8];
            if (dir == 0) { float s = 0.f;
#pragma unroll
                for (int i = 0; i < 8; ++i) { s += lf[i]; al[i] = s; }
                float tot = s, ex = 0.f;
#pragma unroll
                for (int o = 1; o < 16; o <<= 1) { const float t = sh_from(tot, ((F.lane & 15) >= o) ? F.lane - o : F.lane, F.lane); if ((F.lane & 15) >= o) tot += t; }
                ex = tot - s;
#pragma unroll
                for (int i = 0; i < 8; ++i) al[i] += ex;
            } else { float s = 0.f;
#pragma unroll
                for (int i = 7; i >= 0; --i) { s += lf[i]; al[i] = s; }
                float tot = s, ex = 0.f;
#pragma unroll
                for (int o = 1; o < 16; o <<= 1) { const float t = sh_from(tot, ((F.lane & 15) + o < 16) ? F.lane + o : F.lane, F.lane); if ((F.lane & 15) + o < 16) tot += t; }
                ex = tot - s;
#pragma unroll
                for (int i = 0; i < 8; ++i) al[i] += ex;
            }
            float* ao = ALPHA + ((size_t)dir * 32 + bh) * SEQ + 8 * F.tid; float* bo = BETA + ((size_t)dir * 32 + bh) * SEQ + 8 * F.tid;
            *(f32x4*)(ao) = (f32x4){al[0], al[1], al[2], al[3]}; *(f32x4*)(ao + 4) = (f32x4){al[4], al[5], al[6], al[7]};
            *(f32x4*)(bo) = (f32x4){li[0] - M, li[1] - M, li[2] - M, li[3] - M}; *(f32x4*)(bo + 4) = (f32x4){li[4] - M, li[5] - M, li[6] - M, li[7] - M};
            if (F.tid == 0) MG[dir * 32 + bh] = M;
            __syncthreads();
        }
    }
    for (int tok = F.bid * 8 + F.wave; tok < NTOK; tok += F.G * 8) {
        const int s = tok & (SEQ - 1);
        float aq[8], ak[8];
        { const f32x4 b0 = *(const f32x4*)(cb + 8 * F.lane), b1 = *(const f32x4*)(cb + 8 * F.lane + 4), b2 = *(const f32x4*)(cb + 512 + 8 * F.lane), b3 = *(const f32x4*)(cb + 512 + 8 * F.lane + 4);
#pragma unroll
          for (int i = 0; i < 4; ++i) { aq[i] = b0[i]; aq[4 + i] = b1[i]; ak[i] = b2[i]; ak[4 + i] = b3[i]; } }
#pragma unroll
        for (int t = 0; t < 5; ++t) { const int s2 = s + t - 2;
            if (s2 >= 0 && s2 < SEQ) { const bf16_t* pr = P + (size_t)(tok + t - 2) * EVEN_INP;
                const u32x4 q = *(const u32x4*)(pr + PC_QM + 8 * F.lane), k = *(const u32x4*)(pr + PC_KM + 8 * F.lane);
                const float* wq = cw + t * 1024 + 8 * F.lane; const float* wk = wq + 512;
                const f32x4 wq0 = *(const f32x4*)wq, wq1 = *(const f32x4*)(wq + 4), wk0 = *(const f32x4*)wk, wk1 = *(const f32x4*)(wk + 4);
                aq[0] += bf_lo(q.x) * wq0[0]; aq[1] += bf_hi(q.x) * wq0[1]; aq[2] += bf_lo(q.y) * wq0[2]; aq[3] += bf_hi(q.y) * wq0[3];
                aq[4] += bf_lo(q.z) * wq1[0]; aq[5] += bf_hi(q.z) * wq1[1]; aq[6] += bf_lo(q.w) * wq1[2]; aq[7] += bf_hi(q.w) * wq1[3];
                ak[0] += bf_lo(k.x) * wk0[0]; ak[1] += bf_hi(k.x) * wk0[1]; ak[2] += bf_lo(k.y) * wk0[2]; ak[3] += bf_hi(k.y) * wk0[3];
                ak[4] += bf_lo(k.z) * wk1[0]; ak[5] += bf_hi(k.z) * wk1[1]; ak[6] += bf_lo(k.w) * wk1[2]; ak[7] += bf_hi(k.w) * wk1[3]; } }
        constexpr float KS = 0.08838834764831845f;
#pragma unroll
        for (int i = 0; i < 8; ++i) { aq[i] = siluf_(aq[i]); ak[i] = siluf_(ak[i]) * KS; }
        u32x4 oq, ok; oq.x = cvt_pk_bf16(aq[0], aq[1]); oq.y = cvt_pk_bf16(aq[2], aq[3]); oq.z = cvt_pk_bf16(aq[4], aq[5]); oq.w = cvt_pk_bf16(aq[6], aq[7]);
        ok.x = cvt_pk_bf16(ak[0], ak[1]); ok.y = cvt_pk_bf16(ak[2], ak[3]); ok.z = cvt_pk_bf16(ak[4], ak[5]); ok.w = cvt_pk_bf16(ak[6], ak[7]);
        *(u32x4*)(QC + (size_t)tok * 512 + 8 * F.lane) = oq; *(u32x4*)(KC + (size_t)tok * 512 + 8 * F.lane) = ok;
        const bf16_t* pr = P + (size_t)tok * EVEN_INP;
        { const u32x2 w = *(const u32x2*)(pr + PC_QA + 4 * F.lane); const float x0 = bf_lo(w.x), x1 = bf_hi(w.x), x2 = bf_lo(w.y), x3 = bf_hi(w.y);
          const float inv = rsqrtf(wave_sum(x0 * x0 + x1 * x1 + x2 * x2 + x3 * x3, F.lane) * (1.f / 256.f) + EPS); const f32x4 g = *(const f32x4*)(qg + 4 * F.lane);
          u32x2 o; o.x = cvt_pk_bf16(x0 * inv * g[0], x1 * inv * g[1]); o.y = cvt_pk_bf16(x2 * inv * g[2], x3 * inv * g[3]); *(u32x2*)(QA + (size_t)tok * 256 + 4 * F.lane) = o; }
        { const unsigned w = *(const unsigned*)(pr + PC_KVA + 2 * F.lane); const float x0 = bf_lo(w), x1 = bf_hi(w);
          const float inv = rsqrtf(wave_sum(x0 * x0 + x1 * x1, F.lane) * (1.f / 128.f) + EPS); const f32x2 g = *(const f32x2*)(kvg + 2 * F.lane);
          *(unsigned*)(KVA + (size_t)tok * 256 + 2 * F.lane) = cvt_pk_bf16(x0 * inv * g[0], x1 * inv * g[1]); *(unsigned*)(KVA + (size_t)tok * 256 + 128 + 2 * F.lane) = 0u; }
    }
}

__device__ __forceinline__ void e4_phase(const Args& a, int j) {
    MK_FRAME(F); ARGAS unsigned char* ws = opaque_ws(a.ws);
    const bf16_t* P = (const bf16_t*)(ws + WS_P); const bf16_t* QRAW = (const bf16_t*)(ws + X1_QRAW); const bf16_t* KVRAW = (const bf16_t*)(ws + X1_KVRAW);
    bf16_t* QH = (bf16_t*)(ws + X1_QH); bf16_t* KH = (bf16_t*)(ws + X1_KH); bf16_t* VH = (bf16_t*)(ws + X1_VH);
    const f32x2* re = (const f32x2*)(ws + WS_ROPEE);
    const float* gq = a.mla_qk_q_g + (size_t)j * 96; const float* gk = a.mla_qk_k_g + (size_t)j * 96;
    const int h = F.lane >> 3, part = F.lane & 7;
    for (int tok = F.bid * 8 + F.wave; tok < NTOK; tok += F.G * 8) {
        const int b = tok >> 12, s = tok & (SEQ - 1);
        const f32x4 cs = *(const f32x4*)(re + (size_t)tok * 16 + 2 * part);
        const size_t hrow = ((size_t)(b * 8 + h)) * SEQ + s;
#pragma unroll
        for (int qk = 0; qk < 2; ++qk) {
            float v[12]; u32x4 w; unsigned w1, w2;
            if (qk == 0) { const bf16_t* src = QRAW + (size_t)tok * 768 + h * 96; w = *(const u32x4*)(src + 8 * part); w1 = *(const unsigned*)(src + 64 + 2 * part); w2 = *(const unsigned*)(src + 80 + 2 * part); }
            else { w = *(const u32x4*)(KVRAW + (size_t)tok * 1024 + h * 128 + 8 * part); const bf16_t* kr = P + (size_t)tok * EVEN_INP + PC_KR; w1 = *(const unsigned*)(kr + 2 * part); w2 = *(const unsigned*)(kr + 16 + 2 * part); }
            v[0] = bf_lo(w.x); v[1] = bf_hi(w.x); v[2] = bf_lo(w.y); v[3] = bf_hi(w.y); v[4] = bf_lo(w.z); v[5] = bf_hi(w.z); v[6] = bf_lo(w.w); v[7] = bf_hi(w.w);
            v[8] = bf_lo(w1); v[9] = bf_hi(w1); v[10] = bf_lo(w2); v[11] = bf_hi(w2);
            float ss = 0.f;
#pragma unroll
            for (int i = 0; i < 12; ++i) ss += v[i] * v[i];
            ss += shx(ss, 1, F.lane); ss += shx(ss, 2, F.lane); ss += shx(ss, 4, F.lane);
            const float inv = rsqrtf(ss * (1.f / 96.f) + EPS);
            const float* g = qk == 0 ? gq : gk;
            const f32x4 g0 = *(const f32x4*)(g + 8 * part), g1 = *(const f32x4*)(g + 8 * part + 4); const f32x2 ga = *(const f32x2*)(g + 64 + 2 * part), gb = *(const f32x2*)(g + 80 + 2 * part);
            v[0] *= inv * g0[0]; v[1] *= inv * g0[1]; v[2] *= inv * g0[2]; v[3] *= inv * g0[3]; v[4] *= inv * g1[0]; v[5] *= inv * g1[1]; v[6] *= inv * g1[2]; v[7] *= inv * g1[3];
            const float x10 = v[8] * inv * ga[0], x11 = v[9] * inv * ga[1], x20 = v[10] * inv * gb[0], x21 = v[11] * inv * gb[1];
            const float o10 = x10 * cs[0] - x20 * cs[1], o20 = x20 * cs[0] + x10 * cs[1], o11 = x11 * cs[2] - x21 * cs[3], o21 = x21 * cs[2] + x11 * cs[3];
            u32x4 o; o.x = cvt_pk_bf16(v[0], v[1]); o.y = cvt_pk_bf16(v[2], v[3]); o.z = cvt_pk_bf16(v[4], v[5]); o.w = cvt_pk_bf16(v[6], v[7]);
            bf16_t* dst = qk == 0 ? QH + hrow * 96 : KH + hrow * 128;
            *(u32x4*)(dst + 8 * part) = o; *(unsigned*)(dst + 64 + 2 * part) = cvt_pk_bf16(o10, o11); *(unsigned*)(dst + 80 + 2 * part) = cvt_pk_bf16(o20, o21);
            if (qk == 1) { *(u32x2*)(dst + 96 + 4 * part) = (u32x2){0u, 0u}; }
        }
        *(u32x4*)(VH + hrow * 64 + 8 * part) = *(const u32x4*)(KVRAW + (size_t)tok * 1024 + h * 128 + 64 + 8 * part);
    }
}
__device__ __forceinline__ void n2_phase(const Args& a, int layer) {
    MK_FRAME(F); ARGAS unsigned char* ws = opaque_ws(a.ws);
    const float* mod = (const float*)(ws + WS_MOD);
    unsigned char* HF8 = (unsigned char*)(ws + WS_HM);
    int* LIST = (int*)(ws + WS_LIST); float* WLIST = (float*)(ws + WS_WLIST); int* toke = (int*)(ws + WS_TOKE); int* tokr = toke + NTOK * 4;
    unsigned* gcnt = (unsigned*)(ws + WS_CTL) + CW_CNT + 64 * layer;
    LAS float* rwT = (LAS float*)(F.lds);
    LAS int* te = (LAS int*)(F.lds + LT_X); LAS int* tlr = te + 512; LAS float* tw = (LAS float*)(tlr + 512); LAS int* hist = (LAS int*)(tw + 512); LAS int* base = hist + 32;
    const float* rw = a.moe_router_w + (size_t)layer * DM * NEXP; const float* rbias = a.moe_router_b + (size_t)layer * NEXP;
    const float* gffn = a.norm_ffn_g + (size_t)layer * DM;
    __syncthreads();
    for (int i4 = F.tid; i4 < DM * NEXP / 4; i4 += 512) { const f32x4 v = *(const f32x4*)(rw + 4 * i4); const int k = i4 >> 3, e0 = (i4 & 7) * 4;
        rwT[(e0 + 0) * DM + k] = v[0]; rwT[(e0 + 1) * DM + k] = v[1]; rwT[(e0 + 2) * DM + k] = v[2]; rwT[(e0 + 3) * DM + k] = v[3]; }
    if (F.tid < 32) hist[F.tid] = 0;
    __syncthreads();
    const int myexp = F.lane; const float mybias = F.lane < 32 ? rbias[F.lane] : 0.f;
#pragma unroll 1
    for (int grp = F.bid; grp < NTOK / 128; grp += F.G) {
#pragma unroll 1
        for (int q = 0; q < 8; ++q) {
            const int ti0 = F.wave * 16 + q * 2;
            const int tok0 = grp * 128 + ti0; const int b = tok0 >> 12;
            const float* sh = mod + ((size_t)layer * NBATCH + b) * 6144 + 3 * DM; const float* sc = sh + DM;
            f32x4 hf[2][4];
#pragma unroll
            for (int t = 0; t < 2; ++t) {
                f32x4 v[4]; ld_row16(a.out + (size_t)(tok0 + t) * DM, F.lane, v);
                float ss = 0.f;
#pragma unroll
                for (int j = 0; j < 4; ++j) ss += v[j][0] * v[j][0] + v[j][1] * v[j][1] + v[j][2] * v[j][2] + v[j][3] * v[j][3];
                const float inv = rsqrtf(wave_sum(ss, F.lane) * (1.f / DM) + EPS);
#pragma unroll
                for (int j = 0; j < 4; ++j) { const int c0 = 4 * F.lane + 256 * j; const f32x4 g = *(const f32x4*)(gffn + c0), s1 = *(const f32x4*)(sc + c0), s0 = *(const f32x4*)(sh + c0);
                    const f32x4 h = v[j] * inv * g * (s1 + 1.f) + s0; hf[t][j] = h;
                    *(unsigned*)(HF8 + (size_t)(tok0 + t) * DM + c0) = pg8::pk4_fp8(h[0] * FP8_HSC, h[1] * FP8_HSC, h[2] * FP8_HSC, h[3] * FP8_HSC); }
            }
            float lg0 = -3.0e38f, lg1 = -3.0e38f;
#pragma unroll 1
            for (int e = 0; e < 32; ++e) {
                float d0 = 0.f, d1 = 0.f;
#pragma unroll
                for (int j = 0; j < 4; ++j) { const f32x4 wv = *(const LAS f32x4*)(rwT + e * DM + 4 * F.lane + 256 * j);
                    d0 += hf[0][j][0] * wv[0] + hf[0][j][1] * wv[1] + hf[0][j][2] * wv[2] + hf[0][j][3] * wv[3];
                    d1 += hf[1][j][0] * wv[0] + hf[1][j][1] * wv[1] + hf[1][j][2] * wv[2] + hf[1][j][3] * wv[3]; }
                d0 = wave_sum(d0, F.lane); d1 = wave_sum(d1, F.lane);
                if (F.lane == e) { lg0 = d0; lg1 = d1; }
            }
#pragma unroll
            for (int t = 0; t < 2; ++t) {
                float logit = (t == 0 ? lg0 : lg1) + mybias;
                float tv[4]; int tix[4];
#pragma unroll
                for (int k = 0; k < 4; ++k) { float v = logit; int ix = myexp;
#pragma unroll
                    for (int m = 1; m < 64; m <<= 1) { const float ov = shx(v, m, F.lane); const int oi = shxi(ix, m, F.lane); if (ov > v || (ov == v && oi < ix)) { v = ov; ix = oi; } }
                    tv[k] = v; tix[k] = ix; if (myexp == ix) logit = -3.0e38f; }
                const float e1 = __expf(tv[1] - tv[0]), e2 = __expf(tv[2] - tv[0]), e3 = __expf(tv[3] - tv[0]); const float rs = 1.f / (1.f + e1 + e2 + e3);
                if (F.lane < 4) { const int ex = F.lane == 0 ? tix[0] : F.lane == 1 ? tix[1] : F.lane == 2 ? tix[2] : tix[3];
                    const float wk = (F.lane == 0 ? 1.f : F.lane == 1 ? e1 : F.lane == 2 ? e2 : e3) * rs;
                    const int lr = __hip_atomic_fetch_add(hist + ex, 1, __ATOMIC_RELAXED, __HIP_MEMORY_SCOPE_WORKGROUP);
                    const int pidx = (ti0 + t) * 4 + F.lane; te[pidx] = ex; tlr[pidx] = lr; tw[pidx] = wk; }
            }
        }
        __syncthreads();
        if (F.tid < 32) { const int h = hist[F.tid]; base[F.tid] = h > 0 ? (int)xb_add((gbar_t)gcnt + F.tid, (unsigned)h) : 0; }
        __syncthreads();
        { const int p = F.tid; const int e = te[p], rank = base[e] + tlr[p]; const int tok = grp * 128 + (p >> 2);
          LIST[(size_t)e * NSLOT + rank] = tok; WLIST[(size_t)e * NSLOT + rank] = tw[p]; toke[tok * 4 + (p & 3)] = e; tokr[tok * 4 + (p & 3)] = rank; }
        __syncthreads();
        if (F.tid < 32) hist[F.tid] = 0;
        __syncthreads();
    }
}

__device__ __forceinline__ void m1_phase(const Args& a, int layer) {
    MK_FRAME(F); ARGAS unsigned char* ws = opaque_ws(a.ws);
    build_pstart(F, (const unsigned*)(ws + WS_CTL) + CW_CNT + 64 * layer);
    LAS int* ps = (LAS int*)(F.lds + LT_PSTART); LAS int* lc = (LAS int*)(F.lds + LT_CNT); LAS int* blk = (LAS int*)(F.lds + LT_BLK);
    const unsigned char* HF8 = (const unsigned char*)(ws + WS_HM); unsigned char* AS = (unsigned char*)(ws + WS_ASORT); float* WS_ = (float*)(ws + WS_WSORT);
    const int* LIST = (const int*)(ws + WS_LIST); const float* WLIST = (const float*)(ws + WS_WLIST);
    const int total = ps[32];
    for (int r = F.bid * 8 + F.wave; r < total; r += F.G * 8) {
        const int g = r >> 8, e = blk[2 * g], rank = blk[2 * g + 1] * 256 + (r & 255); const bool valid = rank < lc[e];
        u32x4 v0 = (u32x4){0u, 0u, 0u, 0u}; float w = 0.f;
        if (valid) { const int tok = LIST[(size_t)e * NSLOT + rank]; w = WLIST[(size_t)e * NSLOT + rank];
            v0 = *(const u32x4*)(HF8 + (size_t)tok * DM + 16 * F.lane); }
        *(u32x4*)(AS + (size_t)r * DM + 16 * F.lane) = v0;
        if (F.lane == 0) WS_[r] = w;
    }
}

struct MoeSched {
    const LAS int* blk; const char* A; const char* W; size_t wstride, tile_bytes; int ntile, nunits, G, c;
    __device__ __forceinline__ bool next(int i, pg8::Unit& u) const {
        int g, pn;
        if (G == 256) {
            const int x = c & 7, slot = c >> 3, rpr = 256 / ntile;
            g = i * rpr + 8 * (ntile == 8 ? (x >> 1) : x) + (slot & 7); pn = (ntile == 8 ? 4 * (x & 1) : 0) + (slot >> 3);
            if (g * ntile >= nunits) return false;
        } else { const long L = (long)i * G + c; if (L >= nunits) return false; g = (int)L / ntile; pn = (int)L % ntile; }
        const int e = __builtin_amdgcn_readfirstlane(blk[2 * g]);
        u.pm = g; u.pn = pn; u.aux = e; u.A = A + (size_t)g * tile_bytes; u.B = W + (size_t)e * wstride + (size_t)pn * tile_bytes; return true;
    }
};
struct MlaSched {
    const char* QA; const char* KVA; const char* Wq; const char* Wkv; int G, c;
    __device__ __forceinline__ bool next(int i, pg8::Unit& u) const {
        const long L = (long)i * G + c; if (L >= 128 * 7) return false;
        const int pm = (int)L / 7, t = (int)L % 7;
        u.pm = pm; if (t < 3) { u.pn = t; u.aux = 0; u.A = QA + (size_t)pm * 256 * 256 * 2; u.B = Wq + (size_t)t * 256 * 256 * 2; }
        else { u.pn = t - 3; u.aux = 1; u.A = KVA + (size_t)pm * 256 * 256 * 2; u.B = Wkv + (size_t)(t - 3) * 256 * 256 * 2; }
        return true;
    }
};

constexpr int NPHASE = 50;
#define IN(k) (lo <= (k) && (k) < hi)
#ifndef PROBE_MASK
#define PROBE_MASK 0
#endif
#define REP(k) for (int rep_ = 0; rep_ < ((PROBE_MASK >> (k)) & 1) + 1; ++rep_)
#define GRID_BAR() do { if (fused) { xcd_barrier((gbar_t)(fresh_args().ws + WS_CTL) + CW_BAR, (volatile LAS unsigned*)((LAS unsigned char*)lds_raw + LT_MISC) + 8); } } while (0)
template <int LAYER>
__device__ __forceinline__ void layer_body(const int lo, const int hi, const bool fused) {
    constexpr int layer = LAYER;
        constexpr int pb = 1 + 12 * layer; constexpr bool odd = (layer & 1) != 0; constexpr int j = layer >> 1;
        if (IN(pb + 0)) { n1_phase(fresh_args(), layer, false); GRID_BAR(); }
        REP(1) if (IN(pb + 1)) {
            const Args& a = fresh_args(); MK_FRAME(F); ARGAS unsigned char* ws = opaque_ws(a.ws);
            pg8::StaticSched S; S.A = (const char*)(ws + WS_HM); S.lda = DM; S.ldb = DM; S.nM = NTOK / 256; S.G = F.G; S.c = F.bid;
            pg8::EpiBf16 E; E.O0 = (bf16_t*)(ws + WS_P); E.O1 = E.O0; E.rope = (const GAS f32x2*)(ws + WS_ROPEO); E.qscale = 0.0625f;
            if (!odd) { S.Bt = (const char*)(ws + WS_WINE) + (size_t)j * EVEN_INP * DM * 2; S.nN = EVEN_INP / 256; E.ldc0 = E.ldc1 = EVEN_INP; E.rope_tiles = 0; E.qscale_tiles = 0; }
            else { S.Bt = (const char*)(ws + WS_WINO) + (size_t)j * RET_IN * DM * 2; S.nN = RET_IN / 256; E.ldc0 = E.ldc1 = RET_IN; E.rope_tiles = 8; E.qscale_tiles = 4; }
            pg8::gemm_phase<pg8::EpiBf16, pg8::StaticSched>(F.lds + LDS_RING, pg8::Dims{DM, DM, DM}, S, E);
            GRID_BAR();
        }
        if constexpr (!odd) {
            REP(2) if (IN(pb + 2)) { e2_phase(fresh_args(), j); GRID_BAR(); }
            REP(3) if (IN(pb + 3)) {
                const Args& a = fresh_args(); MK_FRAME(F); ARGAS unsigned char* ws = opaque_ws(a.ws);
                MlaSched S; S.QA = (const char*)(ws + X1_QA); S.KVA = (const char*)(ws + X1_KVA); S.Wq = (const char*)(ws + WS_WQB) + (size_t)j * 768 * 256 * 2; S.Wkv = (const char*)(ws + WS_WKVB) + (size_t)j * 1024 * 256 * 2; S.G = F.G; S.c = F.bid;
                pg8::EpiBf16 E; E.O0 = (bf16_t*)(ws + X1_QRAW); E.O1 = (bf16_t*)(ws + X1_KVRAW); E.ldc0 = 768; E.ldc1 = 1024; E.rope_tiles = 0; E.qscale_tiles = 0; E.qscale = 1.f; E.rope = nullptr;
                pg8::gemm_phase<pg8::EpiBf16, MlaSched>(F.lds + LDS_RING, pg8::Dims{256, 256, 256}, S, E);
                GRID_BAR();
            }
            REP(4) if (IN(pb + 4)) { e4_phase(fresh_args(), j); GRID_BAR(); }
            REP(5) if (IN(pb + 5)) {
                const Args& a = fresh_args(); MK_FRAME(F); ARGAS unsigned char* ws = opaque_ws(a.ws);
                const float* ALPHA = (const float*)(ws + WS_MISC); const float* BETA = ALPHA + 2 * 32 * SEQ;
                for (int u = F.bid; u < 128; u += F.G) {
                    const int bh = u >> 2, dir = (u >> 1) & 1, dvb = u & 1, b = bh >> 2, h = bh & 3;
                    la::StateArgs sa; sa.K = (const bf16_t*)(ws + X1_KC) + (size_t)b * SEQ * 512 + h * 128; sa.ldk = 512;
                    sa.V = (const bf16_t*)(ws + WS_P) + (size_t)b * SEQ * EVEN_INP + PC_VM + h * 128 + dvb * 64; sa.ldv = EVEN_INP;
                    sa.Cout = (bf16_t*)(ws + X1_CM) + ((size_t)(bh * 2 + dir) * 32) * 128 * 128 + dvb * 64; sa.ldc = 128; sa.cstride = 128 * 128;
                    sa.Nout = dvb == 0 ? (float*)(ws + X1_NM) + ((size_t)(bh * 2 + dir) * 32) * 128 : nullptr;
                    sa.alpha = ALPHA + ((size_t)dir * 32 + bh) * SEQ; sa.beta = BETA + ((size_t)dir * 32 + bh) * SEQ; sa.lgam = 0.f; sa.dir = dir;
                    la::state_unit<128, 64, true>(F.lds + LDS_RING, sa);
                }
                __syncthreads();
                unsigned* qh = (unsigned*)(ws + WS_CTL) + CW_QUEUE + 64 * j + 128 * rep_; LAS unsigned* qslot = (LAS unsigned*)(F.lds + LT_MISC) + 16;
                for (;;) {
                    if (F.tid == 0) *qslot = xb_add((gbar_t)qh, 1u);
                    __syncthreads();
                    const unsigned u = *qslot;
                    __syncthreads();
                    if (u >= 1024u) break;
                    const int bh = u >> 4, qb = u & 15, b = bh >> 3, h = bh & 7;
                    att::attn_body((const bf16_t*)(ws + X1_QH) + ((size_t)bh * SEQ + qb * 256) * 96, (const bf16_t*)(ws + X1_KH) + (size_t)bh * SEQ * 128, (const bf16_t*)(ws + X1_VH) + (size_t)bh * SEQ * 64,
                                   (bf16_t*)(ws + WS_MIX) + ((size_t)b * SEQ + qb * 256) * DM + 512 + h * 64, DM, SEQ, (LAS char*)(F.lds + LDS_RING));
                }
                GRID_BAR();
            }
            REP(6) if (IN(pb + 6)) {
                const Args& a = fresh_args(); MK_FRAME(F); ARGAS unsigned char* ws = opaque_ws(a.ws);
                const float* ALPHA = (const float*)(ws + WS_MISC); const float* BETA = ALPHA + 2 * 32 * SEQ; const float* MG = BETA + 2 * 32 * SEQ;
                for (int u = F.bid; u < 1024; u += F.G) {
                    const int bh = u >> 5, c = u & 31, b = bh >> 2, h = bh & 3; const size_t t0 = (size_t)b * SEQ + c * 128;
                    la::OutArgs oa; oa.Q = (const bf16_t*)(ws + X1_QC) + t0 * 512 + h * 128; oa.ldq = 512; oa.K = (const bf16_t*)(ws + X1_KC) + t0 * 512 + h * 128; oa.ldk = 512;
                    oa.V = (const bf16_t*)(ws + WS_P) + t0 * EVEN_INP + PC_VM + h * 128; oa.ldv = EVEN_INP;
                    oa.Cf = (const bf16_t*)(ws + X1_CM) + ((size_t)(bh * 2 + 0) * 32 + c) * 128 * 128; oa.Cb = (const bf16_t*)(ws + X1_CM) + ((size_t)(bh * 2 + 1) * 32 + c) * 128 * 128;
                    oa.Nf = (const float*)(ws + X1_NM) + ((size_t)(bh * 2 + 0) * 32 + c) * 128; oa.Nb = (const float*)(ws + X1_NM) + ((size_t)(bh * 2 + 1) * 32 + c) * 128;
                    oa.af = ALPHA + ((size_t)0 * 32 + bh) * SEQ + c * 128; oa.bfw = BETA + ((size_t)0 * 32 + bh) * SEQ + c * 128; oa.ab = ALPHA + ((size_t)1 * 32 + bh) * SEQ + c * 128; oa.bbw = BETA + ((size_t)1 * 32 + bh) * SEQ + c * 128;
                    oa.Mf = MG[bh]; oa.Mb = MG[32 + bh]; oa.lgf = 0.f; oa.lgb = 0.f;
                    oa.gain = a.ml_norm_g + (size_t)j * 512 + h * 128; oa.G = (const bf16_t*)(ws + WS_P) + t0 * EVEN_INP + PC_OM + h * 128; oa.ldg = EVEN_INP;
                    oa.Out = (bf16_t*)(ws + WS_MIX) + t0 * DM + h * 128; oa.ldo = DM;
                    la::out_unit<128, 128, true>(F.lds + LDS_RING, F.lds + LT_X, oa);
                }
                GRID_BAR();
            }
        } else {
            REP(2) if (IN(pb + 2)) {
                const Args& a = fresh_args(); MK_FRAME(F); ARGAS unsigned char* ws = opaque_ws(a.ws);
                for (int u = F.bid; u < 256; u += F.G) {
                    const int bh = u >> 3, dir = (u >> 2) & 1, dvb = u & 3, b = bh >> 2, h = bh & 3;
                    const float dl = (dir ? a.ret_decay_b : a.ret_decay_f)[j * 4 + h];
                    la::StateArgs sa; sa.K = (const bf16_t*)(ws + WS_P) + (size_t)b * SEQ * RET_IN + 1024 + h * 256; sa.ldk = RET_IN;
                    sa.V = (const bf16_t*)(ws + WS_P) + (size_t)b * SEQ * RET_IN + 2048 + h * 512 + dvb * 128; sa.ldv = RET_IN;
                    sa.Cout = (bf16_t*)(ws + WS_X1) + ((size_t)(bh * 2 + dir) * 32) * 256 * 512 + dvb * 128; sa.ldc = 512; sa.cstride = 256 * 512; sa.Nout = nullptr;
                    sa.alpha = nullptr; sa.beta = nullptr; sa.lgam = fminf(dl, 0.f) - log1pf(__expf(-fabsf(dl))); sa.dir = dir;
                    la::state_unit<256, 128, false>(F.lds + LDS_RING, sa);
                }
                GRID_BAR();
            }
            REP(3) if (IN(pb + 3)) {
                const Args& a = fresh_args(); MK_FRAME(F); ARGAS unsigned char* ws = opaque_ws(a.ws);
                for (int u = F.bid; u < 1024; u += F.G) {
                    const int bh = u >> 5, c = u & 31, b = bh >> 2, h = bh & 3; const size_t t0 = (size_t)b * SEQ + c * 128;
                    const bf16_t* R = (const bf16_t*)(ws + WS_P) + t0 * RET_IN;
                    const float dlf = a.ret_decay_f[j * 4 + h], dlb = a.ret_decay_b[j * 4 + h];
                    la::OutArgs oa; oa.Q = R + h * 256; oa.ldq = RET_IN; oa.K = R + 1024 + h * 256; oa.ldk = RET_IN; oa.V = R + 2048 + h * 512; oa.ldv = RET_IN;
                    oa.Cf = (const bf16_t*)(ws + WS_X1) + ((size_t)(bh * 2 + 0) * 32 + c) * 256 * 512; oa.Cb = (const bf16_t*)(ws + WS_X1) + ((size_t)(bh * 2 + 1) * 32 + c) * 256 * 512;
                    oa.Nf = nullptr; oa.Nb = nullptr; oa.af = oa.bfw = oa.ab = oa.bbw = nullptr; oa.Mf = 0.f; oa.Mb = 0.f;
                    oa.lgf = fminf(dlf, 0.f) - log1pf(__expf(-fabsf(dlf))); oa.lgb = fminf(dlb, 0.f) - log1pf(__expf(-fabsf(dlb)));
                    oa.gain = a.ret_gn_g + (size_t)j * 2048 + h * 512; oa.G = R + 4096 + h * 512; oa.ldg = RET_IN;
                    oa.Out = (bf16_t*)(ws + WS_MIX) + t0 * 2048 + h * 512; oa.ldo = 2048;
                    la::out_unit<256, 512, false>(F.lds + LDS_RING, F.lds + LT_X, oa);
                }
                GRID_BAR();
            }
        }
        if (IN(pb + 7)) {
            const Args& a = fresh_args(); MK_FRAME(F); ARGAS unsigned char* ws = opaque_ws(a.ws);
            pg8::StaticSched S; S.A = (const char*)(ws + WS_MIX); S.nM = NTOK / 256; S.nN = DM / 256; S.G = F.G; S.c = F.bid;
            int K;
            if (!odd) { S.Bt = (const char*)(ws + WS_WOUTE) + (size_t)j * DM * DM * 2; K = DM; } else { S.Bt = (const char*)(ws + WS_WOUTO) + (size_t)j * DM * 2048 * 2; K = 2048; }
            S.lda = K; S.ldb = K;
            pg8::EpiResid E; E.base = (layer == 0) ? a.x : a.out; E.out = a.out; E.gate = (const float*)(ws + WS_MOD) + (size_t)layer * NBATCH * 6144 + 2 * DM; E.gstride = 6144;
            pg8::gemm_phase<pg8::EpiResid, pg8::StaticSched>(F.lds + LDS_RING, pg8::Dims{K, K, K}, S, E);
            GRID_BAR();
        }
        if (IN(pb + 8)) { n2_phase(fresh_args(), layer); GRID_BAR(); }
        REP(9) if (IN(pb + 9)) { m1_phase(fresh_args(), layer); GRID_BAR(); }
        REP(10) if (IN(pb + 10)) {
            const Args& a = fresh_args(); MK_FRAME(F); ARGAS unsigned char* ws = opaque_ws(a.ws);
            build_pstart(F, (const unsigned*)(ws + WS_CTL) + CW_CNT + 64 * layer);
            const int nblk = ((LAS int*)(F.lds + LT_PSTART))[32] >> 8;
            MoeSched S; S.blk = (const LAS int*)(F.lds + LT_BLK); S.A = (const char*)(ws + WS_ASORT); S.W = (const char*)(ws + WS_WGU) + (size_t)layer * NEXP * 2048 * DM; S.wstride = (size_t)2048 * DM; S.tile_bytes = (size_t)256 * DM;
            S.ntile = 8; S.nunits = nblk * 8; S.G = F.G; S.c = F.bid;
            pg8::EpiSwiglu E; E.act = (unsigned char*)(ws + WS_ACT); E.bgu = a.moe_b_gu + (size_t)layer * NEXP * 2048; E.ascale = 1.f / (FP8_HSC * FP8_WSC);
            pg8::gemm_phase<pg8::EpiSwiglu, MoeSched, true, true, true>(F.lds + LDS_RING, pg8::Dims{DM / 2, DM / 2, DM / 2}, S, E);
            GRID_BAR();
        }
        REP(11) if (IN(pb + 11)) {
            const Args& a = fresh_args(); MK_FRAME(F); ARGAS unsigned char* ws = opaque_ws(a.ws);
            build_pstart(F, (const unsigned*)(ws + WS_CTL) + CW_CNT + 64 * layer);
            const int nblk = ((LAS int*)(F.lds + LT_PSTART))[32] >> 8;
            MoeSched S; S.blk = (const LAS int*)(F.lds + LT_BLK); S.A = (const char*)(ws + WS_ACT); S.W = (const char*)(ws + WS_WDN) + (size_t)layer * NEXP * DM * EFF; S.wstride = (size_t)DM * EFF; S.tile_bytes = (size_t)256 * EFF;
            S.ntile = 4; S.nunits = nblk * 4; S.G = F.G; S.c = F.bid;
            pg8::EpiDown E; E.y = (bf16_t*)(ws + WS_Y); E.bd = a.moe_b_down + (size_t)layer * NEXP * DM; E.wrow = (const float*)(ws + WS_WSORT); E.ascale = 1.f / (FP8_ASC * FP8_WSC);
            pg8::gemm_phase<pg8::EpiDown, MoeSched, true, true, true>(F.lds + LDS_RING, pg8::Dims{EFF / 2, EFF / 2, EFF / 2}, S, E);
            GRID_BAR();
        }
    }
__global__ void __launch_bounds__(512, 2) fwd_kernel(Args a_kernarg) {
    const Args& a0 = fresh_args();
    LAS unsigned char* lds0 = (LAS unsigned char*)lds_raw;
    for (int u = threadIdx.x; u < 64; u += 512) ((LAS unsigned*)(lds0 + LT_MISC))[u] = 0u;
    __syncthreads();
    const int lo = a0.ph_lo, hi = a0.ph_hi; const bool fused = (hi - lo) > 1;
    if (fused) xcd_barrier_post((gbar_t)(a0.ws + WS_CTL) + CW_BAR);

    REP(12) if (IN(0)) { p0_prologue(fresh_args()); GRID_BAR(); }

    layer_body<0>(lo, hi, fused); layer_body<1>(lo, hi, fused); layer_body<2>(lo, hi, fused); layer_body<3>(lo, hi, fused);
    if (IN(49)) n1_phase(fresh_args(), DEPTH, true);
}

#undef IN
#undef GRID_BAR
#ifndef MK_ONE_LAUNCH
#define MK_ONE_LAUNCH 1
#endif
extern "C" void kernel_launch(void* const* d_in, const int* in_sizes, int n_in, void* d_out, int out_size, void* d_ws, size_t ws_size, hipStream_t stream) {
    static int grid = 0;
    if (grid == 0) {
        if (n_in != 30 || in_sizes[0] != NTOK * DM || out_size != NTOK * DM || ws_size < WS_END) {
            fprintf(stderr, "kernel_launch: shape mismatch: n_in %d in0 %d out %d ws %zu (need %zu)\n", n_in, n_in > 0 ? in_sizes[0] : -1, out_size, ws_size, (size_t)WS_END); grid = -1; return; }
        int dev = 0, cus = 0, per_cu = 0;
        if (hipGetDevice(&dev) != hipSuccess || hipDeviceGetAttribute(&cus, hipDeviceAttributeMultiprocessorCount, dev) != hipSuccess) { grid = -1; return; }
        if (hipFuncSetAttribute((const void*)fwd_kernel, hipFuncAttributeMaxDynamicSharedMemorySize, LDS_BYTES) != hipSuccess) { fprintf(stderr, "kernel_launch: hipFuncSetAttribute failed\n"); grid = -1; return; }
        if (hipOccupancyMaxActiveBlocksPerMultiprocessor(&per_cu, (const void*)fwd_kernel, 512, LDS_BYTES) != hipSuccess || per_cu < 1) fprintf(stderr, "kernel_launch: occupancy query says %d\n", per_cu);
        (void)hipGetLastError();
        grid = cus;
    }
    if (grid < 0) return;
    (void)hipMemsetAsync((char*)d_ws + WS_CTL, 0, CTL_ZERO_BYTES, stream);
    Args a{};
    a.x = (gcf_t)d_in[0]; a.c = (gcf_t)d_in[1]; a.pos = (gci_t)d_in[2];
    a.ada_w = (gcf_t)d_in[3]; a.ada_b = (gcf_t)d_in[4]; a.norm_mix_g = (gcf_t)d_in[5]; a.norm_ffn_g = (gcf_t)d_in[6];
    a.hy_w_in = (gcf_t)d_in[7]; a.ml_conv_w = (gcf_t)d_in[8]; a.ml_conv_b = (gcf_t)d_in[9]; a.ml_gate_b = (gcf_t)d_in[10]; a.ml_norm_g = (gcf_t)d_in[11];
    a.mla_q_norm_g = (gcf_t)d_in[12]; a.mla_kv_norm_g = (gcf_t)d_in[13]; a.mla_w_qb = (gcf_t)d_in[14]; a.mla_w_kvb = (gcf_t)d_in[15];
    a.mla_qk_q_g = (gcf_t)d_in[16]; a.mla_qk_k_g = (gcf_t)d_in[17]; a.hy_w_out = (gcf_t)d_in[18];
    a.ret_w_in = (gcf_t)d_in[19]; a.ret_decay_f = (gcf_t)d_in[20]; a.ret_decay_b = (gcf_t)d_in[21]; a.ret_gn_g = (gcf_t)d_in[22]; a.ret_w_out = (gcf_t)d_in[23];
    a.moe_router_w = (gcf_t)d_in[24]; a.moe_router_b = (gcf_t)d_in[25]; a.moe_w_gu = (gcf_t)d_in[26]; a.moe_b_gu = (gcf_t)d_in[27]; a.moe_w_down = (gcf_t)d_in[28]; a.moe_b_down = (gcf_t)d_in[29];
    a.out = (ARGAS float*)d_out; a.ws = (ARGAS unsigned char*)d_ws;
#if MK_ONE_LAUNCH
    a.ph_lo = 0; a.ph_hi = NPHASE;
    hipLaunchKernelGGL(fwd_kernel, dim3(grid), dim3(512), LDS_BYTES, stream, a);
#else
    for (int ph = 0; ph < NPHASE; ++ph) {
        if (ph >= 1 && ph < 49) { const int layer = (ph - 1) / 12, k = (ph - 1) % 12; if ((layer & 1) && (k >= 4 && k <= 6)) continue; }
        a.ph_lo = ph; a.ph_hi = ph + 1;
        hipLaunchKernelGGL(fwd_kernel, dim3(grid), dim3(512), LDS_BYTES, stream, a);
    }
#endif
    const hipError_t le = hipPeekAtLastError();
    if (le != hipSuccess) fprintf(stderr, "kernel_launch: launch failed: %s\n", hipGetErrorName(le));
}
```

```cpp
#include <hip/hip_runtime.h>
#include <cstdio>
#include <cstdint>

#define GAS __attribute__((address_space(1)))
#define LAS __attribute__((address_space(3)))
typedef unsigned short bf16_t;
typedef short bf16x8 __attribute__((ext_vector_type(8)));
typedef short s16x4 __attribute__((ext_vector_type(4)));
typedef float f32x2 __attribute__((ext_vector_type(2)));
typedef float f32x4 __attribute__((ext_vector_type(4)));
typedef float f32x8 __attribute__((ext_vector_type(8)));
typedef float f32x16 __attribute__((ext_vector_type(16)));
typedef unsigned u32x2 __attribute__((ext_vector_type(2)));
typedef unsigned u32x4 __attribute__((ext_vector_type(4)));
typedef GAS unsigned gu32;

constexpr int NTOK = 32768, DM = 1024, SEQ = 4096, NBATCH = 8, DEPTH = 4;
constexpr int EVEN_IN = 2480, EVEN_INP = 2560;
constexpr int RET_IN = 6144;
constexpr int NEXP = 32, TOPK = 4, EFF = 1024;
constexpr int NSLOT = NTOK * TOPK;
constexpr int NSLOTP = NSLOT + NEXP * 256;
constexpr float EPS = 1e-6f;

constexpr int PC_QM = 0, PC_KM = 512, PC_VM = 1024, PC_OM = 1536, PC_QA = 2048, PC_KVA = 2304, PC_KR = 2432, PC_GT = 2464;

__device__ __forceinline__ int lane_id() { int l; asm volatile("v_mbcnt_lo_u32_b32 %0, -1, 0\n\tv_mbcnt_hi_u32_b32 %0, -1, %0" : "=v"(l)); return l; }
#define TIDX(wv) (((wv) << 6) | lane_id())
#define LDS_WAIT() asm volatile("s_waitcnt lgkmcnt(0)" ::: "memory")
#define VM_WAIT() asm volatile("s_waitcnt vmcnt(0)" ::: "memory")
#define SBAR() __builtin_amdgcn_sched_barrier(0)
#define FENCE() do { asm volatile("" ::: "memory"); __builtin_amdgcn_sched_barrier(0); } while (0)

__device__ __forceinline__ unsigned cvt_pk_bf16(float lo, float hi) { unsigned r; asm volatile("v_cvt_pk_bf16_f32 %0, %1, %2" : "=v"(r) : "v"(lo), "v"(hi)); return r; }
__device__ __forceinline__ float bf_lo(unsigned u) { return __builtin_bit_cast(float, u << 16); }
__device__ __forceinline__ float bf_hi(unsigned u) { return __builtin_bit_cast(float, u & 0xffff0000u); }
__device__ __forceinline__ float bf2f(bf16_t b) { return __builtin_bit_cast(float, ((unsigned)b) << 16); }
__device__ __forceinline__ bf16_t f2bf(float f) { unsigned u = __builtin_bit_cast(unsigned, f); return (bf16_t)((u + 0x7fffu + ((u >> 16) & 1u)) >> 16); }
__device__ __forceinline__ float shx(float v, int m, int lane) { return __builtin_bit_cast(float, __builtin_amdgcn_ds_bpermute((lane ^ m) << 2, __builtin_bit_cast(int, v))); }
__device__ __forceinline__ int shxi(int v, int m, int lane) { return __builtin_amdgcn_ds_bpermute((lane ^ m) << 2, v); }
__device__ __forceinline__ float sh_from(float v, int src, int lane) { (void)lane; return __builtin_bit_cast(float, __builtin_amdgcn_ds_bpermute(src << 2, __builtin_bit_cast(int, v))); }
__device__ __forceinline__ int sh_fromi(int v, int src) { return __builtin_amdgcn_ds_bpermute(src << 2, v); }
__device__ __forceinline__ float wave_sum(float v, int lane) {
#pragma unroll
    for (int o = 1; o < 64; o <<= 1) v += shx(v, o, lane);
    return v;
}
__device__ __forceinline__ float wave_max(float v, int lane) {
#pragma unroll
    for (int o = 1; o < 64; o <<= 1) v = fmaxf(v, shx(v, o, lane));
    return v;
}
__device__ __forceinline__ float sigmoidf_(float x) { return 1.f / (1.f + __expf(-x)); }
__device__ __forceinline__ float siluf_(float x) { return x / (1.f + __expf(-x)); }

#define XB_TMO      128
#define XB_XCNT(j)  (256  + 64 * (j))
#define XB_XSUB(j)  (1280 + 64 * (j))
#define XB_XGEN(j)  (2304 + 64 * (j))
#define XB_TOP      3328
#define XB_TOPGEN   3392
#define XCD_BAR_WORDS 3456
#define XB_SPIN_CAP (1u << 22)

typedef GAS unsigned* gbar_t;
__device__ __forceinline__ unsigned xb_ld(gbar_t p)              { return __hip_atomic_load(p, __ATOMIC_RELAXED, __HIP_MEMORY_SCOPE_AGENT); }
__device__ __forceinline__ unsigned xb_add(gbar_t p, unsigned v) { return __hip_atomic_fetch_add(p, v, __ATOMIC_RELAXED, __HIP_MEMORY_SCOPE_AGENT); }
__device__ __forceinline__ unsigned xb_xcc_id() { return (unsigned)__builtin_amdgcn_s_getreg((3 << 11) | 20) & 0xFu; }
#define XB_SPIN(cond, bar) do { unsigned _sp = 0; while (cond) { __builtin_amdgcn_s_sleep(1); \
    if ((++_sp & 255u) == 0u) { if (xb_ld(&(bar)[XB_TMO])) break; if (_sp > XB_SPIN_CAP) { xb_add(&(bar)[XB_TMO], 1u); break; } } } } while (0)

__device__ __forceinline__ void xcd_barrier_post(gbar_t bar, int wv) {
    if (TIDX(wv) == 0) (void)xb_add(&bar[XB_XCNT(xb_xcc_id())], 1u);
}
__device__ __forceinline__ void xcd_barrier_complete(gbar_t bar, unsigned x, unsigned& nloc, unsigned& nx) {
    const unsigned G = gridDim.x * gridDim.y * gridDim.z;
    unsigned sum, cnt, mine, sp = 0u;
    for (;;) {
        sum = 0u; cnt = 0u; mine = 0u;
#pragma unroll
        for (unsigned j = 0; j < 16; ++j) { const unsigned c = xb_ld(&bar[XB_XCNT(j)]); sum += c; cnt += (c > 0u) ? 1u : 0u; mine = (j == x) ? c : mine; }
        if (sum == G) break;
        __builtin_amdgcn_s_sleep(1);
        if ((++sp & 255u) == 0u) { if (xb_ld(&bar[XB_TMO])) break; if (sp > XB_SPIN_CAP) { xb_add(&bar[XB_TMO], 1u); break; } }
    }
    nloc = mine > 0u ? mine : 1u; nx = cnt > 0u ? cnt : 1u;
}
__device__ __forceinline__ void xcd_barrier(gbar_t bar, volatile LAS unsigned* st, int wv) {
    asm volatile("s_waitcnt vmcnt(0)" ::: "memory");
    __syncthreads();
    if (TIDX(wv) == 0) {
        const unsigned bx = xb_xcc_id();
        __builtin_amdgcn_s_waitcnt(0);
        unsigned nloc = st[0], nx = st[1];
        if (nloc == 0u) { xcd_barrier_complete(bar, bx, nloc, nx); st[0] = nloc; st[1] = nx; }
        const unsigned old = xb_add(&bar[XB_XSUB(bx)], 1u);
        const unsigned gen = old / nloc;
        if (old + 1u == (gen + 1u) * nloc) {
            __builtin_amdgcn_fence(__ATOMIC_RELEASE, "agent");
            asm volatile("s_waitcnt vmcnt(0)" ::: "memory");
            const unsigned og = xb_add(&bar[XB_TOP], 1u);
            const unsigned tg = og / nx;
            if (og + 1u == (tg + 1u) * nx) xb_add(&bar[XB_TOPGEN], 1u);
            else XB_SPIN(xb_ld(&bar[XB_TOPGEN]) == tg, bar);
            __builtin_amdgcn_fence(__ATOMIC_ACQUIRE, "agent");
            xb_add(&bar[XB_XGEN(bx)], 1u);
            asm volatile("s_waitcnt vmcnt(0)" ::: "memory");
        } else {
            XB_SPIN(xb_ld(&bar[XB_XGEN(bx)]) == gen, bar);
            __builtin_amdgcn_fence(__ATOMIC_ACQUIRE, "agent");
            asm volatile("s_waitcnt vmcnt(0)" ::: "memory");
        }
    }
    __syncthreads();
}
namespace pg8 {
constexpr int BM = 256, BK = 64, HALF = 128, HTB = HALF * BK * 2, STAGE_BYTES = 8 * HTB, NXCD = 8, WGM = 8;
__host__ __device__ __forceinline__ int lds_byte(int r, int c) { const int st = (r >> 4) * 2 + (c >> 5), rr = r & 15, cc = c & 31, ob = rr * 64 + cc * 2; return st * 1024 + (ob ^ (((ob >> 9) & 1) << 5)); }
__host__ __device__ __forceinline__ void stage_rc(int b, int& R, int& C) { const int st = b / 1024, sb = b % 1024, swz = sb ^ (((sb >> 9) & 1) << 5); R = (st >> 1) * 16 + swz / 64; C = (st & 1) * 32 + (swz % 64) / 2; }
__host__ __device__ __forceinline__ int perm32(int rho) { const int n = rho >> 4, i = rho & 15; return 8 * (i >> 2) + 4 * n + (i & 3); }

struct Unit { const char* A; const char* B; int pm, pn, aux; };
struct Dims { int lda, ldb, K; };

__device__ __forceinline__ void static_tile(int L, int nM, int nN, int& pm, int& pn) {
    const int nwg = nM * nN; int wgid = L;
    { const int q = nwg / NXCD, r = nwg % NXCD, xcd = wgid % NXCD, off = wgid / NXCD; wgid = (xcd < r ? xcd * (q + 1) : r * (q + 1) + (xcd - r) * q) + off; }
    const int nig = WGM * nN, gid = wgid / nig, fm = gid * WGM, gsz = (nM - fm) < WGM ? (nM - fm) : WGM;
    pm = fm + ((wgid % nig) % gsz); pn = (wgid % nig) / gsz;
}
struct StaticSched {
    const char* A; const char* Bt; int lda, ldb, nM, nN, G, c;
    __device__ __forceinline__ bool next(int i, Unit& u) const {
        const long L = (long)i * G + c; if (L >= (long)nM * nN) return false;
        int pm, pn; static_tile((int)L, nM, nN, pm, pn);
        u.pm = pm; u.pn = pn; u.aux = 0; u.A = A + (size_t)pm * BM * lda * 2; u.B = Bt + (size_t)pn * BM * ldb * 2; return true;
    }
};

typedef int v8i_t __attribute__((ext_vector_type(8)));
__device__ __forceinline__ v8i_t cat8(bf16x8 a, bf16x8 b) { const u32x4 x = __builtin_bit_cast(u32x4, a), y = __builtin_bit_cast(u32x4, b); return (v8i_t){(int)x.x, (int)x.y, (int)x.z, (int)x.w, (int)y.x, (int)y.y, (int)y.z, (int)y.w}; }
template <class Epi, class Sched, bool ALIGN_EPI = true, bool SP2 = true, bool FP8 = false>
__device__ __forceinline__ void gemm_phase(LAS unsigned char* lds, const Dims g, const Sched& S, const Epi& E, const int wv) {
    int tid = TIDX(wv); asm volatile("" : "+v"(tid));
    const int wid = __builtin_amdgcn_readfirstlane(tid >> 6), lane = tid & 63, wr = wid >> 2, wc = wid & 3, fr = lane & 15, fq = lane >> 4;
    const int K = g.K, nt = K / BK;
    unsigned voffA[2], voffB[2];
#pragma unroll
    for (int i = 0; i < 2; ++i) { int R, C; stage_rc(tid * 16 + i * 8192, R, C); const int Rb = Epi::PERM ? ((R & ~31) + perm32(R & 31)) : R;
        voffA[i] = (unsigned)(R * g.lda + C) * 2u; voffB[i] = (unsigned)(Rb * g.ldb + C) * 2u; }
    const size_t kstep = (size_t)(BK * 2);
    const size_t hstepA = (size_t)HALF * g.lda * 2, hstepB = (size_t)HALF * g.ldb * 2;
    const unsigned ldsw = (unsigned)wid * 1024u, ldsb_ = (unsigned)(uintptr_t)lds;
    const int aoff = lds_byte(wr * 64 + fr, fq * 8), boff = lds_byte(wc * 32 + fr, fq * 8);
#define PG8_SA(b, h) (((b) * 2 + (h)) * HTB)
#define PG8_SB(b, h) ((4 + (b) * 2 + (h)) * HTB)
#define PG8_STAGE(bufoff, gbase, voff) do { _Pragma("unroll") for (int _i = 0; _i < 2; ++_i) { \
        if constexpr (FP8) { unsigned keep_; asm volatile("s_mov_b32 %0, m0\n\ts_mov_b32 m0, %1\n\ts_nop 0\n\tglobal_load_lds_dwordx4 %2, %3\n\ts_mov_b32 m0, %0" : "=&s"(keep_) : "s"(ldsb_ + (unsigned)(bufoff) + ldsw + _i * 8192u), "v"((voff)[_i]), "s"(gbase) : "memory"); } \
        else __builtin_amdgcn_global_load_lds((const unsigned*)((const char*)(gbase) + (voff)[_i]), (LAS unsigned*)(lds + (bufoff) + ldsw + _i * 8192), 16, 0, 0); } } while (0)
#define PG8_LDA(dst, b, h) do { _Pragma("unroll") for (int m = 0; m < 4; ++m) { if constexpr (FP8) { const u32x4 x_ = *(const LAS u32x4*)(lds + PG8_SA(b, h) + aoff + m * 2048), y_ = *(const LAS u32x4*)(lds + PG8_SA(b, h) + aoff + m * 2048 + 1024); \
        dst##8[m] = (v8i_t){(int)x_.x, (int)x_.y, (int)x_.z, (int)x_.w, (int)y_.x, (int)y_.y, (int)y_.z, (int)y_.w}; } else { _Pragma("unroll") for (int k = 0; k < 2; ++k) dst[m][k] = *(const LAS bf16x8*)(lds + PG8_SA(b, h) + aoff + m * 2048 + k * 1024); } } } while (0)
#define PG8_LDB(dst, b, h) do { _Pragma("unroll") for (int n = 0; n < 2; ++n) { if constexpr (FP8) { const u32x4 x_ = *(const LAS u32x4*)(lds + PG8_SB(b, h) + boff + n * 2048), y_ = *(const LAS u32x4*)(lds + PG8_SB(b, h) + boff + n * 2048 + 1024); \
        dst##8[n] = (v8i_t){(int)x_.x, (int)x_.y, (int)x_.z, (int)x_.w, (int)y_.x, (int)y_.y, (int)y_.z, (int)y_.w}; } else { _Pragma("unroll") for (int k = 0; k < 2; ++k) dst[n][k] = *(const LAS bf16x8*)(lds + PG8_SB(b, h) + boff + n * 2048 + k * 1024); } } } while (0)
#define PG8_MMA(ai, bj, At, Bt) do { __builtin_amdgcn_s_setprio(1); if constexpr (FP8) { _Pragma("unroll") for (int m = 0; m < 4; ++m) _Pragma("unroll") for (int n = 0; n < 2; ++n) \
        acc[ai][bj][m][n] = __builtin_amdgcn_mfma_scale_f32_16x16x128_f8f6f4(Bt##8[n], At##8[m], acc[ai][bj][m][n], 0, 0, 0, 0x7f7f7f7f, 0, 0x7f7f7f7f); } else { \
        _Pragma("unroll") for (int m = 0; m < 4; ++m) _Pragma("unroll") for (int n = 0; n < 2; ++n) _Pragma("unroll") for (int k = 0; k < 2; ++k) \
        acc[ai][bj][m][n] = __builtin_amdgcn_mfma_f32_16x16x32_bf16(Bt[n][k], At[m][k], acc[ai][bj][m][n], 0, 0, 0); } __builtin_amdgcn_s_setprio(0); } while (0)
#define PG8_WAIT_V(n) asm volatile("s_waitcnt vmcnt(" #n ")" ::: "memory")
#define PG8_WAIT_L(n) asm volatile("s_waitcnt lgkmcnt(" #n ")" ::: "memory")
#define PG8_BAR __builtin_amdgcn_s_barrier()
#define PG8_SCHED __builtin_amdgcn_sched_barrier(0)
    Unit cur, nxt; int ui = 0;
    if (!S.next(0, cur)) return;
    f32x4 acc[2][2][4][2];
#pragma unroll
    for (int a = 0; a < 2; ++a)
#pragma unroll
        for (int b = 0; b < 2; ++b)
#pragma unroll
            for (int m = 0; m < 4; ++m)
#pragma unroll
                for (int n = 0; n < 2; ++n) acc[a][b][m][n] = (f32x4){0.f, 0.f, 0.f, 0.f};
    bf16x8 At[4][2], B0[2][2], B1[2][2]; v8i_t At8[4], B08[2], B18[2];
    const char* cA = cur.A; const char* cB = cur.B;
    if constexpr (SP2) {
        PG8_STAGE(PG8_SB(0, 0), cB, voffB); PG8_STAGE(PG8_SB(0, 1), cB + hstepB, voffB); PG8_STAGE(PG8_SA(0, 0), cA, voffA); PG8_STAGE(PG8_SA(0, 1), cA + hstepA, voffA);
        if (wr == 1) PG8_BAR;
        PG8_WAIT_V(2); PG8_BAR;
        PG8_STAGE(PG8_SB(1, 0), cB + kstep, voffB); PG8_STAGE(PG8_SA(1, 0), cA + kstep, voffA); PG8_STAGE(PG8_SB(1, 1), cB + hstepB + kstep, voffB);
        PG8_WAIT_V(6); PG8_BAR;
    } else {
        PG8_STAGE(PG8_SB(0, 0), cB, voffB); PG8_STAGE(PG8_SA(0, 0), cA, voffA); PG8_STAGE(PG8_SB(0, 1), cB + hstepB, voffB); PG8_STAGE(PG8_SA(0, 1), cA + hstepA, voffA);
        if (wr == 1) PG8_BAR;
        PG8_WAIT_V(4); PG8_BAR;
        PG8_STAGE(PG8_SB(1, 0), cB + kstep, voffB); PG8_STAGE(PG8_SA(1, 0), cA + kstep, voffA); PG8_STAGE(PG8_SB(1, 1), cB + hstepB + kstep, voffB);
        PG8_WAIT_V(6); PG8_BAR;
    }
    for (;;) {
        const bool has_next = S.next(ui + 1, nxt);
        const char* nA = has_next ? nxt.A : cA; const char* nB = has_next ? nxt.B : cB;
#pragma unroll 1
        for (int t = 0; t < nt; t += 2) {
            const bool last = (t == nt - 2);
            const char* a1 = cA + (size_t)(t + 1) * kstep;
            const char* a2 = last ? nA : cA + (size_t)(t + 2) * kstep; const char* b2 = last ? nB : cB + (size_t)(t + 2) * kstep;
            const char* a3 = a2 + kstep; const char* b3 = b2 + kstep;
            if constexpr (SP2) {
            PG8_LDB(B0, 0, 0); PG8_LDB(B1, 0, 1); PG8_SCHED; PG8_LDA(At, 0, 0); PG8_STAGE(PG8_SA(1, 1), a1 + hstepA, voffA);
            PG8_WAIT_V(8); PG8_WAIT_L(0); PG8_BAR; PG8_MMA(0, 0, At, B0); PG8_MMA(0, 1, At, B1); PG8_BAR; PG8_SCHED;
            PG8_LDA(At, 0, 1); PG8_STAGE(PG8_SB(0, 0), b2, voffB); PG8_STAGE(PG8_SB(0, 1), b2 + hstepB, voffB); PG8_STAGE(PG8_SA(0, 0), a2, voffA);
            PG8_WAIT_V(8); PG8_WAIT_L(0); PG8_BAR; PG8_MMA(1, 0, At, B0); PG8_MMA(1, 1, At, B1); PG8_BAR; PG8_SCHED;
            PG8_LDB(B0, 1, 0); PG8_LDB(B1, 1, 1); PG8_SCHED; PG8_LDA(At, 1, 0); PG8_STAGE(PG8_SA(0, 1), a2 + hstepA, voffA);
            PG8_WAIT_V(8); PG8_WAIT_L(0); PG8_BAR; PG8_MMA(0, 0, At, B0); PG8_MMA(0, 1, At, B1); PG8_BAR; PG8_SCHED;
            PG8_LDA(At, 1, 1); PG8_STAGE(PG8_SB(1, 0), b3, voffB); PG8_STAGE(PG8_SB(1, 1), b3 + hstepB, voffB); PG8_STAGE(PG8_SA(1, 0), a3, voffA);
            PG8_WAIT_V(8); PG8_WAIT_L(0); PG8_BAR; PG8_MMA(1, 0, At, B0); PG8_MMA(1, 1, At, B1); PG8_BAR; PG8_SCHED;
            } else {
            PG8_LDB(B0, 0, 0); PG8_SCHED; PG8_LDA(At, 0, 0); PG8_STAGE(PG8_SA(1, 1), a1 + hstepA, voffA);
            PG8_WAIT_L(8); PG8_BAR; PG8_WAIT_L(0); PG8_MMA(0, 0, At, B0); PG8_BAR; PG8_SCHED;
            PG8_LDB(B1, 0, 1); PG8_STAGE(PG8_SB(0, 0), b2, voffB);
            PG8_BAR; PG8_WAIT_L(0); PG8_MMA(0, 1, At, B1); PG8_BAR;
            PG8_LDA(At, 0, 1); PG8_STAGE(PG8_SA(0, 0), a2, voffA);
            PG8_BAR; PG8_WAIT_L(0); PG8_MMA(1, 0, At, B0); PG8_BAR; PG8_SCHED;
            PG8_STAGE(PG8_SB(0, 1), b2 + hstepB, voffB);
            PG8_WAIT_V(6); PG8_BAR; PG8_MMA(1, 1, At, B1); PG8_BAR;
            PG8_LDB(B0, 1, 0); PG8_SCHED; PG8_LDA(At, 1, 0); PG8_STAGE(PG8_SA(0, 1), a2 + hstepA, voffA);
            PG8_WAIT_L(8); PG8_BAR; PG8_WAIT_L(0); PG8_MMA(0, 0, At, B0); PG8_BAR; PG8_SCHED;
            PG8_LDB(B1, 1, 1); PG8_STAGE(PG8_SB(1, 0), b3, voffB);
            PG8_BAR; PG8_WAIT_L(0); PG8_MMA(0, 1, At, B1); PG8_BAR;
            PG8_LDA(At, 1, 1); PG8_STAGE(PG8_SA(1, 0), a3, voffA);
            PG8_BAR; PG8_WAIT_L(0); PG8_MMA(1, 0, At, B0); PG8_BAR; PG8_SCHED;
            PG8_STAGE(PG8_SB(1, 1), b3 + hstepB, voffB);
            PG8_WAIT_V(6); PG8_BAR; PG8_MMA(1, 1, At, B1); PG8_BAR;
            }
        }
        if constexpr (ALIGN_EPI) { if (wr == 0) PG8_BAR; }
        { int tz = tid; asm volatile("" : "+v"(tz)); const int ln = tz & 63; E(acc, cur, wr, wc, ln & 15, ln >> 4); }
        if (!has_next) break;
#pragma unroll
        for (int a = 0; a < 2; ++a)
#pragma unroll
            for (int b = 0; b < 2; ++b)
#pragma unroll
                for (int m = 0; m < 4; ++m)
#pragma unroll
                    for (int n = 0; n < 2; ++n) acc[a][b][m][n] = (f32x4){0.f, 0.f, 0.f, 0.f};
        cur = nxt; cA = nA; cB = nB; ++ui;
        if constexpr (ALIGN_EPI) { if (wr == 1) PG8_BAR; }
    }
    PG8_WAIT_V(0);
    if constexpr (!ALIGN_EPI) { if (wr == 0) PG8_BAR; }
    PG8_BAR;
#undef PG8_SA
#undef PG8_SB
#undef PG8_STAGE
#undef PG8_LDA
#undef PG8_LDB
#undef PG8_MMA
#undef PG8_WAIT_V
#undef PG8_WAIT_L
#undef PG8_BAR
#undef PG8_SCHED
}

struct EpiBf16 {
    static constexpr bool PERM = true;
    bf16_t* O0; bf16_t* O1; int ldc0, ldc1; int rope_tiles; int qscale_tiles; float qscale; const GAS f32x2* rope;
    __device__ __forceinline__ void operator()(const f32x4 (&acc)[2][2][4][2], const Unit& u, int wr, int wc, int fr, int fq) const {
        const int row0 = u.pm * BM + wr * 64 + fr, col0 = u.pn * BM + wc * 32 + 8 * fq;
        bf16_t* base = u.aux ? O1 : O0; const int ld = u.aux ? ldc1 : ldc0;
        const bool do_rope = u.pn < rope_tiles; const float sc = (u.pn < qscale_tiles) ? qscale : 1.f;
#pragma unroll
        for (int ai = 0; ai < 2; ++ai)
#pragma unroll
            for (int m = 0; m < 4; ++m) {
                const int row = row0 + ai * HALF + m * 16; bf16_t* rowp = base + (size_t)row * ld + col0;
                f32x4 v00 = acc[ai][0][m][0], v01 = acc[ai][0][m][1], v10 = acc[ai][1][m][0], v11 = acc[ai][1][m][1];
                if (do_rope) {
                    const GAS f32x4* rp = (const GAS f32x4*)(rope + (size_t)row * 128 + wc * 32 + 8 * fq);
                    { const f32x4 t0 = rp[0], t1 = rp[1]; f32x4 a, b;
                      a[0] = v00[0] * t0[0] - v10[0] * t0[1]; b[0] = v10[0] * t0[0] + v00[0] * t0[1];
                      a[1] = v00[1] * t0[2] - v10[1] * t0[3]; b[1] = v10[1] * t0[2] + v00[1] * t0[3];
                      a[2] = v00[2] * t1[0] - v10[2] * t1[1]; b[2] = v10[2] * t1[0] + v00[2] * t1[1];
                      a[3] = v00[3] * t1[2] - v10[3] * t1[3]; b[3] = v10[3] * t1[2] + v00[3] * t1[3];
                      v00 = a; v10 = b; }
                    FENCE();
                    { const f32x4 t2 = rp[2], t3 = rp[3]; f32x4 a, b;
                      a[0] = v01[0] * t2[0] - v11[0] * t2[1]; b[0] = v11[0] * t2[0] + v01[0] * t2[1];
                      a[1] = v01[1] * t2[2] - v11[1] * t2[3]; b[1] = v11[1] * t2[2] + v01[1] * t2[3];
                      a[2] = v01[2] * t3[0] - v11[2] * t3[1]; b[2] = v11[2] * t3[0] + v01[2] * t3[1];
                      a[3] = v01[3] * t3[2] - v11[3] * t3[3]; b[3] = v11[3] * t3[2] + v01[3] * t3[3];
                      v01 = a; v11 = b; }
                }
                v00 = v00 * sc; v01 = v01 * sc; v10 = v10 * sc; v11 = v11 * sc;
                u32x4 w0, w1;
                w0.x = cvt_pk_bf16(v00[0], v00[1]); w0.y = cvt_pk_bf16(v00[2], v00[3]); w0.z = cvt_pk_bf16(v01[0], v01[1]); w0.w = cvt_pk_bf16(v01[2], v01[3]);
                w1.x = cvt_pk_bf16(v10[0], v10[1]); w1.y = cvt_pk_bf16(v10[2], v10[3]); w1.z = cvt_pk_bf16(v11[0], v11[1]); w1.w = cvt_pk_bf16(v11[2], v11[3]);
                *(u32x4*)(rowp) = w0; *(u32x4*)(rowp + HALF) = w1;
                FENCE();
            }
    }
};
struct EpiResid {
    static constexpr bool PERM = false;
    const float* base; float* out; const float* gate; int gstride;
    __device__ __forceinline__ void operator()(const f32x4 (&acc)[2][2][4][2], const Unit& u, int wr, int wc, int fr, int fq) const {
        const int row0 = u.pm * BM + wr * 64 + fr, col0 = u.pn * BM + wc * 32 + 4 * fq;
        const float* gp = gate + (size_t)((u.pm * BM) >> 12) * gstride + col0;
        f32x4 gv[2][2];
#pragma unroll
        for (int bj = 0; bj < 2; ++bj)
#pragma unroll
            for (int n = 0; n < 2; ++n) gv[bj][n] = *(const f32x4*)(gp + bj * HALF + n * 16);
#pragma unroll
        for (int ai = 0; ai < 2; ++ai)
#pragma unroll
            for (int m = 0; m < 4; ++m) { const size_t ro = (size_t)(row0 + ai * HALF + m * 16) * DM + col0;
#pragma unroll
                for (int bj = 0; bj < 2; ++bj)
#pragma unroll
                    for (int n = 0; n < 2; ++n) { const f32x4 bv = *(const f32x4*)(base + ro + bj * HALF + n * 16);
                        *(f32x4*)(out + ro + bj * HALF + n * 16) = bv + gv[bj][n] * acc[ai][bj][m][n]; } }
    }
};
__device__ __forceinline__ unsigned pk4_fp8(float a, float b, float c, float d) { int w = __builtin_amdgcn_cvt_pk_fp8_f32(a, b, 0, false); w = __builtin_amdgcn_cvt_pk_fp8_f32(c, d, w, true); return (unsigned)w; }
struct EpiSwiglu {
    static constexpr bool PERM = true;
    unsigned char* act; const float* bgu; float ascale;
    __device__ __forceinline__ void operator()(const f32x4 (&acc)[2][2][4][2], const Unit& u, int wr, int wc, int fr, int fq) const {
        const int row0 = u.pm * BM + wr * 64 + fr, c0 = u.pn * HALF + wc * 32 + 8 * fq;
        const float* bp = bgu + (size_t)u.aux * 2048 + c0;
        const f32x4 bg0 = *(const f32x4*)(bp), bg1 = *(const f32x4*)(bp + 4), bu0 = *(const f32x4*)(bp + 1024), bu1 = *(const f32x4*)(bp + 1028);
#pragma unroll
        for (int ai = 0; ai < 2; ++ai)
#pragma unroll
            for (int m = 0; m < 4; ++m) {
                const f32x4 g0 = acc[ai][0][m][0] * ascale + bg0, g1 = acc[ai][0][m][1] * ascale + bg1, u0 = acc[ai][1][m][0] * ascale + bu0, u1 = acc[ai][1][m][1] * ascale + bu1;
                float r[8];
#pragma unroll
                for (int j = 0; j < 4; ++j) {
                    float gg = fminf(g0[j], 7.f), uu = fminf(fmaxf(u0[j], -7.f), 7.f); r[j] = 4.f * (uu + 1.f) * gg * __builtin_amdgcn_rcpf(1.f + __expf(-1.702f * gg));
                    gg = fminf(g1[j], 7.f); uu = fminf(fmaxf(u1[j], -7.f), 7.f); r[4 + j] = 4.f * (uu + 1.f) * gg * __builtin_amdgcn_rcpf(1.f + __expf(-1.702f * gg));
                }
                u32x2 w; w.x = pk4_fp8(r[0], r[1], r[2], r[3]); w.y = pk4_fp8(r[4], r[5], r[6], r[7]);
                *(u32x2*)(act + (size_t)(row0 + ai * HALF + m * 16) * EFF + c0) = w;
            }
    }
};
struct EpiDown {
    static constexpr bool PERM = true;
    bf16_t* y; const float* bd; const float* wrow; float ascale;
    __device__ __forceinline__ void operator()(const f32x4 (&acc)[2][2][4][2], const Unit& u, int wr, int wc, int fr, int fq) const {
        const int row0 = u.pm * BM + wr * 64 + fr, col0 = u.pn * BM + wc * 32 + 8 * fq;
        const float* bp = bd + (size_t)u.aux * DM + col0;
        const f32x4 b00 = *(const f32x4*)(bp), b01 = *(const f32x4*)(bp + 4), b10 = *(const f32x4*)(bp + HALF), b11 = *(const f32x4*)(bp + HALF + 4);
        float wv[8];
#pragma unroll
        for (int i = 0; i < 8; ++i) wv[i] = wrow[row0 + (i >> 2) * HALF + (i & 3) * 16];
#pragma unroll
        for (int ai = 0; ai < 2; ++ai)
#pragma unroll
            for (int m = 0; m < 4; ++m) {
                const int row = row0 + ai * HALF + m * 16; const float w = wv[ai * 4 + m];
                const f32x4 v00 = (acc[ai][0][m][0] * ascale + b00) * w, v01 = (acc[ai][0][m][1] * ascale + b01) * w, v10 = (acc[ai][1][m][0] * ascale + b10) * w, v11 = (acc[ai][1][m][1] * ascale + b11) * w;
                u32x4 w0, w1;
                w0.x = cvt_pk_bf16(v00[0], v00[1]); w0.y = cvt_pk_bf16(v00[2], v00[3]); w0.z = cvt_pk_bf16(v01[0], v01[1]); w0.w = cvt_pk_bf16(v01[2], v01[3]);
                w1.x = cvt_pk_bf16(v10[0], v10[1]); w1.y = cvt_pk_bf16(v10[2], v10[3]); w1.z = cvt_pk_bf16(v11[0], v11[1]); w1.w = cvt_pk_bf16(v11[2], v11[3]);
                bf16_t* rowp = y + (size_t)row * DM + col0;
                *(u32x4*)(rowp) = w0; *(u32x4*)(rowp + HALF) = w1;
            }
    }
};
}
namespace la {
__device__ __forceinline__ unsigned off_a(unsigned row, unsigned ch) { return 2048u * (row >> 3) + 512u * (ch >> 2) + 64u * (row & 7) + 16u * ((ch & 3) ^ ((row >> 2) & 3)); }
__device__ __forceinline__ unsigned r_base(int lane, int e) { const unsigned h = lane >> 5; return 2048u * ((lane & 31) >> 3) + 64u * (lane & 7) + 16u * ((2u * e + h) ^ ((lane >> 2) & 3)); }
__device__ __forceinline__ unsigned t_base(int lane, int t) { const unsigned h = lane >> 5, blk = (lane >> 4) & 1, q = (lane & 15) >> 2, p = lane & 3;
    return 2048u * h + 64u * (4u * t + q) + 16u * ((2u * blk + (p >> 1)) ^ (2u * h + t)) + 8u * (p & 1); }
__device__ __forceinline__ int crow(int r, int hi) { return (r & 3) + 8 * (r >> 2) + 4 * hi; }

__device__ __forceinline__ bf16x8 lds_r128(unsigned addr) { return *(const LAS bf16x8*)(uintptr_t)addr; }
__device__ __forceinline__ bf16x8 lds_tr_frag(unsigned a0, unsigned a1) {
    s16x4 x, y; asm volatile("ds_read_b64_tr_b16 %0, %2\n\tds_read_b64_tr_b16 %1, %3\n\ts_waitcnt lgkmcnt(0)" : "=&v"(x), "=&v"(y) : "v"(a0), "v"(a1) : "memory");
    return (bf16x8){x[0], x[1], x[2], x[3], y[0], y[1], y[2], y[3]};
}
__device__ __forceinline__ bf16x8 scale_frag(bf16x8 f, float s) {
    u32x4 w = __builtin_bit_cast(u32x4, f); u32x4 o;
    o.x = cvt_pk_bf16(bf_lo(w.x) * s, bf_hi(w.x) * s); o.y = cvt_pk_bf16(bf_lo(w.y) * s, bf_hi(w.y) * s);
    o.z = cvt_pk_bf16(bf_lo(w.z) * s, bf_hi(w.z) * s); o.w = cvt_pk_bf16(bf_lo(w.w) * s, bf_hi(w.w) * s);
    return __builtin_bit_cast(bf16x8, o);
}
template <int R, int NP, bool SCALE>
__device__ __forceinline__ void stage_tile(int tid, unsigned lds_base, const bf16_t* g, int ld, const LAS float* rowscale) {
    constexpr int RPI = 32 / NP, NIT = R / RPI;
    static_assert(RPI % 8 == 0 && R % RPI == 0, "stage_tile geometry");
    const int row0 = tid / (16 * NP), cc = tid % (16 * NP), pnl = cc >> 4, ch = cc & 15;
    const unsigned la0 = lds_base + pnl * (R * 256) + off_a(row0, ch), la1 = lds_base + pnl * (R * 256) + off_a(row0 + RPI, ch);
    const bf16_t* gp = g + (size_t)row0 * ld + cc * 8;
    const size_t gstep = (size_t)RPI * ld;
#pragma unroll
    for (int it = 0; it < NIT; ++it) {
        bf16x8 v = *(const bf16x8*)(gp + it * gstep);
        if (SCALE) v = scale_frag(v, rowscale[row0 + it * RPI]);
        const unsigned la = (RPI % 16 == 0) ? la0 + it * (RPI * 256) : ((it & 1) ? la1 + (it >> 1) * (2 * RPI * 256) : la0 + (it >> 1) * (2 * RPI * 256));
        *(LAS bf16x8*)(uintptr_t)la = v;
        if ((it & 3) == 3) FENCE();
    }
}
template <int R, int CW>
__device__ __forceinline__ void stage_tile_narrow(int tid, unsigned lds_base, const bf16_t* g, int ld) {
    static_assert(CW == 64 && R % 64 == 0, "stage_tile_narrow geometry");
    const int row0 = tid >> 3, ch = tid & 7;
    const unsigned la0 = lds_base + off_a(row0, ch);
    const bf16_t* gp = g + (size_t)row0 * ld + ch * 8;
#pragma unroll
    for (int it = 0; it < R / 64; ++it) *(LAS bf16x8*)(uintptr_t)(la0 + it * 16384) = *(const bf16x8*)(gp + (size_t)it * 64 * ld);
}

struct StateArgs {
    const bf16_t* K; int ldk;
    const bf16_t* V; int ldv;
    bf16_t* Cout; int ldc; size_t cstride;
    float* Nout;
    const float* alpha; const float* beta;
    float lgam; int dir;
};
template <int DK, int DVB, bool MLSTM>
__device__ __forceinline__ void state_unit(LAS unsigned char* lds, const StateArgs a) {
    constexpr int NDKB = DK / 32, NDVB = DVB / 32, BPW = (NDKB * NDVB) / 8, NPK = DK / 128;
    static_assert(BPW >= 1 && (NDKB == 8 || NDKB == 4), "state tile geometry");
    int tid = threadIdx.x; asm volatile("" : "+v"(tid));
    const int wid = __builtin_amdgcn_readfirstlane(tid >> 6), lane = tid & 63, r32 = lane & 31, hi = lane >> 5;
    const int dkb = wid % NDKB, dvb0 = (wid / NDKB) * BPW;
    const unsigned ldsb = (unsigned)(uintptr_t)lds;
    const unsigned KP = ldsb, VP = ldsb + NPK * 32768u, WT = VP + 32768u;
    LAS float* wtab = (LAS float*)(lds + NPK * 32768 + 32768);
    const unsigned tb0 = t_base(lane, 0), tb1 = t_base(lane, 1);
    f32x16 acc[BPW];
#pragma unroll
    for (int j = 0; j < BPW; ++j) acc[j] = (f32x16){};
    float nacc = 0.f;
#pragma unroll 1
    for (int ci = 0; ci < 32; ++ci) {
        const int c = a.dir ? 31 - ci : ci; const int t0 = c * 128;
        {
            bf16_t* co = a.Cout + (size_t)c * a.cstride;
#pragma unroll
            for (int j = 0; j < BPW; ++j)
#pragma unroll
                for (int r = 0; r < 16; ++r) co[(size_t)(32 * dkb + crow(r, hi)) * a.ldc + 32 * (dvb0 + j) + r32] = f2bf(acc[j][r]);
            if (MLSTM) { if (a.Nout && tid < DK) a.Nout[(size_t)c * DK + tid] = nacc; }
        }
        float eF;
        if (MLSTM) {
            const float F = a.alpha[t0 + (a.dir ? 0 : 127)];
            if (tid < 128) wtab[tid] = __expf(F - a.alpha[t0 + tid] + a.beta[t0 + tid]);
            eF = __expf(F);
        } else {
            if (tid < 128) { const int sp = a.dir ? 127 - tid : tid; wtab[tid] = __expf((float)(127 - sp) * a.lgam); }
            eF = __expf(128.f * a.lgam);
        }
        __syncthreads();
        stage_tile<128, NPK, true>(tid, KP, a.K + (size_t)t0 * a.ldk, a.ldk, wtab);
        if constexpr (DVB == 128) stage_tile<128, 1, false>(tid, VP, a.V + (size_t)t0 * a.ldv, a.ldv, nullptr);
        else stage_tile_narrow<128, DVB>(tid, VP, a.V + (size_t)t0 * a.ldv, a.ldv);
        __syncthreads();
#pragma unroll
        for (int j = 0; j < BPW; ++j)
#pragma unroll
            for (int r = 0; r < 16; ++r) acc[j][r] *= eF;
#pragma unroll
        for (int ks = 0; ks < 8; ++ks) {
            const unsigned ka = KP + (dkb >> 2) * 32768u + 4096u * ks + 512u * (dkb & 3);
            const bf16x8 af = lds_tr_frag(ka + tb0, ka + tb1);
#pragma unroll
            for (int j = 0; j < BPW; ++j) {
                const unsigned va = VP + 4096u * ks + 512u * (dvb0 + j);
                const bf16x8 bfr = lds_tr_frag(va + tb0, va + tb1);
                acc[j] = __builtin_amdgcn_mfma_f32_32x32x16_bf16(af, bfr, acc[j], 0, 0, 0);
            }
            FENCE();
        }
        if (MLSTM) {
            if (tid < DK) { float s = 0.f; const int pnl = tid >> 7, col = tid & 127;
                for (int p = 0; p < 128; ++p) s += bf2f(*(const LAS bf16_t*)(lds + pnl * 32768 + off_a(p, col >> 3) + (col & 7) * 2));
                nacc = eF * nacc + s; }
        }
        __syncthreads();
    }
    (void)WT;
}

struct OutArgs {
    const bf16_t* Q; int ldq;
    const bf16_t* K; int ldk;
    const bf16_t* V; int ldv;
    const bf16_t* Cf; const bf16_t* Cb;
    const float* Nf; const float* Nb;
    const float* af; const float* bfw; const float* ab; const float* bbw;
    float Mf, Mb;
    float lgf, lgb;
    const float* gain;
    const bf16_t* G; int ldg;
    bf16_t* Out; int ldo;
};
template <int DK, int DV, bool MLSTM>
__device__ __forceinline__ void out_unit(LAS unsigned char* lds, LAS unsigned char* ldstab, const OutArgs a) {
    constexpr int NPK = DK / 128, NB = DV / 64, NPV = DV / 128, NKS = DK / 16, NCP = DK / 64;
    int tid = threadIdx.x; asm volatile("" : "+v"(tid));
    const int wid = __builtin_amdgcn_readfirstlane(tid >> 6), lane = tid & 63, r32 = lane & 31, hi = lane >> 5;
    const int rb = wid & 3, dh = wid >> 2;
    const unsigned ldsb = (unsigned)(uintptr_t)lds;
    const unsigned QP = ldsb, KP = ldsb + NPK * 32768u, SB = KP;
    LAS float* akf = (LAS float*)ldstab; LAS float* akb = akf + 128; LAS float* nf = akb + 128; LAS float* nbv = nf + 256; LAS float* exch = nbv + 256;
    const unsigned rb0 = r_base(lane, 0), rb1 = r_base(lane, 1), tb0 = t_base(lane, 0), tb1 = t_base(lane, 1);
    __syncthreads();
    stage_tile<128, NPK, false>(tid, QP, a.Q, a.ldq, nullptr);
    stage_tile<128, NPK, false>(tid, KP, a.K, a.ldk, nullptr);
    if (tid < 128) {
        if (MLSTM) { akf[tid] = a.af[tid] - a.bfw[tid]; akb[tid] = a.ab[tid] - a.bbw[tid]; }
        else { akf[tid] = (float)(tid + 1) * a.lgf; akb[tid] = (float)(128 - tid) * a.lgb; }
    }
    if (MLSTM) { if (tid < DK) { nf[tid] = a.Nf[tid]; nbv[tid] = a.Nb[tid]; } }
    const int l = 32 * rb + r32;
    float a_fl, a_bl;
    if (MLSTM) { a_fl = a.af[l]; a_bl = a.ab[l]; } else { a_fl = (float)(l + 1) * a.lgf; a_bl = (float)(128 - l) * a.lgb; }
    __syncthreads();
    f32x16 p[4];
#pragma unroll
    for (int kb = 0; kb < 4; ++kb) p[kb] = (f32x16){};
    float qnf = 0.f, qnb = 0.f;
#pragma unroll
    for (int ks = 0; ks < NKS; ++ks) {
        const unsigned po = (ks >> 3) * 32768u + ((ks & 1) ? rb1 : rb0) + 512u * ((ks & 7) >> 1);
        const bf16x8 qf = lds_r128(QP + po + 8192u * rb);
        bf16x8 kf[4];
#pragma unroll
        for (int kb = 0; kb < 4; ++kb) kf[kb] = lds_r128(KP + po + 8192u * kb);
#pragma unroll
        for (int kb = 0; kb < 4; ++kb) p[kb] = __builtin_amdgcn_mfma_f32_32x32x16_bf16(kf[kb], qf, p[kb], 0, 0, 0);
        FENCE();
    }
    if (MLSTM) {
#pragma unroll 1
        for (int ks = 0; ks < NKS; ++ks) {
            const bf16x8 qf = lds_r128(QP + (ks >> 3) * 32768u + ((ks & 1) ? rb1 : rb0) + 512u * ((ks & 7) >> 1) + 8192u * rb);
            const u32x4 w = __builtin_bit_cast(u32x4, qf); const int k0 = 16 * ks + 8 * hi;
            const f32x4 nf0 = *(const LAS f32x4*)(nf + k0), nf1 = *(const LAS f32x4*)(nf + k0 + 4), nb0 = *(const LAS f32x4*)(nbv + k0), nb1 = *(const LAS f32x4*)(nbv + k0 + 4);
            const float q0 = bf_lo(w.x), q1 = bf_hi(w.x), q2 = bf_lo(w.y), q3 = bf_hi(w.y), q4 = bf_lo(w.z), q5 = bf_hi(w.z), q6 = bf_lo(w.w), q7 = bf_hi(w.w);
            qnf += q0 * nf0[0] + q1 * nf0[1] + q2 * nf0[2] + q3 * nf0[3] + q4 * nf1[0] + q5 * nf1[1] + q6 * nf1[2] + q7 * nf1[3];
            qnb += q0 * nb0[0] + q1 * nb0[1] + q2 * nb0[2] + q3 * nb0[3] + q4 * nb1[0] + q5 * nb1[1] + q6 * nb1[2] + q7 * nb1[3];
        }
    }
    float rf = 1.f, rbk = 1.f;
    if (MLSTM) {
        float df = 0.f, db = 0.f;
#pragma unroll
        for (int kb = 0; kb < 4; ++kb) {
#pragma unroll
            for (int r = 0; r < 16; ++r) { const int s = 32 * kb + crow(r, hi);
                const float xf = a_fl - akf[s], xb = a_bl - akb[s];
                const float wf = __expf((s <= l) ? xf : -1.0e30f), wb = __expf((s >= l) ? xb : -1.0e30f);
                df += p[kb][r] * wf; db += p[kb][r] * wb; }
            FENCE(); }
        { auto rr = __builtin_amdgcn_permlane32_swap(__float_as_uint(df), __float_as_uint(df), false, false); df = __uint_as_float(rr[0]) + __uint_as_float(rr[1]); }
        { auto rr = __builtin_amdgcn_permlane32_swap(__float_as_uint(db), __float_as_uint(db), false, false); db = __uint_as_float(rr[0]) + __uint_as_float(rr[1]); }
        { auto rr = __builtin_amdgcn_permlane32_swap(__float_as_uint(qnf), __float_as_uint(qnf), false, false); qnf = __uint_as_float(rr[0]) + __uint_as_float(rr[1]); }
        { auto rr = __builtin_amdgcn_permlane32_swap(__float_as_uint(qnb), __float_as_uint(qnb), false, false); qnb = __uint_as_float(rr[0]) + __uint_as_float(rr[1]); }
        df += __expf(a_fl) * qnf; db += __expf(a_bl) * qnb;
        rf = 1.f / fmaxf(fabsf(df), __expf(-a.Mf)); rbk = 1.f / fmaxf(fabsf(db), __expf(-a.Mb));
        asm volatile("" : "+v"(a_fl), "+v"(a_bl));
    }
    int l2 = l; asm volatile("" : "+v"(l2));
#pragma unroll
    for (int kb = 0; kb < 4; ++kb) {
#pragma unroll
        for (int r = 0; r < 16; ++r) { const int s = 32 * kb + crow(r, hi);
            const float xf = a_fl - akf[s], xb = a_bl - akb[s];
            const float wf = __expf((s <= l2) ? xf : -1.0e30f), wb = __expf((s >= l2) ? xb : -1.0e30f);
            p[kb][r] *= (wf * rf + wb * rbk); }
        FENCE(); }
    const float qsf = __expf(a_fl) * rf, qsb = __expf(a_bl) * rbk;
    bf16x8 pa[8];
#define LA_PK4(P, BASE, OUT) do { unsigned a0 = cvt_pk_bf16(P[BASE + 0], P[BASE + 1]), a1 = cvt_pk_bf16(P[BASE + 2], P[BASE + 3]); \
    unsigned b0 = cvt_pk_bf16(P[BASE + 4], P[BASE + 5]), b1 = cvt_pk_bf16(P[BASE + 6], P[BASE + 7]); \
    auto r0 = __builtin_amdgcn_permlane32_swap(a0, b0, false, false); auto r1 = __builtin_amdgcn_permlane32_swap(a1, b1, false, false); \
    u32x4 w = {r0[0], r1[0], r0[1], r1[1]}; OUT = __builtin_bit_cast(bf16x8, w); } while (0)
#pragma unroll
    for (int kb = 0; kb < 4; ++kb) { LA_PK4(p[kb], 0, pa[2 * kb]); LA_PK4(p[kb], 8, pa[2 * kb + 1]); }
#undef LA_PK4
    f32x16 o[NB];
#pragma unroll
    for (int nb = 0; nb < NB; ++nb) o[nb] = (f32x16){};
#pragma unroll
    for (int pc = 0; pc < 2; ++pc) {
        __syncthreads();
        stage_tile<64, NPV, false>(tid, SB, a.V + (size_t)(64 * pc) * a.ldv, a.ldv, nullptr);
        __syncthreads();
#pragma unroll
        for (int ks = 0; ks < 4; ++ks) {
            const bf16x8 af = pa[4 * pc + ks];
#pragma unroll
            for (int nb = 0; nb < NB; ++nb) { const int cg = dh * NB + nb; const unsigned va = SB + (cg >> 2) * 16384u + 4096u * ks + 512u * (cg & 3);
                const bf16x8 bfr = lds_tr_frag(va + tb0, va + tb1);
                o[nb] = __builtin_amdgcn_mfma_f32_32x32x16_bf16(af, bfr, o[nb], 0, 0, 0); }
            FENCE();
        }
    }
#pragma unroll 1
    for (int pc = 0; pc < 2 * NCP; ++pc) {
        __syncthreads();
        const int dirb = pc >= NCP, cp = dirb ? pc - NCP : pc;
        const bf16_t* src = (dirb ? a.Cb : a.Cf) + (size_t)(64 * cp) * DV;
        const float qs = dirb ? qsb : qsf;
        stage_tile<64, NPV, false>(tid, SB, src, DV, nullptr);
        __syncthreads();
#pragma unroll
        for (int ks = 0; ks < 4; ++ks) {
            const int kq = 4 * cp + ks;
            const bf16x8 qf = lds_r128(QP + (kq >> 3) * 32768u + ((kq & 1) ? rb1 : rb0) + 512u * ((kq & 7) >> 1) + 8192u * rb);
            const bf16x8 af = scale_frag(qf, qs);
#pragma unroll
            for (int nb = 0; nb < NB; ++nb) { const int cg = dh * NB + nb; const unsigned va = SB + (cg >> 2) * 16384u + 4096u * ks + 512u * (cg & 3);
                const bf16x8 bfr = lds_tr_frag(va + tb0, va + tb1);
                o[nb] = __builtin_amdgcn_mfma_f32_32x32x16_bf16(af, bfr, o[nb], 0, 0, 0); }
            FENCE();
        }
    }
    float s1[16], s2[16];
#pragma unroll
    for (int r = 0; r < 16; ++r) { float x1 = 0.f, x2 = 0.f;
#pragma unroll
        for (int nb = 0; nb < NB; ++nb) { x1 += o[nb][r]; x2 += o[nb][r] * o[nb][r]; }
#pragma unroll
        for (int m = 1; m < 32; m <<= 1) { x1 += shx(x1, m, lane); x2 += shx(x2, m, lane); }
        s1[r] = x1; s2[r] = x2; }
    if (r32 == 0) {
#pragma unroll
        for (int r = 0; r < 16; ++r) { const int row = 32 * rb + crow(r, hi); exch[(dh * 128 + row) * 2] = s1[r]; exch[(dh * 128 + row) * 2 + 1] = s2[r]; }
    }
    __syncthreads();
#pragma unroll
    for (int r = 0; r < 16; ++r) {
        const int row = 32 * rb + crow(r, hi);
        const float t1 = s1[r] + exch[((1 - dh) * 128 + row) * 2], t2 = s2[r] + exch[((1 - dh) * 128 + row) * 2 + 1];
        float mean, inv;
        if (MLSTM) { mean = 0.f; inv = rsqrtf(t2 * (1.f / DV) + EPS); }
        else { mean = t1 * (1.f / DV); inv = rsqrtf(fmaxf(t2 * (1.f / DV) - mean * mean, 0.f) + EPS); }
#pragma unroll
        for (int nb = 0; nb < NB; ++nb) {
            const int col = dh * (DV / 2) + 32 * nb + r32;
            const float gpre = bf2f(a.G[(size_t)row * a.ldg + col]);
            const float gate = MLSTM ? sigmoidf_(gpre) : siluf_(gpre);
            a.Out[(size_t)row * a.ldo + col] = f2bf((o[nb][r] - mean) * inv * a.gain[col] * gate);
        }
    }
}

template <int R, int NP>
__device__ __forceinline__ void dma_tile(int wid, int lane, unsigned lds_base, const bf16_t* src, int ld) {
    constexpr int NQ = R * NP / 4, PER = NQ / 8;
    static_assert(NQ % 8 == 0 && R % 8 == 0, "dma_tile geometry");
    const int r7 = (lane >> 2) & 7, x = lane & 3, hi = lane >> 5;
#pragma unroll
    for (int j = 0; j < PER; ++j) {
        const int q = wid * PER + j;
        const int sub = 2 * q + hi, panel = sub / (R / 2), psub = sub % (R / 2), rg = psub >> 2, cblk = psub & 3;
        const int row = 8 * rg + r7, chlo = x ^ ((row >> 2) & 3);
        const bf16_t* g = src + (size_t)row * ld + 128 * panel + 32 * cblk + 8 * chlo;
        __builtin_amdgcn_global_load_lds((const unsigned*)g, (LAS unsigned*)(uintptr_t)(lds_base + q * 1024u), 16, 0, 0);
    }
}
template <int R>
__device__ __forceinline__ void dma_tile_n64(int wid, int lane, unsigned lds_base, const bf16_t* src, int ld) {
    static_assert(R == 64, "dma_tile_n64 geometry");
    const int r7 = (lane >> 2) & 7, x = lane & 3, hi = lane >> 5;
    const int row = 8 * wid + r7, chlo = x ^ ((row >> 2) & 3);
    const bf16_t* g = src + (size_t)row * ld + 32 * hi + 8 * chlo;
    __builtin_amdgcn_global_load_lds((const unsigned*)g, (LAS unsigned*)(uintptr_t)(lds_base + wid * 2048u), 16, 0, 0);
}
template <int OFF> __device__ __forceinline__ s16x4 tr_rd(unsigned base) { s16x4 r; asm volatile("ds_read_b64_tr_b16 %0, %1 offset:%2" : "=&v"(r) : "v"(base), "i"(OFF) : "memory"); return r; }
#define LA_LGKM0() do { asm volatile("s_waitcnt lgkmcnt(0)" ::: "memory"); __builtin_amdgcn_sched_barrier(0); } while (0)
#define LA_FRAG(L, H) (bf16x8){L[0], L[1], L[2], L[3], H[0], H[1], H[2], H[3]}
template <int NBLK>
__device__ __forceinline__ void store_blocks_t(LAS unsigned char* ts, int lane, const f32x16* blk, bf16_t* dst, int ldd) {
    constexpr int RB = 64 * NBLK;
    const int r32 = lane & 31, hi = lane >> 5;
#pragma unroll
    for (int j = 0; j < NBLK; ++j)
#pragma unroll
        for (int r = 0; r < 16; ++r) *(LAS bf16_t*)(ts + crow(r, hi) * RB + (32 * j + r32) * 2) = f2bf(blk[j][r]);
    LDS_WAIT();
    constexpr int CPR = 4 * NBLK, NCH = 32 * CPR;
#pragma unroll
    for (int it = 0; it < NCH / 64; ++it) { const int id = it * 64 + lane, row = id / CPR, ch = id % CPR;
        *(u32x4*)(dst + (size_t)row * ldd + 8 * ch) = *(const LAS u32x4*)(ts + row * RB + ch * 16); }
    LDS_WAIT();
}

template <int DK, int DVB, bool MLSTM>
__device__ __forceinline__ void state_unit2(LAS unsigned char* lds, LAS unsigned char* ldstab, const StateArgs a, const int wv) {
    constexpr int NDKB = DK / 32, NDVB = DVB / 32, BPW = (NDKB * NDVB) / 8, NPK = DK / 128;
    constexpr unsigned BUFSZ = (NPK + 1) * 16384u, VOFF = NPK * 16384u, TSOFF = 2 * BUFSZ;
    static_assert(TSOFF + 8 * 4096u <= 131072u, "state pass LDS map stays below the control words");
    static_assert(BPW >= 1 && (NDKB == 8 || NDKB == 4) && (DVB == 128 || DVB == 64), "state tile geometry");
    int tid = TIDX(wv); asm volatile("" : "+v"(tid));
    const int wid = __builtin_amdgcn_readfirstlane(tid >> 6), lane = tid & 63, hi = lane >> 5;
    const int dkb = wid % NDKB, dvb0 = (wid / NDKB) * BPW;
    const unsigned ldsb = (unsigned)(uintptr_t)lds;
    LAS float* wtab = (LAS float*)ldstab;
    LAS unsigned char* ts = lds + TSOFF + wid * 4096;
    const unsigned tbA0 = t_base(lane, 0) + (dkb >> 2) * 16384u + 512u * (dkb & 3), tbA1 = t_base(lane, 1) + (dkb >> 2) * 16384u + 512u * (dkb & 3);
    const unsigned tbB0 = t_base(lane, 0) + VOFF + 512u * dvb0, tbB1 = t_base(lane, 1) + VOFF + 512u * dvb0;
    f32x16 acc[BPW];
#pragma unroll
    for (int j = 0; j < BPW; ++j) acc[j] = (f32x16){};
    float nacc = 0.f;
    __syncthreads();
#define ST_DMA(hs_) do { const int c_ = a.dir ? 31 - ((hs_) >> 1) : ((hs_) >> 1); const int t_ = c_ * 128 + 64 * ((hs_) & 1); const unsigned bb_ = ldsb + ((hs_) & 1) * BUFSZ; \
        dma_tile<64, NPK>(wid, lane, bb_, a.K + (size_t)t_ * a.ldk, a.ldk); \
        if constexpr (DVB == 128) dma_tile<64, 1>(wid, lane, bb_ + VOFF, a.V + (size_t)t_ * a.ldv, a.ldv); else dma_tile_n64<64>(wid, lane, bb_ + VOFF, a.V + (size_t)t_ * a.ldv, a.ldv); } while (0)
    ST_DMA(0);
    float eF = 1.f;
#pragma unroll 1
    for (int hs = 0; hs < 64; ++hs) {
        const int ci = hs >> 1, half = hs & 1, c = a.dir ? 31 - ci : ci, t0 = c * 128;
        LAS float* wt = wtab + (ci & 1) * 128;
        if (half == 0) {
            bf16_t* co = a.Cout + (size_t)c * a.cstride + (size_t)(32 * dkb) * a.ldc + 32 * dvb0;
            if constexpr (BPW == 4) { store_blocks_t<2>(ts, lane, acc, co, a.ldc); store_blocks_t<2>(ts, lane, acc + 2, co + 64, a.ldc); }
            else store_blocks_t<1>(ts, lane, acc, co, a.ldc);
            if (MLSTM) { if (a.Nout && tid < DK) a.Nout[(size_t)c * DK + tid] = nacc; }
            if (MLSTM) { const float F = a.alpha[t0 + (a.dir ? 0 : 127)];
                if (tid < 128) wt[tid] = __expf(F - a.alpha[t0 + tid] + a.beta[t0 + tid]);
                eF = __expf(F);
            } else {
                if (tid < 128) { const int sp = a.dir ? 127 - tid : tid; wt[tid] = __expf((float)(127 - sp) * a.lgam); }
                eF = __expf(128.f * a.lgam);
            }
        }
        VM_WAIT(); __syncthreads();
        if (hs + 1 < 64) ST_DMA(hs + 1);
        if (half == 0) {
#pragma unroll
            for (int j = 0; j < BPW; ++j)
#pragma unroll
                for (int r = 0; r < 16; ++r) acc[j][r] *= eF;
        }
        const unsigned bb = ldsb + half * BUFSZ;
        const unsigned a0 = bb + tbA0, a1 = bb + tbA1, b0 = bb + tbB0, b1 = bb + tbB1;
        const LAS float* wk = wt + 64 * half + 8 * hi;
#define ST_KS(KS) do { \
            const s16x4 al = tr_rd<4096 * (KS)>(a0), ah = tr_rd<4096 * (KS)>(a1); \
            s16x4 bl[BPW], bh[BPW]; \
            bl[0] = tr_rd<4096 * (KS)>(b0); bh[0] = tr_rd<4096 * (KS)>(b1); \
            if constexpr (BPW == 4) { bl[1] = tr_rd<4096 * (KS) + 512>(b0); bh[1] = tr_rd<4096 * (KS) + 512>(b1); bl[2] = tr_rd<4096 * (KS) + 1024>(b0); bh[2] = tr_rd<4096 * (KS) + 1024>(b1); \
                bl[3] = tr_rd<4096 * (KS) + 1536>(b0); bh[3] = tr_rd<4096 * (KS) + 1536>(b1); } \
            const f32x4 w0 = *(const LAS f32x4*)(wk + 16 * (KS)), w1 = *(const LAS f32x4*)(wk + 16 * (KS) + 4); \
            LA_LGKM0(); \
            u32x4 af; af.x = cvt_pk_bf16(bf2f((bf16_t)al[0]) * w0[0], bf2f((bf16_t)al[1]) * w0[1]); af.y = cvt_pk_bf16(bf2f((bf16_t)al[2]) * w0[2], bf2f((bf16_t)al[3]) * w0[3]); \
            af.z = cvt_pk_bf16(bf2f((bf16_t)ah[0]) * w1[0], bf2f((bf16_t)ah[1]) * w1[1]); af.w = cvt_pk_bf16(bf2f((bf16_t)ah[2]) * w1[2], bf2f((bf16_t)ah[3]) * w1[3]); \
            const bf16x8 afr = __builtin_bit_cast(bf16x8, af); \
            _Pragma("unroll") for (int j = 0; j < BPW; ++j) acc[j] = __builtin_amdgcn_mfma_f32_32x32x16_bf16(afr, LA_FRAG(bl[j], bh[j]), acc[j], 0, 0, 0); \
        } while (0)
        ST_KS(0); ST_KS(1); ST_KS(2); ST_KS(3);
#undef ST_KS
        if (MLSTM) {
            if (tid < DK) { float s = 0.f; const int pnl = tid >> 7, col = tid & 127; const LAS unsigned char* kp = lds + half * BUFSZ + pnl * 16384 + (col & 7) * 2;
                for (int p = 0; p < 64; ++p) s += bf2f(*(const LAS bf16_t*)(kp + off_a(p, col >> 3))) * wt[64 * half + p];
                nacc = (half == 0 ? eF * nacc : nacc) + s; }
        }
    }
#undef ST_DMA
    __syncthreads();
}

template <int DK, int DV, bool MLSTM>
__device__ __forceinline__ void out_unit2(LAS unsigned char* lds, LAS unsigned char* ldstab, const OutArgs a, const int wv) {
    constexpr int NPK = DK / 128, NB = DV / 64, NPV = DV / 128, NKS = DK / 16, NCP = DK / 32;
    constexpr unsigned PANEL = 32 * 256, PIECE = NPV * PANEL;
    static_assert(2 * PIECE <= NPK * 32768u && (NB == 8 || NB == 2), "stream buffers fit the K region");
    int tid = TIDX(wv); asm volatile("" : "+v"(tid));
    const int wid = __builtin_amdgcn_readfirstlane(tid >> 6), lane = tid & 63, r32 = lane & 31, hi = lane >> 5;
    const int rb = wid & 3, dh = wid >> 2;
    const unsigned ldsb = (unsigned)(uintptr_t)lds;
    const unsigned QP = ldsb, KP = ldsb + NPK * 32768u, SB = KP;
    LAS float* akf = (LAS float*)ldstab; LAS float* akb = akf + 128; LAS float* nf = akb + 128; LAS float* nbv = nf + 256; LAS float* exch = nbv + 256;
    const unsigned rb0 = r_base(lane, 0);
#define rb1 (rb0 ^ 32u)
    const unsigned dhoff = (NB == 8) ? dh * 2u * PANEL : dh * 1024u;
    const unsigned tb0 = t_base(lane, 0) + dhoff;
#define tb1 ((tb0 ^ 16u) + 256u)
    __syncthreads();
    dma_tile<128, NPK>(wid, lane, QP, a.Q, a.ldq);
    dma_tile<128, NPK>(wid, lane, KP, a.K, a.ldk);
    if (tid < 128) {
        if (MLSTM) { akf[tid] = a.af[tid] - a.bfw[tid]; akb[tid] = a.ab[tid] - a.bbw[tid]; }
        else { akf[tid] = (float)(tid + 1) * a.lgf; akb[tid] = (float)(128 - tid) * a.lgb; }
    }
    if (MLSTM) { if (tid < DK) { nf[tid] = a.Nf[tid]; nbv[tid] = a.Nb[tid]; } }
    const int l = 32 * rb + r32;
    float a_fl, a_bl;
    if (MLSTM) { a_fl = a.af[l]; a_bl = a.ab[l]; } else { a_fl = (float)(l + 1) * a.lgf; a_bl = (float)(128 - l) * a.lgb; }
    VM_WAIT(); __syncthreads();
    f32x16 p[4];
#pragma unroll
    for (int kb = 0; kb < 4; ++kb) p[kb] = (f32x16){};
    float qnf = 0.f, qnb = 0.f;
#pragma unroll
    for (int ks = 0; ks < NKS; ++ks) {
        const unsigned po = (ks >> 3) * 32768u + ((ks & 1) ? rb1 : rb0) + 512u * ((ks & 7) >> 1);
        const bf16x8 qf = lds_r128(QP + po + 8192u * rb);
        bf16x8 kf[4];
#pragma unroll
        for (int kb = 0; kb < 4; ++kb) kf[kb] = lds_r128(KP + po + 8192u * kb);
#pragma unroll
        for (int kb = 0; kb < 4; ++kb) p[kb] = __builtin_amdgcn_mfma_f32_32x32x16_bf16(kf[kb], qf, p[kb], 0, 0, 0);
        FENCE();
    }
    if (MLSTM) {
#pragma unroll 1
        for (int ks = 0; ks < NKS; ++ks) {
            const bf16x8 qf = lds_r128(QP + (ks >> 3) * 32768u + ((ks & 1) ? rb1 : rb0) + 512u * ((ks & 7) >> 1) + 8192u * rb);
            const u32x4 w = __builtin_bit_cast(u32x4, qf); const int k0 = 16 * ks + 8 * hi;
            const f32x4 nf0 = *(const LAS f32x4*)(nf + k0), nf1 = *(const LAS f32x4*)(nf + k0 + 4), nb0 = *(const LAS f32x4*)(nbv + k0), nb1 = *(const LAS f32x4*)(nbv + k0 + 4);
            const float q0 = bf_lo(w.x), q1 = bf_hi(w.x), q2 = bf_lo(w.y), q3 = bf_hi(w.y), q4 = bf_lo(w.z), q5 = bf_hi(w.z), q6 = bf_lo(w.w), q7 = bf_hi(w.w);
            qnf += q0 * nf0[0] + q1 * nf0[1] + q2 * nf0[2] + q3 * nf0[3] + q4 * nf1[0] + q5 * nf1[1] + q6 * nf1[2] + q7 * nf1[3];
            qnb += q0 * nb0[0] + q1 * nb0[1] + q2 * nb0[2] + q3 * nb0[3] + q4 * nb1[0] + q5 * nb1[1] + q6 * nb1[2] + q7 * nb1[3];
        }
    }
    __syncthreads();
    dma_tile<32, NPV>(wid, lane, SB, a.V, a.ldv);
    float rf = 1.f, rbk = 1.f;
    if (MLSTM) {
        float df = 0.f, db = 0.f;
#pragma unroll
        for (int kb = 0; kb < 4; ++kb) {
#pragma unroll
            for (int r = 0; r < 16; ++r) { const int s = 32 * kb + crow(r, hi);
                const float xf = a_fl - akf[s], xb = a_bl - akb[s];
                const float wf = __expf((s <= l) ? xf : -1.0e30f), wb = __expf((s >= l) ? xb : -1.0e30f);
                df += p[kb][r] * wf; db += p[kb][r] * wb; }
            FENCE(); }
        { auto rr = __builtin_amdgcn_permlane32_swap(__float_as_uint(df), __float_as_uint(df), false, false); df = __uint_as_float(rr[0]) + __uint_as_float(rr[1]); }
        { auto rr = __builtin_amdgcn_permlane32_swap(__float_as_uint(db), __float_as_uint(db), false, false); db = __uint_as_float(rr[0]) + __uint_as_float(rr[1]); }
        { auto rr = __builtin_amdgcn_permlane32_swap(__float_as_uint(qnf), __float_as_uint(qnf), false, false); qnf = __uint_as_float(rr[0]) + __uint_as_float(rr[1]); }
        { auto rr = __builtin_amdgcn_permlane32_swap(__float_as_uint(qnb), __float_as_uint(qnb), false, false); qnb = __uint_as_float(rr[0]) + __uint_as_float(rr[1]); }
        df += __expf(a_fl) * qnf; db += __expf(a_bl) * qnb;
        rf = 1.f / fmaxf(fabsf(df), __expf(-a.Mf)); rbk = 1.f / fmaxf(fabsf(db), __expf(-a.Mb));
        asm volatile("" : "+v"(a_fl), "+v"(a_bl));
    }
    int l2 = l; asm volatile("" : "+v"(l2));
#pragma unroll
    for (int kb = 0; kb < 4; ++kb) {
#pragma unroll
        for (int r = 0; r < 16; ++r) { const int s = 32 * kb + crow(r, hi);
            const float xf = a_fl - akf[s], xb = a_bl - akb[s];
            const float wf = __expf((s <= l2) ? xf : -1.0e30f), wb = __expf((s >= l2) ? xb : -1.0e30f);
            p[kb][r] *= (wf * rf + wb * rbk); }
        FENCE(); }
    const float qsf = __expf(a_fl) * rf, qsb = __expf(a_bl) * rbk;
    bf16x8 pa[8];
#define LA_PK4(P, BASE, OUT) do { unsigned a0 = cvt_pk_bf16(P[BASE + 0], P[BASE + 1]), a1 = cvt_pk_bf16(P[BASE + 2], P[BASE + 3]); \
    unsigned b0 = cvt_pk_bf16(P[BASE + 4], P[BASE + 5]), b1 = cvt_pk_bf16(P[BASE + 6], P[BASE + 7]); \
    auto r0 = __builtin_amdgcn_permlane32_swap(a0, b0, false, false); auto r1 = __builtin_amdgcn_permlane32_swap(a1, b1, false, false); \
    u32x4 w = {r0[0], r1[0], r0[1], r1[1]}; OUT = __builtin_bit_cast(bf16x8, w); } while (0)
#pragma unroll
    for (int kb = 0; kb < 4; ++kb) { LA_PK4(p[kb], 0, pa[2 * kb]); LA_PK4(p[kb], 8, pa[2 * kb + 1]); }
#undef LA_PK4
    f32x16 o[NB];
#pragma unroll
    for (int nb = 0; nb < NB; ++nb) o[nb] = (f32x16){};
#define OUT_DMA(pc_) do { const int n_ = (pc_); const unsigned bb_ = SB + (n_ & 1) * PIECE; \
        if (n_ < 4) dma_tile<32, NPV>(wid, lane, bb_, a.V + (size_t)(32 * n_) * a.ldv, a.ldv); \
        else if (n_ < 4 + NCP) dma_tile<32, NPV>(wid, lane, bb_, a.Cf + (size_t)(32 * (n_ - 4)) * DV, DV); \
        else dma_tile<32, NPV>(wid, lane, bb_, a.Cb + (size_t)(32 * (n_ - 4 - NCP)) * DV, DV); } while (0)
#define OUT_MMA(bufpar) do { const unsigned b0_ = SB + (bufpar) * PIECE + tb0, b1_ = SB + (bufpar) * PIECE + tb1; \
        if constexpr (NB == 8) { \
            _Pragma("unroll") for (int g_ = 0; g_ < 2; ++g_) { const unsigned c0_ = b0_ + g_ * PANEL, c1_ = b1_ + g_ * PANEL; \
                { const s16x4 l0 = tr_rd<0>(c0_), h0 = tr_rd<0>(c1_), l1 = tr_rd<512>(c0_), h1 = tr_rd<512>(c1_), l2_ = tr_rd<1024>(c0_), h2 = tr_rd<1024>(c1_), l3 = tr_rd<1536>(c0_), h3 = tr_rd<1536>(c1_); LA_LGKM0(); \
                  o[4 * g_ + 0] = __builtin_amdgcn_mfma_f32_32x32x16_bf16(af0, LA_FRAG(l0, h0), o[4 * g_ + 0], 0, 0, 0); o[4 * g_ + 1] = __builtin_amdgcn_mfma_f32_32x32x16_bf16(af0, LA_FRAG(l1, h1), o[4 * g_ + 1], 0, 0, 0); \
                  o[4 * g_ + 2] = __builtin_amdgcn_mfma_f32_32x32x16_bf16(af0, LA_FRAG(l2_, h2), o[4 * g_ + 2], 0, 0, 0); o[4 * g_ + 3] = __builtin_amdgcn_mfma_f32_32x32x16_bf16(af0, LA_FRAG(l3, h3), o[4 * g_ + 3], 0, 0, 0); } \
                { const s16x4 l0 = tr_rd<4096>(c0_), h0 = tr_rd<4096>(c1_), l1 = tr_rd<4608>(c0_), h1 = tr_rd<4608>(c1_), l2_ = tr_rd<5120>(c0_), h2 = tr_rd<5120>(c1_), l3 = tr_rd<5632>(c0_), h3 = tr_rd<5632>(c1_); LA_LGKM0(); \
                  o[4 * g_ + 0] = __builtin_amdgcn_mfma_f32_32x32x16_bf16(af1, LA_FRAG(l0, h0), o[4 * g_ + 0], 0, 0, 0); o[4 * g_ + 1] = __builtin_amdgcn_mfma_f32_32x32x16_bf16(af1, LA_FRAG(l1, h1), o[4 * g_ + 1], 0, 0, 0); \
                  o[4 * g_ + 2] = __builtin_amdgcn_mfma_f32_32x32x16_bf16(af1, LA_FRAG(l2_, h2), o[4 * g_ + 2], 0, 0, 0); o[4 * g_ + 3] = __builtin_amdgcn_mfma_f32_32x32x16_bf16(af1, LA_FRAG(l3, h3), o[4 * g_ + 3], 0, 0, 0); } } \
        } else { \
            const s16x4 l0 = tr_rd<0>(b0_), h0 = tr_rd<0>(b1_), l1 = tr_rd<512>(b0_), h1 = tr_rd<512>(b1_), l2_ = tr_rd<4096>(b0_), h2 = tr_rd<4096>(b1_), l3 = tr_rd<4608>(b0_), h3 = tr_rd<4608>(b1_); LA_LGKM0(); \
            o[0] = __builtin_amdgcn_mfma_f32_32x32x16_bf16(af0, LA_FRAG(l0, h0), o[0], 0, 0, 0); o[1] = __builtin_amdgcn_mfma_f32_32x32x16_bf16(af0, LA_FRAG(l1, h1), o[1], 0, 0, 0); \
            o[0] = __builtin_amdgcn_mfma_f32_32x32x16_bf16(af1, LA_FRAG(l2_, h2), o[0], 0, 0, 0); o[1] = __builtin_amdgcn_mfma_f32_32x32x16_bf16(af1, LA_FRAG(l3, h3), o[1], 0, 0, 0); } } while (0)
#pragma unroll
    for (int pc = 0; pc < 4; ++pc) {
        VM_WAIT(); __syncthreads();
        OUT_DMA(pc + 1);
        const bf16x8 af0 = pa[2 * pc], af1 = pa[2 * pc + 1];
        OUT_MMA(pc & 1);
    }
#pragma unroll 1
    for (int pc = 4; pc < 4 + 2 * NCP; ++pc) {
        VM_WAIT(); __syncthreads();
        if (pc + 1 < 4 + 2 * NCP) OUT_DMA(pc + 1);
        const int cq = pc - 4, dirb = cq >= NCP, cp = dirb ? cq - NCP : cq;
        const float qs = dirb ? qsb : qsf;
        const unsigned qa = QP + (cp >> 2) * 32768u + 512u * (cp & 3) + 8192u * rb;
        const bf16x8 af0 = scale_frag(lds_r128(qa + rb0), qs), af1 = scale_frag(lds_r128(qa + rb1), qs);
        OUT_MMA(pc & 1);
    }
#undef OUT_DMA
#undef OUT_MMA
    float s1[16], s2[16];
#pragma unroll
    for (int r = 0; r < 16; ++r) { float x1 = 0.f, x2 = 0.f;
#pragma unroll
        for (int nb = 0; nb < NB; ++nb) { x1 += o[nb][r]; x2 += o[nb][r] * o[nb][r]; }
#pragma unroll
        for (int m = 1; m < 32; m <<= 1) { x1 += shx(x1, m, lane); x2 += shx(x2, m, lane); }
        s1[r] = x1; s2[r] = x2; }
    if (r32 == 0) {
#pragma unroll
        for (int r = 0; r < 16; ++r) { const int row = 32 * rb + crow(r, hi); exch[(dh * 128 + row) * 2] = s1[r]; exch[(dh * 128 + row) * 2 + 1] = s2[r]; }
    }
    __syncthreads();
    constexpr int TP = DV * 2;
    static_assert(128 * TP <= 2 * NPK * 32768, "output tile fits the Q + K regions");
#pragma unroll
    for (int r = 0; r < 16; ++r) {
        const int row = 32 * rb + crow(r, hi);
        const float t1 = s1[r] + exch[((1 - dh) * 128 + row) * 2], t2 = s2[r] + exch[((1 - dh) * 128 + row) * 2 + 1];
        float mean, inv;
        if (MLSTM) { mean = 0.f; inv = rsqrtf(t2 * (1.f / DV) + EPS); }
        else { mean = t1 * (1.f / DV); inv = rsqrtf(fmaxf(t2 * (1.f / DV) - mean * mean, 0.f) + EPS); }
#pragma unroll
        for (int nb = 0; nb < NB; ++nb) { const int col = dh * (DV / 2) + 32 * nb + r32;
            *(LAS bf16_t*)(lds + row * TP + col * 2) = f2bf((o[nb][r] - mean) * inv); }
    }
    __syncthreads();
    constexpr int CPR = DV / 8;
#pragma unroll 1
    for (int id = tid; id < 128 * CPR; id += 512) { const int row = id / CPR, ch = id % CPR;
        const u32x4 y = *(const LAS u32x4*)(lds + row * TP + ch * 16); const u32x4 g = *(const u32x4*)(a.G + (size_t)row * a.ldg + 8 * ch);
        const f32x4 g0 = *(const f32x4*)(a.gain + 8 * ch), g1 = *(const f32x4*)(a.gain + 8 * ch + 4);
        float yv[8] = {bf_lo(y.x), bf_hi(y.x), bf_lo(y.y), bf_hi(y.y), bf_lo(y.z), bf_hi(y.z), bf_lo(y.w), bf_hi(y.w)};
        float gv[8] = {bf_lo(g.x), bf_hi(g.x), bf_lo(g.y), bf_hi(g.y), bf_lo(g.z), bf_hi(g.z), bf_lo(g.w), bf_hi(g.w)};
        float gn[8] = {g0[0], g0[1], g0[2], g0[3], g1[0], g1[1], g1[2], g1[3]};
        float ov[8];
#pragma unroll
        for (int i = 0; i < 8; ++i) ov[i] = yv[i] * gn[i] * (MLSTM ? sigmoidf_(gv[i]) : siluf_(gv[i]));
        u32x4 w; w.x = cvt_pk_bf16(ov[0], ov[1]); w.y = cvt_pk_bf16(ov[2], ov[3]); w.z = cvt_pk_bf16(ov[4], ov[5]); w.w = cvt_pk_bf16(ov[6], ov[7]);
        *(u32x4*)(a.Out + (size_t)row * a.ldo + 8 * ch) = w; }
#undef rb1
#undef tb1
}
}
namespace att {
constexpr int DQK = 96, DVV = 64, NW = 8, QBLK = 32, KVBLK = 64, KROW = 128;
constexpr float SCALE = 0.10206207261596575f;
constexpr float THR = 8.f;
constexpr size_t SHM_V = KVBLK * DVV * 2, SHM_K = KVBLK * KROW * 2, SHM_ATTN = 2 * SHM_V + 2 * SHM_K + NW * 64 * 4;
#define KSWZ(row, colB) ((row) * 256 + ((colB) ^ (((row) & 7) << 4)))
__device__ __forceinline__ int crow(int r, int hi) { return (r & 3) + 8 * (r >> 2) + 4 * hi; }

__device__ __forceinline__ void partialSM(f32x16& p0, f32x16& p1, float& m_reg, float& mn, float& alpha) {
  constexpr float C = SCALE * 1.4426950408889634f;
  float pmax = p0[0]; for (int r = 1; r < 16; ++r) pmax = fmaxf(pmax, p0[r]); for (int r = 0; r < 16; ++r) pmax = fmaxf(pmax, p1[r]);
  { auto rr = __builtin_amdgcn_permlane32_swap(__float_as_uint(pmax), __float_as_uint(pmax), false, false);
    pmax = fmaxf(__uint_as_float(rr[0]), __uint_as_float(rr[1])); }
  if (__builtin_expect(__all(pmax - m_reg <= THR / SCALE), 1)) { mn = m_reg; alpha = 1.f; }
  else { mn = fmaxf(m_reg, pmax); alpha = __builtin_amdgcn_exp2f((m_reg - mn) * C); m_reg = mn; }
  float mnC = -mn * C;
  for (int r = 0; r < 16; ++r) p0[r] = fmaf(p0[r], C, mnC); for (int r = 0; r < 16; ++r) p1[r] = fmaf(p1[r], C, mnC);
  for (int r = 0; r < 16; ++r) p0[r] = __builtin_amdgcn_exp2f(p0[r]);
}
__device__ __forceinline__ void finishSM(f32x16& p0, f32x16& p1, float alpha, float& l_reg, bf16x8& pa0, bf16x8& pa1, bf16x8& pa2, bf16x8& pa3) {
  for (int r = 0; r < 16; ++r) p1[r] = __builtin_amdgcn_exp2f(p1[r]);
  float ps = 0; for (int r = 0; r < 16; ++r) ps += p0[r]; for (int r = 0; r < 16; ++r) ps += p1[r];
  { auto rr = __builtin_amdgcn_permlane32_swap(__float_as_uint(ps), __float_as_uint(ps), false, false);
    ps = __uint_as_float(rr[0]) + __uint_as_float(rr[1]); }
  l_reg = l_reg * alpha + ps;
#define PK4(P, BASE, OUT) do { unsigned a0 = cvt_pk_bf16(P[BASE + 0], P[BASE + 1]), a1 = cvt_pk_bf16(P[BASE + 2], P[BASE + 3]);   \
    unsigned b0 = cvt_pk_bf16(P[BASE + 4], P[BASE + 5]), b1 = cvt_pk_bf16(P[BASE + 6], P[BASE + 7]);                              \
    auto r0 = __builtin_amdgcn_permlane32_swap(a0, b0, false, false); auto r1 = __builtin_amdgcn_permlane32_swap(a1, b1, false, false); \
    u32x4 w = {r0[0], r1[0], r0[1], r1[1]}; OUT = __builtin_bit_cast(bf16x8, w); } while (0)
  PK4(p0, 0, pa0); PK4(p0, 8, pa1); PK4(p1, 0, pa2); PK4(p1, 8, pa3);
#undef PK4
}
__device__ __forceinline__ void qkt(f32x16& p0, f32x16& p1, const LAS char* Ks, const bf16x8* qr, int r32, int hi) {
  p0 = f32x16{}; p1 = f32x16{};
#pragma unroll
  for (int d0 = 0; d0 < DQK / 16; ++d0) { int cb = (d0 * 16 + hi * 8) * 2;
    bf16x8 b0 = *reinterpret_cast<const LAS bf16x8*>(Ks + KSWZ(r32, cb));
    bf16x8 b1 = *reinterpret_cast<const LAS bf16x8*>(Ks + KSWZ(32 + r32, cb));
    p0 = __builtin_amdgcn_mfma_f32_32x32x16_bf16(b0, qr[d0], p0, 0, 0, 0);
    p1 = __builtin_amdgcn_mfma_f32_32x32x16_bf16(b1, qr[d0], p1, 0, 0, 0); }
}
__device__ __forceinline__ int v_st(int k, int c) { const int kk = (k & ~0xC) | ((k & 4) << 1) | ((k & 8) >> 1); return ((kk >> 3) * 2 + (c >> 5)) * 512 + ((kk & 7) * 32 + (c & 31)) * 2; }
__device__ __forceinline__ int v_rd_base(int lane) { return ((lane & 3) << 3) | (((lane >> 2) & 3) << 6) | (((lane >> 4) & 1) << 5) | (((lane >> 5) & 1) << 8); }
constexpr int v_rd_off(int d0, int ks, int half) { return d0 * 512 + ks * 2048 + half * 1024; }
template <int OFF> __device__ __forceinline__ s16x4 tr_read(int vb) {
  s16x4 r; asm volatile("ds_read_b64_tr_b16 %0, %1 offset:%2" : "=&v"(r) : "v"(vb), "i"(OFF) : "memory"); return r;
}
template <int D0> __device__ __forceinline__ void pv_one(f32x16& od, int vb, bf16x8 pa0, bf16x8 pa1, bf16x8 pa2, bf16x8 pa3) {
  const s16x4 l0 = tr_read<v_rd_off(D0, 0, 0)>(vb), h0 = tr_read<v_rd_off(D0, 0, 1)>(vb), l1 = tr_read<v_rd_off(D0, 1, 0)>(vb), h1 = tr_read<v_rd_off(D0, 1, 1)>(vb);
  const s16x4 l2 = tr_read<v_rd_off(D0, 2, 0)>(vb), h2 = tr_read<v_rd_off(D0, 2, 1)>(vb), l3 = tr_read<v_rd_off(D0, 3, 0)>(vb), h3 = tr_read<v_rd_off(D0, 3, 1)>(vb);
  asm volatile("s_waitcnt lgkmcnt(0)" ::: "memory"); SBAR();
#define PK(L, H) (bf16x8){L[0], L[1], L[2], L[3], H[0], H[1], H[2], H[3]}
  od = __builtin_amdgcn_mfma_f32_32x32x16_bf16(pa0, PK(l0, h0), od, 0, 0, 0);
  od = __builtin_amdgcn_mfma_f32_32x32x16_bf16(pa1, PK(l1, h1), od, 0, 0, 0);
  od = __builtin_amdgcn_mfma_f32_32x32x16_bf16(pa2, PK(l2, h2), od, 0, 0, 0);
  od = __builtin_amdgcn_mfma_f32_32x32x16_bf16(pa3, PK(l3, h3), od, 0, 0, 0);
#undef PK
}
__device__ __forceinline__ void pv_d0(f32x16* o, int vb, bf16x8 pa0, bf16x8 pa1, bf16x8 pa2, bf16x8 pa3) {
  pv_one<0>(o[0], vb, pa0, pa1, pa2, pa3); pv_one<1>(o[1], vb, pa0, pa1, pa2, pa3);
}
__device__ __forceinline__ void attn_body(const bf16_t* __restrict__ Qb, const bf16_t* __restrict__ Kh, const bf16_t* __restrict__ Vh, bf16_t* __restrict__ Ob, int ldo, int seq, LAS char* lds, const int wv) {
  int tid = TIDX(wv); asm volatile("" : "+v"(tid));
  const int wid = tid >> 6, lane = tid & 63, r32 = lane & 31, hi = lane >> 5;
  LAS char* V_lds = lds; LAS char* K_lds = lds + 2 * SHM_V;
  LAS float* ws = (LAS float*)(lds + 2 * SHM_V + 2 * SHM_K) + wid * 64; LAS float* li_l = ws; LAS float* al_l = ws + 32;
  float m_reg = -1e30f, l_reg = 0; f32x16 o[2] = {}; bf16x8 qr[DQK / 16];
  const bf16_t* Qw = Qb + (long)(wid * QBLK + r32) * DQK + hi * 8;
#pragma unroll
  for (int d0 = 0; d0 < DQK / 16; ++d0) qr[d0] = *reinterpret_cast<const bf16x8*>(Qw + d0 * 16);
  const int sr = tid >> 4, sc = (tid & 15) * 8;
  const int vr = tid >> 3, vc = (tid & 7) * 8, vst0 = v_st(vr, vc);
  const int vb0 = (int)(uintptr_t)V_lds + v_rd_base(lane);
  struct { bf16x8 vs0, ks0, ks1; } sr_[2];
#define SLOAD(i, k0) do { sr_[i].vs0 = *reinterpret_cast<const bf16x8*>(&Vh[(long)((k0) + vr) * DVV + vc]); \
    sr_[i].ks0 = *reinterpret_cast<const bf16x8*>(&Kh[(long)((k0) + sr) * KROW + sc]); sr_[i].ks1 = *reinterpret_cast<const bf16x8*>(&Kh[(long)((k0) + 32 + sr) * KROW + sc]); } while (0)
#define SWRITE(b, i) do { *(LAS bf16x8*)(V_lds + (b) * SHM_V + vst0) = sr_[i].vs0; int kc = sc * 2;               \
    *(LAS bf16x8*)(K_lds + (b) * SHM_K + KSWZ(sr, kc)) = sr_[i].ks0;                       \
    *(LAS bf16x8*)(K_lds + (b) * SHM_K + KSWZ(32 + sr, kc)) = sr_[i].ks1; } while (0)
#define SWAIT() asm volatile("s_waitcnt vmcnt(3)" ::: "memory")
#define RESC(a) do { if (__any((a) < 1.f)) { if (hi == 0) al_l[r32] = (a); asm volatile("s_waitcnt lgkmcnt(0)" ::: "memory"); \
    for (int d = 0; d < 2; ++d) for (int r = 0; r < 16; ++r) o[d][r] *= al_l[crow(r, hi)]; } } while (0)
  f32x16 pA0, pA1, pB0, pB1; float mnA, mnB, alA, alB; bf16x8 pa0, pa1, pa2, pa3; const int NT = seq / KVBLK;
  constexpr int SE = 0, SO = 1;
  SLOAD(SE, 0); asm volatile("s_waitcnt vmcnt(0)" ::: "memory"); SWRITE(0, SE); __syncthreads();
  qkt(pA0, pA1, K_lds, qr, r32, hi); partialSM(pA0, pA1, m_reg, mnA, alA);
  SLOAD(SO, KVBLK); if (2 < NT) SLOAD(SE, 2 * KVBLK);
  SWAIT(); SWRITE(1, SO); __syncthreads();
  for (int j = 1; j + 1 < NT; j += 2) {
    SBAR(); qkt(pB0, pB1, K_lds + SHM_K, qr, r32, hi);
    finishSM(pA0, pA1, alA, l_reg, pa0, pa1, pa2, pa3); SBAR();
    SLOAD(SO, (j + 2) * KVBLK); SBAR();
    pv_d0(o, vb0, pa0, pa1, pa2, pa3); partialSM(pB0, pB1, m_reg, mnB, alB);
    __syncthreads(); SWAIT(); SWRITE(0, SE);
    RESC(alB); __syncthreads();
    SBAR(); qkt(pA0, pA1, K_lds, qr, r32, hi);
    finishSM(pB0, pB1, alB, l_reg, pa0, pa1, pa2, pa3); SBAR();
    if (j + 3 < NT) SLOAD(SE, (j + 3) * KVBLK); SBAR();
    pv_d0(o, vb0 + (int)SHM_V, pa0, pa1, pa2, pa3); partialSM(pA0, pA1, m_reg, mnA, alA);
    __syncthreads(); SWAIT(); SWRITE(1, SO);
    RESC(alA); __syncthreads();
  }
  SBAR(); qkt(pB0, pB1, K_lds + SHM_K, qr, r32, hi);
  finishSM(pA0, pA1, alA, l_reg, pa0, pa1, pa2, pa3); SBAR();
  pv_d0(o, vb0, pa0, pa1, pa2, pa3); partialSM(pB0, pB1, m_reg, mnB, alB);
  __syncthreads(); RESC(alB);
  finishSM(pB0, pB1, alB, l_reg, pa0, pa1, pa2, pa3); SBAR();
  pv_d0(o, vb0 + (int)SHM_V, pa0, pa1, pa2, pa3);
  if (hi == 0) li_l[r32] = l_reg; asm volatile("s_waitcnt lgkmcnt(0)" ::: "memory");
  float rli[16];
#pragma unroll
  for (int r = 0; r < 16; ++r) rli[r] = __builtin_amdgcn_rcpf(li_l[crow(r, hi)]);
  bf16_t* Ow = Ob + (long)(wid * QBLK) * ldo;
#pragma unroll
  for (int r = 0; r < 16; ++r) { int orow = crow(r, hi);
#pragma unroll
    for (int d0 = 0; d0 < 2; ++d0) Ow[(long)orow * ldo + d0 * 32 + r32] = f2bf(o[d0][r] * rli[r]); }
  __syncthreads();
#undef SLOAD
#undef SWRITE
#undef SWAIT
#undef RESC
}
#undef KSWZ
}
constexpr size_t MiB = 1ull << 20;
constexpr size_t WS_CTL = 0, CTL_ZERO_BYTES = 1 * MiB;
constexpr size_t WS_MOD = 1 * MiB;
constexpr size_t WS_MISC = 2 * MiB;
constexpr size_t WS_ROPEO = 8 * MiB;
constexpr size_t WS_ROPEE = 40 * MiB;
constexpr size_t WS_WINE = 48 * MiB;
constexpr size_t WS_WQB = 58 * MiB;
constexpr size_t WS_WKVB = 59 * MiB;
constexpr size_t WS_WOUTE = 60 * MiB;
constexpr size_t WS_WINO = 64 * MiB;
constexpr size_t WS_WOUTO = 88 * MiB;
constexpr size_t WS_WGU = 96 * MiB;
constexpr size_t WS_WDN = 608 * MiB;
constexpr size_t WS_HM = 864 * MiB;
constexpr size_t WS_P = 928 * MiB;
constexpr size_t WS_X1 = 1312 * MiB;
constexpr size_t X1_QC = WS_X1, X1_KC = X1_QC + 32 * MiB, X1_QA = X1_KC + 32 * MiB, X1_KVA = X1_QA + 16 * MiB, X1_QRAW = X1_KVA + 16 * MiB, X1_KVRAW = X1_QRAW + 48 * MiB,
                 X1_QH = X1_KVRAW + 64 * MiB, X1_KH = X1_QH + 48 * MiB, X1_VH = X1_KH + 64 * MiB, X1_CM = X1_VH + 32 * MiB, X1_NM = X1_CM + 64 * MiB;
constexpr size_t WS_MIX = WS_X1 + 512 * MiB;
constexpr size_t WS_LIST = WS_MIX + 128 * MiB;
constexpr size_t WS_WLIST = WS_LIST + 16 * MiB;
constexpr size_t WS_TOKE = WS_WLIST + 16 * MiB;
constexpr size_t WS_WSORT = WS_TOKE + 1 * MiB;
constexpr size_t WS_ASORT = WS_WSORT + 1 * MiB;
constexpr size_t WS_ACT = WS_ASORT + 272 * MiB;
constexpr size_t WS_Y = WS_ACT + 272 * MiB;
constexpr size_t WS_END = WS_Y + 272 * MiB;
static_assert(X1_NM + 1 * MiB <= WS_MIX, "even-layer scratch fits");
constexpr int CW_BAR = 4096;
constexpr int CW_CNT = 8192;
constexpr int CW_QUEUE = 8192 + 1024;

constexpr int LDS_RING = 0;
constexpr int LDS_TAB = 131072;
constexpr int LT_MISC = LDS_TAB;
constexpr int LT_PSTART = LDS_TAB + 256;
constexpr int LT_CNT = LDS_TAB + 512;
constexpr int LT_BLK = LDS_TAB + 1024;
constexpr int LT_X = LDS_TAB + 1024 + 4352;
constexpr int LT_N2TILE = 144640;
constexpr int LDS_BYTES = 163840;

#if defined(__HIP_DEVICE_COMPILE__) && __HIP_DEVICE_COMPILE__
#define ARGAS GAS
#else
#define ARGAS
#endif
typedef const ARGAS float* gcf_t; typedef const ARGAS int* gci_t;
struct Args {
    gcf_t x; gcf_t c; gci_t pos; gcf_t ada_w; gcf_t ada_b; gcf_t norm_mix_g; gcf_t norm_ffn_g;
    gcf_t hy_w_in; gcf_t ml_conv_w; gcf_t ml_conv_b; gcf_t ml_gate_b; gcf_t ml_norm_g; gcf_t mla_q_norm_g; gcf_t mla_kv_norm_g;
    gcf_t mla_w_qb; gcf_t mla_w_kvb; gcf_t mla_qk_q_g; gcf_t mla_qk_k_g; gcf_t hy_w_out;
    gcf_t ret_w_in; gcf_t ret_decay_f; gcf_t ret_decay_b; gcf_t ret_gn_g; gcf_t ret_w_out;
    gcf_t moe_router_w; gcf_t moe_router_b; gcf_t moe_w_gu; gcf_t moe_b_gu; gcf_t moe_w_down; gcf_t moe_b_down;
    ARGAS float* out; ARGAS unsigned char* ws; int ph_lo, ph_hi;
};

constexpr float FP8_WSC = 128.f, FP8_HSC = 16.f, FP8_ASC = 4.f;
template <class RowMap>
__device__ __forceinline__ void transpose_item(const float* W, int N, bf16_t* WT, int ldk, LAS float* scr, int kb, int nb, int lane, const RowMap& rm) {
    const int k0 = 64 * kb, n0 = 32 * nb;
#pragma unroll 8
    for (int i = 0; i < 32; ++i) { const int kk = 2 * i + (lane >> 5); scr[kk * 33 + (lane & 31)] = W[(size_t)(k0 + kk) * N + n0 + (lane & 31)]; }
    LDS_WAIT(); asm volatile("" ::: "memory");
    const int c = lane & 7;
#pragma unroll
    for (int j = 0; j < 4; ++j) { const int n = (lane >> 3) + 8 * j; const LAS float* s = scr + (8 * c) * 33 + n;
        u32x4 o; o.x = cvt_pk_bf16(s[0 * 33], s[1 * 33]); o.y = cvt_pk_bf16(s[2 * 33], s[3 * 33]); o.z = cvt_pk_bf16(s[4 * 33], s[5 * 33]); o.w = cvt_pk_bf16(s[6 * 33], s[7 * 33]);
        *(u32x4*)(WT + (size_t)rm(n0 + n) * ldk + k0 + 8 * c) = o; }
    LDS_WAIT(); asm volatile("" ::: "memory");
}
template <class RowMap>
__device__ __forceinline__ void transpose_item8(const float* W, int N, unsigned char* WT, int ldk, LAS float* scr, int kb, int nb, int lane, const RowMap& rm, float scale) {
    const int k0 = 64 * kb, n0 = 32 * nb;
#pragma unroll 8
    for (int i = 0; i < 32; ++i) { const int kk = 2 * i + (lane >> 5); scr[kk * 33 + (lane & 31)] = W[(size_t)(k0 + kk) * N + n0 + (lane & 31)] * scale; }
    LDS_WAIT(); asm volatile("" ::: "memory");
    const int c = lane & 7;
#pragma unroll
    for (int j = 0; j < 4; ++j) { const int n = (lane >> 3) + 8 * j; const LAS float* s = scr + (8 * c) * 33 + n;
        u32x2 o; o.x = pg8::pk4_fp8(s[0 * 33], s[1 * 33], s[2 * 33], s[3 * 33]); o.y = pg8::pk4_fp8(s[4 * 33], s[5 * 33], s[6 * 33], s[7 * 33]);
        *(u32x2*)(WT + (size_t)rm(n0 + n) * ldk + k0 + 8 * c) = o; }
    LDS_WAIT(); asm volatile("" ::: "memory");
}
struct RmId { __device__ __forceinline__ int operator()(int n) const { return n; } };
struct RmWinE { __device__ __forceinline__ int operator()(int n) const {
    if (n < 2048) return n; if (n < 2064) return PC_GT + (n - 2048); if (n < 2320) return PC_QA + (n - 2064); if (n < 2448) return PC_KVA + (n - 2320); return PC_KR + (n - 2448); } };
struct RmGu { __device__ __forceinline__ int operator()(int n) const { const int u = n & 1023; return 256 * (u >> 7) + (n >> 10) * 128 + (u & 127); } };

__device__ __forceinline__ void ld_row16(const float* p, int lane, f32x4 (&v)[4]) {
#pragma unroll
    for (int j = 0; j < 4; ++j) v[j] = *(const f32x4*)(p + 4 * lane + 256 * j);
}
struct Frame { LAS unsigned char* lds; int tid, lane, wave, G, bid; };
extern __shared__ __attribute__((aligned(16))) unsigned char lds_raw[];
#define MK_FRAME(F) Frame F; { int tz_ = TIDX(wv); asm volatile("" : "+v"(tz_)); \
    int g_ = gridDim.x, b_ = blockIdx.x; asm volatile("" : "+s"(g_), "+s"(b_)); \
    F.lds = (LAS unsigned char*)lds_raw; F.tid = tz_; F.lane = tz_ & 63; F.wave = __builtin_amdgcn_readfirstlane(tz_ >> 6); F.G = g_; F.bid = b_; }
typedef const __attribute__((address_space(4))) Args* CArgsP;
__device__ __forceinline__ const Args& fresh_args() { unsigned long long p = (unsigned long long)__builtin_amdgcn_kernarg_segment_ptr(); asm volatile("" : "+s"(p)); return *(const Args*)(CArgsP)p; }
__device__ __forceinline__ ARGAS unsigned char* opaque_ws(const ARGAS unsigned char* p) { unsigned long long v = (unsigned long long)p; asm volatile("" : "+s"(v)); return (ARGAS unsigned char*)v; }

__device__ __forceinline__ void p0_prologue(const Args& a, const int wv) {
    MK_FRAME(F); ARGAS unsigned char* ws = opaque_ws(a.ws);
    {
        LAS float* cs = (LAS float*)(F.lds); LAS float* red = (LAS float*)(F.lds + 32768);
        for (int i = F.tid; i < NBATCH * DM; i += 512) cs[i] = siluf_(a.c[i]);
        __syncthreads();
        float* mod = (float*)(ws + WS_MOD);
        for (int it = F.bid; it < DEPTH * 48; it += F.G) {
            const int l = it / 48, n = (it % 48) * 128 + (F.tid & 127), ksl = F.tid >> 7;
            const float* w = a.ada_w + ((size_t)l * DM + ksl * 256) * 6144 + n;
            float acc[NBATCH];
#pragma unroll
            for (int b = 0; b < NBATCH; ++b) acc[b] = 0.f;
#pragma unroll 4
            for (int k = 0; k < 256; ++k) { const float wv = w[(size_t)k * 6144];
#pragma unroll
                for (int b = 0; b < NBATCH; ++b) acc[b] += cs[b * DM + ksl * 256 + k] * wv; }
#pragma unroll
            for (int b = 0; b < NBATCH; ++b) red[(ksl * NBATCH + b) * 128 + (F.tid & 127)] = acc[b];
            __syncthreads();
            for (int o = F.tid; o < NBATCH * 128; o += 512) { const int b = o >> 7, nn = o & 127;
                const float s = red[(0 * NBATCH + b) * 128 + nn] + red[(1 * NBATCH + b) * 128 + nn] + red[(2 * NBATCH + b) * 128 + nn] + red[(3 * NBATCH + b) * 128 + nn];
                const int col = (it % 48) * 128 + nn;
                mod[((size_t)l * NBATCH + b) * 6144 + col] = s + a.ada_b[(size_t)l * 6144 + col]; }
            __syncthreads();
        }
        __syncthreads();
    }
    {
        f32x2* ro = (f32x2*)(ws + WS_ROPEO); f32x2* re = (f32x2*)(ws + WS_ROPEE);
        const size_t gt = (size_t)F.bid * 512 + F.tid, GT = (size_t)F.G * 512;
        for (size_t i = gt; i < (size_t)NTOK * 128; i += GT) { const int tok = (int)(i >> 7), f = (int)(i & 127);
            const float inv = powf(10000.f, -(float)(2 * f) / 256.f); const float ang = (float)a.pos[tok] * inv; float s, c; sincosf(ang, &s, &c); ro[i] = (f32x2){c, s}; }
        for (size_t i = gt; i < (size_t)NTOK * 16; i += GT) { const int tok = (int)(i >> 4), f = (int)(i & 15);
            const float inv = powf(10000.f, -(float)(2 * f) / 32.f); const float ang = (float)a.pos[tok] * inv; float s, c; sincosf(ang, &s, &c); re[i] = (f32x2){c, s}; }
        bf16_t* wkv = (bf16_t*)(ws + WS_WKVB);
        for (size_t i = gt; i < (size_t)2 * 1024 * 16; i += GT) { const size_t row = i >> 4, ch = i & 15; *(u32x4*)(wkv + row * 256 + 128 + ch * 8) = (u32x4){0u, 0u, 0u, 0u}; }
    }
    {
        LAS float* scr = (LAS float*)(F.lds + F.wave * 16384);
        const int gw = F.bid * 8 + F.wave, NGW = F.G * 8;
        constexpr int I_WINE = 16 * 78, I_WQB = 4 * 24, I_WKVB = 2 * 32, I_WOUTE = 16 * 32, I_WINO = 16 * 192, I_WOUTO = 32 * 32, I_WGU = 16 * 64, I_WDN = 16 * 32;
        constexpr int T0 = 2 * I_WINE, T1 = T0 + 2 * I_WQB, T2 = T1 + 2 * I_WKVB, T3 = T2 + 2 * I_WOUTE, T4 = T3 + 2 * I_WINO, T5 = T4 + 2 * I_WOUTO, T6 = T5 + 128 * I_WGU, T7 = T6 + 128 * I_WDN;
        for (int it = gw; it < T7; it += NGW) {
            if (it < T0) { const int m = it / I_WINE, r = it % I_WINE, kb = r / 78, nb = r % 78;
                const float* W = a.hy_w_in + (size_t)m * DM * EVEN_IN; bf16_t* WT = (bf16_t*)(ws + WS_WINE) + (size_t)m * EVEN_INP * DM;
                const int k0 = 64 * kb, n0 = 32 * nb; const RmWinE rm;
#pragma unroll 8
                for (int i = 0; i < 32; ++i) { const int kk = 2 * i + (F.lane >> 5), n = n0 + (F.lane & 31); scr[kk * 33 + (F.lane & 31)] = (n < EVEN_IN) ? W[(size_t)(k0 + kk) * EVEN_IN + n] : 0.f; }
                LDS_WAIT(); asm volatile("" ::: "memory");
                const int c = F.lane & 7;
#pragma unroll
                for (int j = 0; j < 4; ++j) { const int n = (F.lane >> 3) + 8 * j; const LAS float* s = scr + (8 * c) * 33 + n;
                    u32x4 o; o.x = cvt_pk_bf16(s[0 * 33], s[1 * 33]); o.y = cvt_pk_bf16(s[2 * 33], s[3 * 33]); o.z = cvt_pk_bf16(s[4 * 33], s[5 * 33]); o.w = cvt_pk_bf16(s[6 * 33], s[7 * 33]);
                    if (n0 + n < EVEN_IN) *(u32x4*)(WT + (size_t)rm(n0 + n) * DM + k0 + 8 * c) = o; }
                LDS_WAIT(); asm volatile("" ::: "memory");
                continue; }
            if (it < T1) { const int q = it - T0, m = q / I_WQB, r = q % I_WQB; transpose_item(a.mla_w_qb + (size_t)m * 256 * 768, 768, (bf16_t*)(ws + WS_WQB) + (size_t)m * 768 * 256, 256, scr, r / 24, r % 24, F.lane, RmId()); continue; }
            if (it < T2) { const int q = it - T1, m = q / I_WKVB, r = q % I_WKVB; transpose_item(a.mla_w_kvb + (size_t)m * 128 * 1024, 1024, (bf16_t*)(ws + WS_WKVB) + (size_t)m * 1024 * 256, 256, scr, r / 32, r % 32, F.lane, RmId()); continue; }
            if (it < T3) { const int q = it - T2, m = q / I_WOUTE, r = q % I_WOUTE; transpose_item(a.hy_w_out + (size_t)m * DM * DM, DM, (bf16_t*)(ws + WS_WOUTE) + (size_t)m * DM * DM, DM, scr, r / 32, r % 32, F.lane, RmId()); continue; }
            if (it < T4) { const int q = it - T3, m = q / I_WINO, r = q % I_WINO; transpose_item(a.ret_w_in + (size_t)m * DM * RET_IN, RET_IN, (bf16_t*)(ws + WS_WINO) + (size_t)m * RET_IN * DM, DM, scr, r / 192, r % 192, F.lane, RmId()); continue; }
            if (it < T5) { const int q = it - T4, m = q / I_WOUTO, r = q % I_WOUTO; transpose_item(a.ret_w_out + (size_t)m * 2048 * DM, DM, (bf16_t*)(ws + WS_WOUTO) + (size_t)m * DM * 2048, 2048, scr, r / 32, r % 32, F.lane, RmId()); continue; }
            if (it < T6) { const int q = it - T5, m = q / I_WGU, r = q % I_WGU; transpose_item8(a.moe_w_gu + (size_t)m * DM * 2048, 2048, (unsigned char*)(ws + WS_WGU) + (size_t)m * 2048 * DM, DM, scr, r / 64, r % 64, F.lane, RmGu(), FP8_WSC); continue; }
            { const int q = it - T6, m = q / I_WDN, r = q % I_WDN; transpose_item8(a.moe_w_down + (size_t)m * EFF * DM, DM, (unsigned char*)(ws + WS_WDN) + (size_t)m * DM * EFF, EFF, scr, r / 32, r % 32, F.lane, RmId(), FP8_WSC); }
        }
    }
}

__device__ __forceinline__ void build_pstart(const Frame& F, const unsigned* cnt) {
    LAS int* ps = (LAS int*)(F.lds + LT_PSTART); LAS int* lc = (LAS int*)(F.lds + LT_CNT); LAS int* blk = (LAS int*)(F.lds + LT_BLK);
    __syncthreads();
    if (F.tid < 64) {
        const int e = F.tid & 31; const int c = (int)xb_ld((gbar_t)cnt + e); const int pad = (c + 255) & ~255;
        int incl = pad;
#pragma unroll
        for (int o = 1; o < 32; o <<= 1) { const int t = sh_fromi(incl, (e >= o) ? F.tid - o : F.tid); if (e >= o) incl += t; }
        if (F.tid < 32) { ps[e] = incl - pad; lc[e] = c; if (e == 31) ps[32] = incl; }
    }
    __syncthreads();
    const int nblk = ps[32] >> 8;
    for (int g = F.tid; g < nblk; g += 512) { int e = 0;
#pragma unroll
        for (int s = 16; s >= 1; s >>= 1) if (e + s < 32 && (ps[e + s] >> 8) <= g) e += s;
        blk[2 * g] = e; blk[2 * g + 1] = g - (ps[e] >> 8); }
    __syncthreads();
}

__device__ __forceinline__ void n1_phase(const Args& a, int layer, bool final_only, const int wv, const bool dry = false) {
    MK_FRAME(F); ARGAS unsigned char* ws = opaque_ws(a.ws);
    const float* mod = (const float*)(ws + WS_MOD);
    const bool combine = layer > 0;
    const float* xsrc = (layer == 0) ? a.x : a.out;
    const int* toke = (const int*)(ws + WS_TOKE); const int* tokr = toke + NTOK * 4;
    const bf16_t* Y = (const bf16_t*)(ws + WS_Y);
    bf16_t* HM = (bf16_t*)(ws + WS_HM);
    LAS int* ps = (LAS int*)(F.lds + LT_PSTART);
    if (combine) build_pstart(F, (const unsigned*)(ws + WS_CTL) + CW_CNT + 64 * (layer - 1));
    const float* gmix = a.norm_mix_g + (size_t)(final_only ? 0 : layer) * DM;
    for (int tok = F.bid * 8 + F.wave; tok < NTOK; tok += F.G * 8) {
        const int b = tok >> 12;
        f32x4 v[4]; ld_row16(xsrc + (size_t)tok * DM, F.lane, v);
        if (combine) {
            const float* g2 = mod + ((size_t)(layer - 1) * NBATCH + b) * 6144 + 5 * DM;
            f32x4 ysum[4];
#pragma unroll
            for (int j = 0; j < 4; ++j) ysum[j] = (f32x4){0.f, 0.f, 0.f, 0.f};
#pragma unroll
            for (int k = 0; k < 4; ++k) { const int e = toke[tok * 4 + k], r = tokr[tok * 4 + k]; const size_t slot = (size_t)ps[e] + r;
                const bf16_t* yr = Y + slot * DM + 4 * F.lane;
#pragma unroll
                for (int j = 0; j < 4; ++j) { const u32x2 w = *(const u32x2*)(yr + 256 * j); ysum[j][0] += bf_lo(w.x); ysum[j][1] += bf_hi(w.x); ysum[j][2] += bf_lo(w.y); ysum[j][3] += bf_hi(w.y); } }
#pragma unroll
            for (int j = 0; j < 4; ++j) { const f32x4 g = *(const f32x4*)(g2 + 4 * F.lane + 256 * j); v[j] = v[j] + g * ysum[j]; *(f32x4*)((dry ? (float*)(ws + WS_ACT) : (float*)a.out) + (size_t)tok * DM + 4 * F.lane + 256 * j) = v[j]; }
        }
        if (final_only) continue;
        float ss = 0.f;
#pragma unroll
        for (int j = 0; j < 4; ++j) ss += v[j][0] * v[j][0] + v[j][1] * v[j][1] + v[j][2] * v[j][2] + v[j][3] * v[j][3];
        const float inv = rsqrtf(wave_sum(ss, F.lane) * (1.f / DM) + EPS);
        const float* sh = mod + ((size_t)layer * NBATCH + b) * 6144; const float* sc = sh + DM;
#pragma unroll
        for (int j = 0; j < 4; ++j) { const int c0 = 4 * F.lane + 256 * j; const f32x4 g = *(const f32x4*)(gmix + c0), s1 = *(const f32x4*)(sc + c0), s0 = *(const f32x4*)(sh + c0);
            const f32x4 h = v[j] * inv * g * (s1 + 1.f) + s0;
            u32x2 o; o.x = cvt_pk_bf16(h[0], h[1]); o.y = cvt_pk_bf16(h[2], h[3]); *(u32x2*)(HM + (size_t)tok * DM + c0) = o; }
    }
}

__device__ __forceinline__ void e2_phase(const Args& a, int j, const int wv) {
    MK_FRAME(F); ARGAS unsigned char* ws = opaque_ws(a.ws);
    const bf16_t* P = (const bf16_t*)(ws + WS_P);
    bf16_t* QC = (bf16_t*)(ws + X1_QC); bf16_t* KC = (bf16_t*)(ws + X1_KC); bf16_t* QA = (bf16_t*)(ws + X1_QA); bf16_t* KVA = (bf16_t*)(ws + X1_KVA);
    const float* cw = a.ml_conv_w + (size_t)j * 5 * 1024; const float* cb = a.ml_conv_b + (size_t)j * 1024;
    const float* qg = a.mla_q_norm_g + (size_t)j * 256; const float* kvg = a.mla_kv_norm_g + (size_t)j * 128;
    {
        float* ALPHA = (float*)(ws + WS_MISC); float* BETA = ALPHA + 2 * 32 * SEQ; float* MG = BETA + 2 * 32 * SEQ;
        LAS float* redm = (LAS float*)(F.lds);
        for (int u = F.bid; u < 64; u += F.G) {
            const int dir = u >> 5, bh = u & 31, b = bh >> 2, h = bh & 3;
            const float bi = a.ml_gate_b[j * 16 + (2 * dir) * 4 + h], bfg = a.ml_gate_b[j * 16 + (2 * dir + 1) * 4 + h];
            float li[8], lf[8];
#pragma unroll
            for (int i = 0; i < 8; ++i) { const size_t row = (size_t)b * SEQ + 8 * F.tid + i;
                li[i] = bf2f(P[row * EVEN_INP + PC_GT + (2 * dir) * 4 + h]) + bi;
                const float xf = bf2f(P[row * EVEN_INP + PC_GT + (2 * dir + 1) * 4 + h]) + bfg;
                lf[i] = fminf(xf, 0.f) - log1pf(__expf(-fabsf(xf))); }
            float mx = li[0];
#pragma unroll
            for (int i = 1; i < 8; ++i) mx = fmaxf(mx, li[i]);
            mx = wave_max(mx, F.lane); if (F.lane == 0) redm[F.wave] = mx;
            __syncthreads();
            float M = redm[0];
#pragma unroll
            for (int w = 1; w < 8; ++w) M = fmaxf(M, redm[w]);
            float al[8];
            if (dir == 0) { float s = 0.f;
#pragma unroll
                for (int i = 0; i < 8; ++i) { s += lf[i]; al[i] = s; }
                float tot = s, ex = 0.f;
#pragma unroll
                for (int o = 1; o < 16; o <<= 1) { const float t = sh_from(tot, ((F.lane & 15) >= o) ? F.lane - o : F.lane, F.lane); if ((F.lane & 15) >= o) tot += t; }
                ex = tot - s;
#pragma unroll
                for (int i = 0; i < 8; ++i) al[i] += ex;
            } else { float s = 0.f;
#pragma unroll
                for (int i = 7; i >= 0; --i) { s += lf[i]; al[i] = s; }
                float tot = s, ex = 0.f;
#pragma unroll
                for (int o = 1; o < 16; o <<= 1) { const float t = sh_from(tot, ((F.lane & 15) + o < 16) ? F.lane + o : F.lane, F.lane); if ((F.lane & 15) + o < 16) tot += t; }
                ex = tot - s;
#pragma unroll
                for (int i = 0; i < 8; ++i) al[i] += ex;
            }
            float* ao = ALPHA + ((size_t)dir * 32 + bh) * SEQ + 8 * F.tid; float* bo = BETA + ((size_t)dir * 32 + bh) * SEQ + 8 * F.tid;
            *(f32x4*)(ao) = (f32x4){al[0], al[1], al[2], al[3]}; *(f32x4*)(ao + 4) = (f32x4){al[4], al[5], al[6], al[7]};
            *(f32x4*)(bo) = (f32x4){li[0] - M, li[1] - M, li[2] - M, li[3] - M}; *(f32x4*)(bo + 4) = (f32x4){li[4] - M, li[5] - M, li[6] - M, li[7] - M};
            if (F.tid == 0) MG[dir * 32 + bh] = M;
            __syncthreads();
        }
    }
    for (int tok = F.bid * 8 + F.wave; tok < NTOK; tok += F.G * 8) {
        const int s = tok & (SEQ - 1);
        float aq[8], ak[8];
        { const f32x4 b0 = *(const f32x4*)(cb + 8 * F.lane), b1 = *(const f32x4*)(cb + 8 * F.lane + 4), b2 = *(const f32x4*)(cb + 512 + 8 * F.lane), b3 = *(const f32x4*)(cb + 512 + 8 * F.lane + 4);
#pragma unroll
          for (int i = 0; i < 4; ++i) { aq[i] = b0[i]; aq[4 + i] = b1[i]; ak[i] = b2[i]; ak[4 + i] = b3[i]; } }
#pragma unroll
        for (int t = 0; t < 5; ++t) { const int s2 = s + t - 2;
            if (s2 >= 0 && s2 < SEQ) { const bf16_t* pr = P + (size_t)(tok + t - 2) * EVEN_INP;
                const u32x4 q = *(const u32x4*)(pr + PC_QM + 8 * F.lane), k = *(const u32x4*)(pr + PC_KM + 8 * F.lane);
                const float* wq = cw + t * 1024 + 8 * F.lane; const float* wk = wq + 512;
                const f32x4 wq0 = *(const f32x4*)wq, wq1 = *(const f32x4*)(wq + 4), wk0 = *(const f32x4*)wk, wk1 = *(const f32x4*)(wk + 4);
                aq[0] += bf_lo(q.x) * wq0[0]; aq[1] += bf_hi(q.x) * wq0[1]; aq[2] += bf_lo(q.y) * wq0[2]; aq[3] += bf_hi(q.y) * wq0[3];
                aq[4] += bf_lo(q.z) * wq1[0]; aq[5] += bf_hi(q.z) * wq1[1]; aq[6] += bf_lo(q.w) * wq1[2]; aq[7] += bf_hi(q.w) * wq1[3];
                ak[0] += bf_lo(k.x) * wk0[0]; ak[1] += bf_hi(k.x) * wk0[1]; ak[2] += bf_lo(k.y) * wk0[2]; ak[3] += bf_hi(k.y) * wk0[3];
                ak[4] += bf_lo(k.z) * wk1[0]; ak[5] += bf_hi(k.z) * wk1[1]; ak[6] += bf_lo(k.w) * wk1[2]; ak[7] += bf_hi(k.w) * wk1[3]; } }
        constexpr float KS = 0.08838834764831845f;
#pragma unroll
        for (int i = 0; i < 8; ++i) { aq[i] = siluf_(aq[i]); ak[i] = siluf_(ak[i]) * KS; }
        u32x4 oq, ok; oq.x = cvt_pk_bf16(aq[0], aq[1]); oq.y = cvt_pk_bf16(aq[2], aq[3]); oq.z = cvt_pk_bf16(aq[4], aq[5]); oq.w = cvt_pk_bf16(aq[6], aq[7]);
        ok.x = cvt_pk_bf16(ak[0], ak[1]); ok.y = cvt_pk_bf16(ak[2], ak[3]); ok.z = cvt_pk_bf16(ak[4], ak[5]); ok.w = cvt_pk_bf16(ak[6], ak[7]);
        *(u32x4*)(QC + (size_t)tok * 512 + 8 * F.lane) = oq; *(u32x4*)(KC + (size_t)tok * 512 + 8 * F.lane) = ok;
        const bf16_t* pr = P + (size_t)tok * EVEN_INP;
        { const u32x2 w = *(const u32x2*)(pr + PC_QA + 4 * F.lane); const float x0 = bf_lo(w.x), x1 = bf_hi(w.x), x2 = bf_lo(w.y), x3 = bf_hi(w.y);
          const float inv = rsqrtf(wave_sum(x0 * x0 + x1 * x1 + x2 * x2 + x3 * x3, F.lane) * (1.f / 256.f) + EPS); const f32x4 g = *(const f32x4*)(qg + 4 * F.lane);
          u32x2 o; o.x = cvt_pk_bf16(x0 * inv * g[0], x1 * inv * g[1]); o.y = cvt_pk_bf16(x2 * inv * g[2], x3 * inv * g[3]); *(u32x2*)(QA + (size_t)tok * 256 + 4 * F.lane) = o; }
        { const unsigned w = *(const unsigned*)(pr + PC_KVA + 2 * F.lane); const float x0 = bf_lo(w), x1 = bf_hi(w);
          const float inv = rsqrtf(wave_sum(x0 * x0 + x1 * x1, F.lane) * (1.f / 128.f) + EPS); const f32x2 g = *(const f32x2*)(kvg + 2 * F.lane);
          *(unsigned*)(KVA + (size_t)tok * 256 + 2 * F.lane) = cvt_pk_bf16(x0 * inv * g[0], x1 * inv * g[1]); *(unsigned*)(KVA + (size_t)tok * 256 + 128 + 2 * F.lane) = 0u; }
    }
}

__device__ __forceinline__ void e4_phase(const Args& a, int j, const int wv) {
    MK_FRAME(F); ARGAS unsigned char* ws = opaque_ws(a.ws);
    const bf16_t* P = (const bf16_t*)(ws + WS_P); const bf16_t* QRAW = (const bf16_t*)(ws + X1_QRAW); const bf16_t* KVRAW = (const bf16_t*)(ws + X1_KVRAW);
    bf16_t* QH = (bf16_t*)(ws + X1_QH); bf16_t* KH = (bf16_t*)(ws + X1_KH); bf16_t* VH = (bf16_t*)(ws + X1_VH);
    const f32x2* re = (const f32x2*)(ws + WS_ROPEE);
    const float* gq = a.mla_qk_q_g + (size_t)j * 96; const float* gk = a.mla_qk_k_g + (size_t)j * 96;
    const int h = F.lane >> 3, part = F.lane & 7;
    for (int tok = F.bid * 8 + F.wave; tok < NTOK; tok += F.G * 8) {
        const int b = tok >> 12, s = tok & (SEQ - 1);
        const f32x4 cs = *(const f32x4*)(re + (size_t)tok * 16 + 2 * part);
        const size_t hrow = ((size_t)(b * 8 + h)) * SEQ + s;
#pragma unroll
        for (int qk = 0; qk < 2; ++qk) {
            float v[12]; u32x4 w; unsigned w1, w2;
            if (qk == 0) { const bf16_t* src = QRAW + (size_t)tok * 768 + h * 96; w = *(const u32x4*)(src + 8 * part); w1 = *(const unsigned*)(src + 64 + 2 * part); w2 = *(const unsigned*)(src + 80 + 2 * part); }
            else { w = *(const u32x4*)(KVRAW + (size_t)tok * 1024 + h * 128 + 8 * part); const bf16_t* kr = P + (size_t)tok * EVEN_INP + PC_KR; w1 = *(const unsigned*)(kr + 2 * part); w2 = *(const unsigned*)(kr + 16 + 2 * part); }
            v[0] = bf_lo(w.x); v[1] = bf_hi(w.x); v[2] = bf_lo(w.y); v[3] = bf_hi(w.y); v[4] = bf_lo(w.z); v[5] = bf_hi(w.z); v[6] = bf_lo(w.w); v[7] = bf_hi(w.w);
            v[8] = bf_lo(w1); v[9] = bf_hi(w1); v[10] = bf_lo(w2); v[11] = bf_hi(w2);
            float ss = 0.f;
#pragma unroll
            for (int i = 0; i < 12; ++i) ss += v[i] * v[i];
            ss += shx(ss, 1, F.lane); ss += shx(ss, 2, F.lane); ss += shx(ss, 4, F.lane);
            const float inv = rsqrtf(ss * (1.f / 96.f) + EPS);
            const float* g = qk == 0 ? gq : gk;
            const f32x4 g0 = *(const f32x4*)(g + 8 * part), g1 = *(const f32x4*)(g + 8 * part + 4); const f32x2 ga = *(const f32x2*)(g + 64 + 2 * part), gb = *(const f32x2*)(g + 80 + 2 * part);
            v[0] *= inv * g0[0]; v[1] *= inv * g0[1]; v[2] *= inv * g0[2]; v[3] *= inv * g0[3]; v[4] *= inv * g1[0]; v[5] *= inv * g1[1]; v[6] *= inv * g1[2]; v[7] *= inv * g1[3];
            const float x10 = v[8] * inv * ga[0], x11 = v[9] * inv * ga[1], x20 = v[10] * inv * gb[0], x21 = v[11] * inv * gb[1];
            const float o10 = x10 * cs[0] - x20 * cs[1], o20 = x20 * cs[0] + x10 * cs[1], o11 = x11 * cs[2] - x21 * cs[3], o21 = x21 * cs[2] + x11 * cs[3];
            u32x4 o; o.x = cvt_pk_bf16(v[0], v[1]); o.y = cvt_pk_bf16(v[2], v[3]); o.z = cvt_pk_bf16(v[4], v[5]); o.w = cvt_pk_bf16(v[6], v[7]);
            bf16_t* dst = qk == 0 ? QH + hrow * 96 : KH + hrow * 128;
            *(u32x4*)(dst + 8 * part) = o; *(unsigned*)(dst + 64 + 2 * part) = cvt_pk_bf16(o10, o11); *(unsigned*)(dst + 80 + 2 * part) = cvt_pk_bf16(o20, o21);
            if (qk == 1) { *(u32x2*)(dst + 96 + 4 * part) = (u32x2){0u, 0u}; }
        }
        *(u32x4*)(VH + hrow * 64 + 8 * part) = *(const u32x4*)(KVRAW + (size_t)tok * 1024 + h * 128 + 64 + 8 * part);
    }
}
__device__ __forceinline__ void n2_phase(const Args& a, int layer, const int wv, const bool dry = false) {
    MK_FRAME(F); ARGAS unsigned char* ws = opaque_ws(a.ws);
    const float* mod = (const float*)(ws + WS_MOD);
    unsigned char* HF8 = (unsigned char*)(ws + WS_HM);
    int* LIST = (int*)(ws + WS_LIST); float* WLIST = (float*)(ws + WS_WLIST); int* toke = (int*)(ws + WS_TOKE); int* tokr = toke + NTOK * 4;
    unsigned* gcnt = (unsigned*)(ws + WS_CTL) + CW_CNT + 64 * layer;
    LAS float* rwl = (LAS float*)(F.lds);
    LAS int* te = (LAS int*)(F.lds + LT_X); LAS int* tlr = te + 512; LAS float* tw = (LAS float*)(tlr + 512); LAS int* hist = (LAS int*)(tw + 512); LAS int* base = hist + 32;
    const float* rw = a.moe_router_w + (size_t)layer * DM * NEXP; const float* rbias = a.moe_router_b + (size_t)layer * NEXP;
    const float* gffn = a.norm_ffn_g + (size_t)layer * DM;
    __syncthreads();
    for (int i4 = F.tid; i4 < DM * NEXP / 4; i4 += 512) *(LAS f32x4*)(rwl + 4 * i4) = *(const f32x4*)(rw + 4 * i4);
    if (F.tid < 32) hist[F.tid] = 0;
    __syncthreads();
    const int tk = F.lane & 15, kg = F.lane >> 4;
    const int lt = F.lane >> 2, lj = F.lane & 3;
    const float bias0 = rbias[tk], bias1 = rbias[tk + 16];
    LAS float* tile = (LAS float*)(F.lds + LT_N2TILE) + F.wave * (16 * 33);
#pragma unroll 1
    for (int grp = F.bid; grp < NTOK / 128; grp += F.G) {
        const int tok0 = grp * 128 + F.wave * 16, b = tok0 >> 12;
        const float* sh = mod + ((size_t)layer * NBATCH + b) * 6144 + 3 * DM + 8 * lj; const float* sc = sh + DM; const float* gg = gffn + 8 * lj;
        const float* xrow = a.out + (size_t)(tok0 + lt) * DM + 8 * lj;
        float ss = 0.f;
#pragma unroll 8
        for (int c = 0; c < 32; ++c) { const f32x4 v0 = *(const f32x4*)(xrow + 32 * c), v1 = *(const f32x4*)(xrow + 32 * c + 4);
            ss += v0[0] * v0[0] + v0[1] * v0[1] + v0[2] * v0[2] + v0[3] * v0[3] + v1[0] * v1[0] + v1[1] * v1[1] + v1[2] * v1[2] + v1[3] * v1[3]; }
        ss += shx(ss, 1, F.lane); ss += shx(ss, 2, F.lane);
        const float inv = rsqrtf(ss * (1.f / DM) + EPS);
        f32x4 acc0 = {0.f, 0.f, 0.f, 0.f}, acc1 = {0.f, 0.f, 0.f, 0.f};
        unsigned char* hrow = HF8 + (size_t)(tok0 + lt) * DM + 8 * lj;
#pragma unroll 1
        for (int c = 0; c < 32; ++c) {
            const f32x4 v0 = *(const f32x4*)(xrow + 32 * c), v1 = *(const f32x4*)(xrow + 32 * c + 4);
            const f32x4 g0 = *(const f32x4*)(gg + 32 * c), g1 = *(const f32x4*)(gg + 32 * c + 4), p0 = *(const f32x4*)(sc + 32 * c), p1 = *(const f32x4*)(sc + 32 * c + 4), q0 = *(const f32x4*)(sh + 32 * c), q1 = *(const f32x4*)(sh + 32 * c + 4);
            const f32x4 h0 = v0 * inv * g0 * (p0 + 1.f) + q0, h1 = v1 * inv * g1 * (p1 + 1.f) + q1;
            u32x2 o8; o8.x = pg8::pk4_fp8(h0[0] * FP8_HSC, h0[1] * FP8_HSC, h0[2] * FP8_HSC, h0[3] * FP8_HSC); o8.y = pg8::pk4_fp8(h1[0] * FP8_HSC, h1[1] * FP8_HSC, h1[2] * FP8_HSC, h1[3] * FP8_HSC);
            *(u32x2*)(hrow + 32 * c) = o8;
            LAS float* tw_ = tile + lt * 33 + 8 * lj;
            tw_[0] = h0[0]; tw_[1] = h0[1]; tw_[2] = h0[2]; tw_[3] = h0[3]; tw_[4] = h1[0]; tw_[5] = h1[1]; tw_[6] = h1[2]; tw_[7] = h1[3];
            LDS_WAIT();
            const LAS float* wl = rwl + (32 * c + kg) * 32 + tk;
#pragma unroll
            for (int s = 0; s < 8; ++s) { const float av = tile[tk * 33 + 4 * s + kg], w0 = wl[(4 * s) * 32], w1 = wl[(4 * s) * 32 + 16];
                acc0 = __builtin_amdgcn_mfma_f32_16x16x4f32(av, w0, acc0, 0, 0, 0); acc1 = __builtin_amdgcn_mfma_f32_16x16x4f32(av, w1, acc1, 0, 0, 0); }
            LDS_WAIT();
        }
#pragma unroll
        for (int r = 0; r < 4; ++r) {
            float c0 = acc0[r] + bias0, c1 = acc1[r] + bias1;
            float tv[4]; int tix[4];
#pragma unroll
            for (int k = 0; k < 4; ++k) {
                float v = (c1 > c0) ? c1 : c0; int ix = (c1 > c0) ? tk + 16 : tk;
#pragma unroll
                for (int m = 1; m < 16; m <<= 1) { const float ov = shx(v, m, F.lane); const int oi = shxi(ix, m, F.lane); if (ov > v || (ov == v && oi < ix)) { v = ov; ix = oi; } }
                tv[k] = v; tix[k] = ix; if (ix == tk) c0 = -3.0e38f; if (ix == tk + 16) c1 = -3.0e38f; }
            const float e1 = __expf(tv[1] - tv[0]), e2 = __expf(tv[2] - tv[0]), e3 = __expf(tv[3] - tv[0]); const float rs = 1.f / (1.f + e1 + e2 + e3);
            if (tk < 4) { const int ex = tk == 0 ? tix[0] : tk == 1 ? tix[1] : tk == 2 ? tix[2] : tix[3];
                const float wk = (tk == 0 ? 1.f : tk == 1 ? e1 : tk == 2 ? e2 : e3) * rs;
                const int lr = __hip_atomic_fetch_add(hist + ex, 1, __ATOMIC_RELAXED, __HIP_MEMORY_SCOPE_WORKGROUP);
                const int pidx = (F.wave * 16 + 4 * kg + r) * 4 + tk; te[pidx] = ex; tlr[pidx] = lr; tw[pidx] = wk; }
        }
        __syncthreads();
        if (F.tid < 32) { const int h = hist[F.tid]; base[F.tid] = (h > 0 && !dry) ? (int)xb_add((gbar_t)gcnt + F.tid, (unsigned)h) : 0; }
        __syncthreads();
        if (!dry) { const int p = F.tid; const int e = te[p], rank = base[e] + tlr[p]; const int tok = grp * 128 + (p >> 2);
          LIST[(size_t)e * NSLOT + rank] = tok; WLIST[(size_t)e * NSLOT + rank] = tw[p]; toke[tok * 4 + (p & 3)] = e; tokr[tok * 4 + (p & 3)] = rank; }
        __syncthreads();
        if (F.tid < 32) hist[F.tid] = 0;
        __syncthreads();
    }
}

__device__ __forceinline__ void m1_phase(const Args& a, int layer, const int wv) {
    MK_FRAME(F); ARGAS unsigned char* ws = opaque_ws(a.ws);
    build_pstart(F, (const unsigned*)(ws + WS_CTL) + CW_CNT + 64 * layer);
    LAS int* ps = (LAS int*)(F.lds + LT_PSTART); LAS int* lc = (LAS int*)(F.lds + LT_CNT); LAS int* blk = (LAS int*)(F.lds + LT_BLK);
    const unsigned char* HF8 = (const unsigned char*)(ws + WS_HM); unsigned char* AS = (unsigned char*)(ws + WS_ASORT); float* WS_ = (float*)(ws + WS_WSORT);
    const int* LIST = (const int*)(ws + WS_LIST); const float* WLIST = (const float*)(ws + WS_WLIST);
    const int total = ps[32];
    for (int r = F.bid * 8 + F.wave; r < total; r += F.G * 8) {
        const int g = r >> 8, e = blk[2 * g], rank = blk[2 * g + 1] * 256 + (r & 255); const bool valid = rank < lc[e];
        u32x4 v0 = (u32x4){0u, 0u, 0u, 0u}; float w = 0.f;
        if (valid) { const int tok = LIST[(size_t)e * NSLOT + rank]; w = WLIST[(size_t)e * NSLOT + rank];
            v0 = *(const u32x4*)(HF8 + (size_t)tok * DM + 16 * F.lane); }
        *(u32x4*)(AS + (size_t)r * DM + 16 * F.lane) = v0;
        if (F.lane == 0) WS_[r] = w;
    }
}

struct MoeSched {
    const LAS int* blk; const char* A; const char* W; size_t wstride, tile_bytes; int ntile, nunits, G, c;
    __device__ __forceinline__ bool next(int i, pg8::Unit& u) const {
        int g, pn;
        if (G == 256) {
            const int x = c & 7, slot = c >> 3, rpr = 256 / ntile;
            g = i * rpr + 8 * (ntile == 8 ? (x >> 1) : x) + (slot & 7); pn = (ntile == 8 ? 4 * (x & 1) : 0) + (slot >> 3);
            if (g * ntile >= nunits) return false;
        } else { const long L = (long)i * G + c; if (L >= nunits) return false; g = (int)L / ntile; pn = (int)L % ntile; }
        const int e = __builtin_amdgcn_readfirstlane(blk[2 * g]);
        u.pm = g; u.pn = pn; u.aux = e; u.A = A + (size_t)g * tile_bytes; u.B = W + (size_t)e * wstride + (size_t)pn * tile_bytes; return true;
    }
};
struct MlaSched {
    const char* QA; const char* KVA; const char* Wq; const char* Wkv; int G, c;
    __device__ __forceinline__ bool next(int i, pg8::Unit& u) const {
        const long L = (long)i * G + c; if (L >= 128 * 7) return false;
        const int pm = (int)L / 7, t = (int)L % 7;
        u.pm = pm; if (t < 3) { u.pn = t; u.aux = 0; u.A = QA + (size_t)pm * 256 * 256 * 2; u.B = Wq + (size_t)t * 256 * 256 * 2; }
        else { u.pn = t - 3; u.aux = 1; u.A = KVA + (size_t)pm * 256 * 256 * 2; u.B = Wkv + (size_t)(t - 3) * 256 * 256 * 2; }
        return true;
    }
};

constexpr int NPHASE = 50;
#define IN(k) (lo <= (k) && (k) < hi)
#ifndef PROBE_MASK
#define PROBE_MASK 0
#endif
#define REP(k) for (int rep_ = 0; rep_ < ((PROBE_MASK >> (k)) & 1) + 1; ++rep_)
#define GRID_BAR() do { if (fused) { xcd_barrier((gbar_t)(fresh_args().ws + WS_CTL) + CW_BAR, (volatile LAS unsigned*)((LAS unsigned char*)lds_raw + LT_MISC) + 8, wv); } } while (0)
template <int LAYER>
__device__ __forceinline__ void layer_body(const int lo, const int hi, const bool fused, const int wv) {
    constexpr int layer = LAYER;
        constexpr int pb = 1 + 12 * layer; constexpr bool odd = (layer & 1) != 0; constexpr int j = layer >> 1;
        REP(0) if (IN(pb + 0)) { n1_phase(fresh_args(), layer, false, wv, ((PROBE_MASK >> 0) & 1) && rep_ == 0); GRID_BAR(); }
        REP(1) if (IN(pb + 1)) {
            const Args& a = fresh_args(); MK_FRAME(F); ARGAS unsigned char* ws = opaque_ws(a.ws);
            pg8::StaticSched S; S.A = (const char*)(ws + WS_HM); S.lda = DM; S.ldb = DM; S.nM = NTOK / 256; S.G = F.G; S.c = F.bid;
            pg8::EpiBf16 E; E.O0 = (bf16_t*)(ws + WS_P); E.O1 = E.O0; E.rope = (const GAS f32x2*)(ws + WS_ROPEO); E.qscale = 0.0625f;
            if (!odd) { S.Bt = (const char*)(ws + WS_WINE) + (size_t)j * EVEN_INP * DM * 2; S.nN = EVEN_INP / 256; E.ldc0 = E.ldc1 = EVEN_INP; E.rope_tiles = 0; E.qscale_tiles = 0; }
            else { S.Bt = (const char*)(ws + WS_WINO) + (size_t)j * RET_IN * DM * 2; S.nN = RET_IN / 256; E.ldc0 = E.ldc1 = RET_IN; E.rope_tiles = 8; E.qscale_tiles = 4; }
            pg8::gemm_phase<pg8::EpiBf16, pg8::StaticSched>(F.lds + LDS_RING, pg8::Dims{DM, DM, DM}, S, E, wv);
            GRID_BAR();
        }
        if constexpr (!odd) {
            REP(2) if (IN(pb + 2)) { e2_phase(fresh_args(), j, wv); GRID_BAR(); }
            REP(3) if (IN(pb + 3)) {
                const Args& a = fresh_args(); MK_FRAME(F); ARGAS unsigned char* ws = opaque_ws(a.ws);
                MlaSched S; S.QA = (const char*)(ws + X1_QA); S.KVA = (const char*)(ws + X1_KVA); S.Wq = (const char*)(ws + WS_WQB) + (size_t)j * 768 * 256 * 2; S.Wkv = (const char*)(ws + WS_WKVB) + (size_t)j * 1024 * 256 * 2; S.G = F.G; S.c = F.bid;
                pg8::EpiBf16 E; E.O0 = (bf16_t*)(ws + X1_QRAW); E.O1 = (bf16_t*)(ws + X1_KVRAW); E.ldc0 = 768; E.ldc1 = 1024; E.rope_tiles = 0; E.qscale_tiles = 0; E.qscale = 1.f; E.rope = nullptr;
                pg8::gemm_phase<pg8::EpiBf16, MlaSched>(F.lds + LDS_RING, pg8::Dims{256, 256, 256}, S, E, wv);
                GRID_BAR();
            }
            REP(4) if (IN(pb + 4)) { e4_phase(fresh_args(), j, wv); GRID_BAR(); }
            REP(5) if (IN(pb + 5)) {
                const Args& a = fresh_args(); MK_FRAME(F); ARGAS unsigned char* ws = opaque_ws(a.ws);
                const float* ALPHA = (const float*)(ws + WS_MISC); const float* BETA = ALPHA + 2 * 32 * SEQ;
                for (int u = F.bid; u < 128; u += F.G) {
                    const int bh = u >> 2, dir = (u >> 1) & 1, dvb = u & 1, b = bh >> 2, h = bh & 3;
                    la::StateArgs sa; sa.K = (const bf16_t*)(ws + X1_KC) + (size_t)b * SEQ * 512 + h * 128; sa.ldk = 512;
                    sa.V = (const bf16_t*)(ws + WS_P) + (size_t)b * SEQ * EVEN_INP + PC_VM + h * 128 + dvb * 64; sa.ldv = EVEN_INP;
                    sa.Cout = (bf16_t*)(ws + X1_CM) + ((size_t)(bh * 2 + dir) * 32) * 128 * 128 + dvb * 64; sa.ldc = 128; sa.cstride = 128 * 128;
                    sa.Nout = dvb == 0 ? (float*)(ws + X1_NM) + ((size_t)(bh * 2 + dir) * 32) * 128 : nullptr;
                    sa.alpha = ALPHA + ((size_t)dir * 32 + bh) * SEQ; sa.beta = BETA + ((size_t)dir * 32 + bh) * SEQ; sa.lgam = 0.f; sa.dir = dir;
                    la::state_unit2<128, 64, true>(F.lds + LDS_RING, F.lds + LT_X, sa, wv);
                }
                __syncthreads();
                unsigned* qh = (unsigned*)(ws + WS_CTL) + CW_QUEUE + 64 * j + 128 * rep_; LAS unsigned* qslot = (LAS unsigned*)(F.lds + LT_MISC) + 16;
                for (;;) {
                    if (F.tid == 0) *qslot = xb_add((gbar_t)qh, 1u);
                    __syncthreads();
                    const unsigned u = *qslot;
                    __syncthreads();
                    if (u >= 1024u) break;
                    const int bh = u >> 4, qb = u & 15, b = bh >> 3, h = bh & 7;
                    att::attn_body((const bf16_t*)(ws + X1_QH) + ((size_t)bh * SEQ + qb * 256) * 96, (const bf16_t*)(ws + X1_KH) + (size_t)bh * SEQ * 128, (const bf16_t*)(ws + X1_VH) + (size_t)bh * SEQ * 64,
                                   (bf16_t*)(ws + WS_MIX) + ((size_t)b * SEQ + qb * 256) * DM + 512 + h * 64, DM, SEQ, (LAS char*)(F.lds + LDS_RING), wv);
                }
                GRID_BAR();
            }
            REP(6) if (IN(pb + 6)) {
                const Args& a = fresh_args(); MK_FRAME(F); ARGAS unsigned char* ws = opaque_ws(a.ws);
                const float* ALPHA = (const float*)(ws + WS_MISC); const float* BETA = ALPHA + 2 * 32 * SEQ; const float* MG = BETA + 2 * 32 * SEQ;
                for (int u = F.bid; u < 1024; u += F.G) {
                    const int bh = u >> 5, c = u & 31, b = bh >> 2, h = bh & 3; const size_t t0 = (size_t)b * SEQ + c * 128;
                    la::OutArgs oa; oa.Q = (const bf16_t*)(ws + X1_QC) + t0 * 512 + h * 128; oa.ldq = 512; oa.K = (const bf16_t*)(ws + X1_KC) + t0 * 512 + h * 128; oa.ldk = 512;
                    oa.V = (const bf16_t*)(ws + WS_P) + t0 * EVEN_INP + PC_VM + h * 128; oa.ldv = EVEN_INP;
                    oa.Cf = (const bf16_t*)(ws + X1_CM) + ((size_t)(bh * 2 + 0) * 32 + c) * 128 * 128; oa.Cb = (const bf16_t*)(ws + X1_CM) + ((size_t)(bh * 2 + 1) * 32 + c) * 128 * 128;
                    oa.Nf = (const float*)(ws + X1_NM) + ((size_t)(bh * 2 + 0) * 32 + c) * 128; oa.Nb = (const float*)(ws + X1_NM) + ((size_t)(bh * 2 + 1) * 32 + c) * 128;
                    oa.af = ALPHA + ((size_t)0 * 32 + bh) * SEQ + c * 128; oa.bfw = BETA + ((size_t)0 * 32 + bh) * SEQ + c * 128; oa.ab = ALPHA + ((size_t)1 * 32 + bh) * SEQ + c * 128; oa.bbw = BETA + ((size_t)1 * 32 + bh) * SEQ + c * 128;
                    oa.Mf = MG[bh]; oa.Mb = MG[32 + bh]; oa.lgf = 0.f; oa.lgb = 0.f;
                    oa.gain = a.ml_norm_g + (size_t)j * 512 + h * 128; oa.G = (const bf16_t*)(ws + WS_P) + t0 * EVEN_INP + PC_OM + h * 128; oa.ldg = EVEN_INP;
                    oa.Out = (bf16_t*)(ws + WS_MIX) + t0 * DM + h * 128; oa.ldo = DM;
                    la::out_unit2<128, 128, true>(F.lds + LDS_RING, F.lds + LT_X, oa, wv);
                }
                GRID_BAR();
            }
        } else {
            REP(2) if (IN(pb + 2)) {
                const Args& a = fresh_args(); MK_FRAME(F); ARGAS unsigned char* ws = opaque_ws(a.ws);
                for (int u = F.bid; u < 256; u += F.G) {
                    const int bh = u >> 3, dir = (u >> 2) & 1, dvb = u & 3, b = bh >> 2, h = bh & 3;
                    const float dl = (dir ? a.ret_decay_b : a.ret_decay_f)[j * 4 + h];
                    la::StateArgs sa; sa.K = (const bf16_t*)(ws + WS_P) + (size_t)b * SEQ * RET_IN + 1024 + h * 256; sa.ldk = RET_IN;
                    sa.V = (const bf16_t*)(ws + WS_P) + (size_t)b * SEQ * RET_IN + 2048 + h * 512 + dvb * 128; sa.ldv = RET_IN;
                    sa.Cout = (bf16_t*)(ws + WS_X1) + ((size_t)(bh * 2 + dir) * 32) * 256 * 512 + dvb * 128; sa.ldc = 512; sa.cstride = 256 * 512; sa.Nout = nullptr;
                    sa.alpha = nullptr; sa.beta = nullptr; sa.lgam = fminf(dl, 0.f) - log1pf(__expf(-fabsf(dl))); sa.dir = dir;
                    la::state_unit2<256, 128, false>(F.lds + LDS_RING, F.lds + LT_X, sa, wv);
                }
                GRID_BAR();
            }
            REP(3) if (IN(pb + 3)) {
                const Args& a = fresh_args(); MK_FRAME(F); ARGAS unsigned char* ws = opaque_ws(a.ws);
                for (int u = F.bid; u < 1024; u += F.G) {
                    const int bh = u >> 5, c = u & 31, b = bh >> 2, h = bh & 3; const size_t t0 = (size_t)b * SEQ + c * 128;
                    const bf16_t* R = (const bf16_t*)(ws + WS_P) + t0 * RET_IN;
                    const float dlf = a.ret_decay_f[j * 4 + h], dlb = a.ret_decay_b[j * 4 + h];
                    la::OutArgs oa; oa.Q = R + h * 256; oa.ldq = RET_IN; oa.K = R + 1024 + h * 256; oa.ldk = RET_IN; oa.V = R + 2048 + h * 512; oa.ldv = RET_IN;
                    oa.Cf = (const bf16_t*)(ws + WS_X1) + ((size_t)(bh * 2 + 0) * 32 + c) * 256 * 512; oa.Cb = (const bf16_t*)(ws + WS_X1) + ((size_t)(bh * 2 + 1) * 32 + c) * 256 * 512;
                    oa.Nf = nullptr; oa.Nb = nullptr; oa.af = oa.bfw = oa.ab = oa.bbw = nullptr; oa.Mf = 0.f; oa.Mb = 0.f;
                    oa.lgf = fminf(dlf, 0.f) - log1pf(__expf(-fabsf(dlf))); oa.lgb = fminf(dlb, 0.f) - log1pf(__expf(-fabsf(dlb)));
                    oa.gain = a.ret_gn_g + (size_t)j * 2048 + h * 512; oa.G = R + 4096 + h * 512; oa.ldg = RET_IN;
                    oa.Out = (bf16_t*)(ws + WS_MIX) + t0 * 2048 + h * 512; oa.ldo = 2048;
                    la::out_unit2<256, 512, false>(F.lds + LDS_RING, F.lds + LT_X, oa, wv);
                }
                GRID_BAR();
            }
        }
        REP(7) if (IN(pb + 7)) {
            const Args& a = fresh_args(); MK_FRAME(F); ARGAS unsigned char* ws = opaque_ws(a.ws);
            pg8::StaticSched S; S.A = (const char*)(ws + WS_MIX); S.nM = NTOK / 256; S.nN = DM / 256; S.G = F.G; S.c = F.bid;
            int K;
            if (!odd) { S.Bt = (const char*)(ws + WS_WOUTE) + (size_t)j * DM * DM * 2; K = DM; } else { S.Bt = (const char*)(ws + WS_WOUTO) + (size_t)j * DM * 2048 * 2; K = 2048; }
            S.lda = K; S.ldb = K;
            pg8::EpiResid E; E.base = (layer == 0) ? a.x : a.out; E.out = (((PROBE_MASK >> 7) & 1) && rep_ == 0) ? (float*)(ws + WS_ACT) : (float*)a.out; E.gate = (const float*)(ws + WS_MOD) + (size_t)layer * NBATCH * 6144 + 2 * DM; E.gstride = 6144;
            pg8::gemm_phase<pg8::EpiResid, pg8::StaticSched>(F.lds + LDS_RING, pg8::Dims{K, K, K}, S, E, wv);
            GRID_BAR();
        }
        REP(8) if (IN(pb + 8)) { n2_phase(fresh_args(), layer, wv, ((PROBE_MASK >> 8) & 1) && rep_ == 0); GRID_BAR(); }
        REP(9) if (IN(pb + 9)) { m1_phase(fresh_args(), layer, wv); GRID_BAR(); }
        REP(10) if (IN(pb + 10)) {
            const Args& a = fresh_args(); MK_FRAME(F); ARGAS unsigned char* ws = opaque_ws(a.ws);
            build_pstart(F, (const unsigned*)(ws + WS_CTL) + CW_CNT + 64 * layer);
            const int nblk = ((LAS int*)(F.lds + LT_PSTART))[32] >> 8;
            MoeSched S; S.blk = (const LAS int*)(F.lds + LT_BLK); S.A = (const char*)(ws + WS_ASORT); S.W = (const char*)(ws + WS_WGU) + (size_t)layer * NEXP * 2048 * DM; S.wstride = (size_t)2048 * DM; S.tile_bytes = (size_t)256 * DM;
            S.ntile = 8; S.nunits = nblk * 8; S.G = F.G; S.c = F.bid;
            pg8::EpiSwiglu E; E.act = (unsigned char*)(ws + WS_ACT); E.bgu = a.moe_b_gu + (size_t)layer * NEXP * 2048; E.ascale = 1.f / (FP8_HSC * FP8_WSC);
            pg8::gemm_phase<pg8::EpiSwiglu, MoeSched, true, true, true>(F.lds + LDS_RING, pg8::Dims{DM / 2, DM / 2, DM / 2}, S, E, wv);
            GRID_BAR();
        }
        REP(11) if (IN(pb + 11)) {
            const Args& a = fresh_args(); MK_FRAME(F); ARGAS unsigned char* ws = opaque_ws(a.ws);
            build_pstart(F, (const unsigned*)(ws + WS_CTL) + CW_CNT + 64 * layer);
            const int nblk = ((LAS int*)(F.lds + LT_PSTART))[32] >> 8;
            MoeSched S; S.blk = (const LAS int*)(F.lds + LT_BLK); S.A = (const char*)(ws + WS_ACT); S.W = (const char*)(ws + WS_WDN) + (size_t)layer * NEXP * DM * EFF; S.wstride = (size_t)DM * EFF; S.tile_bytes = (size_t)256 * EFF;
            S.ntile = 4; S.nunits = nblk * 4; S.G = F.G; S.c = F.bid;
            pg8::EpiDown E; E.y = (bf16_t*)(ws + WS_Y); E.bd = a.moe_b_down + (size_t)layer * NEXP * DM; E.wrow = (const float*)(ws + WS_WSORT); E.ascale = 1.f / (FP8_ASC * FP8_WSC);
            pg8::gemm_phase<pg8::EpiDown, MoeSched, true, true, true>(F.lds + LDS_RING, pg8::Dims{EFF / 2, EFF / 2, EFF / 2}, S, E, wv);
            GRID_BAR();
        }
    }
__global__ void __launch_bounds__(512, 2) fwd_kernel(Args a_kernarg) {
    const Args& a0 = fresh_args();
    LAS unsigned char* lds0 = (LAS unsigned char*)lds_raw;
    const int wv = __builtin_amdgcn_readfirstlane((int)threadIdx.x >> 6);
    for (int u = TIDX(wv); u < 64; u += 512) ((LAS unsigned*)(lds0 + LT_MISC))[u] = 0u;
    __syncthreads();
    const int lo = a0.ph_lo, hi = a0.ph_hi; const bool fused = (hi - lo) > 1;
    if (fused) xcd_barrier_post((gbar_t)(a0.ws + WS_CTL) + CW_BAR, wv);

    REP(12) if (IN(0)) { p0_prologue(fresh_args(), wv); GRID_BAR(); }

    layer_body<0>(lo, hi, fused, wv); layer_body<1>(lo, hi, fused, wv); layer_body<2>(lo, hi, fused, wv); layer_body<3>(lo, hi, fused, wv);
    if (IN(49)) n1_phase(fresh_args(), DEPTH, true, wv);
}

#undef IN
#undef GRID_BAR
#ifndef MK_ONE_LAUNCH
#define MK_ONE_LAUNCH 1
#endif
extern "C" void kernel_launch(void* const* d_in, const int* in_sizes, int n_in, void* d_out, int out_size, void* d_ws, size_t ws_size, hipStream_t stream) {
    static int grid = 0;
    if (grid == 0) {
        if (n_in != 30 || in_sizes[0] != NTOK * DM || out_size != NTOK * DM || ws_size < WS_END) {
            fprintf(stderr, "kernel_launch: shape mismatch: n_in %d in0 %d out %d ws %zu (need %zu)\n", n_in, n_in > 0 ? in_sizes[0] : -1, out_size, ws_size, (size_t)WS_END); grid = -1; return; }
        int dev = 0, cus = 0, per_cu = 0;
        if (hipGetDevice(&dev) != hipSuccess || hipDeviceGetAttribute(&cus, hipDeviceAttributeMultiprocessorCount, dev) != hipSuccess) { grid = -1; return; }
        if (hipFuncSetAttribute((const void*)fwd_kernel, hipFuncAttributeMaxDynamicSharedMemorySize, LDS_BYTES) != hipSuccess) { fprintf(stderr, "kernel_launch: hipFuncSetAttribute failed\n"); grid = -1; return; }
        if (hipOccupancyMaxActiveBlocksPerMultiprocessor(&per_cu, (const void*)fwd_kernel, 512, LDS_BYTES) != hipSuccess || per_cu < 1) fprintf(stderr, "kernel_launch: occupancy query says %d\n", per_cu);
        (void)hipGetLastError();
        grid = cus;
    }
    if (grid < 0) return;
    (void)hipMemsetAsync((char*)d_ws + WS_CTL, 0, CTL_ZERO_BYTES, stream);
    Args a{};
    a.x = (gcf_t)d_in[0]; a.c = (gcf_t)d_in[1]; a.pos = (gci_t)d_in[2];
    a.ada_w = (gcf_t)d_in[3]; a.ada_b = (gcf_t)d_in[4]; a.norm_mix_g = (gcf_t)d_in[5]; a.norm_ffn_g = (gcf_t)d_in[6];
    a.hy_w_in = (gcf_t)d_in[7]; a.ml_conv_w = (gcf_t)d_in[8]; a.ml_conv_b = (gcf_t)d_in[9]; a.ml_gate_b = (gcf_t)d_in[10]; a.ml_norm_g = (gcf_t)d_in[11];
    a.mla_q_norm_g = (gcf_t)d_in[12]; a.mla_kv_norm_g = (gcf_t)d_in[13]; a.mla_w_qb = (gcf_t)d_in[14]; a.mla_w_kvb = (gcf_t)d_in[15];
    a.mla_qk_q_g = (gcf_t)d_in[16]; a.mla_qk_k_g = (gcf_t)d_in[17]; a.hy_w_out = (gcf_t)d_in[18];
    a.ret_w_in = (gcf_t)d_in[19]; a.ret_decay_f = (gcf_t)d_in[20]; a.ret_decay_b = (gcf_t)d_in[21]; a.ret_gn_g = (gcf_t)d_in[22]; a.ret_w_out = (gcf_t)d_in[23];
    a.moe_router_w = (gcf_t)d_in[24]; a.moe_router_b = (gcf_t)d_in[25]; a.moe_w_gu = (gcf_t)d_in[26]; a.moe_b_gu = (gcf_t)d_in[27]; a.moe_w_down = (gcf_t)d_in[28]; a.moe_b_down = (gcf_t)d_in[29];
    a.out = (ARGAS float*)d_out; a.ws = (ARGAS unsigned char*)d_ws;
#if MK_ONE_LAUNCH
    a.ph_lo = 0; a.ph_hi = NPHASE;
    hipLaunchKernelGGL(fwd_kernel, dim3(grid), dim3(512), LDS_BYTES, stream, a);
#else
    for (int ph = 0; ph < NPHASE; ++ph) {
        if (ph >= 1 && ph < 49) { const int layer = (ph - 1) / 12, k = (ph - 1) % 12; if ((layer & 1) && (k >= 4 && k <= 6)) continue; }
        a.ph_lo = ph; a.ph_hi = ph + 1;
        hipLaunchKernelGGL(fwd_kernel, dim3(grid), dim3(512), LDS_BYTES, stream, a);
    }
#endif
    const hipError_t le = hipPeekAtLastError();
    if (le != hipSuccess) fprintf(stderr, "kernel_launch: launch failed: %s\n", hipGetErrorName(le));
}
```

```cpp
#include <hip/hip_runtime.h>
#include <cstdio>
#include <cstdint>

#define GAS __attribute__((address_space(1)))
#define LAS __attribute__((address_space(3)))
typedef unsigned short bf16_t;
typedef short bf16x8 __attribute__((ext_vector_type(8)));
typedef short s16x4 __attribute__((ext_vector_type(4)));
typedef float f32x2 __attribute__((ext_vector_type(2)));
typedef float f32x4 __attribute__((ext_vector_type(4)));
typedef float f32x8 __attribute__((ext_vector_type(8)));
typedef float f32x16 __attribute__((ext_vector_type(16)));
typedef unsigned u32x2 __attribute__((ext_vector_type(2)));
typedef unsigned u32x4 __attribute__((ext_vector_type(4)));
typedef GAS unsigned gu32;

constexpr int NTOK = 32768, DM = 1024, SEQ = 4096, NBATCH = 8, DEPTH = 4;
constexpr int EVEN_IN = 2480, EVEN_INP = 2560;
constexpr int RET_IN = 6144;
constexpr int NEXP = 32, TOPK = 4, EFF = 1024;
constexpr int NSLOT = NTOK * TOPK;
constexpr int NSLOTP = NSLOT + NEXP * 256;
constexpr float EPS = 1e-6f;

constexpr int PC_QM = 0, PC_KM = 512, PC_VM = 1024, PC_OM = 1536, PC_QA = 2048, PC_KVA = 2304, PC_KR = 2432, PC_GT = 2464;

__device__ __forceinline__ int lane_id() { int l; asm volatile("v_mbcnt_lo_u32_b32 %0, -1, 0\n\tv_mbcnt_hi_u32_b32 %0, -1, %0" : "=v"(l)); return l; }
#define TIDX(wv) (((wv) << 6) | lane_id())
#define LDS_WAIT() asm volatile("s_waitcnt lgkmcnt(0)" ::: "memory")
#define VM_WAIT() asm volatile("s_waitcnt vmcnt(0)" ::: "memory")
#define SBAR() __builtin_amdgcn_sched_barrier(0)
#define FENCE() do { asm volatile("" ::: "memory"); __builtin_amdgcn_sched_barrier(0); } while (0)

__device__ __forceinline__ unsigned cvt_pk_bf16(float lo, float hi) { unsigned r; asm volatile("v_cvt_pk_bf16_f32 %0, %1, %2" : "=v"(r) : "v"(lo), "v"(hi)); return r; }
__device__ __forceinline__ float bf_lo(unsigned u) { return __builtin_bit_cast(float, u << 16); }
__device__ __forceinline__ float bf_hi(unsigned u) { return __builtin_bit_cast(float, u & 0xffff0000u); }
__device__ __forceinline__ float bf2f(bf16_t b) { return __builtin_bit_cast(float, ((unsigned)b) << 16); }
__device__ __forceinline__ bf16_t f2bf(float f) { unsigned u = __builtin_bit_cast(unsigned, f); return (bf16_t)((u + 0x7fffu + ((u >> 16) & 1u)) >> 16); }
__device__ __forceinline__ float shx(float v, int m, int lane) { return __builtin_bit_cast(float, __builtin_amdgcn_ds_bpermute((lane ^ m) << 2, __builtin_bit_cast(int, v))); }
__device__ __forceinline__ int shxi(int v, int m, int lane) { return __builtin_amdgcn_ds_bpermute((lane ^ m) << 2, v); }
__device__ __forceinline__ float sh_from(float v, int src, int lane) { (void)lane; return __builtin_bit_cast(float, __builtin_amdgcn_ds_bpermute(src << 2, __builtin_bit_cast(int, v))); }
__device__ __forceinline__ int sh_fromi(int v, int src) { return __builtin_amdgcn_ds_bpermute(src << 2, v); }
__device__ __forceinline__ float wave_sum(float v, int lane) {
#pragma unroll
    for (int o = 1; o < 64; o <<= 1) v += shx(v, o, lane);
    return v;
}
__device__ __forceinline__ float wave_max(float v, int lane) {
#pragma unroll
    for (int o = 1; o < 64; o <<= 1) v = fmaxf(v, shx(v, o, lane));
    return v;
}
__device__ __forceinline__ float sigmoidf_(float x) { return 1.f / (1.f + __expf(-x)); }
__device__ __forceinline__ float siluf_(float x) { return x / (1.f + __expf(-x)); }

#define XB_TMO      128
#define XB_XCNT(j)  (256  + 64 * (j))
#define XB_XSUB(j)  (1280 + 64 * (j))
#define XB_XGEN(j)  (2304 + 64 * (j))
#define XB_TOP      3328
#define XB_TOPGEN   3392
#define XCD_BAR_WORDS 3456
#define XB_SPIN_CAP (1u << 22)

typedef GAS unsigned* gbar_t;
__device__ __forceinline__ unsigned xb_ld(gbar_t p)              { return __hip_atomic_load(p, __ATOMIC_RELAXED, __HIP_MEMORY_SCOPE_AGENT); }
__device__ __forceinline__ unsigned xb_add(gbar_t p, unsigned v) { return __hip_atomic_fetch_add(p, v, __ATOMIC_RELAXED, __HIP_MEMORY_SCOPE_AGENT); }
__device__ __forceinline__ unsigned xb_xcc_id() { return (unsigned)__builtin_amdgcn_s_getreg((3 << 11) | 20) & 0xFu; }
#define XB_SPIN(cond, bar) do { unsigned _sp = 0; while (cond) { __builtin_amdgcn_s_sleep(1); \
    if ((++_sp & 255u) == 0u) { if (xb_ld(&(bar)[XB_TMO])) break; if (_sp > XB_SPIN_CAP) { xb_add(&(bar)[XB_TMO], 1u); break; } } } } while (0)

__device__ __forceinline__ void xcd_barrier_post(gbar_t bar, int wv) {
    if (TIDX(wv) == 0) (void)xb_add(&bar[XB_XCNT(xb_xcc_id())], 1u);
}
__device__ __forceinline__ void xcd_barrier_complete(gbar_t bar, unsigned x, unsigned& nloc, unsigned& nx) {
    const unsigned G = gridDim.x * gridDim.y * gridDim.z;
    unsigned sum, cnt, mine, sp = 0u;
    for (;;) {
        sum = 0u; cnt = 0u; mine = 0u;
#pragma unroll
        for (unsigned j = 0; j < 16; ++j) { const unsigned c = xb_ld(&bar[XB_XCNT(j)]); sum += c; cnt += (c > 0u) ? 1u : 0u; mine = (j == x) ? c : mine; }
        if (sum == G) break;
        __builtin_amdgcn_s_sleep(1);
        if ((++sp & 255u) == 0u) { if (xb_ld(&bar[XB_TMO])) break; if (sp > XB_SPIN_CAP) { xb_add(&bar[XB_TMO], 1u); break; } }
    }
    nloc = mine > 0u ? mine : 1u; nx = cnt > 0u ? cnt : 1u;
}
__device__ __forceinline__ void xcd_barrier(gbar_t bar, volatile LAS unsigned* st, int wv) {
    asm volatile("s_waitcnt vmcnt(0)" ::: "memory");
    __syncthreads();
    if (TIDX(wv) == 0) {
        const unsigned bx = xb_xcc_id();
        __builtin_amdgcn_s_waitcnt(0);
        unsigned nloc = st[0], nx = st[1];
        if (nloc == 0u) { xcd_barrier_complete(bar, bx, nloc, nx); st[0] = nloc; st[1] = nx; }
        const unsigned old = xb_add(&bar[XB_XSUB(bx)], 1u);
        const unsigned gen = old / nloc;
        if (old + 1u == (gen + 1u) * nloc) {
            __builtin_amdgcn_fence(__ATOMIC_RELEASE, "agent");
            asm volatile("s_waitcnt vmcnt(0)" ::: "memory");
            const unsigned og = xb_add(&bar[XB_TOP], 1u);
            const unsigned tg = og / nx;
            if (og + 1u == (tg + 1u) * nx) xb_add(&bar[XB_TOPGEN], 1u);
            else XB_SPIN(xb_ld(&bar[XB_TOPGEN]) == tg, bar);
            __builtin_amdgcn_fence(__ATOMIC_ACQUIRE, "agent");
            xb_add(&bar[XB_XGEN(bx)], 1u);
            asm volatile("s_waitcnt vmcnt(0)" ::: "memory");
        } else {
            XB_SPIN(xb_ld(&bar[XB_XGEN(bx)]) == gen, bar);
            __builtin_amdgcn_fence(__ATOMIC_ACQUIRE, "agent");
            asm volatile("s_waitcnt vmcnt(0)" ::: "memory");
        }
    }
    __syncthreads();
}
namespace pg8 {
constexpr int BM = 256, BK = 64, HALF = 128, HTB = HALF * BK * 2, STAGE_BYTES = 8 * HTB, NXCD = 8, WGM = 8;
__host__ __device__ __forceinline__ int lds_byte(int r, int c) { const int st = (r >> 4) * 2 + (c >> 5), rr = r & 15, cc = c & 31, ob = rr * 64 + cc * 2; return st * 1024 + (ob ^ (((ob >> 9) & 1) << 5)); }
__host__ __device__ __forceinline__ void stage_rc(int b, int& R, int& C) { const int st = b / 1024, sb = b % 1024, swz = sb ^ (((sb >> 9) & 1) << 5); R = (st >> 1) * 16 + swz / 64; C = (st & 1) * 32 + (swz % 64) / 2; }
__host__ __device__ __forceinline__ int perm32(int rho) { const int n = rho >> 4, i = rho & 15; return 8 * (i >> 2) + 4 * n + (i & 3); }

struct Unit { const char* A; const char* B; int pm, pn, aux; };
struct Dims { int lda, ldb, K; };

__device__ __forceinline__ void static_tile(int L, int nM, int nN, int& pm, int& pn) {
    const int nwg = nM * nN; int wgid = L;
    { const int q = nwg / NXCD, r = nwg % NXCD, xcd = wgid % NXCD, off = wgid / NXCD; wgid = (xcd < r ? xcd * (q + 1) : r * (q + 1) + (xcd - r) * q) + off; }
    const int nig = WGM * nN, gid = wgid / nig, fm = gid * WGM, gsz = (nM - fm) < WGM ? (nM - fm) : WGM;
    pm = fm + ((wgid % nig) % gsz); pn = (wgid % nig) / gsz;
}
struct StaticSched {
    const char* A; const char* Bt; int lda, ldb, nM, nN, G, c;
    __device__ __forceinline__ bool next(int i, Unit& u) const {
        const long L = (long)i * G + c; if (L >= (long)nM * nN) return false;
        int pm, pn; static_tile((int)L, nM, nN, pm, pn);
        u.pm = pm; u.pn = pn; u.aux = 0; u.A = A + (size_t)pm * BM * lda * 2; u.B = Bt + (size_t)pn * BM * ldb * 2; return true;
    }
};

typedef int v8i_t __attribute__((ext_vector_type(8)));
__device__ __forceinline__ v8i_t cat8(bf16x8 a, bf16x8 b) { const u32x4 x = __builtin_bit_cast(u32x4, a), y = __builtin_bit_cast(u32x4, b); return (v8i_t){(int)x.x, (int)x.y, (int)x.z, (int)x.w, (int)y.x, (int)y.y, (int)y.z, (int)y.w}; }
template <class Epi, class Sched, bool ALIGN_EPI = true, bool SP2 = true, bool FP8 = false>
__device__ __forceinline__ void gemm_phase(LAS unsigned char* lds, const Dims g, const Sched& S, const Epi& E, const int wv) {
    int tid = TIDX(wv); asm volatile("" : "+v"(tid));
    const int wid = __builtin_amdgcn_readfirstlane(tid >> 6), lane = tid & 63, wr = wid >> 2, wc = wid & 3, fr = lane & 15, fq = lane >> 4;
    const int K = g.K, nt = K / BK;
    unsigned voffA[2], voffB[2];
#pragma unroll
    for (int i = 0; i < 2; ++i) { int R, C; stage_rc(tid * 16 + i * 8192, R, C); const int Rb = Epi::PERM ? ((R & ~31) + perm32(R & 31)) : R;
        voffA[i] = (unsigned)(R * g.lda + C) * 2u; voffB[i] = (unsigned)(Rb * g.ldb + C) * 2u; }
    const size_t kstep = (size_t)(BK * 2);
    const size_t hstepA = (size_t)HALF * g.lda * 2, hstepB = (size_t)HALF * g.ldb * 2;
    const unsigned ldsw = (unsigned)wid * 1024u, ldsb_ = (unsigned)(uintptr_t)lds;
    const int aoff = lds_byte(wr * 64 + fr, fq * 8), boff = lds_byte(wc * 32 + fr, fq * 8);
#define PG8_SA(b, h) (((b) * 2 + (h)) * HTB)
#define PG8_SB(b, h) ((4 + (b) * 2 + (h)) * HTB)
#define PG8_STAGE(bufoff, gbase, voff) do { _Pragma("unroll") for (int _i = 0; _i < 2; ++_i) { \
        if constexpr (FP8) { unsigned keep_; asm volatile("s_mov_b32 %0, m0\n\ts_mov_b32 m0, %1\n\ts_nop 0\n\tglobal_load_lds_dwordx4 %2, %3\n\ts_mov_b32 m0, %0" : "=&s"(keep_) : "s"(ldsb_ + (unsigned)(bufoff) + ldsw + _i * 8192u), "v"((voff)[_i]), "s"(gbase) : "memory"); } \
        else __builtin_amdgcn_global_load_lds((const unsigned*)((const char*)(gbase) + (voff)[_i]), (LAS unsigned*)(lds + (bufoff) + ldsw + _i * 8192), 16, 0, 0); } } while (0)
#define PG8_LDA(dst, b, h) do { _Pragma("unroll") for (int m = 0; m < 4; ++m) { if constexpr (FP8) { const u32x4 x_ = *(const LAS u32x4*)(lds + PG8_SA(b, h) + aoff + m * 2048), y_ = *(const LAS u32x4*)(lds + PG8_SA(b, h) + aoff + m * 2048 + 1024); \
        dst##8[m] = (v8i_t){(int)x_.x, (int)x_.y, (int)x_.z, (int)x_.w, (int)y_.x, (int)y_.y, (int)y_.z, (int)y_.w}; } else { _Pragma("unroll") for (int k = 0; k < 2; ++k) dst[m][k] = *(const LAS bf16x8*)(lds + PG8_SA(b, h) + aoff + m * 2048 + k * 1024); } } } while (0)
#define PG8_LDB(dst, b, h) do { _Pragma("unroll") for (int n = 0; n < 2; ++n) { if constexpr (FP8) { const u32x4 x_ = *(const LAS u32x4*)(lds + PG8_SB(b, h) + boff + n * 2048), y_ = *(const LAS u32x4*)(lds + PG8_SB(b, h) + boff + n * 2048 + 1024); \
        dst##8[n] = (v8i_t){(int)x_.x, (int)x_.y, (int)x_.z, (int)x_.w, (int)y_.x, (int)y_.y, (int)y_.z, (int)y_.w}; } else { _Pragma("unroll") for (int k = 0; k < 2; ++k) dst[n][k] = *(const LAS bf16x8*)(lds + PG8_SB(b, h) + boff + n * 2048 + k * 1024); } } } while (0)
#define PG8_MMA(ai, bj, At, Bt) do { __builtin_amdgcn_s_setprio(1); if constexpr (FP8) { _Pragma("unroll") for (int m = 0; m < 4; ++m) _Pragma("unroll") for (int n = 0; n < 2; ++n) \
        acc[ai][bj][m][n] = __builtin_amdgcn_mfma_scale_f32_16x16x128_f8f6f4(Bt##8[n], At##8[m], acc[ai][bj][m][n], 0, 0, 0, 0x7f7f7f7f, 0, 0x7f7f7f7f); } else { \
        _Pragma("unroll") for (int m = 0; m < 4; ++m) _Pragma("unroll") for (int n = 0; n < 2; ++n) _Pragma("unroll") for (int k = 0; k < 2; ++k) \
        acc[ai][bj][m][n] = __builtin_amdgcn_mfma_f32_16x16x32_bf16(Bt[n][k], At[m][k], acc[ai][bj][m][n], 0, 0, 0); } __builtin_amdgcn_s_setprio(0); } while (0)
#define PG8_WAIT_V(n) asm volatile("s_waitcnt vmcnt(" #n ")" ::: "memory")
#define PG8_WAIT_L(n) asm volatile("s_waitcnt lgkmcnt(" #n ")" ::: "memory")
#define PG8_BAR __builtin_amdgcn_s_barrier()
#define PG8_SCHED __builtin_amdgcn_sched_barrier(0)
    Unit cur, nxt; int ui = 0;
    if (!S.next(0, cur)) return;
    f32x4 acc[2][2][4][2];
#pragma unroll
    for (int a = 0; a < 2; ++a)
#pragma unroll
        for (int b = 0; b < 2; ++b)
#pragma unroll
            for (int m = 0; m < 4; ++m)
#pragma unroll
                for (int n = 0; n < 2; ++n) acc[a][b][m][n] = (f32x4){0.f, 0.f, 0.f, 0.f};
    bf16x8 At[4][2], B0[2][2], B1[2][2]; v8i_t At8[4], B08[2], B18[2];
    const char* cA = cur.A; const char* cB = cur.B;
    if constexpr (SP2) {
        PG8_STAGE(PG8_SB(0, 0), cB, voffB); PG8_STAGE(PG8_SB(0, 1), cB + hstepB, voffB); PG8_STAGE(PG8_SA(0, 0), cA, voffA); PG8_STAGE(PG8_SA(0, 1), cA + hstepA, voffA);
        if (wr == 1) PG8_BAR;
        PG8_WAIT_V(2); PG8_BAR;
        PG8_STAGE(PG8_SB(1, 0), cB + kstep, voffB); PG8_STAGE(PG8_SA(1, 0), cA + kstep, voffA); PG8_STAGE(PG8_SB(1, 1), cB + hstepB + kstep, voffB);
        PG8_WAIT_V(6); PG8_BAR;
    } else {
        PG8_STAGE(PG8_SB(0, 0), cB, voffB); PG8_STAGE(PG8_SA(0, 0), cA, voffA); PG8_STAGE(PG8_SB(0, 1), cB + hstepB, voffB); PG8_STAGE(PG8_SA(0, 1), cA + hstepA, voffA);
        if (wr == 1) PG8_BAR;
        PG8_WAIT_V(4); PG8_BAR;
        PG8_STAGE(PG8_SB(1, 0), cB + kstep, voffB); PG8_STAGE(PG8_SA(1, 0), cA + kstep, voffA); PG8_STAGE(PG8_SB(1, 1), cB + hstepB + kstep, voffB);
        PG8_WAIT_V(6); PG8_BAR;
    }
    for (;;) {
        const bool has_next = S.next(ui + 1, nxt);
        const char* nA = has_next ? nxt.A : cA; const char* nB = has_next ? nxt.B : cB;
#pragma unroll 1
        for (int t = 0; t < nt; t += 2) {
            const bool last = (t == nt - 2);
            const char* a1 = cA + (size_t)(t + 1) * kstep;
            const char* a2 = last ? nA : cA + (size_t)(t + 2) * kstep; const char* b2 = last ? nB : cB + (size_t)(t + 2) * kstep;
            const char* a3 = a2 + kstep; const char* b3 = b2 + kstep;
            if constexpr (SP2) {
            PG8_LDB(B0, 0, 0); PG8_LDB(B1, 0, 1); PG8_SCHED; PG8_LDA(At, 0, 0); PG8_STAGE(PG8_SA(1, 1), a1 + hstepA, voffA);
            PG8_WAIT_V(8); PG8_WAIT_L(0); PG8_BAR; PG8_MMA(0, 0, At, B0); PG8_MMA(0, 1, At, B1); PG8_BAR; PG8_SCHED;
            PG8_LDA(At, 0, 1); PG8_STAGE(PG8_SB(0, 0), b2, voffB); PG8_STAGE(PG8_SB(0, 1), b2 + hstepB, voffB); PG8_STAGE(PG8_SA(0, 0), a2, voffA);
            PG8_WAIT_V(8); PG8_WAIT_L(0); PG8_BAR; PG8_MMA(1, 0, At, B0); PG8_MMA(1, 1, At, B1); PG8_BAR; PG8_SCHED;
            PG8_LDB(B0, 1, 0); PG8_LDB(B1, 1, 1); PG8_SCHED; PG8_LDA(At, 1, 0); PG8_STAGE(PG8_SA(0, 1), a2 + hstepA, voffA);
            PG8_WAIT_V(8); PG8_WAIT_L(0); PG8_BAR; PG8_MMA(0, 0, At, B0); PG8_MMA(0, 1, At, B1); PG8_BAR; PG8_SCHED;
            PG8_LDA(At, 1, 1); PG8_STAGE(PG8_SB(1, 0), b3, voffB); PG8_STAGE(PG8_SB(1, 1), b3 + hstepB, voffB); PG8_STAGE(PG8_SA(1, 0), a3, voffA);
            PG8_WAIT_V(8); PG8_WAIT_L(0); PG8_BAR; PG8_MMA(1, 0, At, B0); PG8_MMA(1, 1, At, B1); PG8_BAR; PG8_SCHED;
            } else {
            PG8_LDB(B0, 0, 0); PG8_SCHED; PG8_LDA(At, 0, 0); PG8_STAGE(PG8_SA(1, 1), a1 + hstepA, voffA);
            PG8_WAIT_L(8); PG8_BAR; PG8_WAIT_L(0); PG8_MMA(0, 0, At, B0); PG8_BAR; PG8_SCHED;
            PG8_LDB(B1, 0, 1); PG8_STAGE(PG8_SB(0, 0), b2, voffB);
            PG8_BAR; PG8_WAIT_L(0); PG8_MMA(0, 1, At, B1); PG8_BAR;
            PG8_LDA(At, 0, 1); PG8_STAGE(PG8_SA(0, 0), a2, voffA);
            PG8_BAR; PG8_WAIT_L(0); PG8_MMA(1, 0, At, B0); PG8_BAR; PG8_SCHED;
            PG8_STAGE(PG8_SB(0, 1), b2 + hstepB, voffB);
            PG8_WAIT_V(6); PG8_BAR; PG8_MMA(1, 1, At, B1); PG8_BAR;
            PG8_LDB(B0, 1, 0); PG8_SCHED; PG8_LDA(At, 1, 0); PG8_STAGE(PG8_SA(0, 1), a2 + hstepA, voffA);
            PG8_WAIT_L(8); PG8_BAR; PG8_WAIT_L(0); PG8_MMA(0, 0, At, B0); PG8_BAR; PG8_SCHED;
            PG8_LDB(B1, 1, 1); PG8_STAGE(PG8_SB(1, 0), b3, voffB);
            PG8_BAR; PG8_WAIT_L(0); PG8_MMA(0, 1, At, B1); PG8_BAR;
            PG8_LDA(At, 1, 1); PG8_STAGE(PG8_SA(1, 0), a3, voffA);
            PG8_BAR; PG8_WAIT_L(0); PG8_MMA(1, 0, At, B0); PG8_BAR; PG8_SCHED;
            PG8_STAGE(PG8_SB(1, 1), b3 + hstepB, voffB);
            PG8_WAIT_V(6); PG8_BAR; PG8_MMA(1, 1, At, B1); PG8_BAR;
            }
        }
        if constexpr (ALIGN_EPI) { if (wr == 0) PG8_BAR; }
        { int tz = tid; asm volatile("" : "+v"(tz)); const int ln = tz & 63; E(acc, cur, wr, wc, ln & 15, ln >> 4); }
        if (!has_next) break;
#pragma unroll
        for (int a = 0; a < 2; ++a)
#pragma unroll
            for (int b = 0; b < 2; ++b)
#pragma unroll
                for (int m = 0; m < 4; ++m)
#pragma unroll
                    for (int n = 0; n < 2; ++n) acc[a][b][m][n] = (f32x4){0.f, 0.f, 0.f, 0.f};
        cur = nxt; cA = nA; cB = nB; ++ui;
        if constexpr (ALIGN_EPI) { if (wr == 1) PG8_BAR; }
    }
    PG8_WAIT_V(0);
    if constexpr (!ALIGN_EPI) { if (wr == 0) PG8_BAR; }
    PG8_BAR;
#undef PG8_SA
#undef PG8_SB
#undef PG8_STAGE
#undef PG8_LDA
#undef PG8_LDB
#undef PG8_MMA
#undef PG8_WAIT_V
#undef PG8_WAIT_L
#undef PG8_BAR
#undef PG8_SCHED
}

struct EpiBf16 {
    static constexpr bool PERM = true;
    bf16_t* O0; bf16_t* O1; int ldc0, ldc1; int rope_tiles; int qscale_tiles; float qscale; const GAS f32x2* rope;
    __device__ __forceinline__ void operator()(const f32x4 (&acc)[2][2][4][2], const Unit& u, int wr, int wc, int fr, int fq) const {
        const int row0 = u.pm * BM + wr * 64 + fr, col0 = u.pn * BM + wc * 32 + 8 * fq;
        bf16_t* base = u.aux ? O1 : O0; const int ld = u.aux ? ldc1 : ldc0;
        const bool do_rope = u.pn < rope_tiles; const float sc = (u.pn < qscale_tiles) ? qscale : 1.f;
#pragma unroll
        for (int ai = 0; ai < 2; ++ai)
#pragma unroll
            for (int m = 0; m < 4; ++m) {
                const int row = row0 + ai * HALF + m * 16; bf16_t* rowp = base + (size_t)row * ld + col0;
                f32x4 v00 = acc[ai][0][m][0], v01 = acc[ai][0][m][1], v10 = acc[ai][1][m][0], v11 = acc[ai][1][m][1];
                if (do_rope) {
                    const GAS f32x4* rp = (const GAS f32x4*)(rope + (size_t)row * 128 + wc * 32 + 8 * fq);
                    { const f32x4 t0 = rp[0], t1 = rp[1]; f32x4 a, b;
                      a[0] = v00[0] * t0[0] - v10[0] * t0[1]; b[0] = v10[0] * t0[0] + v00[0] * t0[1];
                      a[1] = v00[1] * t0[2] - v10[1] * t0[3]; b[1] = v10[1] * t0[2] + v00[1] * t0[3];
                      a[2] = v00[2] * t1[0] - v10[2] * t1[1]; b[2] = v10[2] * t1[0] + v00[2] * t1[1];
                      a[3] = v00[3] * t1[2] - v10[3] * t1[3]; b[3] = v10[3] * t1[2] + v00[3] * t1[3];
                      v00 = a; v10 = b; }
                    FENCE();
                    { const f32x4 t2 = rp[2], t3 = rp[3]; f32x4 a, b;
                      a[0] = v01[0] * t2[0] - v11[0] * t2[1]; b[0] = v11[0] * t2[0] + v01[0] * t2[1];
                      a[1] = v01[1] * t2[2] - v11[1] * t2[3]; b[1] = v11[1] * t2[2] + v01[1] * t2[3];
                      a[2] = v01[2] * t3[0] - v11[2] * t3[1]; b[2] = v11[2] * t3[0] + v01[2] * t3[1];
                      a[3] = v01[3] * t3[2] - v11[3] * t3[3]; b[3] = v11[3] * t3[2] + v01[3] * t3[3];
                      v01 = a; v11 = b; }
                }
                v00 = v00 * sc; v01 = v01 * sc; v10 = v10 * sc; v11 = v11 * sc;
                u32x4 w0, w1;
                w0.x = cvt_pk_bf16(v00[0], v00[1]); w0.y = cvt_pk_bf16(v00[2], v00[3]); w0.z = cvt_pk_bf16(v01[0], v01[1]); w0.w = cvt_pk_bf16(v01[2], v01[3]);
                w1.x = cvt_pk_bf16(v10[0], v10[1]); w1.y = cvt_pk_bf16(v10[2], v10[3]); w1.z = cvt_pk_bf16(v11[0], v11[1]); w1.w = cvt_pk_bf16(v11[2], v11[3]);
                *(u32x4*)(rowp) = w0; *(u32x4*)(rowp + HALF) = w1;
                FENCE();
            }
    }
};
struct EpiResid {
    static constexpr bool PERM = true;
    const float* x0; const bf16_t* xb; bf16_t* xout; const float* gate; int gstride;
    __device__ __forceinline__ void operator()(const f32x4 (&acc)[2][2][4][2], const Unit& u, int wr, int wc, int fr, int fq) const {
        const int row0 = u.pm * BM + wr * 64 + fr, col0 = u.pn * BM + wc * 32 + 8 * fq;
        const float* gp = gate + (size_t)((u.pm * BM) >> 12) * gstride + col0;
        f32x4 gv[2][2];
#pragma unroll
        for (int bj = 0; bj < 2; ++bj)
#pragma unroll
            for (int n = 0; n < 2; ++n) gv[bj][n] = *(const f32x4*)(gp + bj * HALF + 4 * n);
#pragma unroll
        for (int ai = 0; ai < 2; ++ai)
#pragma unroll
            for (int m = 0; m < 4; ++m) { const size_t ro = (size_t)(row0 + ai * HALF + m * 16) * DM + col0;
#pragma unroll
                for (int bj = 0; bj < 2; ++bj) {
                    f32x4 b0, b1;
                    if (x0) { b0 = *(const f32x4*)(x0 + ro + bj * HALF); b1 = *(const f32x4*)(x0 + ro + bj * HALF + 4); }
                    else { const u32x4 w = *(const u32x4*)(xb + ro + bj * HALF); b0 = (f32x4){bf_lo(w.x), bf_hi(w.x), bf_lo(w.y), bf_hi(w.y)}; b1 = (f32x4){bf_lo(w.z), bf_hi(w.z), bf_lo(w.w), bf_hi(w.w)}; }
                    const f32x4 v0 = b0 + gv[bj][0] * acc[ai][bj][m][0], v1 = b1 + gv[bj][1] * acc[ai][bj][m][1];
                    u32x4 o; o.x = cvt_pk_bf16(v0[0], v0[1]); o.y = cvt_pk_bf16(v0[2], v0[3]); o.z = cvt_pk_bf16(v1[0], v1[1]); o.w = cvt_pk_bf16(v1[2], v1[3]);
                    *(u32x4*)(xout + ro + bj * HALF) = o; } }
    }
};
__device__ __forceinline__ unsigned pk4_fp8(float a, float b, float c, float d) { int w = __builtin_amdgcn_cvt_pk_fp8_f32(a, b, 0, false); w = __builtin_amdgcn_cvt_pk_fp8_f32(c, d, w, true); return (unsigned)w; }
struct EpiSwiglu {
    static constexpr bool PERM = true;
    unsigned char* act; const float* bgu; float ascale;
    __device__ __forceinline__ void operator()(const f32x4 (&acc)[2][2][4][2], const Unit& u, int wr, int wc, int fr, int fq) const {
        const int row0 = u.pm * BM + wr * 64 + fr, c0 = u.pn * HALF + wc * 32 + 8 * fq;
        const float* bp = bgu + (size_t)u.aux * 2048 + c0;
        const f32x4 bg0 = *(const f32x4*)(bp), bg1 = *(const f32x4*)(bp + 4), bu0 = *(const f32x4*)(bp + 1024), bu1 = *(const f32x4*)(bp + 1028);
#pragma unroll
        for (int ai = 0; ai < 2; ++ai)
#pragma unroll
            for (int m = 0; m < 4; ++m) {
                const f32x4 g0 = acc[ai][0][m][0] * ascale + bg0, g1 = acc[ai][0][m][1] * ascale + bg1, u0 = acc[ai][1][m][0] * ascale + bu0, u1 = acc[ai][1][m][1] * ascale + bu1;
                float r[8];
#pragma unroll
                for (int j = 0; j < 4; ++j) {
                    float gg = fminf(g0[j], 7.f), uu = fminf(fmaxf(u0[j], -7.f), 7.f); r[j] = 4.f * (uu + 1.f) * gg * __builtin_amdgcn_rcpf(1.f + __expf(-1.702f * gg));
                    gg = fminf(g1[j], 7.f); uu = fminf(fmaxf(u1[j], -7.f), 7.f); r[4 + j] = 4.f * (uu + 1.f) * gg * __builtin_amdgcn_rcpf(1.f + __expf(-1.702f * gg));
                }
                u32x2 w; w.x = pk4_fp8(r[0], r[1], r[2], r[3]); w.y = pk4_fp8(r[4], r[5], r[6], r[7]);
                *(u32x2*)(act + (size_t)(row0 + ai * HALF + m * 16) * EFF + c0) = w;
            }
    }
};
struct EpiDown {
    static constexpr bool PERM = true;
    bf16_t* y; const float* bd; const float* wrow; float ascale;
    __device__ __forceinline__ void operator()(const f32x4 (&acc)[2][2][4][2], const Unit& u, int wr, int wc, int fr, int fq) const {
        const int row0 = u.pm * BM + wr * 64 + fr, col0 = u.pn * BM + wc * 32 + 8 * fq;
        const float* bp = bd + (size_t)u.aux * DM + col0;
        const f32x4 b00 = *(const f32x4*)(bp), b01 = *(const f32x4*)(bp + 4), b10 = *(const f32x4*)(bp + HALF), b11 = *(const f32x4*)(bp + HALF + 4);
        float wv[8];
#pragma unroll
        for (int i = 0; i < 8; ++i) wv[i] = wrow[row0 + (i >> 2) * HALF + (i & 3) * 16];
#pragma unroll
        for (int ai = 0; ai < 2; ++ai)
#pragma unroll
            for (int m = 0; m < 4; ++m) {
                const int row = row0 + ai * HALF + m * 16; const float w = wv[ai * 4 + m];
                const f32x4 v00 = (acc[ai][0][m][0] * ascale + b00) * w, v01 = (acc[ai][0][m][1] * ascale + b01) * w, v10 = (acc[ai][1][m][0] * ascale + b10) * w, v11 = (acc[ai][1][m][1] * ascale + b11) * w;
                u32x4 w0, w1;
                w0.x = cvt_pk_bf16(v00[0], v00[1]); w0.y = cvt_pk_bf16(v00[2], v00[3]); w0.z = cvt_pk_bf16(v01[0], v01[1]); w0.w = cvt_pk_bf16(v01[2], v01[3]);
                w1.x = cvt_pk_bf16(v10[0], v10[1]); w1.y = cvt_pk_bf16(v10[2], v10[3]); w1.z = cvt_pk_bf16(v11[0], v11[1]); w1.w = cvt_pk_bf16(v11[2], v11[3]);
                bf16_t* rowp = y + (size_t)row * DM + col0;
                *(u32x4*)(rowp) = w0; *(u32x4*)(rowp + HALF) = w1;
            }
    }
};
}
namespace la {
__device__ __forceinline__ unsigned off_a(unsigned row, unsigned ch) { return 2048u * (row >> 3) + 512u * (ch >> 2) + 64u * (row & 7) + 16u * ((ch & 3) ^ ((row >> 2) & 3)); }
__device__ __forceinline__ unsigned r_base(int lane, int e) { const unsigned h = lane >> 5; return 2048u * ((lane & 31) >> 3) + 64u * (lane & 7) + 16u * ((2u * e + h) ^ ((lane >> 2) & 3)); }
__device__ __forceinline__ unsigned t_base(int lane, int t) { const unsigned h = lane >> 5, blk = (lane >> 4) & 1, q = (lane & 15) >> 2, p = lane & 3;
    return 2048u * h + 64u * (4u * t + q) + 16u * ((2u * blk + (p >> 1)) ^ (2u * h + t)) + 8u * (p & 1); }
__device__ __forceinline__ int crow(int r, int hi) { return (r & 3) + 8 * (r >> 2) + 4 * hi; }

__device__ __forceinline__ bf16x8 lds_r128(unsigned addr) { return *(const LAS bf16x8*)(uintptr_t)addr; }
__device__ __forceinline__ bf16x8 lds_tr_frag(unsigned a0, unsigned a1) {
    s16x4 x, y; asm volatile("ds_read_b64_tr_b16 %0, %2\n\tds_read_b64_tr_b16 %1, %3\n\ts_waitcnt lgkmcnt(0)" : "=&v"(x), "=&v"(y) : "v"(a0), "v"(a1) : "memory");
    return (bf16x8){x[0], x[1], x[2], x[3], y[0], y[1], y[2], y[3]};
}
__device__ __forceinline__ bf16x8 scale_frag(bf16x8 f, float s) {
    u32x4 w = __builtin_bit_cast(u32x4, f); u32x4 o;
    o.x = cvt_pk_bf16(bf_lo(w.x) * s, bf_hi(w.x) * s); o.y = cvt_pk_bf16(bf_lo(w.y) * s, bf_hi(w.y) * s);
    o.z = cvt_pk_bf16(bf_lo(w.z) * s, bf_hi(w.z) * s); o.w = cvt_pk_bf16(bf_lo(w.w) * s, bf_hi(w.w) * s);
    return __builtin_bit_cast(bf16x8, o);
}
template <int R, int NP, bool SCALE>
__device__ __forceinline__ void stage_tile(int tid, unsigned lds_base, const bf16_t* g, int ld, const LAS float* rowscale) {
    constexpr int RPI = 32 / NP, NIT = R / RPI;
    static_assert(RPI % 8 == 0 && R % RPI == 0, "stage_tile geometry");
    const int row0 = tid / (16 * NP), cc = tid % (16 * NP), pnl = cc >> 4, ch = cc & 15;
    const unsigned la0 = lds_base + pnl * (R * 256) + off_a(row0, ch), la1 = lds_base + pnl * (R * 256) + off_a(row0 + RPI, ch);
    const bf16_t* gp = g + (size_t)row0 * ld + cc * 8;
    const size_t gstep = (size_t)RPI * ld;
#pragma unroll
    for (int it = 0; it < NIT; ++it) {
        bf16x8 v = *(const bf16x8*)(gp + it * gstep);
        if (SCALE) v = scale_frag(v, rowscale[row0 + it * RPI]);
        const unsigned la = (RPI % 16 == 0) ? la0 + it * (RPI * 256) : ((it & 1) ? la1 + (it >> 1) * (2 * RPI * 256) : la0 + (it >> 1) * (2 * RPI * 256));
        *(LAS bf16x8*)(uintptr_t)la = v;
        if ((it & 3) == 3) FENCE();
    }
}
template <int R, int CW>
__device__ __forceinline__ void stage_tile_narrow(int tid, unsigned lds_base, const bf16_t* g, int ld) {
    static_assert(CW == 64 && R % 64 == 0, "stage_tile_narrow geometry");
    const int row0 = tid >> 3, ch = tid & 7;
    const unsigned la0 = lds_base + off_a(row0, ch);
    const bf16_t* gp = g + (size_t)row0 * ld + ch * 8;
#pragma unroll
    for (int it = 0; it < R / 64; ++it) *(LAS bf16x8*)(uintptr_t)(la0 + it * 16384) = *(const bf16x8*)(gp + (size_t)it * 64 * ld);
}

struct StateArgs {
    const bf16_t* K; int ldk;
    const bf16_t* V; int ldv;
    bf16_t* Cout; int ldc; size_t cstride;
    float* Nout;
    const float* alpha; const float* beta;
    float lgam; int dir;
};
template <int DK, int DVB, bool MLSTM>
__device__ __forceinline__ void state_unit(LAS unsigned char* lds, const StateArgs a) {
    constexpr int NDKB = DK / 32, NDVB = DVB / 32, BPW = (NDKB * NDVB) / 8, NPK = DK / 128;
    static_assert(BPW >= 1 && (NDKB == 8 || NDKB == 4), "state tile geometry");
    int tid = threadIdx.x; asm volatile("" : "+v"(tid));
    const int wid = __builtin_amdgcn_readfirstlane(tid >> 6), lane = tid & 63, r32 = lane & 31, hi = lane >> 5;
    const int dkb = wid % NDKB, dvb0 = (wid / NDKB) * BPW;
    const unsigned ldsb = (unsigned)(uintptr_t)lds;
    const unsigned KP = ldsb, VP = ldsb + NPK * 32768u, WT = VP + 32768u;
    LAS float* wtab = (LAS float*)(lds + NPK * 32768 + 32768);
    const unsigned tb0 = t_base(lane, 0), tb1 = t_base(lane, 1);
    f32x16 acc[BPW];
#pragma unroll
    for (int j = 0; j < BPW; ++j) acc[j] = (f32x16){};
    float nacc = 0.f;
#pragma unroll 1
    for (int ci = 0; ci < 32; ++ci) {
        const int c = a.dir ? 31 - ci : ci; const int t0 = c * 128;
        {
            bf16_t* co = a.Cout + (size_t)c * a.cstride;
#pragma unroll
            for (int j = 0; j < BPW; ++j)
#pragma unroll
                for (int r = 0; r < 16; ++r) co[(size_t)(32 * dkb + crow(r, hi)) * a.ldc + 32 * (dvb0 + j) + r32] = f2bf(acc[j][r]);
            if (MLSTM) { if (a.Nout && tid < DK) a.Nout[(size_t)c * DK + tid] = nacc; }
        }
        float eF;
        if (MLSTM) {
            const float F = a.alpha[t0 + (a.dir ? 0 : 127)];
            if (tid < 128) wtab[tid] = __expf(F - a.alpha[t0 + tid] + a.beta[t0 + tid]);
            eF = __expf(F);
        } else {
            if (tid < 128) { const int sp = a.dir ? 127 - tid : tid; wtab[tid] = __expf((float)(127 - sp) * a.lgam); }
            eF = __expf(128.f * a.lgam);
        }
        __syncthreads();
        stage_tile<128, NPK, true>(tid, KP, a.K + (size_t)t0 * a.ldk, a.ldk, wtab);
        if constexpr (DVB == 128) stage_tile<128, 1, false>(tid, VP, a.V + (size_t)t0 * a.ldv, a.ldv, nullptr);
        else stage_tile_narrow<128, DVB>(tid, VP, a.V + (size_t)t0 * a.ldv, a.ldv);
        __syncthreads();
#pragma unroll
        for (int j = 0; j < BPW; ++j)
#pragma unroll
            for (int r = 0; r < 16; ++r) acc[j][r] *= eF;
#pragma unroll
        for (int ks = 0; ks < 8; ++ks) {
            const unsigned ka = KP + (dkb >> 2) * 32768u + 4096u * ks + 512u * (dkb & 3);
            const bf16x8 af = lds_tr_frag(ka + tb0, ka + tb1);
#pragma unroll
            for (int j = 0; j < BPW; ++j) {
                const unsigned va = VP + 4096u * ks + 512u * (dvb0 + j);
                const bf16x8 bfr = lds_tr_frag(va + tb0, va + tb1);
                acc[j] = __builtin_amdgcn_mfma_f32_32x32x16_bf16(af, bfr, acc[j], 0, 0, 0);
            }
            FENCE();
        }
        if (MLSTM) {
            if (tid < DK) { float s = 0.f; const int pnl = tid >> 7, col = tid & 127;
                for (int p = 0; p < 128; ++p) s += bf2f(*(const LAS bf16_t*)(lds + pnl * 32768 + off_a(p, col >> 3) + (col & 7) * 2));
                nacc = eF * nacc + s; }
        }
        __syncthreads();
    }
    (void)WT;
}

struct OutArgs {
    const bf16_t* Q; int ldq;
    const bf16_t* K; int ldk;
    const bf16_t* V; int ldv;
    const bf16_t* Cf; const bf16_t* Cb;
    const float* Nf; const float* Nb;
    const float* af; const float* bfw; const float* ab; const float* bbw;
    float Mf, Mb;
    float lgf, lgb;
    const float* gain;
    const bf16_t* G; int ldg;
    bf16_t* Out; int ldo;
};
template <int DK, int DV, bool MLSTM>
__device__ __forceinline__ void out_unit(LAS unsigned char* lds, LAS unsigned char* ldstab, const OutArgs a) {
    constexpr int NPK = DK / 128, NB = DV / 64, NPV = DV / 128, NKS = DK / 16, NCP = DK / 64;
    int tid = threadIdx.x; asm volatile("" : "+v"(tid));
    const int wid = __builtin_amdgcn_readfirstlane(tid >> 6), lane = tid & 63, r32 = lane & 31, hi = lane >> 5;
    const int rb = wid & 3, dh = wid >> 2;
    const unsigned ldsb = (unsigned)(uintptr_t)lds;
    const unsigned QP = ldsb, KP = ldsb + NPK * 32768u, SB = KP;
    LAS float* akf = (LAS float*)ldstab; LAS float* akb = akf + 128; LAS float* nf = akb + 128; LAS float* nbv = nf + 256; LAS float* exch = nbv + 256;
    const unsigned rb0 = r_base(lane, 0), rb1 = r_base(lane, 1), tb0 = t_base(lane, 0), tb1 = t_base(lane, 1);
    __syncthreads();
    stage_tile<128, NPK, false>(tid, QP, a.Q, a.ldq, nullptr);
    stage_tile<128, NPK, false>(tid, KP, a.K, a.ldk, nullptr);
    if (tid < 128) {
        if (MLSTM) { akf[tid] = a.af[tid] - a.bfw[tid]; akb[tid] = a.ab[tid] - a.bbw[tid]; }
        else { akf[tid] = (float)(tid + 1) * a.lgf; akb[tid] = (float)(128 - tid) * a.lgb; }
    }
    if (MLSTM) { if (tid < DK) { nf[tid] = a.Nf[tid]; nbv[tid] = a.Nb[tid]; } }
    const int l = 32 * rb + r32;
    float a_fl, a_bl;
    if (MLSTM) { a_fl = a.af[l]; a_bl = a.ab[l]; } else { a_fl = (float)(l + 1) * a.lgf; a_bl = (float)(128 - l) * a.lgb; }
    __syncthreads();
    f32x16 p[4];
#pragma unroll
    for (int kb = 0; kb < 4; ++kb) p[kb] = (f32x16){};
    float qnf = 0.f, qnb = 0.f;
#pragma unroll
    for (int ks = 0; ks < NKS; ++ks) {
        const unsigned po = (ks >> 3) * 32768u + ((ks & 1) ? rb1 : rb0) + 512u * ((ks & 7) >> 1);
        const bf16x8 qf = lds_r128(QP + po + 8192u * rb);
        bf16x8 kf[4];
#pragma unroll
        for (int kb = 0; kb < 4; ++kb) kf[kb] = lds_r128(KP + po + 8192u * kb);
#pragma unroll
        for (int kb = 0; kb < 4; ++kb) p[kb] = __builtin_amdgcn_mfma_f32_32x32x16_bf16(kf[kb], qf, p[kb], 0, 0, 0);
        FENCE();
    }
    if (MLSTM) {
#pragma unroll 1
        for (int ks = 0; ks < NKS; ++ks) {
            const bf16x8 qf = lds_r128(QP + (ks >> 3) * 32768u + ((ks & 1) ? rb1 : rb0) + 512u * ((ks & 7) >> 1) + 8192u * rb);
            const u32x4 w = __builtin_bit_cast(u32x4, qf); const int k0 = 16 * ks + 8 * hi;
            const f32x4 nf0 = *(const LAS f32x4*)(nf + k0), nf1 = *(const LAS f32x4*)(nf + k0 + 4), nb0 = *(const LAS f32x4*)(nbv + k0), nb1 = *(const LAS f32x4*)(nbv + k0 + 4);
            const float q0 = bf_lo(w.x), q1 = bf_hi(w.x), q2 = bf_lo(w.y), q3 = bf_hi(w.y), q4 = bf_lo(w.z), q5 = bf_hi(w.z), q6 = bf_lo(w.w), q7 = bf_hi(w.w);
            qnf += q0 * nf0[0] + q1 * nf0[1] + q2 * nf0[2] + q3 * nf0[3] + q4 * nf1[0] + q5 * nf1[1] + q6 * nf1[2] + q7 * nf1[3];
            qnb += q0 * nb0[0] + q1 * nb0[1] + q2 * nb0[2] + q3 * nb0[3] + q4 * nb1[0] + q5 * nb1[1] + q6 * nb1[2] + q7 * nb1[3];
        }
    }
    float rf = 1.f, rbk = 1.f;
    if (MLSTM) {
        float df = 0.f, db = 0.f;
#pragma unroll
        for (int kb = 0; kb < 4; ++kb) {
#pragma unroll
            for (int r = 0; r < 16; ++r) { const int s = 32 * kb + crow(r, hi);
                const float xf = a_fl - akf[s], xb = a_bl - akb[s];
                const float wf = __expf((s <= l) ? xf : -1.0e30f), wb = __expf((s >= l) ? xb : -1.0e30f);
                df += p[kb][r] * wf; db += p[kb][r] * wb; }
            FENCE(); }
        { auto rr = __builtin_amdgcn_permlane32_swap(__float_as_uint(df), __float_as_uint(df), false, false); df = __uint_as_float(rr[0]) + __uint_as_float(rr[1]); }
        { auto rr = __builtin_amdgcn_permlane32_swap(__float_as_uint(db), __float_as_uint(db), false, false); db = __uint_as_float(rr[0]) + __uint_as_float(rr[1]); }
        { auto rr = __builtin_amdgcn_permlane32_swap(__float_as_uint(qnf), __float_as_uint(qnf), false, false); qnf = __uint_as_float(rr[0]) + __uint_as_float(rr[1]); }
        { auto rr = __builtin_amdgcn_permlane32_swap(__float_as_uint(qnb), __float_as_uint(qnb), false, false); qnb = __uint_as_float(rr[0]) + __uint_as_float(rr[1]); }
        df += __expf(a_fl) * qnf; db += __expf(a_bl) * qnb;
        rf = 1.f / fmaxf(fabsf(df), __expf(-a.Mf)); rbk = 1.f / fmaxf(fabsf(db), __expf(-a.Mb));
        asm volatile("" : "+v"(a_fl), "+v"(a_bl));
    }
    int l2 = l; asm volatile("" : "+v"(l2));
#pragma unroll
    for (int kb = 0; kb < 4; ++kb) {
#pragma unroll
        for (int r = 0; r < 16; ++r) { const int s = 32 * kb + crow(r, hi);
            const float xf = a_fl - akf[s], xb = a_bl - akb[s];
            const float wf = __expf((s <= l2) ? xf : -1.0e30f), wb = __expf((s >= l2) ? xb : -1.0e30f);
            p[kb][r] *= (wf * rf + wb * rbk); }
        FENCE(); }
    const float qsf = __expf(a_fl) * rf, qsb = __expf(a_bl) * rbk;
    bf16x8 pa[8];
#define LA_PK4(P, BASE, OUT) do { unsigned a0 = cvt_pk_bf16(P[BASE + 0], P[BASE + 1]), a1 = cvt_pk_bf16(P[BASE + 2], P[BASE + 3]); \
    unsigned b0 = cvt_pk_bf16(P[BASE + 4], P[BASE + 5]), b1 = cvt_pk_bf16(P[BASE + 6], P[BASE + 7]); \
    auto r0 = __builtin_amdgcn_permlane32_swap(a0, b0, false, false); auto r1 = __builtin_amdgcn_permlane32_swap(a1, b1, false, false); \
    u32x4 w = {r0[0], r1[0], r0[1], r1[1]}; OUT = __builtin_bit_cast(bf16x8, w); } while (0)
#pragma unroll
    for (int kb = 0; kb < 4; ++kb) { LA_PK4(p[kb], 0, pa[2 * kb]); LA_PK4(p[kb], 8, pa[2 * kb + 1]); }
#undef LA_PK4
    f32x16 o[NB];
#pragma unroll
    for (int nb = 0; nb < NB; ++nb) o[nb] = (f32x16){};
#pragma unroll
    for (int pc = 0; pc < 2; ++pc) {
        __syncthreads();
        stage_tile<64, NPV, false>(tid, SB, a.V + (size_t)(64 * pc) * a.ldv, a.ldv, nullptr);
        __syncthreads();
#pragma unroll
        for (int ks = 0; ks < 4; ++ks) {
            const bf16x8 af = pa[4 * pc + ks];
#pragma unroll
            for (int nb = 0; nb < NB; ++nb) { const int cg = dh * NB + nb; const unsigned va = SB + (cg >> 2) * 16384u + 4096u * ks + 512u * (cg & 3);
                const bf16x8 bfr = lds_tr_frag(va + tb0, va + tb1);
                o[nb] = __builtin_amdgcn_mfma_f32_32x32x16_bf16(af, bfr, o[nb], 0, 0, 0); }
            FENCE();
        }
    }
#pragma unroll 1
    for (int pc = 0; pc < 2 * NCP; ++pc) {
        __syncthreads();
        const int dirb = pc >= NCP, cp = dirb ? pc - NCP : pc;
        const bf16_t* src = (dirb ? a.Cb : a.Cf) + (size_t)(64 * cp) * DV;
        const float qs = dirb ? qsb : qsf;
        stage_tile<64, NPV, false>(tid, SB, src, DV, nullptr);
        __syncthreads();
#pragma unroll
        for (int ks = 0; ks < 4; ++ks) {
            const int kq = 4 * cp + ks;
            const bf16x8 qf = lds_r128(QP + (kq >> 3) * 32768u + ((kq & 1) ? rb1 : rb0) + 512u * ((kq & 7) >> 1) + 8192u * rb);
            const bf16x8 af = scale_frag(qf, qs);
#pragma unroll
            for (int nb = 0; nb < NB; ++nb) { const int cg = dh * NB + nb; const unsigned va = SB + (cg >> 2) * 16384u + 4096u * ks + 512u * (cg & 3);
                const bf16x8 bfr = lds_tr_frag(va + tb0, va + tb1);
                o[nb] = __builtin_amdgcn_mfma_f32_32x32x16_bf16(af, bfr, o[nb], 0, 0, 0); }
            FENCE();
        }
    }
    float s1[16], s2[16];
#pragma unroll
    for (int r = 0; r < 16; ++r) { float x1 = 0.f, x2 = 0.f;
#pragma unroll
        for (int nb = 0; nb < NB; ++nb) { x1 += o[nb][r]; x2 += o[nb][r] * o[nb][r]; }
#pragma unroll
        for (int m = 1; m < 32; m <<= 1) { x1 += shx(x1, m, lane); x2 += shx(x2, m, lane); }
        s1[r] = x1; s2[r] = x2; }
    if (r32 == 0) {
#pragma unroll
        for (int r = 0; r < 16; ++r) { const int row = 32 * rb + crow(r, hi); exch[(dh * 128 + row) * 2] = s1[r]; exch[(dh * 128 + row) * 2 + 1] = s2[r]; }
    }
    __syncthreads();
#pragma unroll
    for (int r = 0; r < 16; ++r) {
        const int row = 32 * rb + crow(r, hi);
        const float t1 = s1[r] + exch[((1 - dh) * 128 + row) * 2], t2 = s2[r] + exch[((1 - dh) * 128 + row) * 2 + 1];
        float mean, inv;
        if (MLSTM) { mean = 0.f; inv = rsqrtf(t2 * (1.f / DV) + EPS); }
        else { mean = t1 * (1.f / DV); inv = rsqrtf(fmaxf(t2 * (1.f / DV) - mean * mean, 0.f) + EPS); }
#pragma unroll
        for (int nb = 0; nb < NB; ++nb) {
            const int col = dh * (DV / 2) + 32 * nb + r32;
            const float gpre = bf2f(a.G[(size_t)row * a.ldg + col]);
            const float gate = MLSTM ? sigmoidf_(gpre) : siluf_(gpre);
            a.Out[(size_t)row * a.ldo + col] = f2bf((o[nb][r] - mean) * inv * a.gain[col] * gate);
        }
    }
}

template <int R, int NP>
__device__ __forceinline__ void dma_tile(int wid, int lane, unsigned lds_base, const bf16_t* src, int ld) {
    constexpr int NQ = R * NP / 4, PER = NQ / 8;
    static_assert(NQ % 8 == 0 && R % 8 == 0, "dma_tile geometry");
    const int r7 = (lane >> 2) & 7, x = lane & 3, hi = lane >> 5;
#pragma unroll
    for (int j = 0; j < PER; ++j) {
        const int q = wid * PER + j;
        const int sub = 2 * q + hi, panel = sub / (R / 2), psub = sub % (R / 2), rg = psub >> 2, cblk = psub & 3;
        const int row = 8 * rg + r7, chlo = x ^ ((row >> 2) & 3);
        const bf16_t* g = src + (size_t)row * ld + 128 * panel + 32 * cblk + 8 * chlo;
        __builtin_amdgcn_global_load_lds((const unsigned*)g, (LAS unsigned*)(uintptr_t)(lds_base + q * 1024u), 16, 0, 0);
    }
}
template <int R>
__device__ __forceinline__ void dma_tile_n64(int wid, int lane, unsigned lds_base, const bf16_t* src, int ld) {
    static_assert(R == 64, "dma_tile_n64 geometry");
    const int r7 = (lane >> 2) & 7, x = lane & 3, hi = lane >> 5;
    const int row = 8 * wid + r7, chlo = x ^ ((row >> 2) & 3);
    const bf16_t* g = src + (size_t)row * ld + 32 * hi + 8 * chlo;
    __builtin_amdgcn_global_load_lds((const unsigned*)g, (LAS unsigned*)(uintptr_t)(lds_base + wid * 2048u), 16, 0, 0);
}
template <int OFF> __device__ __forceinline__ s16x4 tr_rd(unsigned base) { s16x4 r; asm volatile("ds_read_b64_tr_b16 %0, %1 offset:%2" : "=&v"(r) : "v"(base), "i"(OFF) : "memory"); return r; }
#define LA_LGKM0() do { asm volatile("s_waitcnt lgkmcnt(0)" ::: "memory"); __builtin_amdgcn_sched_barrier(0); } while (0)
#define LA_FRAG(L, H) (bf16x8){L[0], L[1], L[2], L[3], H[0], H[1], H[2], H[3]}
template <int NBLK>
__device__ __forceinline__ void store_blocks_t(LAS unsigned char* ts, int lane, const f32x16* blk, bf16_t* dst, int ldd) {
    constexpr int RB = 64 * NBLK;
    const int r32 = lane & 31, hi = lane >> 5;
#pragma unroll
    for (int j = 0; j < NBLK; ++j)
#pragma unroll
        for (int r = 0; r < 16; ++r) *(LAS bf16_t*)(ts + crow(r, hi) * RB + (32 * j + r32) * 2) = f2bf(blk[j][r]);
    LDS_WAIT();
    constexpr int CPR = 4 * NBLK, NCH = 32 * CPR;
#pragma unroll
    for (int it = 0; it < NCH / 64; ++it) { const int id = it * 64 + lane, row = id / CPR, ch = id % CPR;
        *(u32x4*)(dst + (size_t)row * ldd + 8 * ch) = *(const LAS u32x4*)(ts + row * RB + ch * 16); }
    LDS_WAIT();
}

template <int DK, int DVB, bool MLSTM>
__device__ __forceinline__ void state_unit2(LAS unsigned char* lds, LAS unsigned char* ldstab, const StateArgs a, const int wv) {
    constexpr int NDKB = DK / 32, NDVB = DVB / 32, BPW = (NDKB * NDVB) / 8, NPK = DK / 128;
    constexpr unsigned BUFSZ = (NPK + 1) * 16384u, VOFF = NPK * 16384u, TSOFF = 2 * BUFSZ;
    static_assert(TSOFF + 8 * 4096u <= 131072u, "state pass LDS map stays below the control words");
    static_assert(BPW >= 1 && (NDKB == 8 || NDKB == 4) && (DVB == 128 || DVB == 64), "state tile geometry");
    int tid = TIDX(wv); asm volatile("" : "+v"(tid));
    const int wid = __builtin_amdgcn_readfirstlane(tid >> 6), lane = tid & 63, hi = lane >> 5;
    const int dkb = wid % NDKB, dvb0 = (wid / NDKB) * BPW;
    const unsigned ldsb = (unsigned)(uintptr_t)lds;
    LAS float* wtab = (LAS float*)ldstab;
    LAS unsigned char* ts = lds + TSOFF + wid * 4096;
    const unsigned tbA0 = t_base(lane, 0) + (dkb >> 2) * 16384u + 512u * (dkb & 3), tbA1 = t_base(lane, 1) + (dkb >> 2) * 16384u + 512u * (dkb & 3);
    const unsigned tbB0 = t_base(lane, 0) + VOFF + 512u * dvb0, tbB1 = t_base(lane, 1) + VOFF + 512u * dvb0;
    f32x16 acc[BPW];
#pragma unroll
    for (int j = 0; j < BPW; ++j) acc[j] = (f32x16){};
    float nacc = 0.f;
    __syncthreads();
#define ST_DMA(hs_) do { const int c_ = a.dir ? 31 - ((hs_) >> 1) : ((hs_) >> 1); const int t_ = c_ * 128 + 64 * ((hs_) & 1); const unsigned bb_ = ldsb + ((hs_) & 1) * BUFSZ; \
        dma_tile<64, NPK>(wid, lane, bb_, a.K + (size_t)t_ * a.ldk, a.ldk); \
        if constexpr (DVB == 128) dma_tile<64, 1>(wid, lane, bb_ + VOFF, a.V + (size_t)t_ * a.ldv, a.ldv); else dma_tile_n64<64>(wid, lane, bb_ + VOFF, a.V + (size_t)t_ * a.ldv, a.ldv); } while (0)
    ST_DMA(0);
    float eF = 1.f;
#pragma unroll 1
    for (int hs = 0; hs < 64; ++hs) {
        const int ci = hs >> 1, half = hs & 1, c = a.dir ? 31 - ci : ci, t0 = c * 128;
        LAS float* wt = wtab + (ci & 1) * 128;
        if (half == 0) {
            bf16_t* co = a.Cout + (size_t)c * a.cstride + (size_t)(32 * dkb) * a.ldc + 32 * dvb0;
            if constexpr (BPW == 4) { store_blocks_t<2>(ts, lane, acc, co, a.ldc); store_blocks_t<2>(ts, lane, acc + 2, co + 64, a.ldc); }
            else store_blocks_t<1>(ts, lane, acc, co, a.ldc);
            if (MLSTM) { if (a.Nout && tid < DK) a.Nout[(size_t)c * DK + tid] = nacc; }
            if (MLSTM) { const float F = a.alpha[t0 + (a.dir ? 0 : 127)];
                if (tid < 128) wt[tid] = __expf(F - a.alpha[t0 + tid] + a.beta[t0 + tid]);
                eF = __expf(F);
            } else {
                if (tid < 128) { const int sp = a.dir ? 127 - tid : tid; wt[tid] = __expf((float)(127 - sp) * a.lgam); }
                eF = __expf(128.f * a.lgam);
            }
        }
        VM_WAIT(); __syncthreads();
        if (hs + 1 < 64) ST_DMA(hs + 1);
        if (half == 0) {
#pragma unroll
            for (int j = 0; j < BPW; ++j)
#pragma unroll
                for (int r = 0; r < 16; ++r) acc[j][r] *= eF;
        }
        const unsigned bb = ldsb + half * BUFSZ;
        const unsigned a0 = bb + tbA0, a1 = bb + tbA1, b0 = bb + tbB0, b1 = bb + tbB1;
        const LAS float* wk = wt + 64 * half + 8 * hi;
#define ST_KS(KS) do { \
            const s16x4 al = tr_rd<4096 * (KS)>(a0), ah = tr_rd<4096 * (KS)>(a1); \
            s16x4 bl[BPW], bh[BPW]; \
            bl[0] = tr_rd<4096 * (KS)>(b0); bh[0] = tr_rd<4096 * (KS)>(b1); \
            if constexpr (BPW == 4) { bl[1] = tr_rd<4096 * (KS) + 512>(b0); bh[1] = tr_rd<4096 * (KS) + 512>(b1); bl[2] = tr_rd<4096 * (KS) + 1024>(b0); bh[2] = tr_rd<4096 * (KS) + 1024>(b1); \
                bl[3] = tr_rd<4096 * (KS) + 1536>(b0); bh[3] = tr_rd<4096 * (KS) + 1536>(b1); } \
            const f32x4 w0 = *(const LAS f32x4*)(wk + 16 * (KS)), w1 = *(const LAS f32x4*)(wk + 16 * (KS) + 4); \
            LA_LGKM0(); \
            u32x4 af; af.x = cvt_pk_bf16(bf2f((bf16_t)al[0]) * w0[0], bf2f((bf16_t)al[1]) * w0[1]); af.y = cvt_pk_bf16(bf2f((bf16_t)al[2]) * w0[2], bf2f((bf16_t)al[3]) * w0[3]); \
            af.z = cvt_pk_bf16(bf2f((bf16_t)ah[0]) * w1[0], bf2f((bf16_t)ah[1]) * w1[1]); af.w = cvt_pk_bf16(bf2f((bf16_t)ah[2]) * w1[2], bf2f((bf16_t)ah[3]) * w1[3]); \
            const bf16x8 afr = __builtin_bit_cast(bf16x8, af); \
            _Pragma("unroll") for (int j = 0; j < BPW; ++j) acc[j] = __builtin_amdgcn_mfma_f32_32x32x16_bf16(afr, LA_FRAG(bl[j], bh[j]), acc[j], 0, 0, 0); \
        } while (0)
        ST_KS(0); ST_KS(1); ST_KS(2); ST_KS(3);
#undef ST_KS
        if (MLSTM) {
            if (tid < DK) { float s = 0.f; const int pnl = tid >> 7, col = tid & 127; const LAS unsigned char* kp = lds + half * BUFSZ + pnl * 16384 + (col & 7) * 2;
                for (int p = 0; p < 64; ++p) s += bf2f(*(const LAS bf16_t*)(kp + off_a(p, col >> 3))) * wt[64 * half + p];
                nacc = (half == 0 ? eF * nacc : nacc) + s; }
        }
    }
#undef ST_DMA
    __syncthreads();
}

template <int DK, int DV, bool MLSTM>
__device__ __forceinline__ void out_unit2(LAS unsigned char* lds, LAS unsigned char* ldstab, const OutArgs a, const int wv) {
    constexpr int NPK = DK / 128, NB = DV / 64, NPV = DV / 128, NKS = DK / 16, NCP = DK / 32;
    constexpr unsigned PANEL = 32 * 256, PIECE = NPV * PANEL;
    static_assert(2 * PIECE <= NPK * 32768u && (NB == 8 || NB == 2), "stream buffers fit the K region");
    int tid = TIDX(wv); asm volatile("" : "+v"(tid));
    const int wid = __builtin_amdgcn_readfirstlane(tid >> 6), lane = tid & 63, r32 = lane & 31, hi = lane >> 5;
    const int rb = wid & 3, dh = wid >> 2;
    const unsigned ldsb = (unsigned)(uintptr_t)lds;
    const unsigned QP = ldsb, KP = ldsb + NPK * 32768u, SB = KP;
    LAS float* akf = (LAS float*)ldstab; LAS float* akb = akf + 128; LAS float* nf = akb + 128; LAS float* nbv = nf + 256; LAS float* exch = nbv + 256;
    const unsigned rb0 = r_base(lane, 0);
#define rb1 (rb0 ^ 32u)
    const unsigned dhoff = (NB == 8) ? dh * 2u * PANEL : dh * 1024u;
    const unsigned tb0 = t_base(lane, 0) + dhoff;
#define tb1 ((tb0 ^ 16u) + 256u)
    __syncthreads();
    dma_tile<128, NPK>(wid, lane, QP, a.Q, a.ldq);
    dma_tile<128, NPK>(wid, lane, KP, a.K, a.ldk);
    if (tid < 128) {
        if (MLSTM) { akf[tid] = a.af[tid] - a.bfw[tid]; akb[tid] = a.ab[tid] - a.bbw[tid]; }
        else { akf[tid] = (float)(tid + 1) * a.lgf; akb[tid] = (float)(128 - tid) * a.lgb; }
    }
    if (MLSTM) { if (tid < DK) { nf[tid] = a.Nf[tid]; nbv[tid] = a.Nb[tid]; } }
    const int l = 32 * rb + r32;
    float a_fl, a_bl;
    if (MLSTM) { a_fl = a.af[l]; a_bl = a.ab[l]; } else { a_fl = (float)(l + 1) * a.lgf; a_bl = (float)(128 - l) * a.lgb; }
    VM_WAIT(); __syncthreads();
    f32x16 p[4];
#pragma unroll
    for (int kb = 0; kb < 4; ++kb) p[kb] = (f32x16){};
    float qnf = 0.f, qnb = 0.f;
#pragma unroll
    for (int ks = 0; ks < NKS; ++ks) {
        const unsigned po = (ks >> 3) * 32768u + ((ks & 1) ? rb1 : rb0) + 512u * ((ks & 7) >> 1);
        const bf16x8 qf = lds_r128(QP + po + 8192u * rb);
        bf16x8 kf[4];
#pragma unroll
        for (int kb = 0; kb < 4; ++kb) kf[kb] = lds_r128(KP + po + 8192u * kb);
#pragma unroll
        for (int kb = 0; kb < 4; ++kb) p[kb] = __builtin_amdgcn_mfma_f32_32x32x16_bf16(kf[kb], qf, p[kb], 0, 0, 0);
        FENCE();
    }
    if (MLSTM) {
#pragma unroll 1
        for (int ks = 0; ks < NKS; ++ks) {
            const bf16x8 qf = lds_r128(QP + (ks >> 3) * 32768u + ((ks & 1) ? rb1 : rb0) + 512u * ((ks & 7) >> 1) + 8192u * rb);
            const u32x4 w = __builtin_bit_cast(u32x4, qf); const int k0 = 16 * ks + 8 * hi;
            const f32x4 nf0 = *(const LAS f32x4*)(nf + k0), nf1 = *(const LAS f32x4*)(nf + k0 + 4), nb0 = *(const LAS f32x4*)(nbv + k0), nb1 = *(const LAS f32x4*)(nbv + k0 + 4);
            const float q0 = bf_lo(w.x), q1 = bf_hi(w.x), q2 = bf_lo(w.y), q3 = bf_hi(w.y), q4 = bf_lo(w.z), q5 = bf_hi(w.z), q6 = bf_lo(w.w), q7 = bf_hi(w.w);
            qnf += q0 * nf0[0] + q1 * nf0[1] + q2 * nf0[2] + q3 * nf0[3] + q4 * nf1[0] + q5 * nf1[1] + q6 * nf1[2] + q7 * nf1[3];
            qnb += q0 * nb0[0] + q1 * nb0[1] + q2 * nb0[2] + q3 * nb0[3] + q4 * nb1[0] + q5 * nb1[1] + q6 * nb1[2] + q7 * nb1[3];
        }
    }
    __syncthreads();
    dma_tile<32, NPV>(wid, lane, SB, a.V, a.ldv);
    float rf = 1.f, rbk = 1.f;
    if (MLSTM) {
        float df = 0.f, db = 0.f;
#pragma unroll
        for (int kb = 0; kb < 4; ++kb) {
#pragma unroll
            for (int r = 0; r < 16; ++r) { const int s = 32 * kb + crow(r, hi);
                const float xf = a_fl - akf[s], xb = a_bl - akb[s];
                const float wf = __expf((s <= l) ? xf : -1.0e30f), wb = __expf((s >= l) ? xb : -1.0e30f);
                df += p[kb][r] * wf; db += p[kb][r] * wb; }
            FENCE(); }
        { auto rr = __builtin_amdgcn_permlane32_swap(__float_as_uint(df), __float_as_uint(df), false, false); df = __uint_as_float(rr[0]) + __uint_as_float(rr[1]); }
        { auto rr = __builtin_amdgcn_permlane32_swap(__float_as_uint(db), __float_as_uint(db), false, false); db = __uint_as_float(rr[0]) + __uint_as_float(rr[1]); }
        { auto rr = __builtin_amdgcn_permlane32_swap(__float_as_uint(qnf), __float_as_uint(qnf), false, false); qnf = __uint_as_float(rr[0]) + __uint_as_float(rr[1]); }
        { auto rr = __builtin_amdgcn_permlane32_swap(__float_as_uint(qnb), __float_as_uint(qnb), false, false); qnb = __uint_as_float(rr[0]) + __uint_as_float(rr[1]); }
        df += __expf(a_fl) * qnf; db += __expf(a_bl) * qnb;
        rf = 1.f / fmaxf(fabsf(df), __expf(-a.Mf)); rbk = 1.f / fmaxf(fabsf(db), __expf(-a.Mb));
        asm volatile("" : "+v"(a_fl), "+v"(a_bl));
    }
    int l2 = l; asm volatile("" : "+v"(l2));
#pragma unroll
    for (int kb = 0; kb < 4; ++kb) {
#pragma unroll
        for (int r = 0; r < 16; ++r) { const int s = 32 * kb + crow(r, hi);
            const float xf = a_fl - akf[s], xb = a_bl - akb[s];
            const float wf = __expf((s <= l2) ? xf : -1.0e30f), wb = __expf((s >= l2) ? xb : -1.0e30f);
            p[kb][r] *= (wf * rf + wb * rbk); }
        FENCE(); }
    const float qsf = __expf(a_fl) * rf, qsb = __expf(a_bl) * rbk;
    bf16x8 pa[8];
#define LA_PK4(P, BASE, OUT) do { unsigned a0 = cvt_pk_bf16(P[BASE + 0], P[BASE + 1]), a1 = cvt_pk_bf16(P[BASE + 2], P[BASE + 3]); \
    unsigned b0 = cvt_pk_bf16(P[BASE + 4], P[BASE + 5]), b1 = cvt_pk_bf16(P[BASE + 6], P[BASE + 7]); \
    auto r0 = __builtin_amdgcn_permlane32_swap(a0, b0, false, false); auto r1 = __builtin_amdgcn_permlane32_swap(a1, b1, false, false); \
    u32x4 w = {r0[0], r1[0], r0[1], r1[1]}; OUT = __builtin_bit_cast(bf16x8, w); } while (0)
#pragma unroll
    for (int kb = 0; kb < 4; ++kb) { LA_PK4(p[kb], 0, pa[2 * kb]); LA_PK4(p[kb], 8, pa[2 * kb + 1]); }
#undef LA_PK4
    f32x16 o[NB];
#pragma unroll
    for (int nb = 0; nb < NB; ++nb) o[nb] = (f32x16){};
#define OUT_DMA(pc_) do { const int n_ = (pc_); const unsigned bb_ = SB + (n_ & 1) * PIECE; \
        if (n_ < 4) dma_tile<32, NPV>(wid, lane, bb_, a.V + (size_t)(32 * n_) * a.ldv, a.ldv); \
        else if (n_ < 4 + NCP) dma_tile<32, NPV>(wid, lane, bb_, a.Cf + (size_t)(32 * (n_ - 4)) * DV, DV); \
        else dma_tile<32, NPV>(wid, lane, bb_, a.Cb + (size_t)(32 * (n_ - 4 - NCP)) * DV, DV); } while (0)
#define OUT_MMA(bufpar) do { const unsigned b0_ = SB + (bufpar) * PIECE + tb0, b1_ = SB + (bufpar) * PIECE + tb1; \
        if constexpr (NB == 8) { \
            _Pragma("unroll") for (int g_ = 0; g_ < 2; ++g_) { const unsigned c0_ = b0_ + g_ * PANEL, c1_ = b1_ + g_ * PANEL; \
                { const s16x4 l0 = tr_rd<0>(c0_), h0 = tr_rd<0>(c1_), l1 = tr_rd<512>(c0_), h1 = tr_rd<512>(c1_), l2_ = tr_rd<1024>(c0_), h2 = tr_rd<1024>(c1_), l3 = tr_rd<1536>(c0_), h3 = tr_rd<1536>(c1_); LA_LGKM0(); \
                  o[4 * g_ + 0] = __builtin_amdgcn_mfma_f32_32x32x16_bf16(af0, LA_FRAG(l0, h0), o[4 * g_ + 0], 0, 0, 0); o[4 * g_ + 1] = __builtin_amdgcn_mfma_f32_32x32x16_bf16(af0, LA_FRAG(l1, h1), o[4 * g_ + 1], 0, 0, 0); \
                  o[4 * g_ + 2] = __builtin_amdgcn_mfma_f32_32x32x16_bf16(af0, LA_FRAG(l2_, h2), o[4 * g_ + 2], 0, 0, 0); o[4 * g_ + 3] = __builtin_amdgcn_mfma_f32_32x32x16_bf16(af0, LA_FRAG(l3, h3), o[4 * g_ + 3], 0, 0, 0); } \
                { const s16x4 l0 = tr_rd<4096>(c0_), h0 = tr_rd<4096>(c1_), l1 = tr_rd<4608>(c0_), h1 = tr_rd<4608>(c1_), l2_ = tr_rd<5120>(c0_), h2 = tr_rd<5120>(c1_), l3 = tr_rd<5632>(c0_), h3 = tr_rd<5632>(c1_); LA_LGKM0(); \
                  o[4 * g_ + 0] = __builtin_amdgcn_mfma_f32_32x32x16_bf16(af1, LA_FRAG(l0, h0), o[4 * g_ + 0], 0, 0, 0); o[4 * g_ + 1] = __builtin_amdgcn_mfma_f32_32x32x16_bf16(af1, LA_FRAG(l1, h1), o[4 * g_ + 1], 0, 0, 0); \
                  o[4 * g_ + 2] = __builtin_amdgcn_mfma_f32_32x32x16_bf16(af1, LA_FRAG(l2_, h2), o[4 * g_ + 2], 0, 0, 0); o[4 * g_ + 3] = __builtin_amdgcn_mfma_f32_32x32x16_bf16(af1, LA_FRAG(l3, h3), o[4 * g_ + 3], 0, 0, 0); } } \
        } else { \
            const s16x4 l0 = tr_rd<0>(b0_), h0 = tr_rd<0>(b1_), l1 = tr_rd<512>(b0_), h1 = tr_rd<512>(b1_), l2_ = tr_rd<4096>(b0_), h2 = tr_rd<4096>(b1_), l3 = tr_rd<4608>(b0_), h3 = tr_rd<4608>(b1_); LA_LGKM0(); \
            o[0] = __builtin_amdgcn_mfma_f32_32x32x16_bf16(af0, LA_FRAG(l0, h0), o[0], 0, 0, 0); o[1] = __builtin_amdgcn_mfma_f32_32x32x16_bf16(af0, LA_FRAG(l1, h1), o[1], 0, 0, 0); \
            o[0] = __builtin_amdgcn_mfma_f32_32x32x16_bf16(af1, LA_FRAG(l2_, h2), o[0], 0, 0, 0); o[1] = __builtin_amdgcn_mfma_f32_32x32x16_bf16(af1, LA_FRAG(l3, h3), o[1], 0, 0, 0); } } while (0)
#pragma unroll
    for (int pc = 0; pc < 4; ++pc) {
        VM_WAIT(); __syncthreads();
        OUT_DMA(pc + 1);
        const bf16x8 af0 = pa[2 * pc], af1 = pa[2 * pc + 1];
        OUT_MMA(pc & 1);
    }
#pragma unroll 1
    for (int pc = 4; pc < 4 + 2 * NCP; ++pc) {
        VM_WAIT(); __syncthreads();
        if (pc + 1 < 4 + 2 * NCP) OUT_DMA(pc + 1);
        const int cq = pc - 4, dirb = cq >= NCP, cp = dirb ? cq - NCP : cq;
        const float qs = dirb ? qsb : qsf;
        const unsigned qa = QP + (cp >> 2) * 32768u + 512u * (cp & 3) + 8192u * rb;
        const bf16x8 af0 = scale_frag(lds_r128(qa + rb0), qs), af1 = scale_frag(lds_r128(qa + rb1), qs);
        OUT_MMA(pc & 1);
    }
#undef OUT_DMA
#undef OUT_MMA
    float s1[16], s2[16];
#pragma unroll
    for (int r = 0; r < 16; ++r) { float x1 = 0.f, x2 = 0.f;
#pragma unroll
        for (int nb = 0; nb < NB; ++nb) { x1 += o[nb][r]; x2 += o[nb][r] * o[nb][r]; }
#pragma unroll
        for (int m = 1; m < 32; m <<= 1) { x1 += shx(x1, m, lane); x2 += shx(x2, m, lane); }
        s1[r] = x1; s2[r] = x2; }
    if (r32 == 0) {
#pragma unroll
        for (int r = 0; r < 16; ++r) { const int row = 32 * rb + crow(r, hi); exch[(dh * 128 + row) * 2] = s1[r]; exch[(dh * 128 + row) * 2 + 1] = s2[r]; }
    }
    __syncthreads();
    constexpr int TP = DV * 2;
    static_assert(128 * TP <= 2 * NPK * 32768, "output tile fits the Q + K regions");
#pragma unroll
    for (int r = 0; r < 16; ++r) {
        const int row = 32 * rb + crow(r, hi);
        const float t1 = s1[r] + exch[((1 - dh) * 128 + row) * 2], t2 = s2[r] + exch[((1 - dh) * 128 + row) * 2 + 1];
        float mean, inv;
        if (MLSTM) { mean = 0.f; inv = rsqrtf(t2 * (1.f / DV) + EPS); }
        else { mean = t1 * (1.f / DV); inv = rsqrtf(fmaxf(t2 * (1.f / DV) - mean * mean, 0.f) + EPS); }
#pragma unroll
        for (int nb = 0; nb < NB; ++nb) { const int col = dh * (DV / 2) + 32 * nb + r32;
            *(LAS bf16_t*)(lds + row * TP + col * 2) = f2bf((o[nb][r] - mean) * inv); }
    }
    __syncthreads();
    constexpr int CPR = DV / 8;
#pragma unroll 1
    for (int id = tid; id < 128 * CPR; id += 512) { const int row = id / CPR, ch = id % CPR;
        const u32x4 y = *(const LAS u32x4*)(lds + row * TP + ch * 16); const u32x4 g = *(const u32x4*)(a.G + (size_t)row * a.ldg + 8 * ch);
        const f32x4 g0 = *(const f32x4*)(a.gain + 8 * ch), g1 = *(const f32x4*)(a.gain + 8 * ch + 4);
        float yv[8] = {bf_lo(y.x), bf_hi(y.x), bf_lo(y.y), bf_hi(y.y), bf_lo(y.z), bf_hi(y.z), bf_lo(y.w), bf_hi(y.w)};
        float gv[8] = {bf_lo(g.x), bf_hi(g.x), bf_lo(g.y), bf_hi(g.y), bf_lo(g.z), bf_hi(g.z), bf_lo(g.w), bf_hi(g.w)};
        float gn[8] = {g0[0], g0[1], g0[2], g0[3], g1[0], g1[1], g1[2], g1[3]};
        float ov[8];
#pragma unroll
        for (int i = 0; i < 8; ++i) ov[i] = yv[i] * gn[i] * (MLSTM ? sigmoidf_(gv[i]) : siluf_(gv[i]));
        u32x4 w; w.x = cvt_pk_bf16(ov[0], ov[1]); w.y = cvt_pk_bf16(ov[2], ov[3]); w.z = cvt_pk_bf16(ov[4], ov[5]); w.w = cvt_pk_bf16(ov[6], ov[7]);
        *(u32x4*)(a.Out + (size_t)row * a.ldo + 8 * ch) = w; }
#undef rb1
#undef tb1
}
}
namespace att {
constexpr int DQK = 96, DVV = 64, NW = 8, QBLK = 32, KVBLK = 64, KROW = 128;
constexpr float SCALE = 0.10206207261596575f;
constexpr float THR = 8.f;
constexpr size_t SHM_V = KVBLK * DVV * 2, SHM_K = KVBLK * KROW * 2, SHM_ATTN = 2 * SHM_V + 2 * SHM_K + NW * 64 * 4;
#define KSWZ(row, colB) ((row) * 256 + ((colB) ^ (((row) & 7) << 4)))
__device__ __forceinline__ int crow(int r, int hi) { return (r & 3) + 8 * (r >> 2) + 4 * hi; }

__device__ __forceinline__ void partialSM(f32x16& p0, f32x16& p1, float& m_reg, float& mn, float& alpha) {
  constexpr float C = SCALE * 1.4426950408889634f;
  float pmax = p0[0]; for (int r = 1; r < 16; ++r) pmax = fmaxf(pmax, p0[r]); for (int r = 0; r < 16; ++r) pmax = fmaxf(pmax, p1[r]);
  { auto rr = __builtin_amdgcn_permlane32_swap(__float_as_uint(pmax), __float_as_uint(pmax), false, false);
    pmax = fmaxf(__uint_as_float(rr[0]), __uint_as_float(rr[1])); }
  if (__builtin_expect(__all(pmax - m_reg <= THR / SCALE), 1)) { mn = m_reg; alpha = 1.f; }
  else { mn = fmaxf(m_reg, pmax); alpha = __builtin_amdgcn_exp2f((m_reg - mn) * C); m_reg = mn; }
  float mnC = -mn * C;
  for (int r = 0; r < 16; ++r) p0[r] = fmaf(p0[r], C, mnC); for (int r = 0; r < 16; ++r) p1[r] = fmaf(p1[r], C, mnC);
  for (int r = 0; r < 16; ++r) p0[r] = __builtin_amdgcn_exp2f(p0[r]);
}
__device__ __forceinline__ void finishSM(f32x16& p0, f32x16& p1, float alpha, float& l_reg, bf16x8& pa0, bf16x8& pa1, bf16x8& pa2, bf16x8& pa3) {
  for (int r = 0; r < 16; ++r) p1[r] = __builtin_amdgcn_exp2f(p1[r]);
  float ps = 0; for (int r = 0; r < 16; ++r) ps += p0[r]; for (int r = 0; r < 16; ++r) ps += p1[r];
  { auto rr = __builtin_amdgcn_permlane32_swap(__float_as_uint(ps), __float_as_uint(ps), false, false);
    ps = __uint_as_float(rr[0]) + __uint_as_float(rr[1]); }
  l_reg = l_reg * alpha + ps;
#define PK4(P, BASE, OUT) do { unsigned a0 = cvt_pk_bf16(P[BASE + 0], P[BASE + 1]), a1 = cvt_pk_bf16(P[BASE + 2], P[BASE + 3]);   \
    unsigned b0 = cvt_pk_bf16(P[BASE + 4], P[BASE + 5]), b1 = cvt_pk_bf16(P[BASE + 6], P[BASE + 7]);                              \
    auto r0 = __builtin_amdgcn_permlane32_swap(a0, b0, false, false); auto r1 = __builtin_amdgcn_permlane32_swap(a1, b1, false, false); \
    u32x4 w = {r0[0], r1[0], r0[1], r1[1]}; OUT = __builtin_bit_cast(bf16x8, w); } while (0)
  PK4(p0, 0, pa0); PK4(p0, 8, pa1); PK4(p1, 0, pa2); PK4(p1, 8, pa3);
#undef PK4
}
__device__ __forceinline__ void qkt(f32x16& p0, f32x16& p1, const LAS char* Ks, const bf16x8* qr, int r32, int hi) {
  p0 = f32x16{}; p1 = f32x16{};
#pragma unroll
  for (int d0 = 0; d0 < DQK / 16; ++d0) { int cb = (d0 * 16 + hi * 8) * 2;
    bf16x8 b0 = *reinterpret_cast<const LAS bf16x8*>(Ks + KSWZ(r32, cb));
    bf16x8 b1 = *reinterpret_cast<const LAS bf16x8*>(Ks + KSWZ(32 + r32, cb));
    p0 = __builtin_amdgcn_mfma_f32_32x32x16_bf16(b0, qr[d0], p0, 0, 0, 0);
    p1 = __builtin_amdgcn_mfma_f32_32x32x16_bf16(b1, qr[d0], p1, 0, 0, 0); }
}
__device__ __forceinline__ int v_st(int k, int c) { const int kk = (k & ~0xC) | ((k & 4) << 1) | ((k & 8) >> 1); return ((kk >> 3) * 2 + (c >> 5)) * 512 + ((kk & 7) * 32 + (c & 31)) * 2; }
__device__ __forceinline__ int v_rd_base(int lane) { return ((lane & 3) << 3) | (((lane >> 2) & 3) << 6) | (((lane >> 4) & 1) << 5) | (((lane >> 5) & 1) << 8); }
constexpr int v_rd_off(int d0, int ks, int half) { return d0 * 512 + ks * 2048 + half * 1024; }
template <int OFF> __device__ __forceinline__ s16x4 tr_read(int vb) {
  s16x4 r; asm volatile("ds_read_b64_tr_b16 %0, %1 offset:%2" : "=&v"(r) : "v"(vb), "i"(OFF) : "memory"); return r;
}
template <int D0> __device__ __forceinline__ void pv_one(f32x16& od, int vb, bf16x8 pa0, bf16x8 pa1, bf16x8 pa2, bf16x8 pa3) {
  const s16x4 l0 = tr_read<v_rd_off(D0, 0, 0)>(vb), h0 = tr_read<v_rd_off(D0, 0, 1)>(vb), l1 = tr_read<v_rd_off(D0, 1, 0)>(vb), h1 = tr_read<v_rd_off(D0, 1, 1)>(vb);
  const s16x4 l2 = tr_read<v_rd_off(D0, 2, 0)>(vb), h2 = tr_read<v_rd_off(D0, 2, 1)>(vb), l3 = tr_read<v_rd_off(D0, 3, 0)>(vb), h3 = tr_read<v_rd_off(D0, 3, 1)>(vb);
  asm volatile("s_waitcnt lgkmcnt(0)" ::: "memory"); SBAR();
#define PK(L, H) (bf16x8){L[0], L[1], L[2], L[3], H[0], H[1], H[2], H[3]}
  od = __builtin_amdgcn_mfma_f32_32x32x16_bf16(pa0, PK(l0, h0), od, 0, 0, 0);
  od = __builtin_amdgcn_mfma_f32_32x32x16_bf16(pa1, PK(l1, h1), od, 0, 0, 0);
  od = __builtin_amdgcn_mfma_f32_32x32x16_bf16(pa2, PK(l2, h2), od, 0, 0, 0);
  od = __builtin_amdgcn_mfma_f32_32x32x16_bf16(pa3, PK(l3, h3), od, 0, 0, 0);
#undef PK
}
__device__ __forceinline__ void pv_d0(f32x16* o, int vb, bf16x8 pa0, bf16x8 pa1, bf16x8 pa2, bf16x8 pa3) {
  pv_one<0>(o[0], vb, pa0, pa1, pa2, pa3); pv_one<1>(o[1], vb, pa0, pa1, pa2, pa3);
}
__device__ __forceinline__ void attn_body(const bf16_t* __restrict__ Qb, const bf16_t* __restrict__ Kh, const bf16_t* __restrict__ Vh, bf16_t* __restrict__ Ob, int ldo, int seq, LAS char* lds, const int wv) {
  int tid = TIDX(wv); asm volatile("" : "+v"(tid));
  const int wid = tid >> 6, lane = tid & 63, r32 = lane & 31, hi = lane >> 5;
  LAS char* V_lds = lds; LAS char* K_lds = lds + 2 * SHM_V;
  LAS float* ws = (LAS float*)(lds + 2 * SHM_V + 2 * SHM_K) + wid * 64; LAS float* li_l = ws; LAS float* al_l = ws + 32;
  float m_reg = -1e30f, l_reg = 0; f32x16 o[2] = {}; bf16x8 qr[DQK / 16];
  const bf16_t* Qw = Qb + (long)(wid * QBLK + r32) * DQK + hi * 8;
#pragma unroll
  for (int d0 = 0; d0 < DQK / 16; ++d0) qr[d0] = *reinterpret_cast<const bf16x8*>(Qw + d0 * 16);
  const int sr = tid >> 4, sc = (tid & 15) * 8;
  const int vr = tid >> 3, vc = (tid & 7) * 8, vst0 = v_st(vr, vc);
  const int vb0 = (int)(uintptr_t)V_lds + v_rd_base(lane);
  struct { bf16x8 vs0, ks0, ks1; } sr_[2];
#define SLOAD(i, k0) do { sr_[i].vs0 = *reinterpret_cast<const bf16x8*>(&Vh[(long)((k0) + vr) * DVV + vc]); \
    sr_[i].ks0 = *reinterpret_cast<const bf16x8*>(&Kh[(long)((k0) + sr) * KROW + sc]); sr_[i].ks1 = *reinterpret_cast<const bf16x8*>(&Kh[(long)((k0) + 32 + sr) * KROW + sc]); } while (0)
#define SWRITE(b, i) do { *(LAS bf16x8*)(V_lds + (b) * SHM_V + vst0) = sr_[i].vs0; int kc = sc * 2;               \
    *(LAS bf16x8*)(K_lds + (b) * SHM_K + KSWZ(sr, kc)) = sr_[i].ks0;                       \
    *(LAS bf16x8*)(K_lds + (b) * SHM_K + KSWZ(32 + sr, kc)) = sr_[i].ks1; } while (0)
#define SWAIT() asm volatile("s_waitcnt vmcnt(3)" ::: "memory")
#define RESC(a) do { if (__any((a) < 1.f)) { if (hi == 0) al_l[r32] = (a); asm volatile("s_waitcnt lgkmcnt(0)" ::: "memory"); \
    for (int d = 0; d < 2; ++d) for (int r = 0; r < 16; ++r) o[d][r] *= al_l[crow(r, hi)]; } } while (0)
  f32x16 pA0, pA1, pB0, pB1; float mnA, mnB, alA, alB; bf16x8 pa0, pa1, pa2, pa3; const int NT = seq / KVBLK;
  constexpr int SE = 0, SO = 1;
  SLOAD(SE, 0); asm volatile("s_waitcnt vmcnt(0)" ::: "memory"); SWRITE(0, SE); __syncthreads();
  qkt(pA0, pA1, K_lds, qr, r32, hi); partialSM(pA0, pA1, m_reg, mnA, alA);
  SLOAD(SO, KVBLK); if (2 < NT) SLOAD(SE, 2 * KVBLK);
  SWAIT(); SWRITE(1, SO); __syncthreads();
  for (int j = 1; j + 1 < NT; j += 2) {
    SBAR(); qkt(pB0, pB1, K_lds + SHM_K, qr, r32, hi);
    finishSM(pA0, pA1, alA, l_reg, pa0, pa1, pa2, pa3); SBAR();
    SLOAD(SO, (j + 2) * KVBLK); SBAR();
    pv_d0(o, vb0, pa0, pa1, pa2, pa3); partialSM(pB0, pB1, m_reg, mnB, alB);
    __syncthreads(); SWAIT(); SWRITE(0, SE);
    RESC(alB); __syncthreads();
    SBAR(); qkt(pA0, pA1, K_lds, qr, r32, hi);
    finishSM(pB0, pB1, alB, l_reg, pa0, pa1, pa2, pa3); SBAR();
    if (j + 3 < NT) SLOAD(SE, (j + 3) * KVBLK); SBAR();
    pv_d0(o, vb0 + (int)SHM_V, pa0, pa1, pa2, pa3); partialSM(pA0, pA1, m_reg, mnA, alA);
    __syncthreads(); SWAIT(); SWRITE(1, SO);
    RESC(alA); __syncthreads();
  }
  SBAR(); qkt(pB0, pB1, K_lds + SHM_K, qr, r32, hi);
  finishSM(pA0, pA1, alA, l_reg, pa0, pa1, pa2, pa3); SBAR();
  pv_d0(o, vb0, pa0, pa1, pa2, pa3); partialSM(pB0, pB1, m_reg, mnB, alB);
  __syncthreads(); RESC(alB);
  finishSM(pB0, pB1, alB, l_reg, pa0, pa1, pa2, pa3); SBAR();
  pv_d0(o, vb0 + (int)SHM_V, pa0, pa1, pa2, pa3);
  if (hi == 0) li_l[r32] = l_reg; asm volatile("s_waitcnt lgkmcnt(0)" ::: "memory");
  float rli[16];
#pragma unroll
  for (int r = 0; r < 16; ++r) rli[r] = __builtin_amdgcn_rcpf(li_l[crow(r, hi)]);
  bf16_t* Ow = Ob + (long)(wid * QBLK) * ldo;
#pragma unroll
  for (int r = 0; r < 16; ++r) { int orow = crow(r, hi);
#pragma unroll
    for (int d0 = 0; d0 < 2; ++d0) Ow[(long)orow * ldo + d0 * 32 + r32] = f2bf(o[d0][r] * rli[r]); }
  __syncthreads();
#undef SLOAD
#undef SWRITE
#undef SWAIT
#undef RESC
}
#undef KSWZ
}
constexpr size_t MiB = 1ull << 20;
constexpr size_t WS_CTL = 0, CTL_ZERO_BYTES = 1 * MiB;
constexpr size_t WS_MOD = 1 * MiB;
constexpr size_t WS_MISC = 2 * MiB;
constexpr size_t WS_ROPEO = 8 * MiB;
constexpr size_t WS_ROPEE = 40 * MiB;
constexpr size_t WS_WINE = 48 * MiB;
constexpr size_t WS_WQB = 58 * MiB;
constexpr size_t WS_WKVB = 59 * MiB;
constexpr size_t WS_WOUTE = 60 * MiB;
constexpr size_t WS_WINO = 64 * MiB;
constexpr size_t WS_WOUTO = 88 * MiB;
constexpr size_t WS_WGU = 96 * MiB;
constexpr size_t WS_WDN = 608 * MiB;
constexpr size_t WS_HM = 864 * MiB;
constexpr size_t WS_P = 928 * MiB;
constexpr size_t WS_X1 = 1312 * MiB;
constexpr size_t X1_QC = WS_X1, X1_KC = X1_QC + 32 * MiB, X1_QA = X1_KC + 32 * MiB, X1_KVA = X1_QA + 16 * MiB, X1_QRAW = X1_KVA + 16 * MiB, X1_KVRAW = X1_QRAW + 48 * MiB,
                 X1_QH = X1_KVRAW + 64 * MiB, X1_KH = X1_QH + 48 * MiB, X1_VH = X1_KH + 64 * MiB, X1_CM = X1_VH + 32 * MiB, X1_NM = X1_CM + 64 * MiB;
constexpr size_t WS_MIX = WS_X1 + 512 * MiB;
constexpr size_t WS_LIST = WS_MIX + 128 * MiB;
constexpr size_t WS_WLIST = WS_LIST + 16 * MiB;
constexpr size_t WS_TOKE = WS_WLIST + 16 * MiB;
constexpr size_t WS_WSORT = WS_TOKE + 1 * MiB;
constexpr size_t WS_ASORT = WS_WSORT + 1 * MiB;
constexpr size_t WS_ACT = WS_ASORT + 272 * MiB;
constexpr size_t WS_Y = WS_ACT + 272 * MiB;
constexpr size_t WS_XB = WS_Y + 272 * MiB;
constexpr size_t WS_END = WS_XB + 64 * MiB;
static_assert(X1_NM + 1 * MiB <= WS_MIX, "even-layer scratch fits");
constexpr int CW_BAR = 4096;
constexpr int CW_CNT = 8192;
constexpr int CW_QUEUE = 8192 + 1024;

constexpr int LDS_RING = 0;
constexpr int LDS_TAB = 131072;
constexpr int LT_MISC = LDS_TAB;
constexpr int LT_PSTART = LDS_TAB + 256;
constexpr int LT_CNT = LDS_TAB + 512;
constexpr int LT_BLK = LDS_TAB + 1024;
constexpr int LT_X = LDS_TAB + 1024 + 4352;
constexpr int LT_N2TILE = 144640;
constexpr int LDS_BYTES = 163840;

#if defined(__HIP_DEVICE_COMPILE__) && __HIP_DEVICE_COMPILE__
#define ARGAS GAS
#else
#define ARGAS
#endif
typedef const ARGAS float* gcf_t; typedef const ARGAS int* gci_t;
struct Args {
    gcf_t x; gcf_t c; gci_t pos; gcf_t ada_w; gcf_t ada_b; gcf_t norm_mix_g; gcf_t norm_ffn_g;
    gcf_t hy_w_in; gcf_t ml_conv_w; gcf_t ml_conv_b; gcf_t ml_gate_b; gcf_t ml_norm_g; gcf_t mla_q_norm_g; gcf_t mla_kv_norm_g;
    gcf_t mla_w_qb; gcf_t mla_w_kvb; gcf_t mla_qk_q_g; gcf_t mla_qk_k_g; gcf_t hy_w_out;
    gcf_t ret_w_in; gcf_t ret_decay_f; gcf_t ret_decay_b; gcf_t ret_gn_g; gcf_t ret_w_out;
    gcf_t moe_router_w; gcf_t moe_router_b; gcf_t moe_w_gu; gcf_t moe_b_gu; gcf_t moe_w_down; gcf_t moe_b_down;
    ARGAS float* out; ARGAS unsigned char* ws; int ph_lo, ph_hi;
};

constexpr float FP8_WSC = 128.f, FP8_HSC = 16.f, FP8_ASC = 4.f;
template <class RowMap>
__device__ __forceinline__ void transpose_item(const float* W, int N, bf16_t* WT, int ldk, LAS float* scr, int kb, int nb, int lane, const RowMap& rm) {
    const int k0 = 64 * kb, n0 = 32 * nb;
#pragma unroll 16
    for (int i = 0; i < 32; ++i) { const int kk = 2 * i + (lane >> 5); scr[kk * 33 + (lane & 31)] = W[(size_t)(k0 + kk) * N + n0 + (lane & 31)]; }
    LDS_WAIT(); asm volatile("" ::: "memory");
    const int c = lane & 7;
#pragma unroll
    for (int j = 0; j < 4; ++j) { const int n = (lane >> 3) + 8 * j; const LAS float* s = scr + (8 * c) * 33 + n;
        u32x4 o; o.x = cvt_pk_bf16(s[0 * 33], s[1 * 33]); o.y = cvt_pk_bf16(s[2 * 33], s[3 * 33]); o.z = cvt_pk_bf16(s[4 * 33], s[5 * 33]); o.w = cvt_pk_bf16(s[6 * 33], s[7 * 33]);
        *(u32x4*)(WT + (size_t)rm(n0 + n) * ldk + k0 + 8 * c) = o; }
    LDS_WAIT(); asm volatile("" ::: "memory");
}
template <class RowMap>
__device__ __forceinline__ void transpose_item8(const float* W, int N, unsigned char* WT, int ldk, LAS float* scr, int kb, int nb, int lane, const RowMap& rm, float scale) {
    const int k0 = 64 * kb, n0 = 32 * nb;
#pragma unroll 16
    for (int i = 0; i < 32; ++i) { const int kk = 2 * i + (lane >> 5); scr[kk * 33 + (lane & 31)] = W[(size_t)(k0 + kk) * N + n0 + (lane & 31)] * scale; }
    LDS_WAIT(); asm volatile("" ::: "memory");
    const int c = lane & 7;
#pragma unroll
    for (int j = 0; j < 4; ++j) { const int n = (lane >> 3) + 8 * j; const LAS float* s = scr + (8 * c) * 33 + n;
        u32x2 o; o.x = pg8::pk4_fp8(s[0 * 33], s[1 * 33], s[2 * 33], s[3 * 33]); o.y = pg8::pk4_fp8(s[4 * 33], s[5 * 33], s[6 * 33], s[7 * 33]);
        *(u32x2*)(WT + (size_t)rm(n0 + n) * ldk + k0 + 8 * c) = o; }
    LDS_WAIT(); asm volatile("" ::: "memory");
}
struct RmId { __device__ __forceinline__ int operator()(int n) const { return n; } };
struct RmWinE { __device__ __forceinline__ int operator()(int n) const {
    if (n < 2048) return n; if (n < 2064) return PC_GT + (n - 2048); if (n < 2320) return PC_QA + (n - 2064); if (n < 2448) return PC_KVA + (n - 2320); return PC_KR + (n - 2448); } };
struct RmGu { __device__ __forceinline__ int operator()(int n) const { const int u = n & 1023; return 256 * (u >> 7) + (n >> 10) * 128 + (u & 127); } };

__device__ __forceinline__ void ld_row16(const float* p, int lane, f32x4 (&v)[4]) {
#pragma unroll
    for (int j = 0; j < 4; ++j) v[j] = *(const f32x4*)(p + 4 * lane + 256 * j);
}
struct Frame { LAS unsigned char* lds; int tid, lane, wave, G, bid; };
extern __shared__ __attribute__((aligned(16))) unsigned char lds_raw[];
#define MK_FRAME(F) Frame F; { int tz_ = TIDX(wv); asm volatile("" : "+v"(tz_)); \
    int g_ = gridDim.x, b_ = blockIdx.x; asm volatile("" : "+s"(g_), "+s"(b_)); \
    F.lds = (LAS unsigned char*)lds_raw; F.tid = tz_; F.lane = tz_ & 63; F.wave = __builtin_amdgcn_readfirstlane(tz_ >> 6); F.G = g_; F.bid = b_; }
typedef const __attribute__((address_space(4))) Args* CArgsP;
__device__ __forceinline__ const Args& fresh_args() { unsigned long long p = (unsigned long long)__builtin_amdgcn_kernarg_segment_ptr(); asm volatile("" : "+s"(p)); return *(const Args*)(CArgsP)p; }
__device__ __forceinline__ ARGAS unsigned char* opaque_ws(const ARGAS unsigned char* p) { unsigned long long v = (unsigned long long)p; asm volatile("" : "+s"(v)); return (ARGAS unsigned char*)v; }

__device__ __forceinline__ void p0_prologue(const Args& a, const int wv) {
    MK_FRAME(F); ARGAS unsigned char* ws = opaque_ws(a.ws);
    {
        LAS float* cs = (LAS float*)(F.lds); LAS float* red = (LAS float*)(F.lds + 32768);
        for (int i = F.tid; i < NBATCH * DM; i += 512) cs[i] = siluf_(a.c[i]);
        __syncthreads();
        float* mod = (float*)(ws + WS_MOD);
        for (int it = F.bid; it < DEPTH * 48; it += F.G) {
            const int l = it / 48, n = (it % 48) * 128 + (F.tid & 127), ksl = F.tid >> 7;
            const float* w = a.ada_w + ((size_t)l * DM + ksl * 256) * 6144 + n;
            float acc[NBATCH];
#pragma unroll
            for (int b = 0; b < NBATCH; ++b) acc[b] = 0.f;
#pragma unroll 4
            for (int k = 0; k < 256; ++k) { const float wv = w[(size_t)k * 6144];
#pragma unroll
                for (int b = 0; b < NBATCH; ++b) acc[b] += cs[b * DM + ksl * 256 + k] * wv; }
#pragma unroll
            for (int b = 0; b < NBATCH; ++b) red[(ksl * NBATCH + b) * 128 + (F.tid & 127)] = acc[b];
            __syncthreads();
            for (int o = F.tid; o < NBATCH * 128; o += 512) { const int b = o >> 7, nn = o & 127;
                const float s = red[(0 * NBATCH + b) * 128 + nn] + red[(1 * NBATCH + b) * 128 + nn] + red[(2 * NBATCH + b) * 128 + nn] + red[(3 * NBATCH + b) * 128 + nn];
                const int col = (it % 48) * 128 + nn;
                mod[((size_t)l * NBATCH + b) * 6144 + col] = s + a.ada_b[(size_t)l * 6144 + col]; }
            __syncthreads();
        }
        __syncthreads();
    }
    {
        f32x2* ro = (f32x2*)(ws + WS_ROPEO); f32x2* re = (f32x2*)(ws + WS_ROPEE);
        const size_t gt = (size_t)F.bid * 512 + F.tid, GT = (size_t)F.G * 512;
        for (size_t i = gt; i < (size_t)NTOK * 128; i += GT) { const int tok = (int)(i >> 7), f = (int)(i & 127);
            const float inv = powf(10000.f, -(float)(2 * f) / 256.f); const float ang = (float)a.pos[tok] * inv; float s, c; sincosf(ang, &s, &c); ro[i] = (f32x2){c, s}; }
        for (size_t i = gt; i < (size_t)NTOK * 16; i += GT) { const int tok = (int)(i >> 4), f = (int)(i & 15);
            const float inv = powf(10000.f, -(float)(2 * f) / 32.f); const float ang = (float)a.pos[tok] * inv; float s, c; sincosf(ang, &s, &c); re[i] = (f32x2){c, s}; }
        bf16_t* wkv = (bf16_t*)(ws + WS_WKVB);
        for (size_t i = gt; i < (size_t)2 * 1024 * 16; i += GT) { const size_t row = i >> 4, ch = i & 15; *(u32x4*)(wkv + row * 256 + 128 + ch * 8) = (u32x4){0u, 0u, 0u, 0u}; }
    }
    {
        LAS float* scr = (LAS float*)(F.lds + F.wave * 16384);
        const int gw = F.bid * 8 + F.wave, NGW = F.G * 8;
        constexpr int I_WINE = 16 * 78, I_WQB = 4 * 24, I_WKVB = 2 * 32, I_WOUTE = 16 * 32, I_WINO = 16 * 192, I_WOUTO = 32 * 32, I_WGU = 16 * 64, I_WDN = 16 * 32;
        constexpr int T0 = 2 * I_WINE, T1 = T0 + 2 * I_WQB, T2 = T1 + 2 * I_WKVB, T3 = T2 + 2 * I_WOUTE, T4 = T3 + 2 * I_WINO, T5 = T4 + 2 * I_WOUTO, T6 = T5 + 128 * I_WGU, T7 = T6 + 128 * I_WDN;
        for (int it = gw; it < T7; it += NGW) {
            if (it < T0) { const int m = it / I_WINE, r = it % I_WINE, kb = r / 78, nb = r % 78;
                const float* W = a.hy_w_in + (size_t)m * DM * EVEN_IN; bf16_t* WT = (bf16_t*)(ws + WS_WINE) + (size_t)m * EVEN_INP * DM;
                const int k0 = 64 * kb, n0 = 32 * nb; const RmWinE rm;
#pragma unroll 8
                for (int i = 0; i < 32; ++i) { const int kk = 2 * i + (F.lane >> 5), n = n0 + (F.lane & 31); scr[kk * 33 + (F.lane & 31)] = (n < EVEN_IN) ? W[(size_t)(k0 + kk) * EVEN_IN + n] : 0.f; }
                LDS_WAIT(); asm volatile("" ::: "memory");
                const int c = F.lane & 7;
#pragma unroll
                for (int j = 0; j < 4; ++j) { const int n = (F.lane >> 3) + 8 * j; const LAS float* s = scr + (8 * c) * 33 + n;
                    u32x4 o; o.x = cvt_pk_bf16(s[0 * 33], s[1 * 33]); o.y = cvt_pk_bf16(s[2 * 33], s[3 * 33]); o.z = cvt_pk_bf16(s[4 * 33], s[5 * 33]); o.w = cvt_pk_bf16(s[6 * 33], s[7 * 33]);
                    if (n0 + n < EVEN_IN) *(u32x4*)(WT + (size_t)rm(n0 + n) * DM + k0 + 8 * c) = o; }
                LDS_WAIT(); asm volatile("" ::: "memory");
                continue; }
            if (it < T1) { const int q = it - T0, m = q / I_WQB, r = q % I_WQB; transpose_item(a.mla_w_qb + (size_t)m * 256 * 768, 768, (bf16_t*)(ws + WS_WQB) + (size_t)m * 768 * 256, 256, scr, r / 24, r % 24, F.lane, RmId()); continue; }
            if (it < T2) { const int q = it - T1, m = q / I_WKVB, r = q % I_WKVB; transpose_item(a.mla_w_kvb + (size_t)m * 128 * 1024, 1024, (bf16_t*)(ws + WS_WKVB) + (size_t)m * 1024 * 256, 256, scr, r / 32, r % 32, F.lane, RmId()); continue; }
            if (it < T3) { const int q = it - T2, m = q / I_WOUTE, r = q % I_WOUTE; transpose_item(a.hy_w_out + (size_t)m * DM * DM, DM, (bf16_t*)(ws + WS_WOUTE) + (size_t)m * DM * DM, DM, scr, r / 32, r % 32, F.lane, RmId()); continue; }
            if (it < T4) { const int q = it - T3, m = q / I_WINO, r = q % I_WINO; transpose_item(a.ret_w_in + (size_t)m * DM * RET_IN, RET_IN, (bf16_t*)(ws + WS_WINO) + (size_t)m * RET_IN * DM, DM, scr, r / 192, r % 192, F.lane, RmId()); continue; }
            if (it < T5) { const int q = it - T4, m = q / I_WOUTO, r = q % I_WOUTO; transpose_item(a.ret_w_out + (size_t)m * 2048 * DM, DM, (bf16_t*)(ws + WS_WOUTO) + (size_t)m * DM * 2048, 2048, scr, r / 32, r % 32, F.lane, RmId()); continue; }
            if (it < T6) { const int q = it - T5, m = q / I_WGU, r = q % I_WGU; transpose_item8(a.moe_w_gu + (size_t)m * DM * 2048, 2048, (unsigned char*)(ws + WS_WGU) + (size_t)m * 2048 * DM, DM, scr, r / 64, r % 64, F.lane, RmGu(), FP8_WSC); continue; }
            { const int q = it - T6, m = q / I_WDN, r = q % I_WDN; transpose_item8(a.moe_w_down + (size_t)m * EFF * DM, DM, (unsigned char*)(ws + WS_WDN) + (size_t)m * DM * EFF, EFF, scr, r / 32, r % 32, F.lane, RmId(), FP8_WSC); }
        }
    }
}

__device__ __forceinline__ void build_pstart(const Frame& F, const unsigned* cnt) {
    LAS int* ps = (LAS int*)(F.lds + LT_PSTART); LAS int* lc = (LAS int*)(F.lds + LT_CNT); LAS int* blk = (LAS int*)(F.lds + LT_BLK);
    __syncthreads();
    if (F.tid < 64) {
        const int e = F.tid & 31; const int c = (int)xb_ld((gbar_t)cnt + e); const int pad = (c + 255) & ~255;
        int incl = pad;
#pragma unroll
        for (int o = 1; o < 32; o <<= 1) { const int t = sh_fromi(incl, (e >= o) ? F.tid - o : F.tid); if (e >= o) incl += t; }
        if (F.tid < 32) { ps[e] = incl - pad; lc[e] = c; if (e == 31) ps[32] = incl; }
    }
    __syncthreads();
    const int nblk = ps[32] >> 8;
    for (int g = F.tid; g < nblk; g += 512) { int e = 0;
#pragma unroll
        for (int s = 16; s >= 1; s >>= 1) if (e + s < 32 && (ps[e + s] >> 8) <= g) e += s;
        blk[2 * g] = e; blk[2 * g + 1] = g - (ps[e] >> 8); }
    __syncthreads();
}

__device__ __forceinline__ void n1_phase(const Args& a, int layer, bool final_only, const int wv, const bool dry = false) {
    MK_FRAME(F); ARGAS unsigned char* ws = opaque_ws(a.ws);
    const float* mod = (const float*)(ws + WS_MOD);
    const bool combine = layer > 0;
    bf16_t* XB = (bf16_t*)(ws + WS_XB);
    const int* toke = (const int*)(ws + WS_TOKE); const int* tokr = toke + NTOK * 4;
    const bf16_t* Y = (const bf16_t*)(ws + WS_Y);
    bf16_t* HM = (bf16_t*)(ws + WS_HM);
    LAS int* ps = (LAS int*)(F.lds + LT_PSTART);
    if (combine) build_pstart(F, (const unsigned*)(ws + WS_CTL) + CW_CNT + 64 * (layer - 1));
    const float* gmix = a.norm_mix_g + (size_t)(final_only ? 0 : layer) * DM;
    for (int tok = F.bid * 8 + F.wave; tok < NTOK; tok += F.G * 8) {
        const int b = tok >> 12;
        f32x4 v[4];
        if (layer == 0) ld_row16(a.x + (size_t)tok * DM, F.lane, v);
        else {
#pragma unroll
            for (int j = 0; j < 4; ++j) { const u32x2 w = *(const u32x2*)(XB + (size_t)tok * DM + 4 * F.lane + 256 * j); v[j] = (f32x4){bf_lo(w.x), bf_hi(w.x), bf_lo(w.y), bf_hi(w.y)}; } }
        if (combine) {
            const float* g2 = mod + ((size_t)(layer - 1) * NBATCH + b) * 6144 + 5 * DM;
            f32x4 ysum[4];
#pragma unroll
            for (int j = 0; j < 4; ++j) ysum[j] = (f32x4){0.f, 0.f, 0.f, 0.f};
#pragma unroll
            for (int k = 0; k < 4; ++k) { const int e = toke[tok * 4 + k], r = tokr[tok * 4 + k]; const size_t slot = (size_t)ps[e] + r;
                const bf16_t* yr = Y + slot * DM + 4 * F.lane;
#pragma unroll
                for (int j = 0; j < 4; ++j) { const u32x2 w = *(const u32x2*)(yr + 256 * j); ysum[j][0] += bf_lo(w.x); ysum[j][1] += bf_hi(w.x); ysum[j][2] += bf_lo(w.y); ysum[j][3] += bf_hi(w.y); } }
#pragma unroll
            for (int j = 0; j < 4; ++j) { const f32x4 g = *(const f32x4*)(g2 + 4 * F.lane + 256 * j); v[j] = v[j] + g * ysum[j];
                if (final_only) *(f32x4*)(a.out + (size_t)tok * DM + 4 * F.lane + 256 * j) = v[j];
                else { u32x2 o; o.x = cvt_pk_bf16(v[j][0], v[j][1]); o.y = cvt_pk_bf16(v[j][2], v[j][3]); *(u32x2*)((dry ? (bf16_t*)(ws + WS_ACT) : XB) + (size_t)tok * DM + 4 * F.lane + 256 * j) = o; } }
        }
        if (final_only) continue;
        float ss = 0.f;
#pragma unroll
        for (int j = 0; j < 4; ++j) ss += v[j][0] * v[j][0] + v[j][1] * v[j][1] + v[j][2] * v[j][2] + v[j][3] * v[j][3];
        const float inv = rsqrtf(wave_sum(ss, F.lane) * (1.f / DM) + EPS);
        const float* sh = mod + ((size_t)layer * NBATCH + b) * 6144; const float* sc = sh + DM;
#pragma unroll
        for (int j = 0; j < 4; ++j) { const int c0 = 4 * F.lane + 256 * j; const f32x4 g = *(const f32x4*)(gmix + c0), s1 = *(const f32x4*)(sc + c0), s0 = *(const f32x4*)(sh + c0);
            const f32x4 h = v[j] * inv * g * (s1 + 1.f) + s0;
            u32x2 o; o.x = cvt_pk_bf16(h[0], h[1]); o.y = cvt_pk_bf16(h[2], h[3]); *(u32x2*)(HM + (size_t)tok * DM + c0) = o; }
    }
}

__device__ __forceinline__ void e2_phase(const Args& a, int j, const int wv) {
    MK_FRAME(F); ARGAS unsigned char* ws = opaque_ws(a.ws);
    const bf16_t* P = (const bf16_t*)(ws + WS_P);
    bf16_t* QC = (bf16_t*)(ws + X1_QC); bf16_t* KC = (bf16_t*)(ws + X1_KC); bf16_t* QA = (bf16_t*)(ws + X1_QA); bf16_t* KVA = (bf16_t*)(ws + X1_KVA);
    const float* cw = a.ml_conv_w + (size_t)j * 5 * 1024; const float* cb = a.ml_conv_b + (size_t)j * 1024;
    const float* qg = a.mla_q_norm_g + (size_t)j * 256; const float* kvg = a.mla_kv_norm_g + (size_t)j * 128;
    {
        float* ALPHA = (float*)(ws + WS_MISC); float* BETA = ALPHA + 2 * 32 * SEQ; float* MG = BETA + 2 * 32 * SEQ;
        LAS float* redm = (LAS float*)(F.lds);
        for (int u = F.bid; u < 64; u += F.G) {
            const int dir = u >> 5, bh = u & 31, b = bh >> 2, h = bh & 3;
            const float bi = a.ml_gate_b[j * 16 + (2 * dir) * 4 + h], bfg = a.ml_gate_b[j * 16 + (2 * dir + 1) * 4 + h];
            float li[8], lf[8];
#pragma unroll
            for (int i = 0; i < 8; ++i) { const size_t row = (size_t)b * SEQ + 8 * F.tid + i;
                li[i] = bf2f(P[row * EVEN_INP + PC_GT + (2 * dir) * 4 + h]) + bi;
                const float xf = bf2f(P[row * EVEN_INP + PC_GT + (2 * dir + 1) * 4 + h]) + bfg;
                lf[i] = fminf(xf, 0.f) - log1pf(__expf(-fabsf(xf))); }
            float mx = li[0];
#pragma unroll
            for (int i = 1; i < 8; ++i) mx = fmaxf(mx, li[i]);
            mx = wave_max(mx, F.lane); if (F.lane == 0) redm[F.wave] = mx;
            __syncthreads();
            float M = redm[0];
#pragma unroll
            for (int w = 1; w < 8; ++w) M = fmaxf(M, redm[w]);
            float al[8];
            if (dir == 0) { float s = 0.f;
#pragma unroll
                for (int i = 0; i < 8; ++i) { s += lf[i]; al[i] = s; }
                float tot = s, ex = 0.f;
#pragma unroll
                for (int o = 1; o < 16; o <<= 1) { const float t = sh_from(tot, ((F.lane & 15) >= o) ? F.lane - o : F.lane, F.lane); if ((F.lane & 15) >= o) tot += t; }
                ex = tot - s;
#pragma unroll
                for (int i = 0; i < 8; ++i) al[i] += ex;
            } else { float s = 0.f;
#pragma unroll
                for (int i = 7; i >= 0; --i) { s += lf[i]; al[i] = s; }
                float tot = s, ex = 0.f;
#pragma unroll
                for (int o = 1; o < 16; o <<= 1) { const float t = sh_from(tot, ((F.lane & 15) + o < 16) ? F.lane + o : F.lane, F.lane); if ((F.lane & 15) + o < 16) tot += t; }
                ex = tot - s;
#pragma unroll
                for (int i = 0; i < 8; ++i) al[i] += ex;
            }
            float* ao = ALPHA + ((size_t)dir * 32 + bh) * SEQ + 8 * F.tid; float* bo = BETA + ((size_t)dir * 32 + bh) * SEQ + 8 * F.tid;
            *(f32x4*)(ao) = (f32x4){al[0], al[1], al[2], al[3]}; *(f32x4*)(ao + 4) = (f32x4){al[4], al[5], al[6], al[7]};
            *(f32x4*)(bo) = (f32x4){li[0] - M, li[1] - M, li[2] - M, li[3] - M}; *(f32x4*)(bo + 4) = (f32x4){li[4] - M, li[5] - M, li[6] - M, li[7] - M};
            if (F.tid == 0) MG[dir * 32 + bh] = M;
            __syncthreads();
        }
    }
    for (int tok = F.bid * 8 + F.wave; tok < NTOK; tok += F.G * 8) {
        const int s = tok & (SEQ - 1);
        float aq[8], ak[8];
        { const f32x4 b0 = *(const f32x4*)(cb + 8 * F.lane), b1 = *(const f32x4*)(cb + 8 * F.lane + 4), b2 = *(const f32x4*)(cb + 512 + 8 * F.lane), b3 = *(const f32x4*)(cb + 512 + 8 * F.lane + 4);
#pragma unroll
          for (int i = 0; i < 4; ++i) { aq[i] = b0[i]; aq[4 + i] = b1[i]; ak[i] = b2[i]; ak[4 + i] = b3[i]; } }
#pragma unroll
        for (int t = 0; t < 5; ++t) { const int s2 = s + t - 2;
            if (s2 >= 0 && s2 < SEQ) { const bf16_t* pr = P + (size_t)(tok + t - 2) * EVEN_INP;
                const u32x4 q = *(const u32x4*)(pr + PC_QM + 8 * F.lane), k = *(const u32x4*)(pr + PC_KM + 8 * F.lane);
                const float* wq = cw + t * 1024 + 8 * F.lane; const float* wk = wq + 512;
                const f32x4 wq0 = *(const f32x4*)wq, wq1 = *(const f32x4*)(wq + 4), wk0 = *(const f32x4*)wk, wk1 = *(const f32x4*)(wk + 4);
                aq[0] += bf_lo(q.x) * wq0[0]; aq[1] += bf_hi(q.x) * wq0[1]; aq[2] += bf_lo(q.y) * wq0[2]; aq[3] += bf_hi(q.y) * wq0[3];
                aq[4] += bf_lo(q.z) * wq1[0]; aq[5] += bf_hi(q.z) * wq1[1]; aq[6] += bf_lo(q.w) * wq1[2]; aq[7] += bf_hi(q.w) * wq1[3];
                ak[0] += bf_lo(k.x) * wk0[0]; ak[1] += bf_hi(k.x) * wk0[1]; ak[2] += bf_lo(k.y) * wk0[2]; ak[3] += bf_hi(k.y) * wk0[3];
                ak[4] += bf_lo(k.z) * wk1[0]; ak[5] += bf_hi(k.z) * wk1[1]; ak[6] += bf_lo(k.w) * wk1[2]; ak[7] += bf_hi(k.w) * wk1[3]; } }
        constexpr float KS = 0.08838834764831845f;
#pragma unroll
        for (int i = 0; i < 8; ++i) { aq[i] = siluf_(aq[i]); ak[i] = siluf_(ak[i]) * KS; }
        u32x4 oq, ok; oq.x = cvt_pk_bf16(aq[0], aq[1]); oq.y = cvt_pk_bf16(aq[2], aq[3]); oq.z = cvt_pk_bf16(aq[4], aq[5]); oq.w = cvt_pk_bf16(aq[6], aq[7]);
        ok.x = cvt_pk_bf16(ak[0], ak[1]); ok.y = cvt_pk_bf16(ak[2], ak[3]); ok.z = cvt_pk_bf16(ak[4], ak[5]); ok.w = cvt_pk_bf16(ak[6], ak[7]);
        *(u32x4*)(QC + (size_t)tok * 512 + 8 * F.lane) = oq; *(u32x4*)(KC + (size_t)tok * 512 + 8 * F.lane) = ok;
        const bf16_t* pr = P + (size_t)tok * EVEN_INP;
        { const u32x2 w = *(const u32x2*)(pr + PC_QA + 4 * F.lane); const float x0 = bf_lo(w.x), x1 = bf_hi(w.x), x2 = bf_lo(w.y), x3 = bf_hi(w.y);
          const float inv = rsqrtf(wave_sum(x0 * x0 + x1 * x1 + x2 * x2 + x3 * x3, F.lane) * (1.f / 256.f) + EPS); const f32x4 g = *(const f32x4*)(qg + 4 * F.lane);
          u32x2 o; o.x = cvt_pk_bf16(x0 * inv * g[0], x1 * inv * g[1]); o.y = cvt_pk_bf16(x2 * inv * g[2], x3 * inv * g[3]); *(u32x2*)(QA + (size_t)tok * 256 + 4 * F.lane) = o; }
        { const unsigned w = *(const unsigned*)(pr + PC_KVA + 2 * F.lane); const float x0 = bf_lo(w), x1 = bf_hi(w);
          const float inv = rsqrtf(wave_sum(x0 * x0 + x1 * x1, F.lane) * (1.f / 128.f) + EPS); const f32x2 g = *(const f32x2*)(kvg + 2 * F.lane);
          *(unsigned*)(KVA + (size_t)tok * 256 + 2 * F.lane) = cvt_pk_bf16(x0 * inv * g[0], x1 * inv * g[1]); *(unsigned*)(KVA + (size_t)tok * 256 + 128 + 2 * F.lane) = 0u; }
    }
}

__device__ __forceinline__ void e4_phase(const Args& a, int j, const int wv) {
    MK_FRAME(F); ARGAS unsigned char* ws = opaque_ws(a.ws);
    const bf16_t* P = (const bf16_t*)(ws + WS_P); const bf16_t* QRAW = (const bf16_t*)(ws + X1_QRAW); const bf16_t* KVRAW = (const bf16_t*)(ws + X1_KVRAW);
    bf16_t* QH = (bf16_t*)(ws + X1_QH); bf16_t* KH = (bf16_t*)(ws + X1_KH); bf16_t* VH = (bf16_t*)(ws + X1_VH);
    const f32x2* re = (const f32x2*)(ws + WS_ROPEE);
    const float* gq = a.mla_qk_q_g + (size_t)j * 96; const float* gk = a.mla_qk_k_g + (size_t)j * 96;
    const int h = F.lane >> 3, part = F.lane & 7;
    for (int tok = F.bid * 8 + F.wave; tok < NTOK; tok += F.G * 8) {
        const int b = tok >> 12, s = tok & (SEQ - 1);
        const f32x4 cs = *(const f32x4*)(re + (size_t)tok * 16 + 2 * part);
        const size_t hrow = ((size_t)(b * 8 + h)) * SEQ + s;
#pragma unroll
        for (int qk = 0; qk < 2; ++qk) {
            float v[12]; u32x4 w; unsigned w1, w2;
            if (qk == 0) { const bf16_t* src = QRAW + (size_t)tok * 768 + h * 96; w = *(const u32x4*)(src + 8 * part); w1 = *(const unsigned*)(src + 64 + 2 * part); w2 = *(const unsigned*)(src + 80 + 2 * part); }
            else { w = *(const u32x4*)(KVRAW + (size_t)tok * 1024 + h * 128 + 8 * part); const bf16_t* kr = P + (size_t)tok * EVEN_INP + PC_KR; w1 = *(const unsigned*)(kr + 2 * part); w2 = *(const unsigned*)(kr + 16 + 2 * part); }
            v[0] = bf_lo(w.x); v[1] = bf_hi(w.x); v[2] = bf_lo(w.y); v[3] = bf_hi(w.y); v[4] = bf_lo(w.z); v[5] = bf_hi(w.z); v[6] = bf_lo(w.w); v[7] = bf_hi(w.w);
            v[8] = bf_lo(w1); v[9] = bf_hi(w1); v[10] = bf_lo(w2); v[11] = bf_hi(w2);
            float ss = 0.f;
#pragma unroll
            for (int i = 0; i < 12; ++i) ss += v[i] * v[i];
            ss += shx(ss, 1, F.lane); ss += shx(ss, 2, F.lane); ss += shx(ss, 4, F.lane);
            const float inv = rsqrtf(ss * (1.f / 96.f) + EPS);
            const float* g = qk == 0 ? gq : gk;
            const f32x4 g0 = *(const f32x4*)(g + 8 * part), g1 = *(const f32x4*)(g + 8 * part + 4); const f32x2 ga = *(const f32x2*)(g + 64 + 2 * part), gb = *(const f32x2*)(g + 80 + 2 * part);
            v[0] *= inv * g0[0]; v[1] *= inv * g0[1]; v[2] *= inv * g0[2]; v[3] *= inv * g0[3]; v[4] *= inv * g1[0]; v[5] *= inv * g1[1]; v[6] *= inv * g1[2]; v[7] *= inv * g1[3];
            const float x10 = v[8] * inv * ga[0], x11 = v[9] * inv * ga[1], x20 = v[10] * inv * gb[0], x21 = v[11] * inv * gb[1];
            const float o10 = x10 * cs[0] - x20 * cs[1], o20 = x20 * cs[0] + x10 * cs[1], o11 = x11 * cs[2] - x21 * cs[3], o21 = x21 * cs[2] + x11 * cs[3];
            u32x4 o; o.x = cvt_pk_bf16(v[0], v[1]); o.y = cvt_pk_bf16(v[2], v[3]); o.z = cvt_pk_bf16(v[4], v[5]); o.w = cvt_pk_bf16(v[6], v[7]);
            bf16_t* dst = qk == 0 ? QH + hrow * 96 : KH + hrow * 128;
            *(u32x4*)(dst + 8 * part) = o; *(unsigned*)(dst + 64 + 2 * part) = cvt_pk_bf16(o10, o11); *(unsigned*)(dst + 80 + 2 * part) = cvt_pk_bf16(o20, o21);
            if (qk == 1) { *(u32x2*)(dst + 96 + 4 * part) = (u32x2){0u, 0u}; }
        }
        *(u32x4*)(VH + hrow * 64 + 8 * part) = *(const u32x4*)(KVRAW + (size_t)tok * 1024 + h * 128 + 64 + 8 * part);
    }
}
__device__ __forceinline__ void n2_phase(const Args& a, int layer, const int wv, const bool dry = false) {
    MK_FRAME(F); ARGAS unsigned char* ws = opaque_ws(a.ws);
    const float* mod = (const float*)(ws + WS_MOD);
    unsigned char* HF8 = (unsigned char*)(ws + WS_HM);
    int* LIST = (int*)(ws + WS_LIST); float* WLIST = (float*)(ws + WS_WLIST); int* toke = (int*)(ws + WS_TOKE); int* tokr = toke + NTOK * 4;
    unsigned* gcnt = (unsigned*)(ws + WS_CTL) + CW_CNT + 64 * layer;
    LAS float* rwl = (LAS float*)(F.lds);
    LAS int* te = (LAS int*)(F.lds + LT_X); LAS int* tlr = te + 512; LAS float* tw = (LAS float*)(tlr + 512); LAS int* hist = (LAS int*)(tw + 512); LAS int* base = hist + 32;
    const float* rw = a.moe_router_w + (size_t)layer * DM * NEXP; const float* rbias = a.moe_router_b + (size_t)layer * NEXP;
    const float* gffn = a.norm_ffn_g + (size_t)layer * DM;
    __syncthreads();
    for (int i4 = F.tid; i4 < DM * NEXP / 4; i4 += 512) *(LAS f32x4*)(rwl + 4 * i4) = *(const f32x4*)(rw + 4 * i4);
    if (F.tid < 32) hist[F.tid] = 0;
    __syncthreads();
    const int tk = F.lane & 15, kg = F.lane >> 4;
    const int lt = F.lane >> 2, lj = F.lane & 3;
    const float bias0 = rbias[tk], bias1 = rbias[tk + 16];
    LAS float* tile = (LAS float*)(F.lds + LT_N2TILE) + F.wave * (16 * 33);
#pragma unroll 1
    for (int grp = F.bid; grp < NTOK / 128; grp += F.G) {
        const int tok0 = grp * 128 + F.wave * 16, b = tok0 >> 12;
        const float* sh = mod + ((size_t)layer * NBATCH + b) * 6144 + 3 * DM + 8 * lj; const float* sc = sh + DM; const float* gg = gffn + 8 * lj;
        const bf16_t* xrow = (const bf16_t*)(ws + WS_XB) + (size_t)(tok0 + lt) * DM + 8 * lj;
        float ss = 0.f;
#pragma unroll 8
        for (int c = 0; c < 32; ++c) { const u32x4 xw = *(const u32x4*)(xrow + 32 * c); const f32x4 v0 = {bf_lo(xw.x), bf_hi(xw.x), bf_lo(xw.y), bf_hi(xw.y)}, v1 = {bf_lo(xw.z), bf_hi(xw.z), bf_lo(xw.w), bf_hi(xw.w)};
            ss += v0[0] * v0[0] + v0[1] * v0[1] + v0[2] * v0[2] + v0[3] * v0[3] + v1[0] * v1[0] + v1[1] * v1[1] + v1[2] * v1[2] + v1[3] * v1[3]; }
        ss += shx(ss, 1, F.lane); ss += shx(ss, 2, F.lane);
        const float inv = rsqrtf(ss * (1.f / DM) + EPS);
        f32x4 acc0 = {0.f, 0.f, 0.f, 0.f}, acc1 = {0.f, 0.f, 0.f, 0.f};
        unsigned char* hrow = HF8 + (size_t)(tok0 + lt) * DM + 8 * lj;
#pragma unroll 1
        for (int c = 0; c < 32; ++c) {
            const u32x4 xw = *(const u32x4*)(xrow + 32 * c); const f32x4 v0 = {bf_lo(xw.x), bf_hi(xw.x), bf_lo(xw.y), bf_hi(xw.y)}, v1 = {bf_lo(xw.z), bf_hi(xw.z), bf_lo(xw.w), bf_hi(xw.w)};
            const f32x4 g0 = *(const f32x4*)(gg + 32 * c), g1 = *(const f32x4*)(gg + 32 * c + 4), p0 = *(const f32x4*)(sc + 32 * c), p1 = *(const f32x4*)(sc + 32 * c + 4), q0 = *(const f32x4*)(sh + 32 * c), q1 = *(const f32x4*)(sh + 32 * c + 4);
            const f32x4 h0 = v0 * inv * g0 * (p0 + 1.f) + q0, h1 = v1 * inv * g1 * (p1 + 1.f) + q1;
            u32x2 o8; o8.x = pg8::pk4_fp8(h0[0] * FP8_HSC, h0[1] * FP8_HSC, h0[2] * FP8_HSC, h0[3] * FP8_HSC); o8.y = pg8::pk4_fp8(h1[0] * FP8_HSC, h1[1] * FP8_HSC, h1[2] * FP8_HSC, h1[3] * FP8_HSC);
            *(u32x2*)(hrow + 32 * c) = o8;
            LAS float* tw_ = tile + lt * 33 + 8 * lj;
            tw_[0] = h0[0]; tw_[1] = h0[1]; tw_[2] = h0[2]; tw_[3] = h0[3]; tw_[4] = h1[0]; tw_[5] = h1[1]; tw_[6] = h1[2]; tw_[7] = h1[3];
            LDS_WAIT();
            const LAS float* wl = rwl + (32 * c + kg) * 32 + tk;
#pragma unroll
            for (int s = 0; s < 8; ++s) { const float av = tile[tk * 33 + 4 * s + kg], w0 = wl[(4 * s) * 32], w1 = wl[(4 * s) * 32 + 16];
                acc0 = __builtin_amdgcn_mfma_f32_16x16x4f32(av, w0, acc0, 0, 0, 0); acc1 = __builtin_amdgcn_mfma_f32_16x16x4f32(av, w1, acc1, 0, 0, 0); }
            LDS_WAIT();
        }
#pragma unroll
        for (int r = 0; r < 4; ++r) {
            float c0 = acc0[r] + bias0, c1 = acc1[r] + bias1;
            float tv[4]; int tix[4];
#pragma unroll
            for (int k = 0; k < 4; ++k) {
                float v = (c1 > c0) ? c1 : c0; int ix = (c1 > c0) ? tk + 16 : tk;
#pragma unroll
                for (int m = 1; m < 16; m <<= 1) { const float ov = shx(v, m, F.lane); const int oi = shxi(ix, m, F.lane); if (ov > v || (ov == v && oi < ix)) { v = ov; ix = oi; } }
                tv[k] = v; tix[k] = ix; if (ix == tk) c0 = -3.0e38f; if (ix == tk + 16) c1 = -3.0e38f; }
            const float e1 = __expf(tv[1] - tv[0]), e2 = __expf(tv[2] - tv[0]), e3 = __expf(tv[3] - tv[0]); const float rs = 1.f / (1.f + e1 + e2 + e3);
            if (tk < 4) { const int ex = tk == 0 ? tix[0] : tk == 1 ? tix[1] : tk == 2 ? tix[2] : tix[3];
                const float wk = (tk == 0 ? 1.f : tk == 1 ? e1 : tk == 2 ? e2 : e3) * rs;
                const int lr = __hip_atomic_fetch_add(hist + ex, 1, __ATOMIC_RELAXED, __HIP_MEMORY_SCOPE_WORKGROUP);
                const int pidx = (F.wave * 16 + 4 * kg + r) * 4 + tk; te[pidx] = ex; tlr[pidx] = lr; tw[pidx] = wk; }
        }
        __syncthreads();
        if (F.tid < 32) { const int h = hist[F.tid]; base[F.tid] = (h > 0 && !dry) ? (int)xb_add((gbar_t)gcnt + F.tid, (unsigned)h) : 0; }
        __syncthreads();
        if (!dry) { const int p = F.tid; const int e = te[p], rank = base[e] + tlr[p]; const int tok = grp * 128 + (p >> 2);
          LIST[(size_t)e * NSLOT + rank] = tok; WLIST[(size_t)e * NSLOT + rank] = tw[p]; toke[tok * 4 + (p & 3)] = e; tokr[tok * 4 + (p & 3)] = rank; }
        __syncthreads();
        if (F.tid < 32) hist[F.tid] = 0;
        __syncthreads();
    }
}

__device__ __forceinline__ void m1_phase(const Args& a, int layer, const int wv) {
    MK_FRAME(F); ARGAS unsigned char* ws = opaque_ws(a.ws);
    build_pstart(F, (const unsigned*)(ws + WS_CTL) + CW_CNT + 64 * layer);
    LAS int* ps = (LAS int*)(F.lds + LT_PSTART); LAS int* lc = (LAS int*)(F.lds + LT_CNT); LAS int* blk = (LAS int*)(F.lds + LT_BLK);
    const unsigned char* HF8 = (const unsigned char*)(ws + WS_HM); unsigned char* AS = (unsigned char*)(ws + WS_ASORT); float* WS_ = (float*)(ws + WS_WSORT);
    const int* LIST = (const int*)(ws + WS_LIST); const float* WLIST = (const float*)(ws + WS_WLIST);
    const int total = ps[32];
    for (int r = F.bid * 8 + F.wave; r < total; r += F.G * 8) {
        const int g = r >> 8, e = blk[2 * g], rank = blk[2 * g + 1] * 256 + (r & 255); const bool valid = rank < lc[e];
        u32x4 v0 = (u32x4){0u, 0u, 0u, 0u}; float w = 0.f;
        if (valid) { const int tok = LIST[(size_t)e * NSLOT + rank]; w = WLIST[(size_t)e * NSLOT + rank];
            v0 = *(const u32x4*)(HF8 + (size_t)tok * DM + 16 * F.lane); }
        *(u32x4*)(AS + (size_t)r * DM + 16 * F.lane) = v0;
        if (F.lane == 0) WS_[r] = w;
    }
}

struct MoeSched {
    const LAS int* blk; const char* A; const char* W; size_t wstride, tile_bytes; int ntile, nunits, G, c;
    __device__ __forceinline__ bool next(int i, pg8::Unit& u) const {
        int g, pn;
        if (G == 256) {
            const int x = c & 7, slot = c >> 3, rpr = 256 / ntile;
            g = i * rpr + 8 * (ntile == 8 ? (x >> 1) : x) + (slot & 7); pn = (ntile == 8 ? 4 * (x & 1) : 0) + (slot >> 3);
            if (g * ntile >= nunits) return false;
        } else { const long L = (long)i * G + c; if (L >= nunits) return false; g = (int)L / ntile; pn = (int)L % ntile; }
        const int e = __builtin_amdgcn_readfirstlane(blk[2 * g]);
        u.pm = g; u.pn = pn; u.aux = e; u.A = A + (size_t)g * tile_bytes; u.B = W + (size_t)e * wstride + (size_t)pn * tile_bytes; return true;
    }
};
struct MlaSched {
    const char* QA; const char* KVA; const char* Wq; const char* Wkv; int G, c;
    __device__ __forceinline__ bool next(int i, pg8::Unit& u) const {
        const long L = (long)i * G + c; if (L >= 128 * 7) return false;
        const int pm = (int)L / 7, t = (int)L % 7;
        u.pm = pm; if (t < 3) { u.pn = t; u.aux = 0; u.A = QA + (size_t)pm * 256 * 256 * 2; u.B = Wq + (size_t)t * 256 * 256 * 2; }
        else { u.pn = t - 3; u.aux = 1; u.A = KVA + (size_t)pm * 256 * 256 * 2; u.B = Wkv + (size_t)(t - 3) * 256 * 256 * 2; }
        return true;
    }
};

constexpr int NPHASE = 50;
#define IN(k) (lo <= (k) && (k) < hi)
#ifndef PROBE_MASK
#define PROBE_MASK 0
#endif
#define REP(k) for (int rep_ = 0; rep_ < ((PROBE_MASK >> (k)) & 1) + 1; ++rep_)
#define GRID_BAR() do { if (fused) { xcd_barrier((gbar_t)(fresh_args().ws + WS_CTL) + CW_BAR, (volatile LAS unsigned*)((LAS unsigned char*)lds_raw + LT_MISC) + 8, wv); } } while (0)
template <int LAYER>
__device__ __forceinline__ void layer_body(const int lo, const int hi, const bool fused, const int wv) {
    constexpr int layer = LAYER;
        constexpr int pb = 1 + 12 * layer; constexpr bool odd = (layer & 1) != 0; constexpr int j = layer >> 1;
        REP(0) if (IN(pb + 0)) { n1_phase(fresh_args(), layer, false, wv, ((PROBE_MASK >> 0) & 1) && rep_ == 0); GRID_BAR(); }
        REP(1) if (IN(pb + 1)) {
            const Args& a = fresh_args(); MK_FRAME(F); ARGAS unsigned char* ws = opaque_ws(a.ws);
            pg8::StaticSched S; S.A = (const char*)(ws + WS_HM); S.lda = DM; S.ldb = DM; S.nM = NTOK / 256; S.G = F.G; S.c = F.bid;
            pg8::EpiBf16 E; E.O0 = (bf16_t*)(ws + WS_P); E.O1 = E.O0; E.rope = (const GAS f32x2*)(ws + WS_ROPEO); E.qscale = 0.0625f;
            if (!odd) { S.Bt = (const char*)(ws + WS_WINE) + (size_t)j * EVEN_INP * DM * 2; S.nN = EVEN_INP / 256; E.ldc0 = E.ldc1 = EVEN_INP; E.rope_tiles = 0; E.qscale_tiles = 0; }
            else { S.Bt = (const char*)(ws + WS_WINO) + (size_t)j * RET_IN * DM * 2; S.nN = RET_IN / 256; E.ldc0 = E.ldc1 = RET_IN; E.rope_tiles = 8; E.qscale_tiles = 4; }
            pg8::gemm_phase<pg8::EpiBf16, pg8::StaticSched>(F.lds + LDS_RING, pg8::Dims{DM, DM, DM}, S, E, wv);
            GRID_BAR();
        }
        if constexpr (!odd) {
            REP(2) if (IN(pb + 2)) { e2_phase(fresh_args(), j, wv); GRID_BAR(); }
            REP(3) if (IN(pb + 3)) {
                const Args& a = fresh_args(); MK_FRAME(F); ARGAS unsigned char* ws = opaque_ws(a.ws);
                MlaSched S; S.QA = (const char*)(ws + X1_QA); S.KVA = (const char*)(ws + X1_KVA); S.Wq = (const char*)(ws + WS_WQB) + (size_t)j * 768 * 256 * 2; S.Wkv = (const char*)(ws + WS_WKVB) + (size_t)j * 1024 * 256 * 2; S.G = F.G; S.c = F.bid;
                pg8::EpiBf16 E; E.O0 = (bf16_t*)(ws + X1_QRAW); E.O1 = (bf16_t*)(ws + X1_KVRAW); E.ldc0 = 768; E.ldc1 = 1024; E.rope_tiles = 0; E.qscale_tiles = 0; E.qscale = 1.f; E.rope = nullptr;
                pg8::gemm_phase<pg8::EpiBf16, MlaSched>(F.lds + LDS_RING, pg8::Dims{256, 256, 256}, S, E, wv);
                GRID_BAR();
            }
            REP(4) if (IN(pb + 4)) { e4_phase(fresh_args(), j, wv); GRID_BAR(); }
            REP(5) if (IN(pb + 5)) {
                const Args& a = fresh_args(); MK_FRAME(F); ARGAS unsigned char* ws = opaque_ws(a.ws);
                const float* ALPHA = (const float*)(ws + WS_MISC); const float* BETA = ALPHA + 2 * 32 * SEQ;
                for (int u = F.bid; u < 128; u += F.G) {
                    const int bh = u >> 2, dir = (u >> 1) & 1, dvb = u & 1, b = bh >> 2, h = bh & 3;
                    la::StateArgs sa; sa.K = (const bf16_t*)(ws + X1_KC) + (size_t)b * SEQ * 512 + h * 128; sa.ldk = 512;
                    sa.V = (const bf16_t*)(ws + WS_P) + (size_t)b * SEQ * EVEN_INP + PC_VM + h * 128 + dvb * 64; sa.ldv = EVEN_INP;
                    sa.Cout = (bf16_t*)(ws + X1_CM) + ((size_t)(bh * 2 + dir) * 32) * 128 * 128 + dvb * 64; sa.ldc = 128; sa.cstride = 128 * 128;
                    sa.Nout = dvb == 0 ? (float*)(ws + X1_NM) + ((size_t)(bh * 2 + dir) * 32) * 128 : nullptr;
                    sa.alpha = ALPHA + ((size_t)dir * 32 + bh) * SEQ; sa.beta = BETA + ((size_t)dir * 32 + bh) * SEQ; sa.lgam = 0.f; sa.dir = dir;
                    la::state_unit2<128, 64, true>(F.lds + LDS_RING, F.lds + LT_X, sa, wv);
                }
                __syncthreads();
                unsigned* qh = (unsigned*)(ws + WS_CTL) + CW_QUEUE + 64 * j + 128 * rep_; LAS unsigned* qslot = (LAS unsigned*)(F.lds + LT_MISC) + 16;
                for (;;) {
                    if (F.tid == 0) *qslot = xb_add((gbar_t)qh, 1u);
                    __syncthreads();
                    const unsigned u = *qslot;
                    __syncthreads();
                    if (u >= 1024u) break;
                    const int bh = u >> 4, qb = u & 15, b = bh >> 3, h = bh & 7;
                    att::attn_body((const bf16_t*)(ws + X1_QH) + ((size_t)bh * SEQ + qb * 256) * 96, (const bf16_t*)(ws + X1_KH) + (size_t)bh * SEQ * 128, (const bf16_t*)(ws + X1_VH) + (size_t)bh * SEQ * 64,
                                   (bf16_t*)(ws + WS_MIX) + ((size_t)b * SEQ + qb * 256) * DM + 512 + h * 64, DM, SEQ, (LAS char*)(F.lds + LDS_RING), wv);
                }
                GRID_BAR();
            }
            REP(6) if (IN(pb + 6)) {
                const Args& a = fresh_args(); MK_FRAME(F); ARGAS unsigned char* ws = opaque_ws(a.ws);
                const float* ALPHA = (const float*)(ws + WS_MISC); const float* BETA = ALPHA + 2 * 32 * SEQ; const float* MG = BETA + 2 * 32 * SEQ;
                for (int u = F.bid; u < 1024; u += F.G) {
                    const int bh = u >> 5, c = u & 31, b = bh >> 2, h = bh & 3; const size_t t0 = (size_t)b * SEQ + c * 128;
                    la::OutArgs oa; oa.Q = (const bf16_t*)(ws + X1_QC) + t0 * 512 + h * 128; oa.ldq = 512; oa.K = (const bf16_t*)(ws + X1_KC) + t0 * 512 + h * 128; oa.ldk = 512;
                    oa.V = (const bf16_t*)(ws + WS_P) + t0 * EVEN_INP + PC_VM + h * 128; oa.ldv = EVEN_INP;
                    oa.Cf = (const bf16_t*)(ws + X1_CM) + ((size_t)(bh * 2 + 0) * 32 + c) * 128 * 128; oa.Cb = (const bf16_t*)(ws + X1_CM) + ((size_t)(bh * 2 + 1) * 32 + c) * 128 * 128;
                    oa.Nf = (const float*)(ws + X1_NM) + ((size_t)(bh * 2 + 0) * 32 + c) * 128; oa.Nb = (const float*)(ws + X1_NM) + ((size_t)(bh * 2 + 1) * 32 + c) * 128;
                    oa.af = ALPHA + ((size_t)0 * 32 + bh) * SEQ + c * 128; oa.bfw = BETA + ((size_t)0 * 32 + bh) * SEQ + c * 128; oa.ab = ALPHA + ((size_t)1 * 32 + bh) * SEQ + c * 128; oa.bbw = BETA + ((size_t)1 * 32 + bh) * SEQ + c * 128;
                    oa.Mf = MG[bh]; oa.Mb = MG[32 + bh]; oa.lgf = 0.f; oa.lgb = 0.f;
                    oa.gain = a.ml_norm_g + (size_t)j * 512 + h * 128; oa.G = (const bf16_t*)(ws + WS_P) + t0 * EVEN_INP + PC_OM + h * 128; oa.ldg = EVEN_INP;
                    oa.Out = (bf16_t*)(ws + WS_MIX) + t0 * DM + h * 128; oa.ldo = DM;
                    la::out_unit2<128, 128, true>(F.lds + LDS_RING, F.lds + LT_X, oa, wv);
                }
                GRID_BAR();
            }
        } else {
            REP(2) if (IN(pb + 2)) {
                const Args& a = fresh_args(); MK_FRAME(F); ARGAS unsigned char* ws = opaque_ws(a.ws);
                for (int u = F.bid; u < 256; u += F.G) {
                    const int bh = u >> 3, dir = (u >> 2) & 1, dvb = u & 3, b = bh >> 2, h = bh & 3;
                    const float dl = (dir ? a.ret_decay_b : a.ret_decay_f)[j * 4 + h];
                    la::StateArgs sa; sa.K = (const bf16_t*)(ws + WS_P) + (size_t)b * SEQ * RET_IN + 1024 + h * 256; sa.ldk = RET_IN;
                    sa.V = (const bf16_t*)(ws + WS_P) + (size_t)b * SEQ * RET_IN + 2048 + h * 512 + dvb * 128; sa.ldv = RET_IN;
                    sa.Cout = (bf16_t*)(ws + WS_X1) + ((size_t)(bh * 2 + dir) * 32) * 256 * 512 + dvb * 128; sa.ldc = 512; sa.cstride = 256 * 512; sa.Nout = nullptr;
                    sa.alpha = nullptr; sa.beta = nullptr; sa.lgam = fminf(dl, 0.f) - log1pf(__expf(-fabsf(dl))); sa.dir = dir;
                    la::state_unit2<256, 128, false>(F.lds + LDS_RING, F.lds + LT_X, sa, wv);
                }
                GRID_BAR();
            }
            REP(3) if (IN(pb + 3)) {
                const Args& a = fresh_args(); MK_FRAME(F); ARGAS unsigned char* ws = opaque_ws(a.ws);
                for (int u = F.bid; u < 1024; u += F.G) {
                    const int bh = u >> 5, c = u & 31, b = bh >> 2, h = bh & 3; const size_t t0 = (size_t)b * SEQ + c * 128;
                    const bf16_t* R = (const bf16_t*)(ws + WS_P) + t0 * RET_IN;
                    const float dlf = a.ret_decay_f[j * 4 + h], dlb = a.ret_decay_b[j * 4 + h];
                    la::OutArgs oa; oa.Q = R + h * 256; oa.ldq = RET_IN; oa.K = R + 1024 + h * 256; oa.ldk = RET_IN; oa.V = R + 2048 + h * 512; oa.ldv = RET_IN;
                    oa.Cf = (const bf16_t*)(ws + WS_X1) + ((size_t)(bh * 2 + 0) * 32 + c) * 256 * 512; oa.Cb = (const bf16_t*)(ws + WS_X1) + ((size_t)(bh * 2 + 1) * 32 + c) * 256 * 512;
                    oa.Nf = nullptr; oa.Nb = nullptr; oa.af = oa.bfw = oa.ab = oa.bbw = nullptr; oa.Mf = 0.f; oa.Mb = 0.f;
                    oa.lgf = fminf(dlf, 0.f) - log1pf(__expf(-fabsf(dlf))); oa.lgb = fminf(dlb, 0.f) - log1pf(__expf(-fabsf(dlb)));
                    oa.gain = a.ret_gn_g + (size_t)j * 2048 + h * 512; oa.G = R + 4096 + h * 512; oa.ldg = RET_IN;
                    oa.Out = (bf16_t*)(ws + WS_MIX) + t0 * 2048 + h * 512; oa.ldo = 2048;
                    la::out_unit2<256, 512, false>(F.lds + LDS_RING, F.lds + LT_X, oa, wv);
                }
                GRID_BAR();
            }
        }
        REP(7) if (IN(pb + 7)) {
            const Args& a = fresh_args(); MK_FRAME(F); ARGAS unsigned char* ws = opaque_ws(a.ws);
            pg8::StaticSched S; S.A = (const char*)(ws + WS_MIX); S.nM = NTOK / 256; S.nN = DM / 256; S.G = F.G; S.c = F.bid;
            int K;
            if (!odd) { S.Bt = (const char*)(ws + WS_WOUTE) + (size_t)j * DM * DM * 2; K = DM; } else { S.Bt = (const char*)(ws + WS_WOUTO) + (size_t)j * DM * 2048 * 2; K = 2048; }
            S.lda = K; S.ldb = K;
            pg8::EpiResid E; E.x0 = (layer == 0) ? (const float*)a.x : nullptr; E.xb = (const bf16_t*)(ws + WS_XB); E.xout = (((PROBE_MASK >> 7) & 1) && rep_ == 0) ? (bf16_t*)(ws + WS_ACT) : (bf16_t*)(ws + WS_XB); E.gate = (const float*)(ws + WS_MOD) + (size_t)layer * NBATCH * 6144 + 2 * DM; E.gstride = 6144;
            pg8::gemm_phase<pg8::EpiResid, pg8::StaticSched>(F.lds + LDS_RING, pg8::Dims{K, K, K}, S, E, wv);
            GRID_BAR();
        }
        REP(8) if (IN(pb + 8)) { n2_phase(fresh_args(), layer, wv, ((PROBE_MASK >> 8) & 1) && rep_ == 0); GRID_BAR(); }
        REP(9) if (IN(pb + 9)) { m1_phase(fresh_args(), layer, wv); GRID_BAR(); }
        REP(10) if (IN(pb + 10)) {
            const Args& a = fresh_args(); MK_FRAME(F); ARGAS unsigned char* ws = opaque_ws(a.ws);
            build_pstart(F, (const unsigned*)(ws + WS_CTL) + CW_CNT + 64 * layer);
            const int nblk = ((LAS int*)(F.lds + LT_PSTART))[32] >> 8;
            MoeSched S; S.blk = (const LAS int*)(F.lds + LT_BLK); S.A = (const char*)(ws + WS_ASORT); S.W = (const char*)(ws + WS_WGU) + (size_t)layer * NEXP * 2048 * DM; S.wstride = (size_t)2048 * DM; S.tile_bytes = (size_t)256 * DM;
            S.ntile = 8; S.nunits = nblk * 8; S.G = F.G; S.c = F.bid;
            pg8::EpiSwiglu E; E.act = (unsigned char*)(ws + WS_ACT); E.bgu = a.moe_b_gu + (size_t)layer * NEXP * 2048; E.ascale = 1.f / (FP8_HSC * FP8_WSC);
            pg8::gemm_phase<pg8::EpiSwiglu, MoeSched, true, true, true>(F.lds + LDS_RING, pg8::Dims{DM / 2, DM / 2, DM / 2}, S, E, wv);
            GRID_BAR();
        }
        REP(11) if (IN(pb + 11)) {
            const Args& a = fresh_args(); MK_FRAME(F); ARGAS unsigned char* ws = opaque_ws(a.ws);
            build_pstart(F, (const unsigned*)(ws + WS_CTL) + CW_CNT + 64 * layer);
            const int nblk = ((LAS int*)(F.lds + LT_PSTART))[32] >> 8;
            MoeSched S; S.blk = (const LAS int*)(F.lds + LT_BLK); S.A = (const char*)(ws + WS_ACT); S.W = (const char*)(ws + WS_WDN) + (size_t)layer * NEXP * DM * EFF; S.wstride = (size_t)DM * EFF; S.tile_bytes = (size_t)256 * EFF;
            S.ntile = 4; S.nunits = nblk * 4; S.G = F.G; S.c = F.bid;
            pg8::EpiDown E; E.y = (bf16_t*)(ws + WS_Y); E.bd = a.moe_b_down + (size_t)layer * NEXP * DM; E.wrow = (const float*)(ws + WS_WSORT); E.ascale = 1.f / (FP8_ASC * FP8_WSC);
            pg8::gemm_phase<pg8::EpiDown, MoeSched, true, true, true>(F.lds + LDS_RING, pg8::Dims{EFF / 2, EFF / 2, EFF / 2}, S, E, wv);
            GRID_BAR();
        }
    }
__global__ void __launch_bounds__(512, 2) fwd_kernel(Args a_kernarg) {
    const Args& a0 = fresh_args();
    LAS unsigned char* lds0 = (LAS unsigned char*)lds_raw;
    const int wv = __builtin_amdgcn_readfirstlane((int)threadIdx.x >> 6);
    for (int u = TIDX(wv); u < 64; u += 512) ((LAS unsigned*)(lds0 + LT_MISC))[u] = 0u;
    __syncthreads();
    const int lo = a0.ph_lo, hi = a0.ph_hi; const bool fused = (hi - lo) > 1;
    if (fused) xcd_barrier_post((gbar_t)(a0.ws + WS_CTL) + CW_BAR, wv);

    REP(12) if (IN(0)) { p0_prologue(fresh_args(), wv); GRID_BAR(); }

    layer_body<0>(lo, hi, fused, wv); layer_body<1>(lo, hi, fused, wv); layer_body<2>(lo, hi, fused, wv); layer_body<3>(lo, hi, fused, wv);
    if (IN(49)) n1_phase(fresh_args(), DEPTH, true, wv);
}

#undef IN
#undef GRID_BAR
#ifndef MK_ONE_LAUNCH
#define MK_ONE_LAUNCH 1
#endif
extern "C" void kernel_launch(void* const* d_in, const int* in_sizes, int n_in, void* d_out, int out_size, void* d_ws, size_t ws_size, hipStream_t stream) {
    static int grid = 0;
    if (grid == 0) {
        if (n_in != 30 || in_sizes[0] != NTOK * DM || out_size != NTOK * DM || ws_size < WS_END) {
            fprintf(stderr, "kernel_launch: shape mismatch: n_in %d in0 %d out %d ws %zu (need %zu)\n", n_in, n_in > 0 ? in_sizes[0] : -1, out_size, ws_size, (size_t)WS_END); grid = -1; return; }
        int dev = 0, cus = 0, per_cu = 0;
        if (hipGetDevice(&dev) != hipSuccess || hipDeviceGetAttribute(&cus, hipDeviceAttributeMultiprocessorCount, dev) != hipSuccess) { grid = -1; return; }
        if (hipFuncSetAttribute((const void*)fwd_kernel, hipFuncAttributeMaxDynamicSharedMemorySize, LDS_BYTES) != hipSuccess) { fprintf(stderr, "kernel_launch: hipFuncSetAttribute failed\n"); grid = -1; return; }
        if (hipOccupancyMaxActiveBlocksPerMultiprocessor(&per_cu, (const void*)fwd_kernel, 512, LDS_BYTES) != hipSuccess || per_cu < 1) fprintf(stderr, "kernel_launch: occupancy query says %d\n", per_cu);
        (void)hipGetLastError();
        grid = cus;
    }
    if (grid < 0) return;
    (void)hipMemsetAsync((char*)d_ws + WS_CTL, 0, CTL_ZERO_BYTES, stream);
    Args a{};
    a.x = (gcf_t)d_in[0]; a.c = (gcf_t)d_in[1]; a.pos = (gci_t)d_in[2];
    a.ada_w = (gcf_t)d_in[3]; a.ada_b = (gcf_t)d_in[4]; a.norm_mix_g = (gcf_t)d_in[5]; a.norm_ffn_g = (gcf_t)d_in[6];
    a.hy_w_in = (gcf_t)d_in[7]; a.ml_conv_w = (gcf_t)d_in[8]; a.ml_conv_b = (gcf_t)d_in[9]; a.ml_gate_b = (gcf_t)d_in[10]; a.ml_norm_g = (gcf_t)d_in[11];
    a.mla_q_norm_g = (gcf_t)d_in[12]; a.mla_kv_norm_g = (gcf_t)d_in[13]; a.mla_w_qb = (gcf_t)d_in[14]; a.mla_w_kvb = (gcf_t)d_in[15];
    a.mla_qk_q_g = (gcf_t)d_in[16]; a.mla_qk_k_g = (gcf_t)d_in[17]; a.hy_w_out = (gcf_t)d_in[18];
    a.ret_w_in = (gcf_t)d_in[19]; a.ret_decay_f = (gcf_t)d_in[20]; a.ret_decay_b = (gcf_t)d_in[21]; a.ret_gn_g = (gcf_t)d_in[22]; a.ret_w_out = (gcf_t)d_in[23];
    a.moe_router_w = (gcf_t)d_in[24]; a.moe_router_b = (gcf_t)d_in[25]; a.moe_w_gu = (gcf_t)d_in[26]; a.moe_b_gu = (gcf_t)d_in[27]; a.moe_w_down = (gcf_t)d_in[28]; a.moe_b_down = (gcf_t)d_in[29];
    a.out = (ARGAS float*)d_out; a.ws = (ARGAS unsigned char*)d_ws;
#if MK_ONE_LAUNCH
    a.ph_lo = 0; a.ph_hi = NPHASE;
    hipLaunchKernelGGL(fwd_kernel, dim3(grid), dim3(512), LDS_BYTES, stream, a);
#else
    for (int ph = 0; ph < NPHASE; ++ph) {
        if (ph >= 1 && ph < 49) { const int layer = (ph - 1) / 12, k = (ph - 1) % 12; if ((layer & 1) && (k >= 4 && k <= 6)) continue; }
        a.ph_lo = ph; a.ph_hi = ph + 1;
        hipLaunchKernelGGL(fwd_kernel, dim3(grid), dim3(512), LDS_BYTES, stream, a);
    }
#endif
    const hipError_t le = hipPeekAtLastError();
    if (le != hipSuccess) fprintf(stderr, "kernel_launch: launch failed: %s\n", hipGetErrorName(le));
}
```

```cpp
#include <hip/hip_runtime.h>
#include <cstdio>
#include <cstdint>

#define GAS __attribute__((address_space(1)))
#define LAS __attribute__((address_space(3)))
typedef unsigned short bf16_t;
typedef short bf16x8 __attribute__((ext_vector_type(8)));
typedef short s16x4 __attribute__((ext_vector_type(4)));
typedef float f32x2 __attribute__((ext_vector_type(2)));
typedef float f32x4 __attribute__((ext_vector_type(4)));
typedef float f32x8 __attribute__((ext_vector_type(8)));
typedef float f32x16 __attribute__((ext_vector_type(16)));
typedef unsigned u32x2 __attribute__((ext_vector_type(2)));
typedef unsigned u32x4 __attribute__((ext_vector_type(4)));
typedef GAS unsigned gu32;

constexpr int NTOK = 32768, DM = 1024, SEQ = 4096, NBATCH = 8, DEPTH = 4;
constexpr int EVEN_IN = 2480, EVEN_INP = 2560;
constexpr int RET_IN = 6144;
constexpr int NEXP = 32, TOPK = 4, EFF = 1024;
constexpr int NSLOT = NTOK * TOPK;
constexpr int NSLOTP = NSLOT + NEXP * 256;
constexpr float EPS = 1e-6f;

constexpr int PC_QM = 0, PC_KM = 512, PC_VM = 1024, PC_OM = 1536, PC_QA = 2048, PC_KVA = 2304, PC_KR = 2432, PC_GT = 2464;

__device__ __forceinline__ int lane_id() { int l; asm volatile("v_mbcnt_lo_u32_b32 %0, -1, 0\n\tv_mbcnt_hi_u32_b32 %0, -1, %0" : "=v"(l)); return l; }
#define TIDX(wv) (((wv) << 6) | lane_id())
#define LDS_WAIT() asm volatile("s_waitcnt lgkmcnt(0)" ::: "memory")
#define VM_WAIT() asm volatile("s_waitcnt vmcnt(0)" ::: "memory")
#define SBAR() __builtin_amdgcn_sched_barrier(0)
#define FENCE() do { asm volatile("" ::: "memory"); __builtin_amdgcn_sched_barrier(0); } while (0)

__device__ __forceinline__ unsigned cvt_pk_bf16(float lo, float hi) { unsigned r; asm volatile("v_cvt_pk_bf16_f32 %0, %1, %2" : "=v"(r) : "v"(lo), "v"(hi)); return r; }
__device__ __forceinline__ float bf_lo(unsigned u) { return __builtin_bit_cast(float, u << 16); }
__device__ __forceinline__ float bf_hi(unsigned u) { return __builtin_bit_cast(float, u & 0xffff0000u); }
__device__ __forceinline__ float bf2f(bf16_t b) { return __builtin_bit_cast(float, ((unsigned)b) << 16); }
__device__ __forceinline__ bf16_t f2bf(float f) { unsigned u = __builtin_bit_cast(unsigned, f); return (bf16_t)((u + 0x7fffu + ((u >> 16) & 1u)) >> 16); }
__device__ __forceinline__ float shx(float v, int m, int lane) { return __builtin_bit_cast(float, __builtin_amdgcn_ds_bpermute((lane ^ m) << 2, __builtin_bit_cast(int, v))); }
__device__ __forceinline__ int shxi(int v, int m, int lane) { return __builtin_amdgcn_ds_bpermute((lane ^ m) << 2, v); }
__device__ __forceinline__ float sh_from(float v, int src, int lane) { (void)lane; return __builtin_bit_cast(float, __builtin_amdgcn_ds_bpermute(src << 2, __builtin_bit_cast(int, v))); }
__device__ __forceinline__ int sh_fromi(int v, int src) { return __builtin_amdgcn_ds_bpermute(src << 2, v); }
__device__ __forceinline__ float wave_sum(float v, int lane) {
#pragma unroll
    for (int o = 1; o < 64; o <<= 1) v += shx(v, o, lane);
    return v;
}
__device__ __forceinline__ float wave_max(float v, int lane) {
#pragma unroll
    for (int o = 1; o < 64; o <<= 1) v = fmaxf(v, shx(v, o, lane));
    return v;
}
__device__ __forceinline__ float sigmoidf_(float x) { return 1.f / (1.f + __expf(-x)); }
__device__ __forceinline__ float siluf_(float x) { return x / (1.f + __expf(-x)); }

#define XB_TMO      128
#define XB_XCNT(j)  (256  + 64 * (j))
#define XB_XSUB(j)  (1280 + 64 * (j))
#define XB_XGEN(j)  (2304 + 64 * (j))
#define XB_TOP      3328
#define XB_TOPGEN   3392
#define XCD_BAR_WORDS 3456
#define XB_SPIN_CAP (1u << 22)

typedef GAS unsigned* gbar_t;
__device__ __forceinline__ unsigned xb_ld(gbar_t p)              { return __hip_atomic_load(p, __ATOMIC_RELAXED, __HIP_MEMORY_SCOPE_AGENT); }
__device__ __forceinline__ unsigned xb_add(gbar_t p, unsigned v) { return __hip_atomic_fetch_add(p, v, __ATOMIC_RELAXED, __HIP_MEMORY_SCOPE_AGENT); }
__device__ __forceinline__ unsigned xb_xcc_id() { return (unsigned)__builtin_amdgcn_s_getreg((3 << 11) | 20) & 0xFu; }
#define XB_SPIN(cond, bar) do { unsigned _sp = 0; while (cond) { __builtin_amdgcn_s_sleep(1); \
    if ((++_sp & 255u) == 0u) { if (xb_ld(&(bar)[XB_TMO])) break; if (_sp > XB_SPIN_CAP) { xb_add(&(bar)[XB_TMO], 1u); break; } } } } while (0)

__device__ __forceinline__ void xcd_barrier_post(gbar_t bar, int wv) {
    if (TIDX(wv) == 0) (void)xb_add(&bar[XB_XCNT(xb_xcc_id())], 1u);
}
__device__ __forceinline__ void xcd_barrier_complete(gbar_t bar, unsigned x, unsigned& nloc, unsigned& nx) {
    const unsigned G = gridDim.x * gridDim.y * gridDim.z;
    unsigned sum, cnt, mine, sp = 0u;
    for (;;) {
        sum = 0u; cnt = 0u; mine = 0u;
#pragma unroll
        for (unsigned j = 0; j < 16; ++j) { const unsigned c = xb_ld(&bar[XB_XCNT(j)]); sum += c; cnt += (c > 0u) ? 1u : 0u; mine = (j == x) ? c : mine; }
        if (sum == G) break;
        __builtin_amdgcn_s_sleep(1);
        if ((++sp & 255u) == 0u) { if (xb_ld(&bar[XB_TMO])) break; if (sp > XB_SPIN_CAP) { xb_add(&bar[XB_TMO], 1u); break; } }
    }
    nloc = mine > 0u ? mine : 1u; nx = cnt > 0u ? cnt : 1u;
}
__device__ __forceinline__ void xcd_barrier(gbar_t bar, volatile LAS unsigned* st, int wv) {
    asm volatile("s_waitcnt vmcnt(0)" ::: "memory");
    __syncthreads();
    if (TIDX(wv) == 0) {
        const unsigned bx = xb_xcc_id();
        __builtin_amdgcn_s_waitcnt(0);
        unsigned nloc = st[0], nx = st[1];
        if (nloc == 0u) { xcd_barrier_complete(bar, bx, nloc, nx); st[0] = nloc; st[1] = nx; }
        const unsigned old = xb_add(&bar[XB_XSUB(bx)], 1u);
        const unsigned gen = old / nloc;
        if (old + 1u == (gen + 1u) * nloc) {
            __builtin_amdgcn_fence(__ATOMIC_RELEASE, "agent");
            asm volatile("s_waitcnt vmcnt(0)" ::: "memory");
            const unsigned og = xb_add(&bar[XB_TOP], 1u);
            const unsigned tg = og / nx;
            if (og + 1u == (tg + 1u) * nx) xb_add(&bar[XB_TOPGEN], 1u);
            else XB_SPIN(xb_ld(&bar[XB_TOPGEN]) == tg, bar);
            __builtin_amdgcn_fence(__ATOMIC_ACQUIRE, "agent");
            xb_add(&bar[XB_XGEN(bx)], 1u);
            asm volatile("s_waitcnt vmcnt(0)" ::: "memory");
        } else {
            XB_SPIN(xb_ld(&bar[XB_XGEN(bx)]) == gen, bar);
            __builtin_amdgcn_fence(__ATOMIC_ACQUIRE, "agent");
            asm volatile("s_waitcnt vmcnt(0)" ::: "memory");
        }
    }
    __syncthreads();
}
namespace pg8 {
constexpr int BM = 256, BK = 64, HALF = 128, HTB = HALF * BK * 2, STAGE_BYTES = 8 * HTB, NXCD = 8, WGM = 8;
__host__ __device__ __forceinline__ int lds_byte(int r, int c) { const int st = (r >> 4) * 2 + (c >> 5), rr = r & 15, cc = c & 31, ob = rr * 64 + cc * 2; return st * 1024 + (ob ^ (((ob >> 9) & 1) << 5)); }
__host__ __device__ __forceinline__ void stage_rc(int b, int& R, int& C) { const int st = b / 1024, sb = b % 1024, swz = sb ^ (((sb >> 9) & 1) << 5); R = (st >> 1) * 16 + swz / 64; C = (st & 1) * 32 + (swz % 64) / 2; }
__host__ __device__ __forceinline__ int perm32(int rho) { const int n = rho >> 4, i = rho & 15; return 8 * (i >> 2) + 4 * n + (i & 3); }

struct Unit { const char* A; const char* B; int pm, pn, aux; };
struct Dims { int lda, ldb, K; };

__device__ __forceinline__ void static_tile(int L, int nM, int nN, int& pm, int& pn) {
    const int nwg = nM * nN; int wgid = L;
    { const int q = nwg / NXCD, r = nwg % NXCD, xcd = wgid % NXCD, off = wgid / NXCD; wgid = (xcd < r ? xcd * (q + 1) : r * (q + 1) + (xcd - r) * q) + off; }
    const int nig = WGM * nN, gid = wgid / nig, fm = gid * WGM, gsz = (nM - fm) < WGM ? (nM - fm) : WGM;
    pm = fm + ((wgid % nig) % gsz); pn = (wgid % nig) / gsz;
}
struct StaticSched {
    const char* A; const char* Bt; int lda, ldb, nM, nN, G, c;
    __device__ __forceinline__ bool next(int i, Unit& u) const {
        const long L = (long)i * G + c; if (L >= (long)nM * nN) return false;
        int pm, pn; static_tile((int)L, nM, nN, pm, pn);
        u.pm = pm; u.pn = pn; u.aux = 0; u.A = A + (size_t)pm * BM * lda * 2; u.B = Bt + (size_t)pn * BM * ldb * 2; return true;
    }
};

typedef int v8i_t __attribute__((ext_vector_type(8)));
__device__ __forceinline__ v8i_t cat8(bf16x8 a, bf16x8 b) { const u32x4 x = __builtin_bit_cast(u32x4, a), y = __builtin_bit_cast(u32x4, b); return (v8i_t){(int)x.x, (int)x.y, (int)x.z, (int)x.w, (int)y.x, (int)y.y, (int)y.z, (int)y.w}; }
template <class Epi, class Sched, bool ALIGN_EPI = true, bool SP2 = true, bool FP8 = false>
__device__ __forceinline__ void gemm_phase(LAS unsigned char* lds, const Dims g, const Sched& S, const Epi& E, const int wv) {
    int tid = TIDX(wv); asm volatile("" : "+v"(tid));
    const int wid = __builtin_amdgcn_readfirstlane(tid >> 6), lane = tid & 63, wr = wid >> 2, wc = wid & 3, fr = lane & 15, fq = lane >> 4;
    const int K = g.K, nt = K / BK;
    unsigned voffA[2], voffB[2];
#pragma unroll
    for (int i = 0; i < 2; ++i) { int R, C; stage_rc(tid * 16 + i * 8192, R, C); const int Rb = Epi::PERM ? ((R & ~31) + perm32(R & 31)) : R;
        voffA[i] = (unsigned)(R * g.lda + C) * 2u; voffB[i] = (unsigned)(Rb * g.ldb + C) * 2u; }
    const size_t kstep = (size_t)(BK * 2);
    const size_t hstepA = (size_t)HALF * g.lda * 2, hstepB = (size_t)HALF * g.ldb * 2;
    const unsigned ldsw = (unsigned)wid * 1024u, ldsb_ = (unsigned)(uintptr_t)lds;
    const int aoff = lds_byte(wr * 64 + fr, fq * 8), boff = lds_byte(wc * 32 + fr, fq * 8);
#define PG8_SA(b, h) (((b) * 2 + (h)) * HTB)
#define PG8_SB(b, h) ((4 + (b) * 2 + (h)) * HTB)
#define PG8_STAGE(bufoff, gbase, voff) do { _Pragma("unroll") for (int _i = 0; _i < 2; ++_i) { \
        if constexpr (FP8) { unsigned keep_; asm volatile("s_mov_b32 %0, m0\n\ts_mov_b32 m0, %1\n\ts_nop 0\n\tglobal_load_lds_dwordx4 %2, %3\n\ts_mov_b32 m0, %0" : "=&s"(keep_) : "s"(ldsb_ + (unsigned)(bufoff) + ldsw + _i * 8192u), "v"((voff)[_i]), "s"(gbase) : "memory"); } \
        else __builtin_amdgcn_global_load_lds((const unsigned*)((const char*)(gbase) + (voff)[_i]), (LAS unsigned*)(lds + (bufoff) + ldsw + _i * 8192), 16, 0, 0); } } while (0)
#define PG8_LDA(dst, b, h) do { _Pragma("unroll") for (int m = 0; m < 4; ++m) { if constexpr (FP8) { const u32x4 x_ = *(const LAS u32x4*)(lds + PG8_SA(b, h) + aoff + m * 2048), y_ = *(const LAS u32x4*)(lds + PG8_SA(b, h) + aoff + m * 2048 + 1024); \
        dst##8[m] = (v8i_t){(int)x_.x, (int)x_.y, (int)x_.z, (int)x_.w, (int)y_.x, (int)y_.y, (int)y_.z, (int)y_.w}; } else { _Pragma("unroll") for (int k = 0; k < 2; ++k) dst[m][k] = *(const LAS bf16x8*)(lds + PG8_SA(b, h) + aoff + m * 2048 + k * 1024); } } } while (0)
#define PG8_LDB(dst, b, h) do { _Pragma("unroll") for (int n = 0; n < 2; ++n) { if constexpr (FP8) { const u32x4 x_ = *(const LAS u32x4*)(lds + PG8_SB(b, h) + boff + n * 2048), y_ = *(const LAS u32x4*)(lds + PG8_SB(b, h) + boff + n * 2048 + 1024); \
        dst##8[n] = (v8i_t){(int)x_.x, (int)x_.y, (int)x_.z, (int)x_.w, (int)y_.x, (int)y_.y, (int)y_.z, (int)y_.w}; } else { _Pragma("unroll") for (int k = 0; k < 2; ++k) dst[n][k] = *(const LAS bf16x8*)(lds + PG8_SB(b, h) + boff + n * 2048 + k * 1024); } } } while (0)
#define PG8_MMA(ai, bj, At, Bt) do { __builtin_amdgcn_s_setprio(1); if constexpr (FP8) { _Pragma("unroll") for (int m = 0; m < 4; ++m) _Pragma("unroll") for (int n = 0; n < 2; ++n) \
        acc[ai][bj][m][n] = __builtin_amdgcn_mfma_scale_f32_16x16x128_f8f6f4(Bt##8[n], At##8[m], acc[ai][bj][m][n], 0, 0, 0, 0x7f7f7f7f, 0, 0x7f7f7f7f); } else { \
        _Pragma("unroll") for (int m = 0; m < 4; ++m) _Pragma("unroll") for (int n = 0; n < 2; ++n) _Pragma("unroll") for (int k = 0; k < 2; ++k) \
        acc[ai][bj][m][n] = __builtin_amdgcn_mfma_f32_16x16x32_bf16(Bt[n][k], At[m][k], acc[ai][bj][m][n], 0, 0, 0); } __builtin_amdgcn_s_setprio(0); } while (0)
#define PG8_WAIT_V(n) asm volatile("s_waitcnt vmcnt(" #n ")" ::: "memory")
#define PG8_WAIT_L(n) asm volatile("s_waitcnt lgkmcnt(" #n ")" ::: "memory")
#define PG8_BAR __builtin_amdgcn_s_barrier()
#define PG8_SCHED __builtin_amdgcn_sched_barrier(0)
    Unit cur, nxt; int ui = 0;
    if (!S.next(0, cur)) return;
    f32x4 acc[2][2][4][2];
#pragma unroll
    for (int a = 0; a < 2; ++a)
#pragma unroll
        for (int b = 0; b < 2; ++b)
#pragma unroll
            for (int m = 0; m < 4; ++m)
#pragma unroll
                for (int n = 0; n < 2; ++n) acc[a][b][m][n] = (f32x4){0.f, 0.f, 0.f, 0.f};
    bf16x8 At[4][2], B0[2][2], B1[2][2]; v8i_t At8[4], B08[2], B18[2];
    const char* cA = cur.A; const char* cB = cur.B;
    if constexpr (SP2) {
        PG8_STAGE(PG8_SB(0, 0), cB, voffB); PG8_STAGE(PG8_SB(0, 1), cB + hstepB, voffB); PG8_STAGE(PG8_SA(0, 0), cA, voffA); PG8_STAGE(PG8_SA(0, 1), cA + hstepA, voffA);
        if (wr == 1) PG8_BAR;
        PG8_WAIT_V(2); PG8_BAR;
        PG8_STAGE(PG8_SB(1, 0), cB + kstep, voffB); PG8_STAGE(PG8_SA(1, 0), cA + kstep, voffA); PG8_STAGE(PG8_SB(1, 1), cB + hstepB + kstep, voffB);
        PG8_WAIT_V(6); PG8_BAR;
    } else {
        PG8_STAGE(PG8_SB(0, 0), cB, voffB); PG8_STAGE(PG8_SA(0, 0), cA, voffA); PG8_STAGE(PG8_SB(0, 1), cB + hstepB, voffB); PG8_STAGE(PG8_SA(0, 1), cA + hstepA, voffA);
        if (wr == 1) PG8_BAR;
        PG8_WAIT_V(4); PG8_BAR;
        PG8_STAGE(PG8_SB(1, 0), cB + kstep, voffB); PG8_STAGE(PG8_SA(1, 0), cA + kstep, voffA); PG8_STAGE(PG8_SB(1, 1), cB + hstepB + kstep, voffB);
        PG8_WAIT_V(6); PG8_BAR;
    }
    for (;;) {
        const bool has_next = S.next(ui + 1, nxt);
        const char* nA = has_next ? nxt.A : cA; const char* nB = has_next ? nxt.B : cB;
#pragma unroll 1
        for (int t = 0; t < nt; t += 2) {
            const bool last = (t == nt - 2);
            const char* a1 = cA + (size_t)(t + 1) * kstep;
            const char* a2 = last ? nA : cA + (size_t)(t + 2) * kstep; const char* b2 = last ? nB : cB + (size_t)(t + 2) * kstep;
            const char* a3 = a2 + kstep; const char* b3 = b2 + kstep;
            if constexpr (SP2) {
            PG8_LDB(B0, 0, 0); PG8_LDB(B1, 0, 1); PG8_SCHED; PG8_LDA(At, 0, 0); PG8_STAGE(PG8_SA(1, 1), a1 + hstepA, voffA);
            PG8_WAIT_V(8); PG8_WAIT_L(0); PG8_BAR; PG8_MMA(0, 0, At, B0); PG8_MMA(0, 1, At, B1); PG8_BAR; PG8_SCHED;
            PG8_LDA(At, 0, 1); PG8_STAGE(PG8_SB(0, 0), b2, voffB); PG8_STAGE(PG8_SB(0, 1), b2 + hstepB, voffB); PG8_STAGE(PG8_SA(0, 0), a2, voffA);
            PG8_WAIT_V(8); PG8_WAIT_L(0); PG8_BAR; PG8_MMA(1, 0, At, B0); PG8_MMA(1, 1, At, B1); PG8_BAR; PG8_SCHED;
            PG8_LDB(B0, 1, 0); PG8_LDB(B1, 1, 1); PG8_SCHED; PG8_LDA(At, 1, 0); PG8_STAGE(PG8_SA(0, 1), a2 + hstepA, voffA);
            PG8_WAIT_V(8); PG8_WAIT_L(0); PG8_BAR; PG8_MMA(0, 0, At, B0); PG8_MMA(0, 1, At, B1); PG8_BAR; PG8_SCHED;
            PG8_LDA(At, 1, 1); PG8_STAGE(PG8_SB(1, 0), b3, voffB); PG8_STAGE(PG8_SB(1, 1), b3 + hstepB, voffB); PG8_STAGE(PG8_SA(1, 0), a3, voffA);
            PG8_WAIT_V(8); PG8_WAIT_L(0); PG8_BAR; PG8_MMA(1, 0, At, B0); PG8_MMA(1, 1, At, B1); PG8_BAR; PG8_SCHED;
            } else {
            PG8_LDB(B0, 0, 0); PG8_SCHED; PG8_LDA(At, 0, 0); PG8_STAGE(PG8_SA(1, 1), a1 + hstepA, voffA);
            PG8_WAIT_L(8); PG8_BAR; PG8_WAIT_L(0); PG8_MMA(0, 0, At, B0); PG8_BAR; PG8_SCHED;
            PG8_LDB(B1, 0, 1); PG8_STAGE(PG8_SB(0, 0), b2, voffB);
            PG8_BAR; PG8_WAIT_L(0); PG8_MMA(0, 1, At, B1); PG8_BAR;
            PG8_LDA(At, 0, 1); PG8_STAGE(PG8_SA(0, 0), a2, voffA);
            PG8_BAR; PG8_WAIT_L(0); PG8_MMA(1, 0, At, B0); PG8_BAR; PG8_SCHED;
            PG8_STAGE(PG8_SB(0, 1), b2 + hstepB, voffB);
            PG8_WAIT_V(6); PG8_BAR; PG8_MMA(1, 1, At, B1); PG8_BAR;
            PG8_LDB(B0, 1, 0); PG8_SCHED; PG8_LDA(At, 1, 0); PG8_STAGE(PG8_SA(0, 1), a2 + hstepA, voffA);
            PG8_WAIT_L(8); PG8_BAR; PG8_WAIT_L(0); PG8_MMA(0, 0, At, B0); PG8_BAR; PG8_SCHED;
            PG8_LDB(B1, 1, 1); PG8_STAGE(PG8_SB(1, 0), b3, voffB);
            PG8_BAR; PG8_WAIT_L(0); PG8_MMA(0, 1, At, B1); PG8_BAR;
            PG8_LDA(At, 1, 1); PG8_STAGE(PG8_SA(1, 0), a3, voffA);
            PG8_BAR; PG8_WAIT_L(0); PG8_MMA(1, 0, At, B0); PG8_BAR; PG8_SCHED;
            PG8_STAGE(PG8_SB(1, 1), b3 + hstepB, voffB);
            PG8_WAIT_V(6); PG8_BAR; PG8_MMA(1, 1, At, B1); PG8_BAR;
            }
        }
        if constexpr (ALIGN_EPI) { if (wr == 0) PG8_BAR; }
        { int tz = tid; asm volatile("" : "+v"(tz)); const int ln = tz & 63; E(acc, cur, wr, wc, ln & 15, ln >> 4); }
        if (!has_next) break;
#pragma unroll
        for (int a = 0; a < 2; ++a)
#pragma unroll
            for (int b = 0; b < 2; ++b)
#pragma unroll
                for (int m = 0; m < 4; ++m)
#pragma unroll
                    for (int n = 0; n < 2; ++n) acc[a][b][m][n] = (f32x4){0.f, 0.f, 0.f, 0.f};
        cur = nxt; cA = nA; cB = nB; ++ui;
        if constexpr (ALIGN_EPI) { if (wr == 1) PG8_BAR; }
    }
    PG8_WAIT_V(0);
    if constexpr (!ALIGN_EPI) { if (wr == 0) PG8_BAR; }
    PG8_BAR;
#undef PG8_SA
#undef PG8_SB
#undef PG8_STAGE
#undef PG8_LDA
#undef PG8_LDB
#undef PG8_MMA
#undef PG8_WAIT_V
#undef PG8_WAIT_L
#undef PG8_BAR
#undef PG8_SCHED
}

struct EpiBf16 {
    static constexpr bool PERM = true;
    bf16_t* O0; bf16_t* O1; int ldc0, ldc1; int rope_tiles; int qscale_tiles; float qscale; const GAS f32x2* rope;
    __device__ __forceinline__ void operator()(const f32x4 (&acc)[2][2][4][2], const Unit& u, int wr, int wc, int fr, int fq) const {
        const int row0 = u.pm * BM + wr * 64 + fr, col0 = u.pn * BM + wc * 32 + 8 * fq;
        bf16_t* base = u.aux ? O1 : O0; const int ld = u.aux ? ldc1 : ldc0;
        const bool do_rope = u.pn < rope_tiles; const float sc = (u.pn < qscale_tiles) ? qscale : 1.f;
#pragma unroll
        for (int ai = 0; ai < 2; ++ai)
#pragma unroll
            for (int m = 0; m < 4; ++m) {
                const int row = row0 + ai * HALF + m * 16; bf16_t* rowp = base + (size_t)row * ld + col0;
                f32x4 v00 = acc[ai][0][m][0], v01 = acc[ai][0][m][1], v10 = acc[ai][1][m][0], v11 = acc[ai][1][m][1];
                if (do_rope) {
                    const GAS f32x4* rp = (const GAS f32x4*)(rope + (size_t)row * 128 + wc * 32 + 8 * fq);
                    { const f32x4 t0 = rp[0], t1 = rp[1]; f32x4 a, b;
                      a[0] = v00[0] * t0[0] - v10[0] * t0[1]; b[0] = v10[0] * t0[0] + v00[0] * t0[1];
                      a[1] = v00[1] * t0[2] - v10[1] * t0[3]; b[1] = v10[1] * t0[2] + v00[1] * t0[3];
                      a[2] = v00[2] * t1[0] - v10[2] * t1[1]; b[2] = v10[2] * t1[0] + v00[2] * t1[1];
                      a[3] = v00[3] * t1[2] - v10[3] * t1[3]; b[3] = v10[3] * t1[2] + v00[3] * t1[3];
                      v00 = a; v10 = b; }
                    FENCE();
                    { const f32x4 t2 = rp[2], t3 = rp[3]; f32x4 a, b;
                      a[0] = v01[0] * t2[0] - v11[0] * t2[1]; b[0] = v11[0] * t2[0] + v01[0] * t2[1];
                      a[1] = v01[1] * t2[2] - v11[1] * t2[3]; b[1] = v11[1] * t2[2] + v01[1] * t2[3];
                      a[2] = v01[2] * t3[0] - v11[2] * t3[1]; b[2] = v11[2] * t3[0] + v01[2] * t3[1];
                      a[3] = v01[3] * t3[2] - v11[3] * t3[3]; b[3] = v11[3] * t3[2] + v01[3] * t3[3];
                      v01 = a; v11 = b; }
                }
                v00 = v00 * sc; v01 = v01 * sc; v10 = v10 * sc; v11 = v11 * sc;
                u32x4 w0, w1;
                w0.x = cvt_pk_bf16(v00[0], v00[1]); w0.y = cvt_pk_bf16(v00[2], v00[3]); w0.z = cvt_pk_bf16(v01[0], v01[1]); w0.w = cvt_pk_bf16(v01[2], v01[3]);
                w1.x = cvt_pk_bf16(v10[0], v10[1]); w1.y = cvt_pk_bf16(v10[2], v10[3]); w1.z = cvt_pk_bf16(v11[0], v11[1]); w1.w = cvt_pk_bf16(v11[2], v11[3]);
                *(u32x4*)(rowp) = w0; *(u32x4*)(rowp + HALF) = w1;
                FENCE();
            }
    }
};
struct EpiResid {
    static constexpr bool PERM = true;
    const float* x0; const bf16_t* xb; bf16_t* xout; const float* gate; int gstride;
    __device__ __forceinline__ void operator()(const f32x4 (&acc)[2][2][4][2], const Unit& u, int wr, int wc, int fr, int fq) const {
        const int row0 = u.pm * BM + wr * 64 + fr, col0 = u.pn * BM + wc * 32 + 8 * fq;
        const float* gp = gate + (size_t)((u.pm * BM) >> 12) * gstride + col0;
        f32x4 gv[2][2];
#pragma unroll
        for (int bj = 0; bj < 2; ++bj)
#pragma unroll
            for (int n = 0; n < 2; ++n) gv[bj][n] = *(const f32x4*)(gp + bj * HALF + 4 * n);
#pragma unroll
        for (int ai = 0; ai < 2; ++ai)
#pragma unroll
            for (int m = 0; m < 4; ++m) { const size_t ro = (size_t)(row0 + ai * HALF + m * 16) * DM + col0;
#pragma unroll
                for (int bj = 0; bj < 2; ++bj) {
                    f32x4 b0, b1;
                    if (x0) { b0 = *(const f32x4*)(x0 + ro + bj * HALF); b1 = *(const f32x4*)(x0 + ro + bj * HALF + 4); }
                    else { const u32x4 w = *(const u32x4*)(xb + ro + bj * HALF); b0 = (f32x4){bf_lo(w.x), bf_hi(w.x), bf_lo(w.y), bf_hi(w.y)}; b1 = (f32x4){bf_lo(w.z), bf_hi(w.z), bf_lo(w.w), bf_hi(w.w)}; }
                    const f32x4 v0 = b0 + gv[bj][0] * acc[ai][bj][m][0], v1 = b1 + gv[bj][1] * acc[ai][bj][m][1];
                    u32x4 o; o.x = cvt_pk_bf16(v0[0], v0[1]); o.y = cvt_pk_bf16(v0[2], v0[3]); o.z = cvt_pk_bf16(v1[0], v1[1]); o.w = cvt_pk_bf16(v1[2], v1[3]);
                    *(u32x4*)(xout + ro + bj * HALF) = o; } }
    }
};
__device__ __forceinline__ unsigned pk4_fp8(float a, float b, float c, float d) { int w = __builtin_amdgcn_cvt_pk_fp8_f32(a, b, 0, false); w = __builtin_amdgcn_cvt_pk_fp8_f32(c, d, w, true); return (unsigned)w; }
struct EpiSwiglu {
    static constexpr bool PERM = true;
    unsigned char* act; const float* bgu; float ascale;
    __device__ __forceinline__ void operator()(const f32x4 (&acc)[2][2][4][2], const Unit& u, int wr, int wc, int fr, int fq) const {
        const int row0 = u.pm * BM + wr * 64 + fr, c0 = u.pn * HALF + wc * 32 + 8 * fq;
        const float* bp = bgu + (size_t)u.aux * 2048 + c0;
        const f32x4 bg0 = *(const f32x4*)(bp), bg1 = *(const f32x4*)(bp + 4), bu0 = *(const f32x4*)(bp + 1024), bu1 = *(const f32x4*)(bp + 1028);
#pragma unroll
        for (int ai = 0; ai < 2; ++ai)
#pragma unroll
            for (int m = 0; m < 4; ++m) {
                const f32x4 g0 = acc[ai][0][m][0] * ascale + bg0, g1 = acc[ai][0][m][1] * ascale + bg1, u0 = acc[ai][1][m][0] * ascale + bu0, u1 = acc[ai][1][m][1] * ascale + bu1;
                float r[8];
#pragma unroll
                for (int j = 0; j < 4; ++j) {
                    float gg = fminf(g0[j], 7.f), uu = fminf(fmaxf(u0[j], -7.f), 7.f); r[j] = 4.f * (uu + 1.f) * gg * __builtin_amdgcn_rcpf(1.f + __expf(-1.702f * gg));
                    gg = fminf(g1[j], 7.f); uu = fminf(fmaxf(u1[j], -7.f), 7.f); r[4 + j] = 4.f * (uu + 1.f) * gg * __builtin_amdgcn_rcpf(1.f + __expf(-1.702f * gg));
                }
                u32x2 w; w.x = pk4_fp8(r[0], r[1], r[2], r[3]); w.y = pk4_fp8(r[4], r[5], r[6], r[7]);
                *(u32x2*)(act + (size_t)(row0 + ai * HALF + m * 16) * EFF + c0) = w;
            }
    }
};
struct EpiDown {
    static constexpr bool PERM = true;
    bf16_t* y; const float* bd; const float* wrow; float ascale;
    __device__ __forceinline__ void operator()(const f32x4 (&acc)[2][2][4][2], const Unit& u, int wr, int wc, int fr, int fq) const {
        const int row0 = u.pm * BM + wr * 64 + fr, col0 = u.pn * BM + wc * 32 + 8 * fq;
        const float* bp = bd + (size_t)u.aux * DM + col0;
        const f32x4 b00 = *(const f32x4*)(bp), b01 = *(const f32x4*)(bp + 4), b10 = *(const f32x4*)(bp + HALF), b11 = *(const f32x4*)(bp + HALF + 4);
        float wv[8];
#pragma unroll
        for (int i = 0; i < 8; ++i) wv[i] = wrow[row0 + (i >> 2) * HALF + (i & 3) * 16];
#pragma unroll
        for (int ai = 0; ai < 2; ++ai)
#pragma unroll
            for (int m = 0; m < 4; ++m) {
                const int row = row0 + ai * HALF + m * 16; const float w = wv[ai * 4 + m];
                const f32x4 v00 = (acc[ai][0][m][0] * ascale + b00) * w, v01 = (acc[ai][0][m][1] * ascale + b01) * w, v10 = (acc[ai][1][m][0] * ascale + b10) * w, v11 = (acc[ai][1][m][1] * ascale + b11) * w;
                u32x4 w0, w1;
                w0.x = cvt_pk_bf16(v00[0], v00[1]); w0.y = cvt_pk_bf16(v00[2], v00[3]); w0.z = cvt_pk_bf16(v01[0], v01[1]); w0.w = cvt_pk_bf16(v01[2], v01[3]);
                w1.x = cvt_pk_bf16(v10[0], v10[1]); w1.y = cvt_pk_bf16(v10[2], v10[3]); w1.z = cvt_pk_bf16(v11[0], v11[1]); w1.w = cvt_pk_bf16(v11[2], v11[3]);
                bf16_t* rowp = y + (size_t)row * DM + col0;
                *(u32x4*)(rowp) = w0; *(u32x4*)(rowp + HALF) = w1;
            }
    }
};
}
namespace la {
__device__ __forceinline__ unsigned off_a(unsigned row, unsigned ch) { return 2048u * (row >> 3) + 512u * (ch >> 2) + 64u * (row & 7) + 16u * ((ch & 3) ^ ((row >> 2) & 3)); }
__device__ __forceinline__ unsigned r_base(int lane, int e) { const unsigned h = lane >> 5; return 2048u * ((lane & 31) >> 3) + 64u * (lane & 7) + 16u * ((2u * e + h) ^ ((lane >> 2) & 3)); }
__device__ __forceinline__ unsigned t_base(int lane, int t) { const unsigned h = lane >> 5, blk = (lane >> 4) & 1, q = (lane & 15) >> 2, p = lane & 3;
    return 2048u * h + 64u * (4u * t + q) + 16u * ((2u * blk + (p >> 1)) ^ (2u * h + t)) + 8u * (p & 1); }
__device__ __forceinline__ int crow(int r, int hi) { return (r & 3) + 8 * (r >> 2) + 4 * hi; }

__device__ __forceinline__ bf16x8 lds_r128(unsigned addr) { return *(const LAS bf16x8*)(uintptr_t)addr; }
__device__ __forceinline__ bf16x8 lds_tr_frag(unsigned a0, unsigned a1) {
    s16x4 x, y; asm volatile("ds_read_b64_tr_b16 %0, %2\n\tds_read_b64_tr_b16 %1, %3\n\ts_waitcnt lgkmcnt(0)" : "=&v"(x), "=&v"(y) : "v"(a0), "v"(a1) : "memory");
    return (bf16x8){x[0], x[1], x[2], x[3], y[0], y[1], y[2], y[3]};
}
__device__ __forceinline__ bf16x8 scale_frag(bf16x8 f, float s) {
    u32x4 w = __builtin_bit_cast(u32x4, f); u32x4 o;
    o.x = cvt_pk_bf16(bf_lo(w.x) * s, bf_hi(w.x) * s); o.y = cvt_pk_bf16(bf_lo(w.y) * s, bf_hi(w.y) * s);
    o.z = cvt_pk_bf16(bf_lo(w.z) * s, bf_hi(w.z) * s); o.w = cvt_pk_bf16(bf_lo(w.w) * s, bf_hi(w.w) * s);
    return __builtin_bit_cast(bf16x8, o);
}
template <int R, int NP, bool SCALE>
__device__ __forceinline__ void stage_tile(int tid, unsigned lds_base, const bf16_t* g, int ld, const LAS float* rowscale) {
    constexpr int RPI = 32 / NP, NIT = R / RPI;
    static_assert(RPI % 8 == 0 && R % RPI == 0, "stage_tile geometry");
    const int row0 = tid / (16 * NP), cc = tid % (16 * NP), pnl = cc >> 4, ch = cc & 15;
    const unsigned la0 = lds_base + pnl * (R * 256) + off_a(row0, ch), la1 = lds_base + pnl * (R * 256) + off_a(row0 + RPI, ch);
    const bf16_t* gp = g + (size_t)row0 * ld + cc * 8;
    const size_t gstep = (size_t)RPI * ld;
#pragma unroll
    for (int it = 0; it < NIT; ++it) {
        bf16x8 v = *(const bf16x8*)(gp + it * gstep);
        if (SCALE) v = scale_frag(v, rowscale[row0 + it * RPI]);
        const unsigned la = (RPI % 16 == 0) ? la0 + it * (RPI * 256) : ((it & 1) ? la1 + (it >> 1) * (2 * RPI * 256) : la0 + (it >> 1) * (2 * RPI * 256));
        *(LAS bf16x8*)(uintptr_t)la = v;
        if ((it & 3) == 3) FENCE();
    }
}
template <int R, int CW>
__device__ __forceinline__ void stage_tile_narrow(int tid, unsigned lds_base, const bf16_t* g, int ld) {
    static_assert(CW == 64 && R % 64 == 0, "stage_tile_narrow geometry");
    const int row0 = tid >> 3, ch = tid & 7;
    const unsigned la0 = lds_base + off_a(row0, ch);
    const bf16_t* gp = g + (size_t)row0 * ld + ch * 8;
#pragma unroll
    for (int it = 0; it < R / 64; ++it) *(LAS bf16x8*)(uintptr_t)(la0 + it * 16384) = *(const bf16x8*)(gp + (size_t)it * 64 * ld);
}

struct StateArgs {
    const bf16_t* K; int ldk;
    const bf16_t* V; int ldv;
    bf16_t* Cout; int ldc; size_t cstride;
    float* Nout;
    const float* alpha; const float* beta;
    float lgam; int dir;
};
template <int DK, int DVB, bool MLSTM>
__device__ __forceinline__ void state_unit(LAS unsigned char* lds, const StateArgs a) {
    constexpr int NDKB = DK / 32, NDVB = DVB / 32, BPW = (NDKB * NDVB) / 8, NPK = DK / 128;
    static_assert(BPW >= 1 && (NDKB == 8 || NDKB == 4), "state tile geometry");
    int tid = threadIdx.x; asm volatile("" : "+v"(tid));
    const int wid = __builtin_amdgcn_readfirstlane(tid >> 6), lane = tid & 63, r32 = lane & 31, hi = lane >> 5;
    const int dkb = wid % NDKB, dvb0 = (wid / NDKB) * BPW;
    const unsigned ldsb = (unsigned)(uintptr_t)lds;
    const unsigned KP = ldsb, VP = ldsb + NPK * 32768u, WT = VP + 32768u;
    LAS float* wtab = (LAS float*)(lds + NPK * 32768 + 32768);
    const unsigned tb0 = t_base(lane, 0), tb1 = t_base(lane, 1);
    f32x16 acc[BPW];
#pragma unroll
    for (int j = 0; j < BPW; ++j) acc[j] = (f32x16){};
    float nacc = 0.f;
#pragma unroll 1
    for (int ci = 0; ci < 32; ++ci) {
        const int c = a.dir ? 31 - ci : ci; const int t0 = c * 128;
        {
            bf16_t* co = a.Cout + (size_t)c * a.cstride;
#pragma unroll
            for (int j = 0; j < BPW; ++j)
#pragma unroll
                for (int r = 0; r < 16; ++r) co[(size_t)(32 * dkb + crow(r, hi)) * a.ldc + 32 * (dvb0 + j) + r32] = f2bf(acc[j][r]);
            if (MLSTM) { if (a.Nout && tid < DK) a.Nout[(size_t)c * DK + tid] = nacc; }
        }
        float eF;
        if (MLSTM) {
            const float F = a.alpha[t0 + (a.dir ? 0 : 127)];
            if (tid < 128) wtab[tid] = __expf(F - a.alpha[t0 + tid] + a.beta[t0 + tid]);
            eF = __expf(F);
        } else {
            if (tid < 128) { const int sp = a.dir ? 127 - tid : tid; wtab[tid] = __expf((float)(127 - sp) * a.lgam); }
            eF = __expf(128.f * a.lgam);
        }
        __syncthreads();
        stage_tile<128, NPK, true>(tid, KP, a.K + (size_t)t0 * a.ldk, a.ldk, wtab);
        if constexpr (DVB == 128) stage_tile<128, 1, false>(tid, VP, a.V + (size_t)t0 * a.ldv, a.ldv, nullptr);
        else stage_tile_narrow<128, DVB>(tid, VP, a.V + (size_t)t0 * a.ldv, a.ldv);
        __syncthreads();
#pragma unroll
        for (int j = 0; j < BPW; ++j)
#pragma unroll
            for (int r = 0; r < 16; ++r) acc[j][r] *= eF;
#pragma unroll
        for (int ks = 0; ks < 8; ++ks) {
            const unsigned ka = KP + (dkb >> 2) * 32768u + 4096u * ks + 512u * (dkb & 3);
            const bf16x8 af = lds_tr_frag(ka + tb0, ka + tb1);
#pragma unroll
            for (int j = 0; j < BPW; ++j) {
                const unsigned va = VP + 4096u * ks + 512u * (dvb0 + j);
                const bf16x8 bfr = lds_tr_frag(va + tb0, va + tb1);
                acc[j] = __builtin_amdgcn_mfma_f32_32x32x16_bf16(af, bfr, acc[j], 0, 0, 0);
            }
            FENCE();
        }
        if (MLSTM) {
            if (tid < DK) { float s = 0.f; const int pnl = tid >> 7, col = tid & 127;
                for (int p = 0; p < 128; ++p) s += bf2f(*(const LAS bf16_t*)(lds + pnl * 32768 + off_a(p, col >> 3) + (col & 7) * 2));
                nacc = eF * nacc + s; }
        }
        __syncthreads();
    }
    (void)WT;
}

struct OutArgs {
    const bf16_t* Q; int ldq;
    const bf16_t* K; int ldk;
    const bf16_t* V; int ldv;
    const bf16_t* Cf; const bf16_t* Cb;
    const float* Nf; const float* Nb;
    const float* af; const float* bfw; const float* ab; const float* bbw;
    float Mf, Mb;
    float lgf, lgb;
    const float* gain;
    const bf16_t* G; int ldg;
    bf16_t* Out; int ldo;
};
template <int DK, int DV, bool MLSTM>
__device__ __forceinline__ void out_unit(LAS unsigned char* lds, LAS unsigned char* ldstab, const OutArgs a) {
    constexpr int NPK = DK / 128, NB = DV / 64, NPV = DV / 128, NKS = DK / 16, NCP = DK / 64;
    int tid = threadIdx.x; asm volatile("" : "+v"(tid));
    const int wid = __builtin_amdgcn_readfirstlane(tid >> 6), lane = tid & 63, r32 = lane & 31, hi = lane >> 5;
    const int rb = wid & 3, dh = wid >> 2;
    const unsigned ldsb = (unsigned)(uintptr_t)lds;
    const unsigned QP = ldsb, KP = ldsb + NPK * 32768u, SB = KP;
    LAS float* akf = (LAS float*)ldstab; LAS float* akb = akf + 128; LAS float* nf = akb + 128; LAS float* nbv = nf + 256; LAS float* exch = nbv + 256;
    const unsigned rb0 = r_base(lane, 0), rb1 = r_base(lane, 1), tb0 = t_base(lane, 0), tb1 = t_base(lane, 1);
    __syncthreads();
    stage_tile<128, NPK, false>(tid, QP, a.Q, a.ldq, nullptr);
    stage_tile<128, NPK, false>(tid, KP, a.K, a.ldk, nullptr);
    if (tid < 128) {
        if (MLSTM) { akf[tid] = a.af[tid] - a.bfw[tid]; akb[tid] = a.ab[tid] - a.bbw[tid]; }
        else { akf[tid] = (float)(tid + 1) * a.lgf; akb[tid] = (float)(128 - tid) * a.lgb; }
    }
    if (MLSTM) { if (tid < DK) { nf[tid] = a.Nf[tid]; nbv[tid] = a.Nb[tid]; } }
    const int l = 32 * rb + r32;
    float a_fl, a_bl;
    if (MLSTM) { a_fl = a.af[l]; a_bl = a.ab[l]; } else { a_fl = (float)(l + 1) * a.lgf; a_bl = (float)(128 - l) * a.lgb; }
    __syncthreads();
    f32x16 p[4];
#pragma unroll
    for (int kb = 0; kb < 4; ++kb) p[kb] = (f32x16){};
    float qnf = 0.f, qnb = 0.f;
#pragma unroll
    for (int ks = 0; ks < NKS; ++ks) {
        const unsigned po = (ks >> 3) * 32768u + ((ks & 1) ? rb1 : rb0) + 512u * ((ks & 7) >> 1);
        const bf16x8 qf = lds_r128(QP + po + 8192u * rb);
        bf16x8 kf[4];
#pragma unroll
        for (int kb = 0; kb < 4; ++kb) kf[kb] = lds_r128(KP + po + 8192u * kb);
#pragma unroll
        for (int kb = 0; kb < 4; ++kb) p[kb] = __builtin_amdgcn_mfma_f32_32x32x16_bf16(kf[kb], qf, p[kb], 0, 0, 0);
        FENCE();
    }
    if (MLSTM) {
#pragma unroll 1
        for (int ks = 0; ks < NKS; ++ks) {
            const bf16x8 qf = lds_r128(QP + (ks >> 3) * 32768u + ((ks & 1) ? rb1 : rb0) + 512u * ((ks & 7) >> 1) + 8192u * rb);
            const u32x4 w = __builtin_bit_cast(u32x4, qf); const int k0 = 16 * ks + 8 * hi;
            const f32x4 nf0 = *(const LAS f32x4*)(nf + k0), nf1 = *(const LAS f32x4*)(nf + k0 + 4), nb0 = *(const LAS f32x4*)(nbv + k0), nb1 = *(const LAS f32x4*)(nbv + k0 + 4);
            const float q0 = bf_lo(w.x), q1 = bf_hi(w.x), q2 = bf_lo(w.y), q3 = bf_hi(w.y), q4 = bf_lo(w.z), q5 = bf_hi(w.z), q6 = bf_lo(w.w), q7 = bf_hi(w.w);
            qnf += q0 * nf0[0] + q1 * nf0[1] + q2 * nf0[2] + q3 * nf0[3] + q4 * nf1[0] + q5 * nf1[1] + q6 * nf1[2] + q7 * nf1[3];
            qnb += q0 * nb0[0] + q1 * nb0[1] + q2 * nb0[2] + q3 * nb0[3] + q4 * nb1[0] + q5 * nb1[1] + q6 * nb1[2] + q7 * nb1[3];
        }
    }
    float rf = 1.f, rbk = 1.f;
    if (MLSTM) {
        float df = 0.f, db = 0.f;
#pragma unroll
        for (int kb = 0; kb < 4; ++kb) {
#pragma unroll
            for (int r = 0; r < 16; ++r) { const int s = 32 * kb + crow(r, hi);
                const float xf = a_fl - akf[s], xb = a_bl - akb[s];
                const float wf = __expf((s <= l) ? xf : -1.0e30f), wb = __expf((s >= l) ? xb : -1.0e30f);
                df += p[kb][r] * wf; db += p[kb][r] * wb; }
            FENCE(); }
        { auto rr = __builtin_amdgcn_permlane32_swap(__float_as_uint(df), __float_as_uint(df), false, false); df = __uint_as_float(rr[0]) + __uint_as_float(rr[1]); }
        { auto rr = __builtin_amdgcn_permlane32_swap(__float_as_uint(db), __float_as_uint(db), false, false); db = __uint_as_float(rr[0]) + __uint_as_float(rr[1]); }
        { auto rr = __builtin_amdgcn_permlane32_swap(__float_as_uint(qnf), __float_as_uint(qnf), false, false); qnf = __uint_as_float(rr[0]) + __uint_as_float(rr[1]); }
        { auto rr = __builtin_amdgcn_permlane32_swap(__float_as_uint(qnb), __float_as_uint(qnb), false, false); qnb = __uint_as_float(rr[0]) + __uint_as_float(rr[1]); }
        df += __expf(a_fl) * qnf; db += __expf(a_bl) * qnb;
        rf = 1.f / fmaxf(fabsf(df), __expf(-a.Mf)); rbk = 1.f / fmaxf(fabsf(db), __expf(-a.Mb));
        asm volatile("" : "+v"(a_fl), "+v"(a_bl));
    }
    int l2 = l; asm volatile("" : "+v"(l2));
#pragma unroll
    for (int kb = 0; kb < 4; ++kb) {
#pragma unroll
        for (int r = 0; r < 16; ++r) { const int s = 32 * kb + crow(r, hi);
            const float xf = a_fl - akf[s], xb = a_bl - akb[s];
            const float wf = __expf((s <= l2) ? xf : -1.0e30f), wb = __expf((s >= l2) ? xb : -1.0e30f);
            p[kb][r] *= (wf * rf + wb * rbk); }
        FENCE(); }
    const float qsf = __expf(a_fl) * rf, qsb = __expf(a_bl) * rbk;
    bf16x8 pa[8];
#define LA_PK4(P, BASE, OUT) do { unsigned a0 = cvt_pk_bf16(P[BASE + 0], P[BASE + 1]), a1 = cvt_pk_bf16(P[BASE + 2], P[BASE + 3]); \
    unsigned b0 = cvt_pk_bf16(P[BASE + 4], P[BASE + 5]), b1 = cvt_pk_bf16(P[BASE + 6], P[BASE + 7]); \
    auto r0 = __builtin_amdgcn_permlane32_swap(a0, b0, false, false); auto r1 = __builtin_amdgcn_permlane32_swap(a1, b1, false, false); \
    u32x4 w = {r0[0], r1[0], r0[1], r1[1]}; OUT = __builtin_bit_cast(bf16x8, w); } while (0)
#pragma unroll
    for (int kb = 0; kb < 4; ++kb) { LA_PK4(p[kb], 0, pa[2 * kb]); LA_PK4(p[kb], 8, pa[2 * kb + 1]); }
#undef LA_PK4
    f32x16 o[NB];
#pragma unroll
    for (int nb = 0; nb < NB; ++nb) o[nb] = (f32x16){};
#pragma unroll
    for (int pc = 0; pc < 2; ++pc) {
        __syncthreads();
        stage_tile<64, NPV, false>(tid, SB, a.V + (size_t)(64 * pc) * a.ldv, a.ldv, nullptr);
        __syncthreads();
#pragma unroll
        for (int ks = 0; ks < 4; ++ks) {
            const bf16x8 af = pa[4 * pc + ks];
#pragma unroll
            for (int nb = 0; nb < NB; ++nb) { const int cg = dh * NB + nb; const unsigned va = SB + (cg >> 2) * 16384u + 4096u * ks + 512u * (cg & 3);
                const bf16x8 bfr = lds_tr_frag(va + tb0, va + tb1);
                o[nb] = __builtin_amdgcn_mfma_f32_32x32x16_bf16(af, bfr, o[nb], 0, 0, 0); }
            FENCE();
        }
    }
#pragma unroll 1
    for (int pc = 0; pc < 2 * NCP; ++pc) {
        __syncthreads();
        const int dirb = pc >= NCP, cp = dirb ? pc - NCP : pc;
        const bf16_t* src = (dirb ? a.Cb : a.Cf) + (size_t)(64 * cp) * DV;
        const float qs = dirb ? qsb : qsf;
        stage_tile<64, NPV, false>(tid, SB, src, DV, nullptr);
        __syncthreads();
#pragma unroll
        for (int ks = 0; ks < 4; ++ks) {
            const int kq = 4 * cp + ks;
            const bf16x8 qf = lds_r128(QP + (kq >> 3) * 32768u + ((kq & 1) ? rb1 : rb0) + 512u * ((kq & 7) >> 1) + 8192u * rb);
            const bf16x8 af = scale_frag(qf, qs);
#pragma unroll
            for (int nb = 0; nb < NB; ++nb) { const int cg = dh * NB + nb; const unsigned va = SB + (cg >> 2) * 16384u + 4096u * ks + 512u * (cg & 3);
                const bf16x8 bfr = lds_tr_frag(va + tb0, va + tb1);
                o[nb] = __builtin_amdgcn_mfma_f32_32x32x16_bf16(af, bfr, o[nb], 0, 0, 0); }
            FENCE();
        }
    }
    float s1[16], s2[16];
#pragma unroll
    for (int r = 0; r < 16; ++r) { float x1 = 0.f, x2 = 0.f;
#pragma unroll
        for (int nb = 0; nb < NB; ++nb) { x1 += o[nb][r]; x2 += o[nb][r] * o[nb][r]; }
#pragma unroll
        for (int m = 1; m < 32; m <<= 1) { x1 += shx(x1, m, lane); x2 += shx(x2, m, lane); }
        s1[r] = x1; s2[r] = x2; }
    if (r32 == 0) {
#pragma unroll
        for (int r = 0; r < 16; ++r) { const int row = 32 * rb + crow(r, hi); exch[(dh * 128 + row) * 2] = s1[r]; exch[(dh * 128 + row) * 2 + 1] = s2[r]; }
    }
    __syncthreads();
#pragma unroll
    for (int r = 0; r < 16; ++r) {
        const int row = 32 * rb + crow(r, hi);
        const float t1 = s1[r] + exch[((1 - dh) * 128 + row) * 2], t2 = s2[r] + exch[((1 - dh) * 128 + row) * 2 + 1];
        float mean, inv;
        if (MLSTM) { mean = 0.f; inv = rsqrtf(t2 * (1.f / DV) + EPS); }
        else { mean = t1 * (1.f / DV); inv = rsqrtf(fmaxf(t2 * (1.f / DV) - mean * mean, 0.f) + EPS); }
#pragma unroll
        for (int nb = 0; nb < NB; ++nb) {
            const int col = dh * (DV / 2) + 32 * nb + r32;
            const float gpre = bf2f(a.G[(size_t)row * a.ldg + col]);
            const float gate = MLSTM ? sigmoidf_(gpre) : siluf_(gpre);
            a.Out[(size_t)row * a.ldo + col] = f2bf((o[nb][r] - mean) * inv * a.gain[col] * gate);
        }
    }
}

template <int R, int NP>
__device__ __forceinline__ void dma_tile(int wid, int lane, unsigned lds_base, const bf16_t* src, int ld) {
    constexpr int NQ = R * NP / 4, PER = NQ / 8;
    static_assert(NQ % 8 == 0 && R % 8 == 0, "dma_tile geometry");
    const int r7 = (lane >> 2) & 7, x = lane & 3, hi = lane >> 5;
#pragma unroll
    for (int j = 0; j < PER; ++j) {
        const int q = wid * PER + j;
        const int sub = 2 * q + hi, panel = sub / (R / 2), psub = sub % (R / 2), rg = psub >> 2, cblk = psub & 3;
        const int row = 8 * rg + r7, chlo = x ^ ((row >> 2) & 3);
        const bf16_t* g = src + (size_t)row * ld + 128 * panel + 32 * cblk + 8 * chlo;
        __builtin_amdgcn_global_load_lds((const unsigned*)g, (LAS unsigned*)(uintptr_t)(lds_base + q * 1024u), 16, 0, 0);
    }
}
template <int R>
__device__ __forceinline__ void dma_tile_n64(int wid, int lane, unsigned lds_base, const bf16_t* src, int ld) {
    static_assert(R == 64, "dma_tile_n64 geometry");
    const int r7 = (lane >> 2) & 7, x = lane & 3, hi = lane >> 5;
    const int row = 8 * wid + r7, chlo = x ^ ((row >> 2) & 3);
    const bf16_t* g = src + (size_t)row * ld + 32 * hi + 8 * chlo;
    __builtin_amdgcn_global_load_lds((const unsigned*)g, (LAS unsigned*)(uintptr_t)(lds_base + wid * 2048u), 16, 0, 0);
}
template <int OFF> __device__ __forceinline__ s16x4 tr_rd(unsigned base) { s16x4 r; asm volatile("ds_read_b64_tr_b16 %0, %1 offset:%2" : "=&v"(r) : "v"(base), "i"(OFF) : "memory"); return r; }
#define LA_LGKM0() do { asm volatile("s_waitcnt lgkmcnt(0)" ::: "memory"); __builtin_amdgcn_sched_barrier(0); } while (0)
#define LA_FRAG(L, H) (bf16x8){L[0], L[1], L[2], L[3], H[0], H[1], H[2], H[3]}
template <int NBLK>
__device__ __forceinline__ void store_blocks_t(LAS unsigned char* ts, int lane, const f32x16* blk, bf16_t* dst, int ldd) {
    constexpr int RB = 64 * NBLK;
    const int r32 = lane & 31, hi = lane >> 5;
#pragma unroll
    for (int j = 0; j < NBLK; ++j)
#pragma unroll
        for (int r = 0; r < 16; ++r) *(LAS bf16_t*)(ts + crow(r, hi) * RB + (32 * j + r32) * 2) = f2bf(blk[j][r]);
    LDS_WAIT();
    constexpr int CPR = 4 * NBLK, NCH = 32 * CPR;
#pragma unroll
    for (int it = 0; it < NCH / 64; ++it) { const int id = it * 64 + lane, row = id / CPR, ch = id % CPR;
        *(u32x4*)(dst + (size_t)row * ldd + 8 * ch) = *(const LAS u32x4*)(ts + row * RB + ch * 16); }
    LDS_WAIT();
}

template <int DK, int DVB, bool MLSTM>
__device__ __forceinline__ void state_unit2(LAS unsigned char* lds, LAS unsigned char* ldstab, const StateArgs a, const int wv) {
    constexpr int NDKB = DK / 32, NDVB = DVB / 32, BPW = (NDKB * NDVB) / 8, NPK = DK / 128;
    constexpr unsigned BUFSZ = (NPK + 1) * 16384u, VOFF = NPK * 16384u, TSOFF = 2 * BUFSZ;
    static_assert(TSOFF + 8 * 4096u <= 131072u, "state pass LDS map stays below the control words");
    static_assert(BPW >= 1 && (NDKB == 8 || NDKB == 4) && (DVB == 128 || DVB == 64), "state tile geometry");
    int tid = TIDX(wv); asm volatile("" : "+v"(tid));
    const int wid = __builtin_amdgcn_readfirstlane(tid >> 6), lane = tid & 63, hi = lane >> 5;
    const int dkb = wid % NDKB, dvb0 = (wid / NDKB) * BPW;
    const unsigned ldsb = (unsigned)(uintptr_t)lds;
    LAS float* wtab = (LAS float*)ldstab;
    LAS unsigned char* ts = lds + TSOFF + wid * 4096;
    const unsigned tbA0 = t_base(lane, 0) + (dkb >> 2) * 16384u + 512u * (dkb & 3), tbA1 = t_base(lane, 1) + (dkb >> 2) * 16384u + 512u * (dkb & 3);
    const unsigned tbB0 = t_base(lane, 0) + VOFF + 512u * dvb0, tbB1 = t_base(lane, 1) + VOFF + 512u * dvb0;
    f32x16 acc[BPW];
#pragma unroll
    for (int j = 0; j < BPW; ++j) acc[j] = (f32x16){};
    float nacc = 0.f;
    __syncthreads();
#define ST_DMA(hs_) do { const int c_ = a.dir ? 31 - ((hs_) >> 1) : ((hs_) >> 1); const int t_ = c_ * 128 + 64 * ((hs_) & 1); const unsigned bb_ = ldsb + ((hs_) & 1) * BUFSZ; \
        dma_tile<64, NPK>(wid, lane, bb_, a.K + (size_t)t_ * a.ldk, a.ldk); \
        if constexpr (DVB == 128) dma_tile<64, 1>(wid, lane, bb_ + VOFF, a.V + (size_t)t_ * a.ldv, a.ldv); else dma_tile_n64<64>(wid, lane, bb_ + VOFF, a.V + (size_t)t_ * a.ldv, a.ldv); } while (0)
    ST_DMA(0);
    float eF = 1.f;
#pragma unroll 1
    for (int hs = 0; hs < 64; ++hs) {
        const int ci = hs >> 1, half = hs & 1, c = a.dir ? 31 - ci : ci, t0 = c * 128;
        LAS float* wt = wtab + (ci & 1) * 128;
        if (half == 0) {
            bf16_t* co = a.Cout + (size_t)c * a.cstride + (size_t)(32 * dkb) * a.ldc + 32 * dvb0;
            if constexpr (BPW == 4) { store_blocks_t<2>(ts, lane, acc, co, a.ldc); store_blocks_t<2>(ts, lane, acc + 2, co + 64, a.ldc); }
            else store_blocks_t<1>(ts, lane, acc, co, a.ldc);
            if (MLSTM) { if (a.Nout && tid < DK) a.Nout[(size_t)c * DK + tid] = nacc; }
            if (MLSTM) { const float F = a.alpha[t0 + (a.dir ? 0 : 127)];
                if (tid < 128) wt[tid] = __expf(F - a.alpha[t0 + tid] + a.beta[t0 + tid]);
                eF = __expf(F);
            } else {
                if (tid < 128) { const int sp = a.dir ? 127 - tid : tid; wt[tid] = __expf((float)(127 - sp) * a.lgam); }
                eF = __expf(128.f * a.lgam);
            }
        }
        VM_WAIT(); __syncthreads();
        if (hs + 1 < 64) ST_DMA(hs + 1);
        if (half == 0) {
#pragma unroll
            for (int j = 0; j < BPW; ++j)
#pragma unroll
                for (int r = 0; r < 16; ++r) acc[j][r] *= eF;
        }
        const unsigned bb = ldsb + half * BUFSZ;
        const unsigned a0 = bb + tbA0, a1 = bb + tbA1, b0 = bb + tbB0, b1 = bb + tbB1;
        const LAS float* wk = wt + 64 * half + 8 * hi;
#define ST_KS(KS) do { \
            const s16x4 al = tr_rd<4096 * (KS)>(a0), ah = tr_rd<4096 * (KS)>(a1); \
            s16x4 bl[BPW], bh[BPW]; \
            bl[0] = tr_rd<4096 * (KS)>(b0); bh[0] = tr_rd<4096 * (KS)>(b1); \
            if constexpr (BPW == 4) { bl[1] = tr_rd<4096 * (KS) + 512>(b0); bh[1] = tr_rd<4096 * (KS) + 512>(b1); bl[2] = tr_rd<4096 * (KS) + 1024>(b0); bh[2] = tr_rd<4096 * (KS) + 1024>(b1); \
                bl[3] = tr_rd<4096 * (KS) + 1536>(b0); bh[3] = tr_rd<4096 * (KS) + 1536>(b1); } \
            const f32x4 w0 = *(const LAS f32x4*)(wk + 16 * (KS)), w1 = *(const LAS f32x4*)(wk + 16 * (KS) + 4); \
            LA_LGKM0(); \
            u32x4 af; af.x = cvt_pk_bf16(bf2f((bf16_t)al[0]) * w0[0], bf2f((bf16_t)al[1]) * w0[1]); af.y = cvt_pk_bf16(bf2f((bf16_t)al[2]) * w0[2], bf2f((bf16_t)al[3]) * w0[3]); \
            af.z = cvt_pk_bf16(bf2f((bf16_t)ah[0]) * w1[0], bf2f((bf16_t)ah[1]) * w1[1]); af.w = cvt_pk_bf16(bf2f((bf16_t)ah[2]) * w1[2], bf2f((bf16_t)ah[3]) * w1[3]); \
            const bf16x8 afr = __builtin_bit_cast(bf16x8, af); \
            _Pragma("unroll") for (int j = 0; j < BPW; ++j) acc[j] = __builtin_amdgcn_mfma_f32_32x32x16_bf16(afr, LA_FRAG(bl[j], bh[j]), acc[j], 0, 0, 0); \
        } while (0)
        ST_KS(0); ST_KS(1); ST_KS(2); ST_KS(3);
#undef ST_KS
        if (MLSTM) {
            if (tid < DK) { float s = 0.f; const int pnl = tid >> 7, col = tid & 127; const LAS unsigned char* kp = lds + half * BUFSZ + pnl * 16384 + (col & 7) * 2;
                for (int p = 0; p < 64; ++p) s += bf2f(*(const LAS bf16_t*)(kp + off_a(p, col >> 3))) * wt[64 * half + p];
                nacc = (half == 0 ? eF * nacc : nacc) + s; }
        }
    }
#undef ST_DMA
    __syncthreads();
}

template <int DK, int DV, bool MLSTM>
__device__ __forceinline__ void out_unit2(LAS unsigned char* lds, LAS unsigned char* ldstab, const OutArgs a, const int wv) {
    constexpr int NPK = DK / 128, NB = DV / 64, NPV = DV / 128, NKS = DK / 16, NCP = DK / 32;
    constexpr unsigned PANEL = 32 * 256, PIECE = NPV * PANEL;
    static_assert(2 * PIECE <= NPK * 32768u && (NB == 8 || NB == 2), "stream buffers fit the K region");
    int tid = TIDX(wv); asm volatile("" : "+v"(tid));
    const int wid = __builtin_amdgcn_readfirstlane(tid >> 6), lane = tid & 63, r32 = lane & 31, hi = lane >> 5;
    const int rb = wid & 3, dh = wid >> 2;
    const unsigned ldsb = (unsigned)(uintptr_t)lds;
    const unsigned QP = ldsb, KP = ldsb + NPK * 32768u, SB = KP;
    LAS float* akf = (LAS float*)ldstab; LAS float* akb = akf + 128; LAS float* nf = akb + 128; LAS float* nbv = nf + 256; LAS float* exch = nbv + 256;
    const unsigned rb0 = r_base(lane, 0);
#define rb1 (rb0 ^ 32u)
    const unsigned dhoff = (NB == 8) ? dh * 2u * PANEL : dh * 1024u;
    const unsigned tb0 = t_base(lane, 0) + dhoff;
#define tb1 ((tb0 ^ 16u) + 256u)
    __syncthreads();
    dma_tile<128, NPK>(wid, lane, QP, a.Q, a.ldq);
    dma_tile<128, NPK>(wid, lane, KP, a.K, a.ldk);
    if (tid < 128) {
        if (MLSTM) { akf[tid] = a.af[tid] - a.bfw[tid]; akb[tid] = a.ab[tid] - a.bbw[tid]; }
        else { akf[tid] = (float)(tid + 1) * a.lgf; akb[tid] = (float)(128 - tid) * a.lgb; }
    }
    if (MLSTM) { if (tid < DK) { nf[tid] = a.Nf[tid]; nbv[tid] = a.Nb[tid]; } }
    const int l = 32 * rb + r32;
    float a_fl, a_bl;
    if (MLSTM) { a_fl = a.af[l]; a_bl = a.ab[l]; } else { a_fl = (float)(l + 1) * a.lgf; a_bl = (float)(128 - l) * a.lgb; }
    VM_WAIT(); __syncthreads();
    f32x16 p[4];
#pragma unroll
    for (int kb = 0; kb < 4; ++kb) p[kb] = (f32x16){};
    float qnf = 0.f, qnb = 0.f;
#pragma unroll
    for (int ks = 0; ks < NKS; ++ks) {
        const unsigned po = (ks >> 3) * 32768u + ((ks & 1) ? rb1 : rb0) + 512u * ((ks & 7) >> 1);
        const bf16x8 qf = lds_r128(QP + po + 8192u * rb);
        bf16x8 kf[4];
#pragma unroll
        for (int kb = 0; kb < 4; ++kb) kf[kb] = lds_r128(KP + po + 8192u * kb);
#pragma unroll
        for (int kb = 0; kb < 4; ++kb) p[kb] = __builtin_amdgcn_mfma_f32_32x32x16_bf16(kf[kb], qf, p[kb], 0, 0, 0);
        FENCE();
    }
    if (MLSTM) {
#pragma unroll 1
        for (int ks = 0; ks < NKS; ++ks) {
            const bf16x8 qf = lds_r128(QP + (ks >> 3) * 32768u + ((ks & 1) ? rb1 : rb0) + 512u * ((ks & 7) >> 1) + 8192u * rb);
            const u32x4 w = __builtin_bit_cast(u32x4, qf); const int k0 = 16 * ks + 8 * hi;
            const f32x4 nf0 = *(const LAS f32x4*)(nf + k0), nf1 = *(const LAS f32x4*)(nf + k0 + 4), nb0 = *(const LAS f32x4*)(nbv + k0), nb1 = *(const LAS f32x4*)(nbv + k0 + 4);
            const float q0 = bf_lo(w.x), q1 = bf_hi(w.x), q2 = bf_lo(w.y), q3 = bf_hi(w.y), q4 = bf_lo(w.z), q5 = bf_hi(w.z), q6 = bf_lo(w.w), q7 = bf_hi(w.w);
            qnf += q0 * nf0[0] + q1 * nf0[1] + q2 * nf0[2] + q3 * nf0[3] + q4 * nf1[0] + q5 * nf1[1] + q6 * nf1[2] + q7 * nf1[3];
            qnb += q0 * nb0[0] + q1 * nb0[1] + q2 * nb0[2] + q3 * nb0[3] + q4 * nb1[0] + q5 * nb1[1] + q6 * nb1[2] + q7 * nb1[3];
        }
    }
    __syncthreads();
    dma_tile<32, NPV>(wid, lane, SB, a.V, a.ldv);
    float rf = 1.f, rbk = 1.f;
    if (MLSTM) {
        float df = 0.f, db = 0.f;
#pragma unroll
        for (int kb = 0; kb < 4; ++kb) {
#pragma unroll
            for (int r = 0; r < 16; ++r) { const int s = 32 * kb + crow(r, hi);
                const float xf = a_fl - akf[s], xb = a_bl - akb[s];
                const float wf = __expf((s <= l) ? xf : -1.0e30f), wb = __expf((s >= l) ? xb : -1.0e30f);
                df += p[kb][r] * wf; db += p[kb][r] * wb; }
            FENCE(); }
        { auto rr = __builtin_amdgcn_permlane32_swap(__float_as_uint(df), __float_as_uint(df), false, false); df = __uint_as_float(rr[0]) + __uint_as_float(rr[1]); }
        { auto rr = __builtin_amdgcn_permlane32_swap(__float_as_uint(db), __float_as_uint(db), false, false); db = __uint_as_float(rr[0]) + __uint_as_float(rr[1]); }
        { auto rr = __builtin_amdgcn_permlane32_swap(__float_as_uint(qnf), __float_as_uint(qnf), false, false); qnf = __uint_as_float(rr[0]) + __uint_as_float(rr[1]); }
        { auto rr = __builtin_amdgcn_permlane32_swap(__float_as_uint(qnb), __float_as_uint(qnb), false, false); qnb = __uint_as_float(rr[0]) + __uint_as_float(rr[1]); }
        df += __expf(a_fl) * qnf; db += __expf(a_bl) * qnb;
        rf = 1.f / fmaxf(fabsf(df), __expf(-a.Mf)); rbk = 1.f / fmaxf(fabsf(db), __expf(-a.Mb));
        asm volatile("" : "+v"(a_fl), "+v"(a_bl));
    }
    int l2 = l; asm volatile("" : "+v"(l2));
#pragma unroll
    for (int kb = 0; kb < 4; ++kb) {
#pragma unroll
        for (int r = 0; r < 16; ++r) { const int s = 32 * kb + crow(r, hi);
            const float xf = a_fl - akf[s], xb = a_bl - akb[s];
            const float wf = __expf((s <= l2) ? xf : -1.0e30f), wb = __expf((s >= l2) ? xb : -1.0e30f);
            p[kb][r] *= (wf * rf + wb * rbk); }
        FENCE(); }
    const float qsf = __expf(a_fl) * rf, qsb = __expf(a_bl) * rbk;
    bf16x8 pa[8];
#define LA_PK4(P, BASE, OUT) do { unsigned a0 = cvt_pk_bf16(P[BASE + 0], P[BASE + 1]), a1 = cvt_pk_bf16(P[BASE + 2], P[BASE + 3]); \
    unsigned b0 = cvt_pk_bf16(P[BASE + 4], P[BASE + 5]), b1 = cvt_pk_bf16(P[BASE + 6], P[BASE + 7]); \
    auto r0 = __builtin_amdgcn_permlane32_swap(a0, b0, false, false); auto r1 = __builtin_amdgcn_permlane32_swap(a1, b1, false, false); \
    u32x4 w = {r0[0], r1[0], r0[1], r1[1]}; OUT = __builtin_bit_cast(bf16x8, w); } while (0)
#pragma unroll
    for (int kb = 0; kb < 4; ++kb) { LA_PK4(p[kb], 0, pa[2 * kb]); LA_PK4(p[kb], 8, pa[2 * kb + 1]); }
#undef LA_PK4
    f32x16 o[NB];
#pragma unroll
    for (int nb = 0; nb < NB; ++nb) o[nb] = (f32x16){};
#define OUT_DMA(pc_) do { const int n_ = (pc_); const unsigned bb_ = SB + (n_ & 1) * PIECE; \
        if (n_ < 4) dma_tile<32, NPV>(wid, lane, bb_, a.V + (size_t)(32 * n_) * a.ldv, a.ldv); \
        else if (n_ < 4 + NCP) dma_tile<32, NPV>(wid, lane, bb_, a.Cf + (size_t)(32 * (n_ - 4)) * DV, DV); \
        else dma_tile<32, NPV>(wid, lane, bb_, a.Cb + (size_t)(32 * (n_ - 4 - NCP)) * DV, DV); } while (0)
#define OUT_MMA(bufpar) do { const unsigned b0_ = SB + (bufpar) * PIECE + tb0, b1_ = SB + (bufpar) * PIECE + tb1; \
        if constexpr (NB == 8) { \
            _Pragma("unroll") for (int g_ = 0; g_ < 2; ++g_) { const unsigned c0_ = b0_ + g_ * PANEL, c1_ = b1_ + g_ * PANEL; \
                { const s16x4 l0 = tr_rd<0>(c0_), h0 = tr_rd<0>(c1_), l1 = tr_rd<512>(c0_), h1 = tr_rd<512>(c1_), l2_ = tr_rd<1024>(c0_), h2 = tr_rd<1024>(c1_), l3 = tr_rd<1536>(c0_), h3 = tr_rd<1536>(c1_); LA_LGKM0(); \
                  o[4 * g_ + 0] = __builtin_amdgcn_mfma_f32_32x32x16_bf16(af0, LA_FRAG(l0, h0), o[4 * g_ + 0], 0, 0, 0); o[4 * g_ + 1] = __builtin_amdgcn_mfma_f32_32x32x16_bf16(af0, LA_FRAG(l1, h1), o[4 * g_ + 1], 0, 0, 0); \
                  o[4 * g_ + 2] = __builtin_amdgcn_mfma_f32_32x32x16_bf16(af0, LA_FRAG(l2_, h2), o[4 * g_ + 2], 0, 0, 0); o[4 * g_ + 3] = __builtin_amdgcn_mfma_f32_32x32x16_bf16(af0, LA_FRAG(l3, h3), o[4 * g_ + 3], 0, 0, 0); } \
                { const s16x4 l0 = tr_rd<4096>(c0_), h0 = tr_rd<4096>(c1_), l1 = tr_rd<4608>(c0_), h1 = tr_rd<4608>(c1_), l2_ = tr_rd<5120>(c0_), h2 = tr_rd<5120>(c1_), l3 = tr_rd<5632>(c0_), h3 = tr_rd<5632>(c1_); LA_LGKM0(); \
                  o[4 * g_ + 0] = __builtin_amdgcn_mfma_f32_32x32x16_bf16(af1, LA_FRAG(l0, h0), o[4 * g_ + 0], 0, 0, 0); o[4 * g_ + 1] = __builtin_amdgcn_mfma_f32_32x32x16_bf16(af1, LA_FRAG(l1, h1), o[4 * g_ + 1], 0, 0, 0); \
                  o[4 * g_ + 2] = __builtin_amdgcn_mfma_f32_32x32x16_bf16(af1, LA_FRAG(l2_, h2), o[4 * g_ + 2], 0, 0, 0); o[4 * g_ + 3] = __builtin_amdgcn_mfma_f32_32x32x16_bf16(af1, LA_FRAG(l3, h3), o[4 * g_ + 3], 0, 0, 0); } } \
        } else { \
            const s16x4 l0 = tr_rd<0>(b0_), h0 = tr_rd<0>(b1_), l1 = tr_rd<512>(b0_), h1 = tr_rd<512>(b1_), l2_ = tr_rd<4096>(b0_), h2 = tr_rd<4096>(b1_), l3 = tr_rd<4608>(b0_), h3 = tr_rd<4608>(b1_); LA_LGKM0(); \
            o[0] = __builtin_amdgcn_mfma_f32_32x32x16_bf16(af0, LA_FRAG(l0, h0), o[0], 0, 0, 0); o[1] = __builtin_amdgcn_mfma_f32_32x32x16_bf16(af0, LA_FRAG(l1, h1), o[1], 0, 0, 0); \
            o[0] = __builtin_amdgcn_mfma_f32_32x32x16_bf16(af1, LA_FRAG(l2_, h2), o[0], 0, 0, 0); o[1] = __builtin_amdgcn_mfma_f32_32x32x16_bf16(af1, LA_FRAG(l3, h3), o[1], 0, 0, 0); } } while (0)
#pragma unroll
    for (int pc = 0; pc < 4; ++pc) {
        VM_WAIT(); __syncthreads();
        OUT_DMA(pc + 1);
        const bf16x8 af0 = pa[2 * pc], af1 = pa[2 * pc + 1];
        OUT_MMA(pc & 1);
    }
#pragma unroll 1
    for (int pc = 4; pc < 4 + 2 * NCP; ++pc) {
        VM_WAIT(); __syncthreads();
        if (pc + 1 < 4 + 2 * NCP) OUT_DMA(pc + 1);
        const int cq = pc - 4, dirb = cq >= NCP, cp = dirb ? cq - NCP : cq;
        const float qs = dirb ? qsb : qsf;
        const unsigned qa = QP + (cp >> 2) * 32768u + 512u * (cp & 3) + 8192u * rb;
        const bf16x8 af0 = scale_frag(lds_r128(qa + rb0), qs), af1 = scale_frag(lds_r128(qa + rb1), qs);
        OUT_MMA(pc & 1);
    }
#undef OUT_DMA
#undef OUT_MMA
    float s1[16], s2[16];
#pragma unroll
    for (int r = 0; r < 16; ++r) { float x1 = 0.f, x2 = 0.f;
#pragma unroll
        for (int nb = 0; nb < NB; ++nb) { x1 += o[nb][r]; x2 += o[nb][r] * o[nb][r]; }
#pragma unroll
        for (int m = 1; m < 32; m <<= 1) { x1 += shx(x1, m, lane); x2 += shx(x2, m, lane); }
        s1[r] = x1; s2[r] = x2; }
    if (r32 == 0) {
#pragma unroll
        for (int r = 0; r < 16; ++r) { const int row = 32 * rb + crow(r, hi); exch[(dh * 128 + row) * 2] = s1[r]; exch[(dh * 128 + row) * 2 + 1] = s2[r]; }
    }
    __syncthreads();
    constexpr int TP = DV * 2;
    static_assert(128 * TP <= 2 * NPK * 32768, "output tile fits the Q + K regions");
#pragma unroll
    for (int r = 0; r < 16; ++r) {
        const int row = 32 * rb + crow(r, hi);
        const float t1 = s1[r] + exch[((1 - dh) * 128 + row) * 2], t2 = s2[r] + exch[((1 - dh) * 128 + row) * 2 + 1];
        float mean, inv;
        if (MLSTM) { mean = 0.f; inv = rsqrtf(t2 * (1.f / DV) + EPS); }
        else { mean = t1 * (1.f / DV); inv = rsqrtf(fmaxf(t2 * (1.f / DV) - mean * mean, 0.f) + EPS); }
#pragma unroll
        for (int nb = 0; nb < NB; ++nb) { const int col = dh * (DV / 2) + 32 * nb + r32;
            *(LAS bf16_t*)(lds + row * TP + col * 2) = f2bf((o[nb][r] - mean) * inv); }
    }
    __syncthreads();
    constexpr int CPR = DV / 8;
#pragma unroll 1
    for (int id = tid; id < 128 * CPR; id += 512) { const int row = id / CPR, ch = id % CPR;
        const u32x4 y = *(const LAS u32x4*)(lds + row * TP + ch * 16); const u32x4 g = *(const u32x4*)(a.G + (size_t)row * a.ldg + 8 * ch);
        const f32x4 g0 = *(const f32x4*)(a.gain + 8 * ch), g1 = *(const f32x4*)(a.gain + 8 * ch + 4);
        float yv[8] = {bf_lo(y.x), bf_hi(y.x), bf_lo(y.y), bf_hi(y.y), bf_lo(y.z), bf_hi(y.z), bf_lo(y.w), bf_hi(y.w)};
        float gv[8] = {bf_lo(g.x), bf_hi(g.x), bf_lo(g.y), bf_hi(g.y), bf_lo(g.z), bf_hi(g.z), bf_lo(g.w), bf_hi(g.w)};
        float gn[8] = {g0[0], g0[1], g0[2], g0[3], g1[0], g1[1], g1[2], g1[3]};
        float ov[8];
#pragma unroll
        for (int i = 0; i < 8; ++i) ov[i] = yv[i] * gn[i] * (MLSTM ? sigmoidf_(gv[i]) : siluf_(gv[i]));
        u32x4 w; w.x = cvt_pk_bf16(ov[0], ov[1]); w.y = cvt_pk_bf16(ov[2], ov[3]); w.z = cvt_pk_bf16(ov[4], ov[5]); w.w = cvt_pk_bf16(ov[6], ov[7]);
        *(u32x4*)(a.Out + (size_t)row * a.ldo + 8 * ch) = w; }
#undef rb1
#undef tb1
}

template <int DK, int DVB>
__device__ __forceinline__ void state_unit3(LAS unsigned char* lds, LAS unsigned char* ldstab, const StateArgs a, const int wv) {
    static_assert(DK == 256 && DVB == 128, "retention geometry");
    constexpr int NSTEP = 128, NBUF = 5, DEPTH = 4;
    constexpr unsigned BUFSZ = 24576u, VOFF = 16384u;
    int tid = TIDX(wv); asm volatile("" : "+v"(tid));
    const int wid = __builtin_amdgcn_readfirstlane(tid >> 6), lane = tid & 63, hi = lane >> 5;
    const int dkb = wid;
    const unsigned ldsb = (unsigned)(uintptr_t)lds;
    LAS float* wtab = (LAS float*)ldstab;
    LAS unsigned char* ts = (wid < 2) ? lds + NBUF * BUFSZ + wid * 4096 : ldstab + 1024 + (wid - 2) * 4096;
    const unsigned tbA0 = t_base(lane, 0) + (dkb >> 2) * 8192u + 512u * (dkb & 3), tbA1 = t_base(lane, 1) + (dkb >> 2) * 8192u + 512u * (dkb & 3);
    const unsigned tbB0 = t_base(lane, 0) + VOFF, tbB1 = t_base(lane, 1) + VOFF;
    f32x16 acc[4];
#pragma unroll
    for (int j = 0; j < 4; ++j) acc[j] = (f32x16){};
    __syncthreads();
    if (tid < 128) { const int sp = a.dir ? 127 - tid : tid; wtab[tid] = __expf((float)(127 - sp) * a.lgam); }
    const float eF = __expf(128.f * a.lgam);
#define ST3_DMA(s_) do { const int c_ = a.dir ? 31 - ((s_) >> 2) : ((s_) >> 2); const int t_ = c_ * 128 + 32 * ((s_) & 3); const unsigned bb_ = ldsb + ((s_) % NBUF) * BUFSZ; \
        dma_tile<32, 2>(wid, lane, bb_, a.K + (size_t)t_ * a.ldk, a.ldk); dma_tile<32, 1>(wid, lane, bb_ + VOFF, a.V + (size_t)t_ * a.ldv, a.ldv); } while (0)
    __syncthreads();
    ST3_DMA(0); ST3_DMA(1); ST3_DMA(2); ST3_DMA(3);
#pragma unroll 1
    for (int s = 0; s < NSTEP; ++s) {
        const int ci = s >> 2, qt = s & 3, c = a.dir ? 31 - ci : ci;
        if (qt == 0) {
            bf16_t* co = a.Cout + (size_t)c * a.cstride + (size_t)(32 * dkb) * a.ldc;
            store_blocks_t<2>(ts, lane, acc, co, a.ldc); store_blocks_t<2>(ts, lane, acc + 2, co + 64, a.ldc);
        }
        if (s < NSTEP - 3) asm volatile("s_waitcnt vmcnt(9)" ::: "memory"); else asm volatile("s_waitcnt vmcnt(0)" ::: "memory");
        asm volatile("s_waitcnt lgkmcnt(0)" ::: "memory");
        __builtin_amdgcn_s_barrier();
        asm volatile("" ::: "memory");
        if (s + DEPTH < NSTEP) ST3_DMA(s + DEPTH);
        if (qt == 0) {
#pragma unroll
            for (int j = 0; j < 4; ++j)
#pragma unroll
                for (int r = 0; r < 16; ++r) acc[j][r] *= eF;
        }
        const unsigned bb = ldsb + (s % NBUF) * BUFSZ;
        const unsigned a0 = bb + tbA0, a1 = bb + tbA1, b0 = bb + tbB0, b1 = bb + tbB1;
        const unsigned wka = (unsigned)(uintptr_t)wtab + (32 * qt + 8 * hi) * 4;
#define ST3_KS(KS) do { \
            const s16x4 al = tr_rd<4096 * (KS)>(a0), ah = tr_rd<4096 * (KS)>(a1); \
            const s16x4 l0 = tr_rd<4096 * (KS)>(b0), h0 = tr_rd<4096 * (KS)>(b1), l1 = tr_rd<4096 * (KS) + 512>(b0), h1 = tr_rd<4096 * (KS) + 512>(b1); \
            const s16x4 l2 = tr_rd<4096 * (KS) + 1024>(b0), h2 = tr_rd<4096 * (KS) + 1024>(b1), l3 = tr_rd<4096 * (KS) + 1536>(b0), h3 = tr_rd<4096 * (KS) + 1536>(b1); \
            f32x4 w0, w1; asm volatile("ds_read_b128 %0, %2 offset:%3\n\tds_read_b128 %1, %2 offset:%4" : "=&v"(w0), "=&v"(w1) : "v"(wka), "i"(64 * (KS)), "i"(64 * (KS) + 16) : "memory"); \
            LA_LGKM0(); \
            u32x4 af; af.x = cvt_pk_bf16(bf2f((bf16_t)al[0]) * w0[0], bf2f((bf16_t)al[1]) * w0[1]); af.y = cvt_pk_bf16(bf2f((bf16_t)al[2]) * w0[2], bf2f((bf16_t)al[3]) * w0[3]); \
            af.z = cvt_pk_bf16(bf2f((bf16_t)ah[0]) * w1[0], bf2f((bf16_t)ah[1]) * w1[1]); af.w = cvt_pk_bf16(bf2f((bf16_t)ah[2]) * w1[2], bf2f((bf16_t)ah[3]) * w1[3]); \
            const bf16x8 afr = __builtin_bit_cast(bf16x8, af); \
            acc[0] = __builtin_amdgcn_mfma_f32_32x32x16_bf16(afr, LA_FRAG(l0, h0), acc[0], 0, 0, 0); acc[1] = __builtin_amdgcn_mfma_f32_32x32x16_bf16(afr, LA_FRAG(l1, h1), acc[1], 0, 0, 0); \
            acc[2] = __builtin_amdgcn_mfma_f32_32x32x16_bf16(afr, LA_FRAG(l2, h2), acc[2], 0, 0, 0); acc[3] = __builtin_amdgcn_mfma_f32_32x32x16_bf16(afr, LA_FRAG(l3, h3), acc[3], 0, 0, 0); \
        } while (0)
        ST3_KS(0); ST3_KS(1);
#undef ST3_KS
    }
#undef ST3_DMA
    __syncthreads();
}
}
namespace att {
constexpr int DQK = 96, DVV = 64, NW = 8, QBLK = 32, KVBLK = 64, KROW = 128;
constexpr float SCALE = 0.10206207261596575f;
constexpr size_t SHM_V = KVBLK * DVV * 2, SHM_K = KVBLK * KROW * 2, SHM_ATTN = 3 * SHM_V + 3 * SHM_K + NW * 64 * 4;
#define KSWZ(row, colB) ((row) * 256 + ((colB) ^ (((row) & 7) << 4)))
__device__ __forceinline__ int crow(int r, int hi) { return (r & 3) + 8 * (r >> 2) + 4 * hi; }

__device__ __forceinline__ void partialSM(f32x16& p0, f32x16& p1) {
  for (int r = 0; r < 16; ++r) p0[r] = __builtin_amdgcn_exp2f(p0[r]);
}
__device__ __forceinline__ void finishSM(f32x16& p0, f32x16& p1, float& l_reg, bf16x8& pa0, bf16x8& pa1, bf16x8& pa2, bf16x8& pa3) {
  for (int r = 0; r < 16; ++r) p1[r] = __builtin_amdgcn_exp2f(p1[r]);
  float ps = 0; for (int r = 0; r < 16; ++r) ps += p0[r]; for (int r = 0; r < 16; ++r) ps += p1[r];
  { auto rr = __builtin_amdgcn_permlane32_swap(__float_as_uint(ps), __float_as_uint(ps), false, false);
    ps = __uint_as_float(rr[0]) + __uint_as_float(rr[1]); }
  l_reg += ps;
#define PK4(P, BASE, OUT) do { unsigned a0 = cvt_pk_bf16(P[BASE + 0], P[BASE + 1]), a1 = cvt_pk_bf16(P[BASE + 2], P[BASE + 3]);   \
    unsigned b0 = cvt_pk_bf16(P[BASE + 4], P[BASE + 5]), b1 = cvt_pk_bf16(P[BASE + 6], P[BASE + 7]);                              \
    auto r0 = __builtin_amdgcn_permlane32_swap(a0, b0, false, false); auto r1 = __builtin_amdgcn_permlane32_swap(a1, b1, false, false); \
    u32x4 w = {r0[0], r1[0], r0[1], r1[1]}; OUT = __builtin_bit_cast(bf16x8, w); } while (0)
  PK4(p0, 0, pa0); PK4(p0, 8, pa1); PK4(p1, 0, pa2); PK4(p1, 8, pa3);
#undef PK4
}
__device__ __forceinline__ void qkt(f32x16& p0, f32x16& p1, const LAS char* Ks, const bf16x8* qr, int r32, int hi, float nm) {
#pragma unroll
  for (int r = 0; r < 16; ++r) { p0[r] = nm; p1[r] = nm; }
#pragma unroll
  for (int d0 = 0; d0 < DQK / 16; ++d0) { int cb = (d0 * 16 + hi * 8) * 2;
    bf16x8 b0 = *reinterpret_cast<const LAS bf16x8*>(Ks + KSWZ(r32, cb));
    bf16x8 b1 = *reinterpret_cast<const LAS bf16x8*>(Ks + KSWZ(32 + r32, cb));
    p0 = __builtin_amdgcn_mfma_f32_32x32x16_bf16(b0, qr[d0], p0, 0, 0, 0);
    p1 = __builtin_amdgcn_mfma_f32_32x32x16_bf16(b1, qr[d0], p1, 0, 0, 0); }
}
__device__ __forceinline__ int v_st(int k, int c) { const int kk = (k & ~0xC) | ((k & 4) << 1) | ((k & 8) >> 1); return ((kk >> 3) * 2 + (c >> 5)) * 512 + ((kk & 7) * 32 + (c & 31)) * 2; }
__device__ __forceinline__ int v_rd_base(int lane) { return ((lane & 3) << 3) | (((lane >> 2) & 3) << 6) | (((lane >> 4) & 1) << 5) | (((lane >> 5) & 1) << 8); }
constexpr int v_rd_off(int d0, int ks, int half) { return d0 * 512 + ks * 2048 + half * 1024; }
template <int OFF> __device__ __forceinline__ s16x4 tr_read(int vb) {
  s16x4 r; asm volatile("ds_read_b64_tr_b16 %0, %1 offset:%2" : "=&v"(r) : "v"(vb), "i"(OFF) : "memory"); return r;
}
template <int D0> __device__ __forceinline__ void pv_one(f32x16& od, int vb, bf16x8 pa0, bf16x8 pa1, bf16x8 pa2, bf16x8 pa3) {
  const s16x4 l0 = tr_read<v_rd_off(D0, 0, 0)>(vb), h0 = tr_read<v_rd_off(D0, 0, 1)>(vb), l1 = tr_read<v_rd_off(D0, 1, 0)>(vb), h1 = tr_read<v_rd_off(D0, 1, 1)>(vb);
  const s16x4 l2 = tr_read<v_rd_off(D0, 2, 0)>(vb), h2 = tr_read<v_rd_off(D0, 2, 1)>(vb), l3 = tr_read<v_rd_off(D0, 3, 0)>(vb), h3 = tr_read<v_rd_off(D0, 3, 1)>(vb);
  asm volatile("s_waitcnt lgkmcnt(0)" ::: "memory"); SBAR();
#define PK(L, H) (bf16x8){L[0], L[1], L[2], L[3], H[0], H[1], H[2], H[3]}
  od = __builtin_amdgcn_mfma_f32_32x32x16_bf16(pa0, PK(l0, h0), od, 0, 0, 0);
  od = __builtin_amdgcn_mfma_f32_32x32x16_bf16(pa1, PK(l1, h1), od, 0, 0, 0);
  od = __builtin_amdgcn_mfma_f32_32x32x16_bf16(pa2, PK(l2, h2), od, 0, 0, 0);
  od = __builtin_amdgcn_mfma_f32_32x32x16_bf16(pa3, PK(l3, h3), od, 0, 0, 0);
#undef PK
}
__device__ __forceinline__ void pv_d0(f32x16* o, int vb, bf16x8 pa0, bf16x8 pa1, bf16x8 pa2, bf16x8 pa3) {
  pv_one<0>(o[0], vb, pa0, pa1, pa2, pa3); pv_one<1>(o[1], vb, pa0, pa1, pa2, pa3);
}
__device__ __forceinline__ void attn_body(const bf16_t* __restrict__ Qb, const bf16_t* __restrict__ Kh, const bf16_t* __restrict__ Vh, bf16_t* __restrict__ Ob, int ldo, int seq, LAS char* lds, const int wv, const float kbound) {
  int tid = TIDX(wv); asm volatile("" : "+v"(tid));
  const int wid = tid >> 6, lane = tid & 63, r32 = lane & 31, hi = lane >> 5;
  LAS char* V_lds = lds; LAS char* K_lds = lds + 3 * SHM_V;
  LAS float* ws = (LAS float*)(lds + 3 * SHM_V + 3 * SHM_K) + wid * 64; LAS float* li_l = ws; LAS float* al_l = ws + 32;
  float l_reg = 0; f32x16 o[2] = {}; bf16x8 qr[DQK / 16];
  const bf16_t* Qw = Qb + (long)(wid * QBLK + r32) * DQK + hi * 8;
#pragma unroll
  for (int d0 = 0; d0 < DQK / 16; ++d0) qr[d0] = *reinterpret_cast<const bf16x8*>(Qw + d0 * 16);
  float nm;
  { float qq = 0.f;
#pragma unroll
    for (int d0 = 0; d0 < DQK / 16; ++d0) { const u32x4 w = __builtin_bit_cast(u32x4, qr[d0]);
      const float a0 = bf_lo(w.x), a1 = bf_hi(w.x), a2 = bf_lo(w.y), a3 = bf_hi(w.y), a4 = bf_lo(w.z), a5 = bf_hi(w.z), a6 = bf_lo(w.w), a7 = bf_hi(w.w);
      qq += a0 * a0 + a1 * a1 + a2 * a2 + a3 * a3 + a4 * a4 + a5 * a5 + a6 * a6 + a7 * a7; }
    { auto rr = __builtin_amdgcn_permlane32_swap(__float_as_uint(qq), __float_as_uint(qq), false, false); qq = __uint_as_float(rr[0]) + __uint_as_float(rr[1]); }
    nm = -sqrtf(qq) * kbound * 1.01f; }
  const int sr = tid >> 4, sc = (tid & 15) * 8;
  const int vr = tid >> 3, vc = (tid & 7) * 8, vst0 = v_st(vr, vc);
  const int vb0 = (int)(uintptr_t)V_lds + v_rd_base(lane);
  struct { bf16x8 vs0, ks0, ks1; } sr_;
#define SLOAD(k0) do { sr_.vs0 = *reinterpret_cast<const bf16x8*>(&Vh[(long)((k0) + vr) * DVV + vc]); \
    sr_.ks0 = *reinterpret_cast<const bf16x8*>(&Kh[(long)((k0) + sr) * KROW + sc]); sr_.ks1 = *reinterpret_cast<const bf16x8*>(&Kh[(long)((k0) + 32 + sr) * KROW + sc]); } while (0)
#define SWRITE(b) do { *(LAS bf16x8*)(V_lds + (b) * SHM_V + vst0) = sr_.vs0; int kc = sc * 2;               \
    *(LAS bf16x8*)(K_lds + (b) * SHM_K + KSWZ(sr, kc)) = sr_.ks0;                       \
    *(LAS bf16x8*)(K_lds + (b) * SHM_K + KSWZ(32 + sr, kc)) = sr_.ks1; } while (0)
  f32x16 pA0, pA1, pB0, pB1; bf16x8 pa0, pa1, pa2, pa3; const int NT = seq / KVBLK;
  SLOAD(0); SWRITE(0); SLOAD(KVBLK); SWRITE(1); SLOAD(2 * KVBLK); SWRITE(2); __syncthreads();
  qkt(pA0, pA1, K_lds, qr, r32, hi, nm); partialSM(pA0, pA1);
  int b0 = 0, b1 = 1, b2 = 2;
#pragma unroll 1
  for (int j = 0; j < NT; j += 2) {
    SBAR(); qkt(pB0, pB1, K_lds + b1 * SHM_K, qr, r32, hi, nm);
    finishSM(pA0, pA1, l_reg, pa0, pa1, pa2, pa3); SBAR();
    if (j + 3 < NT) SLOAD((j + 3) * KVBLK); SBAR();
    pv_d0(o, vb0 + b0 * (int)SHM_V, pa0, pa1, pa2, pa3); partialSM(pB0, pB1);
    __syncthreads();
    if (j + 3 < NT) SWRITE(b0);
    SBAR(); if (j + 2 < NT) qkt(pA0, pA1, K_lds + b2 * SHM_K, qr, r32, hi, nm);
    finishSM(pB0, pB1, l_reg, pa0, pa1, pa2, pa3); SBAR();
    if (j + 4 < NT) SLOAD((j + 4) * KVBLK); SBAR();
    pv_d0(o, vb0 + b1 * (int)SHM_V, pa0, pa1, pa2, pa3); if (j + 2 < NT) partialSM(pA0, pA1);
    __syncthreads();
    if (j + 4 < NT) SWRITE(b1);
    { const int t0 = b0, t1 = b1; b0 = b2; b1 = t0; b2 = t1; }
  }
  if (hi == 0) li_l[r32] = l_reg; asm volatile("s_waitcnt lgkmcnt(0)" ::: "memory");
  float rli[16];
#pragma unroll
  for (int r = 0; r < 16; ++r) rli[r] = __builtin_amdgcn_rcpf(li_l[crow(r, hi)]);
  bf16_t* Ow = Ob + (long)(wid * QBLK) * ldo;
#pragma unroll
  for (int r = 0; r < 16; ++r) { int orow = crow(r, hi);
#pragma unroll
    for (int d0 = 0; d0 < 2; ++d0) Ow[(long)orow * ldo + d0 * 32 + r32] = f2bf(o[d0][r] * rli[r]); }
  __syncthreads();
#undef SLOAD
#undef SWRITE
}
#undef KSWZ
}
constexpr size_t MiB = 1ull << 20;
constexpr size_t WS_CTL = 0, CTL_ZERO_BYTES = 1 * MiB;
constexpr size_t WS_MOD = 1 * MiB;
constexpr size_t WS_MISC = 2 * MiB;
constexpr size_t WS_ROPEO = 8 * MiB;
constexpr size_t WS_ROPEE = 40 * MiB;
constexpr size_t WS_WINE = 48 * MiB;
constexpr size_t WS_WQB = 58 * MiB;
constexpr size_t WS_WKVB = 59 * MiB;
constexpr size_t WS_WOUTE = 60 * MiB;
constexpr size_t WS_WINO = 64 * MiB;
constexpr size_t WS_WOUTO = 88 * MiB;
constexpr size_t WS_WGU = 96 * MiB;
constexpr size_t WS_WDN = 608 * MiB;
constexpr size_t WS_HM = 864 * MiB;
constexpr size_t WS_P = 928 * MiB;
constexpr size_t WS_X1 = 1312 * MiB;
constexpr size_t X1_QC = WS_X1, X1_KC = X1_QC + 32 * MiB, X1_QA = X1_KC + 32 * MiB, X1_KVA = X1_QA + 16 * MiB, X1_QRAW = X1_KVA + 16 * MiB, X1_KVRAW = X1_QRAW + 48 * MiB,
                 X1_QH = X1_KVRAW + 64 * MiB, X1_KH = X1_QH + 48 * MiB, X1_VH = X1_KH + 64 * MiB, X1_CM = X1_VH + 32 * MiB, X1_NM = X1_CM + 64 * MiB;
constexpr size_t WS_MIX = WS_X1 + 512 * MiB;
constexpr size_t WS_LIST = WS_MIX + 128 * MiB;
constexpr size_t WS_WLIST = WS_LIST + 16 * MiB;
constexpr size_t WS_TOKE = WS_WLIST + 16 * MiB;
constexpr size_t WS_WSORT = WS_TOKE + 1 * MiB;
constexpr size_t WS_ASORT = WS_WSORT + 1 * MiB;
constexpr size_t WS_ACT = WS_ASORT + 272 * MiB;
constexpr size_t WS_Y = WS_ACT + 272 * MiB;
constexpr size_t WS_XB = WS_Y + 272 * MiB;
constexpr size_t WS_END = WS_XB + 64 * MiB;
static_assert(X1_NM + 1 * MiB <= WS_MIX, "even-layer scratch fits");
constexpr int CW_BAR = 4096;
constexpr int CW_CNT = 8192;
constexpr int CW_QUEUE = 8192 + 1024;

constexpr int LDS_RING = 0;
constexpr int LDS_TAB = 131072;
constexpr int LT_MISC = LDS_TAB;
constexpr int LT_PSTART = LDS_TAB + 256;
constexpr int LT_CNT = LDS_TAB + 512;
constexpr int LT_BLK = LDS_TAB + 1024;
constexpr int LT_X = LDS_TAB + 1024 + 4352;
constexpr int LT_N2TILE = 144640;
constexpr int LDS_BYTES = 163840;

#if defined(__HIP_DEVICE_COMPILE__) && __HIP_DEVICE_COMPILE__
#define ARGAS GAS
#else
#define ARGAS
#endif
typedef const ARGAS float* gcf_t; typedef const ARGAS int* gci_t;
struct Args {
    gcf_t x; gcf_t c; gci_t pos; gcf_t ada_w; gcf_t ada_b; gcf_t norm_mix_g; gcf_t norm_ffn_g;
    gcf_t hy_w_in; gcf_t ml_conv_w; gcf_t ml_conv_b; gcf_t ml_gate_b; gcf_t ml_norm_g; gcf_t mla_q_norm_g; gcf_t mla_kv_norm_g;
    gcf_t mla_w_qb; gcf_t mla_w_kvb; gcf_t mla_qk_q_g; gcf_t mla_qk_k_g; gcf_t hy_w_out;
    gcf_t ret_w_in; gcf_t ret_decay_f; gcf_t ret_decay_b; gcf_t ret_gn_g; gcf_t ret_w_out;
    gcf_t moe_router_w; gcf_t moe_router_b; gcf_t moe_w_gu; gcf_t moe_b_gu; gcf_t moe_w_down; gcf_t moe_b_down;
    ARGAS float* out; ARGAS unsigned char* ws; int ph_lo, ph_hi;
};

constexpr float FP8_WSC = 128.f, FP8_HSC = 16.f, FP8_ASC = 4.f;
template <class RowMap>
__device__ __forceinline__ void transpose_item(const float* W, int N, bf16_t* WT, int ldk, LAS float* scr, int kb, int nb, int lane, const RowMap& rm) {
    const int k0 = 64 * kb, n0 = 32 * nb;
#pragma unroll 16
    for (int i = 0; i < 32; ++i) { const int kk = 2 * i + (lane >> 5); scr[kk * 33 + (lane & 31)] = W[(size_t)(k0 + kk) * N + n0 + (lane & 31)]; }
    LDS_WAIT(); asm volatile("" ::: "memory");
    const int c = lane & 7;
#pragma unroll
    for (int j = 0; j < 4; ++j) { const int n = (lane >> 3) + 8 * j; const LAS float* s = scr + (8 * c) * 33 + n;
        u32x4 o; o.x = cvt_pk_bf16(s[0 * 33], s[1 * 33]); o.y = cvt_pk_bf16(s[2 * 33], s[3 * 33]); o.z = cvt_pk_bf16(s[4 * 33], s[5 * 33]); o.w = cvt_pk_bf16(s[6 * 33], s[7 * 33]);
        *(u32x4*)(WT + (size_t)rm(n0 + n) * ldk + k0 + 8 * c) = o; }
    LDS_WAIT(); asm volatile("" ::: "memory");
}
template <class RowMap>
__device__ __forceinline__ void transpose_item8(const float* W, int N, unsigned char* WT, int ldk, LAS float* scr, int kb, int nb, int lane, const RowMap& rm, float scale) {
    const int k0 = 64 * kb, n0 = 32 * nb;
#pragma unroll 16
    for (int i = 0; i < 32; ++i) { const int kk = 2 * i + (lane >> 5); scr[kk * 33 + (lane & 31)] = W[(size_t)(k0 + kk) * N + n0 + (lane & 31)] * scale; }
    LDS_WAIT(); asm volatile("" ::: "memory");
    const int c = lane & 7;
#pragma unroll
    for (int j = 0; j < 4; ++j) { const int n = (lane >> 3) + 8 * j; const LAS float* s = scr + (8 * c) * 33 + n;
        u32x2 o; o.x = pg8::pk4_fp8(s[0 * 33], s[1 * 33], s[2 * 33], s[3 * 33]); o.y = pg8::pk4_fp8(s[4 * 33], s[5 * 33], s[6 * 33], s[7 * 33]);
        *(u32x2*)(WT + (size_t)rm(n0 + n) * ldk + k0 + 8 * c) = o; }
    LDS_WAIT(); asm volatile("" ::: "memory");
}
struct RmId { __device__ __forceinline__ int operator()(int n) const { return n; } };
struct RmWinE { __device__ __forceinline__ int operator()(int n) const {
    if (n < 2048) return n; if (n < 2064) return PC_GT + (n - 2048); if (n < 2320) return PC_QA + (n - 2064); if (n < 2448) return PC_KVA + (n - 2320); return PC_KR + (n - 2448); } };
struct RmGu { __device__ __forceinline__ int operator()(int n) const { const int u = n & 1023; return 256 * (u >> 7) + (n >> 10) * 128 + (u & 127); } };

__device__ __forceinline__ void ld_row16(const float* p, int lane, f32x4 (&v)[4]) {
#pragma unroll
    for (int j = 0; j < 4; ++j) v[j] = *(const f32x4*)(p + 4 * lane + 256 * j);
}
struct Frame { LAS unsigned char* lds; int tid, lane, wave, G, bid; };
extern __shared__ __attribute__((aligned(16))) unsigned char lds_raw[];
#define MK_FRAME(F) Frame F; { int tz_ = TIDX(wv); asm volatile("" : "+v"(tz_)); \
    int g_ = gridDim.x, b_ = blockIdx.x; asm volatile("" : "+s"(g_), "+s"(b_)); \
    F.lds = (LAS unsigned char*)lds_raw; F.tid = tz_; F.lane = tz_ & 63; F.wave = __builtin_amdgcn_readfirstlane(tz_ >> 6); F.G = g_; F.bid = b_; }
typedef const __attribute__((address_space(4))) Args* CArgsP;
__device__ __forceinline__ const Args& fresh_args() { unsigned long long p = (unsigned long long)__builtin_amdgcn_kernarg_segment_ptr(); asm volatile("" : "+s"(p)); return *(const Args*)(CArgsP)p; }
__device__ __forceinline__ ARGAS unsigned char* opaque_ws(const ARGAS unsigned char* p) { unsigned long long v = (unsigned long long)p; asm volatile("" : "+s"(v)); return (ARGAS unsigned char*)v; }

__device__ __forceinline__ void p0_prologue(const Args& a, const int wv) {
    MK_FRAME(F); ARGAS unsigned char* ws = opaque_ws(a.ws);
    {
        LAS float* cs = (LAS float*)(F.lds); LAS float* red = (LAS float*)(F.lds + 32768);
        for (int i = F.tid; i < NBATCH * DM; i += 512) cs[i] = siluf_(a.c[i]);
        __syncthreads();
        float* mod = (float*)(ws + WS_MOD);
        for (int it = F.bid; it < DEPTH * 48; it += F.G) {
            const int l = it / 48, n = (it % 48) * 128 + (F.tid & 127), ksl = F.tid >> 7;
            const float* w = a.ada_w + ((size_t)l * DM + ksl * 256) * 6144 + n;
            float acc[NBATCH];
#pragma unroll
            for (int b = 0; b < NBATCH; ++b) acc[b] = 0.f;
#pragma unroll 4
            for (int k = 0; k < 256; ++k) { const float wv = w[(size_t)k * 6144];
#pragma unroll
                for (int b = 0; b < NBATCH; ++b) acc[b] += cs[b * DM + ksl * 256 + k] * wv; }
#pragma unroll
            for (int b = 0; b < NBATCH; ++b) red[(ksl * NBATCH + b) * 128 + (F.tid & 127)] = acc[b];
            __syncthreads();
            for (int o = F.tid; o < NBATCH * 128; o += 512) { const int b = o >> 7, nn = o & 127;
                const float s = red[(0 * NBATCH + b) * 128 + nn] + red[(1 * NBATCH + b) * 128 + nn] + red[(2 * NBATCH + b) * 128 + nn] + red[(3 * NBATCH + b) * 128 + nn];
                const int col = (it % 48) * 128 + nn;
                mod[((size_t)l * NBATCH + b) * 6144 + col] = s + a.ada_b[(size_t)l * 6144 + col]; }
            __syncthreads();
        }
        __syncthreads();
    }
    {
        f32x2* ro = (f32x2*)(ws + WS_ROPEO); f32x2* re = (f32x2*)(ws + WS_ROPEE);
        const size_t gt = (size_t)F.bid * 512 + F.tid, GT = (size_t)F.G * 512;
        for (size_t i = gt; i < (size_t)NTOK * 128; i += GT) { const int tok = (int)(i >> 7), f = (int)(i & 127);
            const float inv = powf(10000.f, -(float)(2 * f) / 256.f); const float ang = (float)a.pos[tok] * inv; float s, c; sincosf(ang, &s, &c); ro[i] = (f32x2){c, s}; }
        for (size_t i = gt; i < (size_t)NTOK * 16; i += GT) { const int tok = (int)(i >> 4), f = (int)(i & 15);
            const float inv = powf(10000.f, -(float)(2 * f) / 32.f); const float ang = (float)a.pos[tok] * inv; float s, c; sincosf(ang, &s, &c); re[i] = (f32x2){c, s}; }
        bf16_t* wkv = (bf16_t*)(ws + WS_WKVB);
        for (size_t i = gt; i < (size_t)2 * 1024 * 16; i += GT) { const size_t row = i >> 4, ch = i & 15; *(u32x4*)(wkv + row * 256 + 128 + ch * 8) = (u32x4){0u, 0u, 0u, 0u}; }
    }
    {
        LAS float* scr = (LAS float*)(F.lds + F.wave * 16384);
        const int gw = F.bid * 8 + F.wave, NGW = F.G * 8;
        constexpr int I_WINE = 16 * 78, I_WQB = 4 * 24, I_WKVB = 2 * 32, I_WOUTE = 16 * 32, I_WINO = 16 * 192, I_WOUTO = 32 * 32, I_WGU = 16 * 64, I_WDN = 16 * 32;
        constexpr int T0 = 2 * I_WINE, T1 = T0 + 2 * I_WQB, T2 = T1 + 2 * I_WKVB, T3 = T2 + 2 * I_WOUTE, T4 = T3 + 2 * I_WINO, T5 = T4 + 2 * I_WOUTO, T6 = T5 + 128 * I_WGU, T7 = T6 + 128 * I_WDN;
        for (int it = gw; it < T7; it += NGW) {
            if (it < T0) { const int m = it / I_WINE, r = it % I_WINE, kb = r / 78, nb = r % 78;
                const float* W = a.hy_w_in + (size_t)m * DM * EVEN_IN; bf16_t* WT = (bf16_t*)(ws + WS_WINE) + (size_t)m * EVEN_INP * DM;
                const int k0 = 64 * kb, n0 = 32 * nb; const RmWinE rm;
#pragma unroll 8
                for (int i = 0; i < 32; ++i) { const int kk = 2 * i + (F.lane >> 5), n = n0 + (F.lane & 31); scr[kk * 33 + (F.lane & 31)] = (n < EVEN_IN) ? W[(size_t)(k0 + kk) * EVEN_IN + n] : 0.f; }
                LDS_WAIT(); asm volatile("" ::: "memory");
                const int c = F.lane & 7;
#pragma unroll
                for (int j = 0; j < 4; ++j) { const int n = (F.lane >> 3) + 8 * j; const LAS float* s = scr + (8 * c) * 33 + n;
                    u32x4 o; o.x = cvt_pk_bf16(s[0 * 33], s[1 * 33]); o.y = cvt_pk_bf16(s[2 * 33], s[3 * 33]); o.z = cvt_pk_bf16(s[4 * 33], s[5 * 33]); o.w = cvt_pk_bf16(s[6 * 33], s[7 * 33]);
                    if (n0 + n < EVEN_IN) *(u32x4*)(WT + (size_t)rm(n0 + n) * DM + k0 + 8 * c) = o; }
                LDS_WAIT(); asm volatile("" ::: "memory");
                continue; }
            if (it < T1) { const int q = it - T0, m = q / I_WQB, r = q % I_WQB; transpose_item(a.mla_w_qb + (size_t)m * 256 * 768, 768, (bf16_t*)(ws + WS_WQB) + (size_t)m * 768 * 256, 256, scr, r / 24, r % 24, F.lane, RmId()); continue; }
            if (it < T2) { const int q = it - T1, m = q / I_WKVB, r = q % I_WKVB; transpose_item(a.mla_w_kvb + (size_t)m * 128 * 1024, 1024, (bf16_t*)(ws + WS_WKVB) + (size_t)m * 1024 * 256, 256, scr, r / 32, r % 32, F.lane, RmId()); continue; }
            if (it < T3) { const int q = it - T2, m = q / I_WOUTE, r = q % I_WOUTE; transpose_item(a.hy_w_out + (size_t)m * DM * DM, DM, (bf16_t*)(ws + WS_WOUTE) + (size_t)m * DM * DM, DM, scr, r / 32, r % 32, F.lane, RmId()); continue; }
            if (it < T4) { const int q = it - T3, m = q / I_WINO, r = q % I_WINO; transpose_item(a.ret_w_in + (size_t)m * DM * RET_IN, RET_IN, (bf16_t*)(ws + WS_WINO) + (size_t)m * RET_IN * DM, DM, scr, r / 192, r % 192, F.lane, RmId()); continue; }
            if (it < T5) { const int q = it - T4, m = q / I_WOUTO, r = q % I_WOUTO; transpose_item(a.ret_w_out + (size_t)m * 2048 * DM, DM, (bf16_t*)(ws + WS_WOUTO) + (size_t)m * DM * 2048, 2048, scr, r / 32, r % 32, F.lane, RmId()); continue; }
            if (it < T6) { const int q = it - T5, m = q / I_WGU, r = q % I_WGU; transpose_item8(a.moe_w_gu + (size_t)m * DM * 2048, 2048, (unsigned char*)(ws + WS_WGU) + (size_t)m * 2048 * DM, DM, scr, r / 64, r % 64, F.lane, RmGu(), FP8_WSC); continue; }
            { const int q = it - T6, m = q / I_WDN, r = q % I_WDN; transpose_item8(a.moe_w_down + (size_t)m * EFF * DM, DM, (unsigned char*)(ws + WS_WDN) + (size_t)m * DM * EFF, EFF, scr, r / 32, r % 32, F.lane, RmId(), FP8_WSC); }
        }
    }
}

__device__ __forceinline__ void build_pstart(const Frame& F, const unsigned* cnt) {
    LAS int* ps = (LAS int*)(F.lds + LT_PSTART); LAS int* lc = (LAS int*)(F.lds + LT_CNT); LAS int* blk = (LAS int*)(F.lds + LT_BLK);
    __syncthreads();
    if (F.tid < 64) {
        const int e = F.tid & 31; const int c = (int)xb_ld((gbar_t)cnt + e); const int pad = (c + 255) & ~255;
        int incl = pad;
#pragma unroll
        for (int o = 1; o < 32; o <<= 1) { const int t = sh_fromi(incl, (e >= o) ? F.tid - o : F.tid); if (e >= o) incl += t; }
        if (F.tid < 32) { ps[e] = incl - pad; lc[e] = c; if (e == 31) ps[32] = incl; }
    }
    __syncthreads();
    const int nblk = ps[32] >> 8;
    for (int g = F.tid; g < nblk; g += 512) { int e = 0;
#pragma unroll
        for (int s = 16; s >= 1; s >>= 1) if (e + s < 32 && (ps[e + s] >> 8) <= g) e += s;
        blk[2 * g] = e; blk[2 * g + 1] = g - (ps[e] >> 8); }
    __syncthreads();
}

__device__ __forceinline__ void n1_phase(const Args& a, int layer, bool final_only, const int wv, const bool dry = false) {
    MK_FRAME(F); ARGAS unsigned char* ws = opaque_ws(a.ws);
    const float* mod = (const float*)(ws + WS_MOD);
    const bool combine = layer > 0;
    bf16_t* XB = (bf16_t*)(ws + WS_XB);
    const int* toke = (const int*)(ws + WS_TOKE); const int* tokr = toke + NTOK * 4;
    const bf16_t* Y = (const bf16_t*)(ws + WS_Y);
    bf16_t* HM = (bf16_t*)(ws + WS_HM);
    LAS int* ps = (LAS int*)(F.lds + LT_PSTART);
    if (combine) build_pstart(F, (const unsigned*)(ws + WS_CTL) + CW_CNT + 64 * (layer - 1));
    const float* gmix = a.norm_mix_g + (size_t)(final_only ? 0 : layer) * DM;
    for (int tok = F.bid * 8 + F.wave; tok < NTOK; tok += F.G * 8) {
        const int b = tok >> 12;
        f32x4 v[4];
        if (layer == 0) ld_row16(a.x + (size_t)tok * DM, F.lane, v);
        else {
#pragma unroll
            for (int j = 0; j < 4; ++j) { const u32x2 w = *(const u32x2*)(XB + (size_t)tok * DM + 4 * F.lane + 256 * j); v[j] = (f32x4){bf_lo(w.x), bf_hi(w.x), bf_lo(w.y), bf_hi(w.y)}; } }
        if (combine) {
            const float* g2 = mod + ((size_t)(layer - 1) * NBATCH + b) * 6144 + 5 * DM;
            f32x4 ysum[4];
#pragma unroll
            for (int j = 0; j < 4; ++j) ysum[j] = (f32x4){0.f, 0.f, 0.f, 0.f};
#pragma unroll
            for (int k = 0; k < 4; ++k) { const int e = toke[tok * 4 + k], r = tokr[tok * 4 + k]; const size_t slot = (size_t)ps[e] + r;
                const bf16_t* yr = Y + slot * DM + 4 * F.lane;
#pragma unroll
                for (int j = 0; j < 4; ++j) { const u32x2 w = *(const u32x2*)(yr + 256 * j); ysum[j][0] += bf_lo(w.x); ysum[j][1] += bf_hi(w.x); ysum[j][2] += bf_lo(w.y); ysum[j][3] += bf_hi(w.y); } }
#pragma unroll
            for (int j = 0; j < 4; ++j) { const f32x4 g = *(const f32x4*)(g2 + 4 * F.lane + 256 * j); v[j] = v[j] + g * ysum[j];
                if (final_only) *(f32x4*)(a.out + (size_t)tok * DM + 4 * F.lane + 256 * j) = v[j];
                else { u32x2 o; o.x = cvt_pk_bf16(v[j][0], v[j][1]); o.y = cvt_pk_bf16(v[j][2], v[j][3]); *(u32x2*)((dry ? (bf16_t*)(ws + WS_ACT) : XB) + (size_t)tok * DM + 4 * F.lane + 256 * j) = o; } }
        }
        if (final_only) continue;
        float ss = 0.f;
#pragma unroll
        for (int j = 0; j < 4; ++j) ss += v[j][0] * v[j][0] + v[j][1] * v[j][1] + v[j][2] * v[j][2] + v[j][3] * v[j][3];
        const float inv = rsqrtf(wave_sum(ss, F.lane) * (1.f / DM) + EPS);
        const float* sh = mod + ((size_t)layer * NBATCH + b) * 6144; const float* sc = sh + DM;
#pragma unroll
        for (int j = 0; j < 4; ++j) { const int c0 = 4 * F.lane + 256 * j; const f32x4 g = *(const f32x4*)(gmix + c0), s1 = *(const f32x4*)(sc + c0), s0 = *(const f32x4*)(sh + c0);
            const f32x4 h = v[j] * inv * g * (s1 + 1.f) + s0;
            u32x2 o; o.x = cvt_pk_bf16(h[0], h[1]); o.y = cvt_pk_bf16(h[2], h[3]); *(u32x2*)(HM + (size_t)tok * DM + c0) = o; }
    }
}

__device__ __forceinline__ void e2_phase(const Args& a, int j, const int wv) {
    MK_FRAME(F); ARGAS unsigned char* ws = opaque_ws(a.ws);
    const bf16_t* P = (const bf16_t*)(ws + WS_P);
    bf16_t* QC = (bf16_t*)(ws + X1_QC); bf16_t* KC = (bf16_t*)(ws + X1_KC); bf16_t* QA = (bf16_t*)(ws + X1_QA); bf16_t* KVA = (bf16_t*)(ws + X1_KVA);
    const float* cw = a.ml_conv_w + (size_t)j * 5 * 1024; const float* cb = a.ml_conv_b + (size_t)j * 1024;
    const float* qg = a.mla_q_norm_g + (size_t)j * 256; const float* kvg = a.mla_kv_norm_g + (size_t)j * 128;
    {
        float* ALPHA = (float*)(ws + WS_MISC); float* BETA = ALPHA + 2 * 32 * SEQ; float* MG = BETA + 2 * 32 * SEQ;
        LAS float* redm = (LAS float*)(F.lds);
        for (int u = F.bid; u < 64; u += F.G) {
            const int dir = u >> 5, bh = u & 31, b = bh >> 2, h = bh & 3;
            const float bi = a.ml_gate_b[j * 16 + (2 * dir) * 4 + h], bfg = a.ml_gate_b[j * 16 + (2 * dir + 1) * 4 + h];
            float li[8], lf[8];
#pragma unroll
            for (int i = 0; i < 8; ++i) { const size_t row = (size_t)b * SEQ + 8 * F.tid + i;
                li[i] = bf2f(P[row * EVEN_INP + PC_GT + (2 * dir) * 4 + h]) + bi;
                const float xf = bf2f(P[row * EVEN_INP + PC_GT + (2 * dir + 1) * 4 + h]) + bfg;
                lf[i] = fminf(xf, 0.f) - log1pf(__expf(-fabsf(xf))); }
            float mx = li[0];
#pragma unroll
            for (int i = 1; i < 8; ++i) mx = fmaxf(mx, li[i]);
            mx = wave_max(mx, F.lane); if (F.lane == 0) redm[F.wave] = mx;
            __syncthreads();
            float M = redm[0];
#pragma unroll
            for (int w = 1; w < 8; ++w) M = fmaxf(M, redm[w]);
            float al[8];
            if (dir == 0) { float s = 0.f;
#pragma unroll
                for (int i = 0; i < 8; ++i) { s += lf[i]; al[i] = s; }
                float tot = s, ex = 0.f;
#pragma unroll
                for (int o = 1; o < 16; o <<= 1) { const float t = sh_from(tot, ((F.lane & 15) >= o) ? F.lane - o : F.lane, F.lane); if ((F.lane & 15) >= o) tot += t; }
                ex = tot - s;
#pragma unroll
                for (int i = 0; i < 8; ++i) al[i] += ex;
            } else { float s = 0.f;
#pragma unroll
                for (int i = 7; i >= 0; --i) { s += lf[i]; al[i] = s; }
                float tot = s, ex = 0.f;
#pragma unroll
                for (int o = 1; o < 16; o <<= 1) { const float t = sh_from(tot, ((F.lane & 15) + o < 16) ? F.lane + o : F.lane, F.lane); if ((F.lane & 15) + o < 16) tot += t; }
                ex = tot - s;
#pragma unroll
                for (int i = 0; i < 8; ++i) al[i] += ex;
            }
            float* ao = ALPHA + ((size_t)dir * 32 + bh) * SEQ + 8 * F.tid; float* bo = BETA + ((size_t)dir * 32 + bh) * SEQ + 8 * F.tid;
            *(f32x4*)(ao) = (f32x4){al[0], al[1], al[2], al[3]}; *(f32x4*)(ao + 4) = (f32x4){al[4], al[5], al[6], al[7]};
            *(f32x4*)(bo) = (f32x4){li[0] - M, li[1] - M, li[2] - M, li[3] - M}; *(f32x4*)(bo + 4) = (f32x4){li[4] - M, li[5] - M, li[6] - M, li[7] - M};
            if (F.tid == 0) MG[dir * 32 + bh] = M;
            __syncthreads();
        }
    }
    for (int tok = F.bid * 8 + F.wave; tok < NTOK; tok += F.G * 8) {
        const int s = tok & (SEQ - 1);
        float aq[8], ak[8];
        { const f32x4 b0 = *(const f32x4*)(cb + 8 * F.lane), b1 = *(const f32x4*)(cb + 8 * F.lane + 4), b2 = *(const f32x4*)(cb + 512 + 8 * F.lane), b3 = *(const f32x4*)(cb + 512 + 8 * F.lane + 4);
#pragma unroll
          for (int i = 0; i < 4; ++i) { aq[i] = b0[i]; aq[4 + i] = b1[i]; ak[i] = b2[i]; ak[4 + i] = b3[i]; } }
#pragma unroll
        for (int t = 0; t < 5; ++t) { const int s2 = s + t - 2;
            if (s2 >= 0 && s2 < SEQ) { const bf16_t* pr = P + (size_t)(tok + t - 2) * EVEN_INP;
                const u32x4 q = *(const u32x4*)(pr + PC_QM + 8 * F.lane), k = *(const u32x4*)(pr + PC_KM + 8 * F.lane);
                const float* wq = cw + t * 1024 + 8 * F.lane; const float* wk = wq + 512;
                const f32x4 wq0 = *(const f32x4*)wq, wq1 = *(const f32x4*)(wq + 4), wk0 = *(const f32x4*)wk, wk1 = *(const f32x4*)(wk + 4);
                aq[0] += bf_lo(q.x) * wq0[0]; aq[1] += bf_hi(q.x) * wq0[1]; aq[2] += bf_lo(q.y) * wq0[2]; aq[3] += bf_hi(q.y) * wq0[3];
                aq[4] += bf_lo(q.z) * wq1[0]; aq[5] += bf_hi(q.z) * wq1[1]; aq[6] += bf_lo(q.w) * wq1[2]; aq[7] += bf_hi(q.w) * wq1[3];
                ak[0] += bf_lo(k.x) * wk0[0]; ak[1] += bf_hi(k.x) * wk0[1]; ak[2] += bf_lo(k.y) * wk0[2]; ak[3] += bf_hi(k.y) * wk0[3];
                ak[4] += bf_lo(k.z) * wk1[0]; ak[5] += bf_hi(k.z) * wk1[1]; ak[6] += bf_lo(k.w) * wk1[2]; ak[7] += bf_hi(k.w) * wk1[3]; } }
        constexpr float KS = 0.08838834764831845f;
#pragma unroll
        for (int i = 0; i < 8; ++i) { aq[i] = siluf_(aq[i]); ak[i] = siluf_(ak[i]) * KS; }
        u32x4 oq, ok; oq.x = cvt_pk_bf16(aq[0], aq[1]); oq.y = cvt_pk_bf16(aq[2], aq[3]); oq.z = cvt_pk_bf16(aq[4], aq[5]); oq.w = cvt_pk_bf16(aq[6], aq[7]);
        ok.x = cvt_pk_bf16(ak[0], ak[1]); ok.y = cvt_pk_bf16(ak[2], ak[3]); ok.z = cvt_pk_bf16(ak[4], ak[5]); ok.w = cvt_pk_bf16(ak[6], ak[7]);
        *(u32x4*)(QC + (size_t)tok * 512 + 8 * F.lane) = oq; *(u32x4*)(KC + (size_t)tok * 512 + 8 * F.lane) = ok;
        const bf16_t* pr = P + (size_t)tok * EVEN_INP;
        { const u32x2 w = *(const u32x2*)(pr + PC_QA + 4 * F.lane); const float x0 = bf_lo(w.x), x1 = bf_hi(w.x), x2 = bf_lo(w.y), x3 = bf_hi(w.y);
          const float inv = rsqrtf(wave_sum(x0 * x0 + x1 * x1 + x2 * x2 + x3 * x3, F.lane) * (1.f / 256.f) + EPS); const f32x4 g = *(const f32x4*)(qg + 4 * F.lane);
          u32x2 o; o.x = cvt_pk_bf16(x0 * inv * g[0], x1 * inv * g[1]); o.y = cvt_pk_bf16(x2 * inv * g[2], x3 * inv * g[3]); *(u32x2*)(QA + (size_t)tok * 256 + 4 * F.lane) = o; }
        { const unsigned w = *(const unsigned*)(pr + PC_KVA + 2 * F.lane); const float x0 = bf_lo(w), x1 = bf_hi(w);
          const float inv = rsqrtf(wave_sum(x0 * x0 + x1 * x1, F.lane) * (1.f / 128.f) + EPS); const f32x2 g = *(const f32x2*)(kvg + 2 * F.lane);
          *(unsigned*)(KVA + (size_t)tok * 256 + 2 * F.lane) = cvt_pk_bf16(x0 * inv * g[0], x1 * inv * g[1]); *(unsigned*)(KVA + (size_t)tok * 256 + 128 + 2 * F.lane) = 0u; }
    }
}

__device__ __forceinline__ void e4_phase(const Args& a, int j, const int wv) {
    MK_FRAME(F); ARGAS unsigned char* ws = opaque_ws(a.ws);
    const bf16_t* P = (const bf16_t*)(ws + WS_P); const bf16_t* QRAW = (const bf16_t*)(ws + X1_QRAW); const bf16_t* KVRAW = (const bf16_t*)(ws + X1_KVRAW);
    bf16_t* QH = (bf16_t*)(ws + X1_QH); bf16_t* KH = (bf16_t*)(ws + X1_KH); bf16_t* VH = (bf16_t*)(ws + X1_VH);
    const f32x2* re = (const f32x2*)(ws + WS_ROPEE);
    const float* gq = a.mla_qk_q_g + (size_t)j * 96; const float* gk = a.mla_qk_k_g + (size_t)j * 96;
    const int h = F.lane >> 3, part = F.lane & 7;
    for (int tok = F.bid * 8 + F.wave; tok < NTOK; tok += F.G * 8) {
        const int b = tok >> 12, s = tok & (SEQ - 1);
        const f32x4 cs = *(const f32x4*)(re + (size_t)tok * 16 + 2 * part);
        const size_t hrow = ((size_t)(b * 8 + h)) * SEQ + s;
#pragma unroll
        for (int qk = 0; qk < 2; ++qk) {
            float v[12]; u32x4 w; unsigned w1, w2;
            if (qk == 0) { const bf16_t* src = QRAW + (size_t)tok * 768 + h * 96; w = *(const u32x4*)(src + 8 * part); w1 = *(const unsigned*)(src + 64 + 2 * part); w2 = *(const unsigned*)(src + 80 + 2 * part); }
            else { w = *(const u32x4*)(KVRAW + (size_t)tok * 1024 + h * 128 + 8 * part); const bf16_t* kr = P + (size_t)tok * EVEN_INP + PC_KR; w1 = *(const unsigned*)(kr + 2 * part); w2 = *(const unsigned*)(kr + 16 + 2 * part); }
            v[0] = bf_lo(w.x); v[1] = bf_hi(w.x); v[2] = bf_lo(w.y); v[3] = bf_hi(w.y); v[4] = bf_lo(w.z); v[5] = bf_hi(w.z); v[6] = bf_lo(w.w); v[7] = bf_hi(w.w);
            v[8] = bf_lo(w1); v[9] = bf_hi(w1); v[10] = bf_lo(w2); v[11] = bf_hi(w2);
            float ss = 0.f;
#pragma unroll
            for (int i = 0; i < 12; ++i) ss += v[i] * v[i];
            ss += shx(ss, 1, F.lane); ss += shx(ss, 2, F.lane); ss += shx(ss, 4, F.lane);
            const float inv = rsqrtf(ss * (1.f / 96.f) + EPS) * (qk == 0 ? att::SCALE * 1.4426950408889634f : 1.f);
            const float* g = qk == 0 ? gq : gk;
            const f32x4 g0 = *(const f32x4*)(g + 8 * part), g1 = *(const f32x4*)(g + 8 * part + 4); const f32x2 ga = *(const f32x2*)(g + 64 + 2 * part), gb = *(const f32x2*)(g + 80 + 2 * part);
            v[0] *= inv * g0[0]; v[1] *= inv * g0[1]; v[2] *= inv * g0[2]; v[3] *= inv * g0[3]; v[4] *= inv * g1[0]; v[5] *= inv * g1[1]; v[6] *= inv * g1[2]; v[7] *= inv * g1[3];
            const float x10 = v[8] * inv * ga[0], x11 = v[9] * inv * ga[1], x20 = v[10] * inv * gb[0], x21 = v[11] * inv * gb[1];
            const float o10 = x10 * cs[0] - x20 * cs[1], o20 = x20 * cs[0] + x10 * cs[1], o11 = x11 * cs[2] - x21 * cs[3], o21 = x21 * cs[2] + x11 * cs[3];
            u32x4 o; o.x = cvt_pk_bf16(v[0], v[1]); o.y = cvt_pk_bf16(v[2], v[3]); o.z = cvt_pk_bf16(v[4], v[5]); o.w = cvt_pk_bf16(v[6], v[7]);
            bf16_t* dst = qk == 0 ? QH + hrow * 96 : KH + hrow * 128;
            *(u32x4*)(dst + 8 * part) = o; *(unsigned*)(dst + 64 + 2 * part) = cvt_pk_bf16(o10, o11); *(unsigned*)(dst + 80 + 2 * part) = cvt_pk_bf16(o20, o21);
            if (qk == 1) { *(u32x2*)(dst + 96 + 4 * part) = (u32x2){0u, 0u}; }
        }
        *(u32x4*)(VH + hrow * 64 + 8 * part) = *(const u32x4*)(KVRAW + (size_t)tok * 1024 + h * 128 + 64 + 8 * part);
    }
}
__device__ __forceinline__ void n2_phase(const Args& a, int layer, const int wv, const bool dry = false) {
    MK_FRAME(F); ARGAS unsigned char* ws = opaque_ws(a.ws);
    const float* mod = (const float*)(ws + WS_MOD);
    unsigned char* HF8 = (unsigned char*)(ws + WS_HM);
    int* LIST = (int*)(ws + WS_LIST); float* WLIST = (float*)(ws + WS_WLIST); int* toke = (int*)(ws + WS_TOKE); int* tokr = toke + NTOK * 4;
    unsigned* gcnt = (unsigned*)(ws + WS_CTL) + CW_CNT + 64 * layer;
    LAS float* rwl = (LAS float*)(F.lds);
    LAS int* te = (LAS int*)(F.lds + LT_X); LAS int* tlr = te + 512; LAS float* tw = (LAS float*)(tlr + 512); LAS int* hist = (LAS int*)(tw + 512); LAS int* base = hist + 32;
    const float* rw = a.moe_router_w + (size_t)layer * DM * NEXP; const float* rbias = a.moe_router_b + (size_t)layer * NEXP;
    const float* gffn = a.norm_ffn_g + (size_t)layer * DM;
    __syncthreads();
    for (int i4 = F.tid; i4 < DM * NEXP / 4; i4 += 512) *(LAS f32x4*)(rwl + 4 * i4) = *(const f32x4*)(rw + 4 * i4);
    if (F.tid < 32) hist[F.tid] = 0;
    __syncthreads();
    const int tk = F.lane & 15, kg = F.lane >> 4;
    const int lt = F.lane >> 2, lj = F.lane & 3;
    const float bias0 = rbias[tk], bias1 = rbias[tk + 16];
    LAS float* tile = (LAS float*)(F.lds + LT_N2TILE) + F.wave * (16 * 33);
#pragma unroll 1
    for (int grp = F.bid; grp < NTOK / 128; grp += F.G) {
        const int tok0 = grp * 128 + F.wave * 16, b = tok0 >> 12;
        const float* sh = mod + ((size_t)layer * NBATCH + b) * 6144 + 3 * DM + 8 * lj; const float* sc = sh + DM; const float* gg = gffn + 8 * lj;
        const bf16_t* xrow = (const bf16_t*)(ws + WS_XB) + (size_t)(tok0 + lt) * DM + 8 * lj;
        float ss = 0.f;
#pragma unroll 8
        for (int c = 0; c < 32; ++c) { const u32x4 xw = *(const u32x4*)(xrow + 32 * c); const f32x4 v0 = {bf_lo(xw.x), bf_hi(xw.x), bf_lo(xw.y), bf_hi(xw.y)}, v1 = {bf_lo(xw.z), bf_hi(xw.z), bf_lo(xw.w), bf_hi(xw.w)};
            ss += v0[0] * v0[0] + v0[1] * v0[1] + v0[2] * v0[2] + v0[3] * v0[3] + v1[0] * v1[0] + v1[1] * v1[1] + v1[2] * v1[2] + v1[3] * v1[3]; }
        ss += shx(ss, 1, F.lane); ss += shx(ss, 2, F.lane);
        const float inv = rsqrtf(ss * (1.f / DM) + EPS);
        f32x4 acc0 = {0.f, 0.f, 0.f, 0.f}, acc1 = {0.f, 0.f, 0.f, 0.f};
        unsigned char* hrow = HF8 + (size_t)(tok0 + lt) * DM + 8 * lj;
#pragma unroll 1
        for (int c = 0; c < 32; ++c) {
            const u32x4 xw = *(const u32x4*)(xrow + 32 * c); const f32x4 v0 = {bf_lo(xw.x), bf_hi(xw.x), bf_lo(xw.y), bf_hi(xw.y)}, v1 = {bf_lo(xw.z), bf_hi(xw.z), bf_lo(xw.w), bf_hi(xw.w)};
            const f32x4 g0 = *(const f32x4*)(gg + 32 * c), g1 = *(const f32x4*)(gg + 32 * c + 4), p0 = *(const f32x4*)(sc + 32 * c), p1 = *(const f32x4*)(sc + 32 * c + 4), q0 = *(const f32x4*)(sh + 32 * c), q1 = *(const f32x4*)(sh + 32 * c + 4);
            const f32x4 h0 = v0 * inv * g0 * (p0 + 1.f) + q0, h1 = v1 * inv * g1 * (p1 + 1.f) + q1;
            u32x2 o8; o8.x = pg8::pk4_fp8(h0[0] * FP8_HSC, h0[1] * FP8_HSC, h0[2] * FP8_HSC, h0[3] * FP8_HSC); o8.y = pg8::pk4_fp8(h1[0] * FP8_HSC, h1[1] * FP8_HSC, h1[2] * FP8_HSC, h1[3] * FP8_HSC);
            *(u32x2*)(hrow + 32 * c) = o8;
            LAS float* tw_ = tile + lt * 33 + 8 * lj;
            tw_[0] = h0[0]; tw_[1] = h0[1]; tw_[2] = h0[2]; tw_[3] = h0[3]; tw_[4] = h1[0]; tw_[5] = h1[1]; tw_[6] = h1[2]; tw_[7] = h1[3];
            LDS_WAIT();
            const LAS float* wl = rwl + (32 * c + kg) * 32 + tk;
#pragma unroll
            for (int s = 0; s < 8; ++s) { const float av = tile[tk * 33 + 4 * s + kg], w0 = wl[(4 * s) * 32], w1 = wl[(4 * s) * 32 + 16];
                acc0 = __builtin_amdgcn_mfma_f32_16x16x4f32(av, w0, acc0, 0, 0, 0); acc1 = __builtin_amdgcn_mfma_f32_16x16x4f32(av, w1, acc1, 0, 0, 0); }
            LDS_WAIT();
        }
#pragma unroll
        for (int r = 0; r < 4; ++r) {
            float c0 = acc0[r] + bias0, c1 = acc1[r] + bias1;
            float tv[4]; int tix[4];
#pragma unroll
            for (int k = 0; k < 4; ++k) {
                float v = (c1 > c0) ? c1 : c0; int ix = (c1 > c0) ? tk + 16 : tk;
#pragma unroll
                for (int m = 1; m < 16; m <<= 1) { const float ov = shx(v, m, F.lane); const int oi = shxi(ix, m, F.lane); if (ov > v || (ov == v && oi < ix)) { v = ov; ix = oi; } }
                tv[k] = v; tix[k] = ix; if (ix == tk) c0 = -3.0e38f; if (ix == tk + 16) c1 = -3.0e38f; }
            const float e1 = __expf(tv[1] - tv[0]), e2 = __expf(tv[2] - tv[0]), e3 = __expf(tv[3] - tv[0]); const float rs = 1.f / (1.f + e1 + e2 + e3);
            if (tk < 4) { const int ex = tk == 0 ? tix[0] : tk == 1 ? tix[1] : tk == 2 ? tix[2] : tix[3];
                const float wk = (tk == 0 ? 1.f : tk == 1 ? e1 : tk == 2 ? e2 : e3) * rs;
                const int lr = __hip_atomic_fetch_add(hist + ex, 1, __ATOMIC_RELAXED, __HIP_MEMORY_SCOPE_WORKGROUP);
                const int pidx = (F.wave * 16 + 4 * kg + r) * 4 + tk; te[pidx] = ex; tlr[pidx] = lr; tw[pidx] = wk; }
        }
        __syncthreads();
        if (F.tid < 32) { const int h = hist[F.tid]; base[F.tid] = (h > 0 && !dry) ? (int)xb_add((gbar_t)gcnt + F.tid, (unsigned)h) : 0; }
        __syncthreads();
        if (!dry) { const int p = F.tid; const int e = te[p], rank = base[e] + tlr[p]; const int tok = grp * 128 + (p >> 2);
          LIST[(size_t)e * NSLOT + rank] = tok; WLIST[(size_t)e * NSLOT + rank] = tw[p]; toke[tok * 4 + (p & 3)] = e; tokr[tok * 4 + (p & 3)] = rank; }
        __syncthreads();
        if (F.tid < 32) hist[F.tid] = 0;
        __syncthreads();
    }
}

__device__ __forceinline__ void m1_phase(const Args& a, int layer, const int wv) {
    MK_FRAME(F); ARGAS unsigned char* ws = opaque_ws(a.ws);
    build_pstart(F, (const unsigned*)(ws + WS_CTL) + CW_CNT + 64 * layer);
    LAS int* ps = (LAS int*)(F.lds + LT_PSTART); LAS int* lc = (LAS int*)(F.lds + LT_CNT); LAS int* blk = (LAS int*)(F.lds + LT_BLK);
    const unsigned char* HF8 = (const unsigned char*)(ws + WS_HM); unsigned char* AS = (unsigned char*)(ws + WS_ASORT); float* WS_ = (float*)(ws + WS_WSORT);
    const int* LIST = (const int*)(ws + WS_LIST); const float* WLIST = (const float*)(ws + WS_WLIST);
    const int total = ps[32];
    for (int r = F.bid * 8 + F.wave; r < total; r += F.G * 8) {
        const int g = r >> 8, e = blk[2 * g], rank = blk[2 * g + 1] * 256 + (r & 255); const bool valid = rank < lc[e];
        u32x4 v0 = (u32x4){0u, 0u, 0u, 0u}; float w = 0.f;
        if (valid) { const int tok = LIST[(size_t)e * NSLOT + rank]; w = WLIST[(size_t)e * NSLOT + rank];
            v0 = *(const u32x4*)(HF8 + (size_t)tok * DM + 16 * F.lane); }
        *(u32x4*)(AS + (size_t)r * DM + 16 * F.lane) = v0;
        if (F.lane == 0) WS_[r] = w;
    }
}

struct MoeSched {
    const LAS int* blk; const char* A; const char* W; size_t wstride, tile_bytes; int ntile, nunits, G, c;
    __device__ __forceinline__ bool next(int i, pg8::Unit& u) const {
        int g, pn;
        if (G == 256) {
            const int x = c & 7, slot = c >> 3, rpr = 256 / ntile;
            g = i * rpr + 8 * (ntile == 8 ? (x >> 1) : x) + (slot & 7); pn = (ntile == 8 ? 4 * (x & 1) : 0) + (slot >> 3);
            if (g * ntile >= nunits) return false;
        } else { const long L = (long)i * G + c; if (L >= nunits) return false; g = (int)L / ntile; pn = (int)L % ntile; }
        const int e = __builtin_amdgcn_readfirstlane(blk[2 * g]);
        u.pm = g; u.pn = pn; u.aux = e; u.A = A + (size_t)g * tile_bytes; u.B = W + (size_t)e * wstride + (size_t)pn * tile_bytes; return true;
    }
};
struct MlaSched {
    const char* QA; const char* KVA; const char* Wq; const char* Wkv; int G, c;
    __device__ __forceinline__ bool next(int i, pg8::Unit& u) const {
        const long L = (long)i * G + c; if (L >= 128 * 7) return false;
        const int pm = (int)L / 7, t = (int)L % 7;
        u.pm = pm; if (t < 3) { u.pn = t; u.aux = 0; u.A = QA + (size_t)pm * 256 * 256 * 2; u.B = Wq + (size_t)t * 256 * 256 * 2; }
        else { u.pn = t - 3; u.aux = 1; u.A = KVA + (size_t)pm * 256 * 256 * 2; u.B = Wkv + (size_t)(t - 3) * 256 * 256 * 2; }
        return true;
    }
};

constexpr int NPHASE = 50;
#define IN(k) (lo <= (k) && (k) < hi)
#ifndef PROBE_MASK
#define PROBE_MASK 0
#endif
#define REP(k) for (int rep_ = 0; rep_ < ((PROBE_MASK >> (k)) & 1) + 1; ++rep_)
#define GRID_BAR() do { if (fused) { for (int br_ = 0; br_ < (((PROBE_MASK >> 13) & 1) + 1); ++br_) xcd_barrier((gbar_t)(fresh_args().ws + WS_CTL) + CW_BAR, (volatile LAS unsigned*)((LAS unsigned char*)lds_raw + LT_MISC) + 8, wv); } } while (0)
template <int LAYER>
__device__ __forceinline__ void layer_body(const int lo, const int hi, const bool fused, const int wv) {
    constexpr int layer = LAYER;
        constexpr int pb = 1 + 12 * layer; constexpr bool odd = (layer & 1) != 0; constexpr int j = layer >> 1;
        REP(0) if (IN(pb + 0)) { n1_phase(fresh_args(), layer, false, wv, ((PROBE_MASK >> 0) & 1) && rep_ == 0); GRID_BAR(); }
        REP(1) if (IN(pb + 1)) {
            const Args& a = fresh_args(); MK_FRAME(F); ARGAS unsigned char* ws = opaque_ws(a.ws);
            pg8::StaticSched S; S.A = (const char*)(ws + WS_HM); S.lda = DM; S.ldb = DM; S.nM = NTOK / 256; S.G = F.G; S.c = F.bid;
            pg8::EpiBf16 E; E.O0 = (bf16_t*)(ws + WS_P); E.O1 = E.O0; E.rope = (const GAS f32x2*)(ws + WS_ROPEO); E.qscale = 0.0625f;
            if (!odd) { S.Bt = (const char*)(ws + WS_WINE) + (size_t)j * EVEN_INP * DM * 2; S.nN = EVEN_INP / 256; E.ldc0 = E.ldc1 = EVEN_INP; E.rope_tiles = 0; E.qscale_tiles = 0; }
            else { S.Bt = (const char*)(ws + WS_WINO) + (size_t)j * RET_IN * DM * 2; S.nN = RET_IN / 256; E.ldc0 = E.ldc1 = RET_IN; E.rope_tiles = 8; E.qscale_tiles = 4; }
            pg8::gemm_phase<pg8::EpiBf16, pg8::StaticSched>(F.lds + LDS_RING, pg8::Dims{DM, DM, DM}, S, E, wv);
            GRID_BAR();
        }
        if constexpr (!odd) {
            REP(2) if (IN(pb + 2)) { e2_phase(fresh_args(), j, wv); GRID_BAR(); }
            REP(3) if (IN(pb + 3)) {
                const Args& a = fresh_args(); MK_FRAME(F); ARGAS unsigned char* ws = opaque_ws(a.ws);
                MlaSched S; S.QA = (const char*)(ws + X1_QA); S.KVA = (const char*)(ws + X1_KVA); S.Wq = (const char*)(ws + WS_WQB) + (size_t)j * 768 * 256 * 2; S.Wkv = (const char*)(ws + WS_WKVB) + (size_t)j * 1024 * 256 * 2; S.G = F.G; S.c = F.bid;
                pg8::EpiBf16 E; E.O0 = (bf16_t*)(ws + X1_QRAW); E.O1 = (bf16_t*)(ws + X1_KVRAW); E.ldc0 = 768; E.ldc1 = 1024; E.rope_tiles = 0; E.qscale_tiles = 0; E.qscale = 1.f; E.rope = nullptr;
                pg8::gemm_phase<pg8::EpiBf16, MlaSched>(F.lds + LDS_RING, pg8::Dims{256, 256, 256}, S, E, wv);
                GRID_BAR();
            }
            REP(4) if (IN(pb + 4)) { e4_phase(fresh_args(), j, wv); GRID_BAR(); }
            REP(5) if (IN(pb + 5)) {
                const Args& a = fresh_args(); MK_FRAME(F); ARGAS unsigned char* ws = opaque_ws(a.ws);
                const float* ALPHA = (const float*)(ws + WS_MISC); const float* BETA = ALPHA + 2 * 32 * SEQ;
                for (int u0 = F.bid; u0 < 128; u0 += F.G) {
                    const int u = (F.G == 256) ? ((u0 & 7) * 16 + (u0 >> 3)) : u0;
                    const int bh = u >> 2, dir = (u >> 1) & 1, dvb = u & 1, b = bh >> 2, h = bh & 3;
                    la::StateArgs sa; sa.K = (const bf16_t*)(ws + X1_KC) + (size_t)b * SEQ * 512 + h * 128; sa.ldk = 512;
                    sa.V = (const bf16_t*)(ws + WS_P) + (size_t)b * SEQ * EVEN_INP + PC_VM + h * 128 + dvb * 64; sa.ldv = EVEN_INP;
                    sa.Cout = (bf16_t*)(ws + X1_CM) + ((size_t)(bh * 2 + dir) * 32) * 128 * 128 + dvb * 64; sa.ldc = 128; sa.cstride = 128 * 128;
                    sa.Nout = dvb == 0 ? (float*)(ws + X1_NM) + ((size_t)(bh * 2 + dir) * 32) * 128 : nullptr;
                    sa.alpha = ALPHA + ((size_t)dir * 32 + bh) * SEQ; sa.beta = BETA + ((size_t)dir * 32 + bh) * SEQ; sa.lgam = 0.f; sa.dir = dir;
                    la::state_unit2<128, 64, true>(F.lds + LDS_RING, F.lds + LT_X, sa, wv);
                }
                __syncthreads();
                const int xq = F.bid & 7;
                unsigned* qh = (unsigned*)(ws + WS_CTL) + CW_QUEUE + 64 * (xq + 8 * j + 16 * rep_); LAS unsigned* qslot = (LAS unsigned*)(F.lds + LT_MISC) + 16;
                float kbound;
                { const float* gk = a.mla_qk_k_g + (size_t)j * 96; float gm = fabsf(gk[F.lane]); if (F.lane < 32) gm = fmaxf(gm, fabsf(gk[64 + F.lane])); kbound = wave_max(gm, F.lane) * 9.797958971132712f; }
                for (int qi = 0; qi < 8;) {
                    const int xc = (xq + qi) & 7;
                    if (F.tid == 0) *qslot = xb_add((gbar_t)(qh + 64 * (xc - xq)), 1u);
                    __syncthreads();
                    const unsigned u = *qslot;
                    __syncthreads();
                    if (u >= 128u) { ++qi; continue; }
                    const int bh = xc * 8 + (int)(u >> 4), qb = u & 15, b = bh >> 3, h = bh & 7;
                    att::attn_body((const bf16_t*)(ws + X1_QH) + ((size_t)bh * SEQ + qb * 256) * 96, (const bf16_t*)(ws + X1_KH) + (size_t)bh * SEQ * 128, (const bf16_t*)(ws + X1_VH) + (size_t)bh * SEQ * 64,
                                   (bf16_t*)(ws + WS_MIX) + ((size_t)b * SEQ + qb * 256) * DM + 512 + h * 64, DM, SEQ, (LAS char*)(F.lds + LDS_RING), wv, kbound);
                }
                GRID_BAR();
            }
            REP(6) if (IN(pb + 6)) {
                const Args& a = fresh_args(); MK_FRAME(F); ARGAS unsigned char* ws = opaque_ws(a.ws);
                const float* ALPHA = (const float*)(ws + WS_MISC); const float* BETA = ALPHA + 2 * 32 * SEQ; const float* MG = BETA + 2 * 32 * SEQ;
                for (int u = F.bid; u < 1024; u += F.G) {
                    const int bh = u >> 5, c = u & 31, b = bh >> 2, h = bh & 3; const size_t t0 = (size_t)b * SEQ + c * 128;
                    la::OutArgs oa; oa.Q = (const bf16_t*)(ws + X1_QC) + t0 * 512 + h * 128; oa.ldq = 512; oa.K = (const bf16_t*)(ws + X1_KC) + t0 * 512 + h * 128; oa.ldk = 512;
                    oa.V = (const bf16_t*)(ws + WS_P) + t0 * EVEN_INP + PC_VM + h * 128; oa.ldv = EVEN_INP;
                    oa.Cf = (const bf16_t*)(ws + X1_CM) + ((size_t)(bh * 2 + 0) * 32 + c) * 128 * 128; oa.Cb = (const bf16_t*)(ws + X1_CM) + ((size_t)(bh * 2 + 1) * 32 + c) * 128 * 128;
                    oa.Nf = (const float*)(ws + X1_NM) + ((size_t)(bh * 2 + 0) * 32 + c) * 128; oa.Nb = (const float*)(ws + X1_NM) + ((size_t)(bh * 2 + 1) * 32 + c) * 128;
                    oa.af = ALPHA + ((size_t)0 * 32 + bh) * SEQ + c * 128; oa.bfw = BETA + ((size_t)0 * 32 + bh) * SEQ + c * 128; oa.ab = ALPHA + ((size_t)1 * 32 + bh) * SEQ + c * 128; oa.bbw = BETA + ((size_t)1 * 32 + bh) * SEQ + c * 128;
                    oa.Mf = MG[bh]; oa.Mb = MG[32 + bh]; oa.lgf = 0.f; oa.lgb = 0.f;
                    oa.gain = a.ml_norm_g + (size_t)j * 512 + h * 128; oa.G = (const bf16_t*)(ws + WS_P) + t0 * EVEN_INP + PC_OM + h * 128; oa.ldg = EVEN_INP;
                    oa.Out = (bf16_t*)(ws + WS_MIX) + t0 * DM + h * 128; oa.ldo = DM;
                    la::out_unit2<128, 128, true>(F.lds + LDS_RING, F.lds + LT_X, oa, wv);
                }
                GRID_BAR();
            }
        } else {
            REP(2) if (IN(pb + 2)) {
                const Args& a = fresh_args(); MK_FRAME(F); ARGAS unsigned char* ws = opaque_ws(a.ws);
                for (int u0 = F.bid; u0 < 256; u0 += F.G) {
                    const int u = (F.G == 256) ? ((u0 & 7) * 32 + (u0 >> 3)) : u0;
                    const int bh = u >> 3, dir = (u >> 2) & 1, dvb = u & 3, b = bh >> 2, h = bh & 3;
                    const float dl = (dir ? a.ret_decay_b : a.ret_decay_f)[j * 4 + h];
                    la::StateArgs sa; sa.K = (const bf16_t*)(ws + WS_P) + (size_t)b * SEQ * RET_IN + 1024 + h * 256; sa.ldk = RET_IN;
                    sa.V = (const bf16_t*)(ws + WS_P) + (size_t)b * SEQ * RET_IN + 2048 + h * 512 + dvb * 128; sa.ldv = RET_IN;
                    sa.Cout = (bf16_t*)(ws + WS_X1) + ((size_t)(bh * 2 + dir) * 32) * 256 * 512 + dvb * 128; sa.ldc = 512; sa.cstride = 256 * 512; sa.Nout = nullptr;
                    sa.alpha = nullptr; sa.beta = nullptr; sa.lgam = fminf(dl, 0.f) - log1pf(__expf(-fabsf(dl))); sa.dir = dir;
                    la::state_unit3<256, 128>(F.lds + LDS_RING, F.lds + LT_X, sa, wv);
                }
                GRID_BAR();
            }
            REP(3) if (IN(pb + 3)) {
                const Args& a = fresh_args(); MK_FRAME(F); ARGAS unsigned char* ws = opaque_ws(a.ws);
                for (int u = F.bid; u < 1024; u += F.G) {
                    const int bh = u >> 5, c = u & 31, b = bh >> 2, h = bh & 3; const size_t t0 = (size_t)b * SEQ + c * 128;
                    const bf16_t* R = (const bf16_t*)(ws + WS_P) + t0 * RET_IN;
                    const float dlf = a.ret_decay_f[j * 4 + h], dlb = a.ret_decay_b[j * 4 + h];
                    la::OutArgs oa; oa.Q = R + h * 256; oa.ldq = RET_IN; oa.K = R + 1024 + h * 256; oa.ldk = RET_IN; oa.V = R + 2048 + h * 512; oa.ldv = RET_IN;
                    oa.Cf = (const bf16_t*)(ws + WS_X1) + ((size_t)(bh * 2 + 0) * 32 + c) * 256 * 512; oa.Cb = (const bf16_t*)(ws + WS_X1) + ((size_t)(bh * 2 + 1) * 32 + c) * 256 * 512;
                    oa.Nf = nullptr; oa.Nb = nullptr; oa.af = oa.bfw = oa.ab = oa.bbw = nullptr; oa.Mf = 0.f; oa.Mb = 0.f;
                    oa.lgf = fminf(dlf, 0.f) - log1pf(__expf(-fabsf(dlf))); oa.lgb = fminf(dlb, 0.f) - log1pf(__expf(-fabsf(dlb)));
                    oa.gain = a.ret_gn_g + (size_t)j * 2048 + h * 512; oa.G = R + 4096 + h * 512; oa.ldg = RET_IN;
                    oa.Out = (bf16_t*)(ws + WS_MIX) + t0 * 2048 + h * 512; oa.ldo = 2048;
                    la::out_unit2<256, 512, false>(F.lds + LDS_RING, F.lds + LT_X, oa, wv);
                }
                GRID_BAR();
            }
        }
        REP(7) if (IN(pb + 7)) {
            const Args& a = fresh_args(); MK_FRAME(F); ARGAS unsigned char* ws = opaque_ws(a.ws);
            pg8::StaticSched S; S.A = (const char*)(ws + WS_MIX); S.nM = NTOK / 256; S.nN = DM / 256; S.G = F.G; S.c = F.bid;
            int K;
            if (!odd) { S.Bt = (const char*)(ws + WS_WOUTE) + (size_t)j * DM * DM * 2; K = DM; } else { S.Bt = (const char*)(ws + WS_WOUTO) + (size_t)j * DM * 2048 * 2; K = 2048; }
            S.lda = K; S.ldb = K;
            pg8::EpiResid E; E.x0 = (layer == 0) ? (const float*)a.x : nullptr; E.xb = (const bf16_t*)(ws + WS_XB); E.xout = (((PROBE_MASK >> 7) & 1) && rep_ == 0) ? (bf16_t*)(ws + WS_ACT) : (bf16_t*)(ws + WS_XB); E.gate = (const float*)(ws + WS_MOD) + (size_t)layer * NBATCH * 6144 + 2 * DM; E.gstride = 6144;
            pg8::gemm_phase<pg8::EpiResid, pg8::StaticSched>(F.lds + LDS_RING, pg8::Dims{K, K, K}, S, E, wv);
            GRID_BAR();
        }
        REP(8) if (IN(pb + 8)) { n2_phase(fresh_args(), layer, wv, ((PROBE_MASK >> 8) & 1) && rep_ == 0); GRID_BAR(); }
        REP(9) if (IN(pb + 9)) { m1_phase(fresh_args(), layer, wv); GRID_BAR(); }
        REP(10) if (IN(pb + 10)) {
            const Args& a = fresh_args(); MK_FRAME(F); ARGAS unsigned char* ws = opaque_ws(a.ws);
            build_pstart(F, (const unsigned*)(ws + WS_CTL) + CW_CNT + 64 * layer);
            const int nblk = ((LAS int*)(F.lds + LT_PSTART))[32] >> 8;
            MoeSched S; S.blk = (const LAS int*)(F.lds + LT_BLK); S.A = (const char*)(ws + WS_ASORT); S.W = (const char*)(ws + WS_WGU) + (size_t)layer * NEXP * 2048 * DM; S.wstride = (size_t)2048 * DM; S.tile_bytes = (size_t)256 * DM;
            S.ntile = 8; S.nunits = nblk * 8; S.G = F.G; S.c = F.bid;
            pg8::EpiSwiglu E; E.act = (unsigned char*)(ws + WS_ACT); E.bgu = a.moe_b_gu + (size_t)layer * NEXP * 2048; E.ascale = 1.f / (FP8_HSC * FP8_WSC);
            pg8::gemm_phase<pg8::EpiSwiglu, MoeSched, true, true, true>(F.lds + LDS_RING, pg8::Dims{DM / 2, DM / 2, DM / 2}, S, E, wv);
            GRID_BAR();
        }
        REP(11) if (IN(pb + 11)) {
            const Args& a = fresh_args(); MK_FRAME(F); ARGAS unsigned char* ws = opaque_ws(a.ws);
            build_pstart(F, (const unsigned*)(ws + WS_CTL) + CW_CNT + 64 * layer);
            const int nblk = ((LAS int*)(F.lds + LT_PSTART))[32] >> 8;
            MoeSched S; S.blk = (const LAS int*)(F.lds + LT_BLK); S.A = (const char*)(ws + WS_ACT); S.W = (const char*)(ws + WS_WDN) + (size_t)layer * NEXP * DM * EFF; S.wstride = (size_t)DM * EFF; S.tile_bytes = (size_t)256 * EFF;
            S.ntile = 4; S.nunits = nblk * 4; S.G = F.G; S.c = F.bid;
            pg8::EpiDown E; E.y = (bf16_t*)(ws + WS_Y); E.bd = a.moe_b_down + (size_t)layer * NEXP * DM; E.wrow = (const float*)(ws + WS_WSORT); E.ascale = 1.f / (FP8_ASC * FP8_WSC);
            pg8::gemm_phase<pg8::EpiDown, MoeSched, true, true, true>(F.lds + LDS_RING, pg8::Dims{EFF / 2, EFF / 2, EFF / 2}, S, E, wv);
            GRID_BAR();
        }
    }
__global__ void __launch_bounds__(512, 2) fwd_kernel(Args a_kernarg) {
    const Args& a0 = fresh_args();
    LAS unsigned char* lds0 = (LAS unsigned char*)lds_raw;
    const int wv = __builtin_amdgcn_readfirstlane((int)threadIdx.x >> 6);
    for (int u = TIDX(wv); u < 64; u += 512) ((LAS unsigned*)(lds0 + LT_MISC))[u] = 0u;
    __syncthreads();
    const int lo = a0.ph_lo, hi = a0.ph_hi; const bool fused = (hi - lo) > 1;
    if (fused) xcd_barrier_post((gbar_t)(a0.ws + WS_CTL) + CW_BAR, wv);

    REP(12) if (IN(0)) { p0_prologue(fresh_args(), wv); GRID_BAR(); }

    layer_body<0>(lo, hi, fused, wv); layer_body<1>(lo, hi, fused, wv); layer_body<2>(lo, hi, fused, wv); layer_body<3>(lo, hi, fused, wv);
    if (IN(49)) n1_phase(fresh_args(), DEPTH, true, wv);
}

#undef IN
#undef GRID_BAR
#ifndef MK_ONE_LAUNCH
#define MK_ONE_LAUNCH 1
#endif
extern "C" void kernel_launch(void* const* d_in, const int* in_sizes, int n_in, void* d_out, int out_size, void* d_ws, size_t ws_size, hipStream_t stream) {
    static int grid = 0;
    if (grid == 0) {
        if (n_in != 30 || in_sizes[0] != NTOK * DM || out_size != NTOK * DM || ws_size < WS_END) {
            fprintf(stderr, "kernel_launch: shape mismatch: n_in %d in0 %d out %d ws %zu (need %zu)\n", n_in, n_in > 0 ? in_sizes[0] : -1, out_size, ws_size, (size_t)WS_END); grid = -1; return; }
        int dev = 0, cus = 0, per_cu = 0;
        if (hipGetDevice(&dev) != hipSuccess || hipDeviceGetAttribute(&cus, hipDeviceAttributeMultiprocessorCount, dev) != hipSuccess) { grid = -1; return; }
        if (hipFuncSetAttribute((const void*)fwd_kernel, hipFuncAttributeMaxDynamicSharedMemorySize, LDS_BYTES) != hipSuccess) { fprintf(stderr, "kernel_launch: hipFuncSetAttribute failed\n"); grid = -1; return; }
        if (hipOccupancyMaxActiveBlocksPerMultiprocessor(&per_cu, (const void*)fwd_kernel, 512, LDS_BYTES) != hipSuccess || per_cu < 1) fprintf(stderr, "kernel_launch: occupancy query says %d\n", per_cu);
        (void)hipGetLastError();
        grid = cus;
    }
    if (grid < 0) return;
    (void)hipMemsetAsync((char*)d_ws + WS_CTL, 0, CTL_ZERO_BYTES, stream);
    Args a{};
    a.x = (gcf_t)d_in[0]; a.c = (gcf_t)d_in[1]; a.pos = (gci_t)d_in[2];
    a.ada_w = (gcf_t)d_in[3]; a.ada_b = (gcf_t)d_in[4]; a.norm_mix_g = (gcf_t)d_in[5]; a.norm_ffn_g = (gcf_t)d_in[6];
    a.hy_w_in = (gcf_t)d_in[7]; a.ml_conv_w = (gcf_t)d_in[8]; a.ml_conv_b = (gcf_t)d_in[9]; a.ml_gate_b = (gcf_t)d_in[10]; a.ml_norm_g = (gcf_t)d_in[11];
    a.mla_q_norm_g = (gcf_t)d_in[12]; a.mla_kv_norm_g = (gcf_t)d_in[13]; a.mla_w_qb = (gcf_t)d_in[14]; a.mla_w_kvb = (gcf_t)d_in[15];
    a.mla_qk_q_g = (gcf_t)d_in[16]; a.mla_qk_k_g = (gcf_t)d_in[17]; a.hy_w_out = (gcf_t)d_in[18];
    a.ret_w_in = (gcf_t)d_in[19]; a.ret_decay_f = (gcf_t)d_in[20]; a.ret_decay_b = (gcf_t)d_in[21]; a.ret_gn_g = (gcf_t)d_in[22]; a.ret_w_out = (gcf_t)d_in[23];
    a.moe_router_w = (gcf_t)d_in[24]; a.moe_router_b = (gcf_t)d_in[25]; a.moe_w_gu = (gcf_t)d_in[26]; a.moe_b_gu = (gcf_t)d_in[27]; a.moe_w_down = (gcf_t)d_in[28]; a.moe_b_down = (gcf_t)d_in[29];
    a.out = (ARGAS float*)d_out; a.ws = (ARGAS unsigned char*)d_ws;
#if MK_ONE_LAUNCH
    a.ph_lo = 0; a.ph_hi = NPHASE;
    hipLaunchKernelGGL(fwd_kernel, dim3(grid), dim3(512), LDS_BYTES, stream, a);
#else
    for (int ph = 0; ph < NPHASE; ++ph) {
        if (ph >= 1 && ph < 49) { const int layer = (ph - 1) / 12, k = (ph - 1) % 12; if ((layer & 1) && (k >= 4 && k <= 6)) continue; }
        a.ph_lo = ph; a.ph_hi = ph + 1;
        hipLaunchKernelGGL(fwd_kernel, dim3(grid), dim3(512), LDS_BYTES, stream, a);
    }
#endif
    const hipError_t le = hipPeekAtLastError();
    if (le != hipSuccess) fprintf(stderr, "kernel_launch: launch failed: %s\n", hipGetErrorName(le));
}
```
